# Optimizing an MI355X kernel written in HIP

```python
import math
import jax, jax.numpy as jnp
from jax import lax
import numpy as np

D_MODEL = 2048
BATCH = 2
SEQ = 4096
DEPTH = 1

HYENA_WIDTH = D_MODEL // 2
HYENA_ORDER = 2
FILTER_BANDS = 16
FILTER_EMB_DIM = 1 + 2 * FILTER_BANDS
FILTER_HIDDEN = 64
DECAY_TARGET = 1e-2
FAST_DECAY_PCT = 0.3
SLOW_DECAY_PCT = 1.5

HEAD_DIM = 128
ATTN_GROUPS = ((128, 1), (512, 4), (2048, 16))
HEADS_PER_GROUP = 4
N_ATTN_HEADS = HEADS_PER_GROUP * len(ATTN_GROUPS)
ATTN_OUT_WIDTH = HEADS_PER_GROUP * HEAD_DIM
ROT_DIM = HEAD_DIM // 4
ROPE_THETA = 500000.0

IN_WIDTH = 3 * HYENA_WIDTH + 3 * N_ATTN_HEADS * HEAD_DIM

N_EXPERT_GROUPS = 8
EXPERTS_PER_GROUP = 8
N_EXPERTS = N_EXPERT_GROUPS * EXPERTS_PER_GROUP
TOP_K = 2
EXPERT_FF = D_MODEL // 4
EXPERT_ROW_BLOCK = 128

RMS_EPS = 1e-6
NEG_INF = -1e30

kernel_name = 'hybrid_hyena_dilated_attn_hmoe_block'


def rmsnorm(x, g):
    xf = x.astype(jnp.float32)
    y = xf * lax.rsqrt(jnp.mean(xf * xf, axis=-1, keepdims=True) + RMS_EPS)
    return (y * g.astype(jnp.float32)).astype(x.dtype)


def short_conv(u, w, b):
    up = jnp.pad(u, ((0, 0), (1, 1), (0, 0)))
    return up[:, :-2] * w[0] + up[:, 1:-1] * w[1] + up[:, 2:] * w[2] + b


def hyena_filters(L, w1, b1, w2, b2, w3, freq):
    f32 = jnp.float32
    t = jnp.linspace(0.0, 1.0, L, dtype=f32)[:, None]
    w = 2.0 * math.pi * jnp.arange(L, dtype=f32)[:, None] / L
    bands = jnp.linspace(1e-4, FILTER_BANDS - 1, FILTER_BANDS, dtype=f32)[None, :]
    feats = jnp.concatenate([t, jnp.cos(bands * w), -jnp.sin(bands * w)], axis=-1)
    hid = jnp.sin(freq * (feats @ w1 + b1))
    hid = jnp.sin(freq * (hid @ w2 + b2))
    h = (hid @ w3).astype(f32).reshape(L, HYENA_ORDER, 2, HYENA_WIDTH)
    max_decay = math.log(DECAY_TARGET) / FAST_DECAY_PCT
    min_decay = math.log(DECAY_TARGET) / SLOW_DECAY_PCT
    deltas = jnp.abs(jnp.linspace(min_decay, max_decay, HYENA_WIDTH, dtype=f32))
    decay = jnp.exp(-t * deltas[None, :])
    return h * decay[:, None, None, :]


def bidir_long_conv(z, hf, hb, skip):
    L = z.shape[1]
    k = jnp.concatenate([hf, jnp.zeros((1, hf.shape[1]), hf.dtype), jnp.flip(hb[1:], axis=0)], axis=0)
    kf = jnp.fft.rfft(k, n=2 * L, axis=0)
    zf32 = z.astype(jnp.float32)
    zf = jnp.fft.rfft(zf32, n=2 * L, axis=1)
    y = jnp.fft.irfft(zf * kf[None], n=2 * L, axis=1)[:, :L]
    return y + zf32 * skip.astype(jnp.float32)


def partial_rotary(t, positions):
    half = ROT_DIM // 2
    inv_freq = jnp.power(ROPE_THETA, -2.0 * jnp.arange(half, dtype=jnp.float32) / ROT_DIM)
    ang = positions.astype(jnp.float32)[:, :, None] * inv_freq
    cos = jnp.cos(ang)[:, :, None, :]
    sin = jnp.sin(ang)[:, :, None, :]
    t1 = t[..., :half].astype(jnp.float32)
    t2 = t[..., half:ROT_DIM].astype(jnp.float32)
    rot = jnp.concatenate([t1 * cos - t2 * sin, t2 * cos + t1 * sin], axis=-1).astype(t.dtype)
    return jnp.concatenate([rot, t[..., ROT_DIM:]], axis=-1)


def dilated_window_attention(q, k, v, window, dilation):
    B, S, H, E = q.shape
    n = S // dilation
    half = window // (2 * dilation)
    blk = half
    nb = -(-n // blk)
    n_pad = nb * blk

    def to_sub(t):
        return t.reshape(B, n, dilation, H, E).transpose(0, 2, 3, 1, 4)

    qs, ks, vs = to_sub(q), to_sub(k), to_sub(v)
    qb = jnp.pad(qs, ((0, 0), (0, 0), (0, 0), (0, n_pad - n), (0, 0))).reshape(B, dilation, H, nb, blk, E)

    def key_windows(t):
        tp = jnp.pad(t, ((0, 0), (0, 0), (0, 0), (blk, n_pad - n + blk), (0, 0)))
        tp = tp.reshape(B, dilation, H, nb + 2, blk, E)
        return jnp.concatenate([tp[:, :, :, :-2], tp[:, :, :, 1:-1], tp[:, :, :, 2:]], axis=4)

    kw, vw = key_windows(ks), key_windows(vs)
    qi = jnp.arange(nb)[:, None] * blk + jnp.arange(blk)[None, :]
    kj = jnp.arange(nb)[:, None] * blk - blk + jnp.arange(3 * blk)[None, :]
    valid = ((jnp.abs(qi[:, :, None] - kj[:, None, :]) <= half)
             & (kj[:, None, :] >= 0) & (kj[:, None, :] < n))
    s = jnp.einsum('bdhnqe,bdhnke->bdhnqk', qb, kw).astype(jnp.float32) * (HEAD_DIM ** -0.5)
    s = jnp.where(valid, s, NEG_INF)
    m = jnp.max(s, axis=-1, keepdims=True)
    p = jnp.exp(s - m)
    l = jnp.sum(p, axis=-1)
    o = jnp.einsum('bdhnqk,bdhnke->bdhnqe', p, vw.astype(jnp.float32)) / l[..., None]
    lse = m[..., 0] + jnp.log(l)
    o = o.reshape(B, dilation, H, n_pad, E)[:, :, :, :n].transpose(0, 3, 1, 2, 4).reshape(B, S, H, E)
    lse = lse.reshape(B, dilation, H, n_pad)[:, :, :, :n].transpose(0, 3, 1, 2).reshape(B, S, H)
    return o, lse


def token_mixer(h, positions, w_in, conv_w, conv_b, filt_w1, filt_b1, filt_w2, filt_b2, filt_w3,
                filt_freq, hyena_skip, w_branch_gate, b_branch_gate, w_hy_o, w_at_o, w_out):
    B, S, _ = h.shape
    proj = h @ w_in

    hy = short_conv(proj[..., :3 * HYENA_WIDTH], conv_w, conv_b)
    v_h, x1, x2 = jnp.split(hy, 3, axis=-1)
    filt = hyena_filters(S, filt_w1, filt_b1, filt_w2, filt_b2, filt_w3, filt_freq)
    z = x1 * bidir_long_conv(v_h, filt[:, 0, 0], filt[:, 0, 1], hyena_skip[0])
    z = x2 * bidir_long_conv(z, filt[:, 1, 0], filt[:, 1, 1], hyena_skip[1])
    y_hy = z.astype(h.dtype)

    qkv = proj[..., 3 * HYENA_WIDTH:].reshape(B, S, 3, N_ATTN_HEADS, HEAD_DIM)
    q = partial_rotary(qkv[:, :, 0], positions)
    k = partial_rotary(qkv[:, :, 1], positions)
    v = qkv[:, :, 2]
    outs, lses = [], []
    for gi, (window, dilation) in enumerate(ATTN_GROUPS):
        hs = slice(gi * HEADS_PER_GROUP, (gi + 1) * HEADS_PER_GROUP)
        o, lse = dilated_window_attention(q[:, :, hs], k[:, :, hs], v[:, :, hs], window, dilation)
        outs.append(o)
        lses.append(lse)
    alpha = jax.nn.softmax(jnp.stack(lses, axis=0), axis=0)
    y_at = jnp.sum(alpha[..., None] * jnp.stack(outs, axis=0), axis=0)
    y_at = y_at.reshape(B, S, ATTN_OUT_WIDTH).astype(h.dtype)

    gates = jax.nn.sigmoid(h @ w_branch_gate + b_branch_gate)
    g_hy, g_at = jnp.split(gates, 2, axis=-1)
    merged = g_hy * (y_hy @ w_hy_o) + g_at * (y_at @ w_at_o)
    return (merged @ w_out).astype(h.dtype)


def hierarchical_moe(h, w_group, b_group, w_expert, b_expert, w1, w3, w2):
    B, S, D = h.shape
    T = B * S
    hf = h.reshape(T, D)
    g_logits = (hf @ w_group).astype(jnp.float32) + b_group
    g_prob = jax.nn.softmax(g_logits, axis=-1)
    g_val, g_idx = lax.top_k(g_prob, 1)
    e_logits = jnp.einsum('td,gde->tge', hf, w_expert).astype(jnp.float32) + b_expert
    e_logits = jnp.take_along_axis(e_logits, g_idx[:, :, None], axis=1)[:, 0]
    e_val, e_idx = lax.top_k(e_logits, TOP_K)
    gate = g_val * jax.nn.softmax(e_val, axis=-1)
    expert_id = g_idx * EXPERTS_PER_GROUP + e_idx

    A = T * TOP_K
    flat_e = expert_id.reshape(A)
    flat_gate = gate.reshape(A)
    flat_tok = jnp.arange(A, dtype=jnp.int32) // TOP_K
    order = jnp.argsort(flat_e)
    sorted_e = flat_e[order]
    sorted_tok = flat_tok[order]
    counts = jnp.bincount(flat_e, length=N_EXPERTS)
    starts = jnp.cumsum(counts) - counts
    padded = (counts + EXPERT_ROW_BLOCK - 1) // EXPERT_ROW_BLOCK * EXPERT_ROW_BLOCK
    pends = jnp.cumsum(padded)
    pstarts = pends - padded
    dest = pstarts[sorted_e] + jnp.arange(A, dtype=jnp.int32) - starts[sorted_e]
    n_blocks = -(-A // EXPERT_ROW_BLOCK) + N_EXPERTS
    rows = n_blocks * EXPERT_ROW_BLOCK
    xbuf = jnp.zeros((rows, D), h.dtype).at[dest].set(hf[sorted_tok])
    block_start = jnp.arange(n_blocks, dtype=jnp.int32) * EXPERT_ROW_BLOCK
    block_e = jnp.minimum(jnp.searchsorted(pends, block_start, side='right'), N_EXPERTS - 1)

    def expert_block(args):
        xb, e = args
        return (jax.nn.silu(xb @ w1[e]) * (xb @ w3[e])) @ w2[e]

    ybuf = lax.map(expert_block, (xbuf.reshape(n_blocks, EXPERT_ROW_BLOCK, D), block_e)).reshape(rows, D)
    y = ybuf[dest].astype(jnp.float32) * flat_gate[order][:, None]
    out = jax.ops.segment_sum(y, sorted_tok, num_segments=T)
    return out.reshape(B, S, D).astype(h.dtype)


def setup_inputs(seed: int = 0) -> dict:
    key = jax.random.key(seed)
    keys = list(jax.random.split(key, 40))

    def nrm(shape, std):
        return std * jax.random.normal(keys.pop(), shape, jnp.float32)

    D = D_MODEL
    L = DEPTH
    return {
        'x': nrm((BATCH, SEQ, D), 1.0),
        'c': nrm((BATCH, D), 1.0),
        'positions': jnp.broadcast_to(jnp.arange(SEQ, dtype=jnp.int32), (BATCH, SEQ)),
        'w_ada': nrm((L, D, 6 * D), 0.5 * D ** -0.5),
        'b_ada': nrm((L, 6 * D), 0.02),
        'g_mix_pre': 1.0 + nrm((L, D), 0.05),
        'g_mix_post': 1.0 + nrm((L, D), 0.05),
        'g_ffn_pre': 1.0 + nrm((L, D), 0.05),
        'g_ffn_post': 1.0 + nrm((L, D), 0.05),
        'w_in': nrm((L, D, IN_WIDTH), D ** -0.5),
        'conv_w': nrm((L, 3, 3 * HYENA_WIDTH), 0.5),
        'conv_b': nrm((L, 3 * HYENA_WIDTH), 0.02),
        'filt_w1': nrm((L, FILTER_EMB_DIM, FILTER_HIDDEN), FILTER_EMB_DIM ** -0.5),
        'filt_b1': nrm((L, FILTER_HIDDEN), 0.1),
        'filt_w2': nrm((L, FILTER_HIDDEN, FILTER_HIDDEN), FILTER_HIDDEN ** -0.5),
        'filt_b2': nrm((L, FILTER_HIDDEN), 0.1),
        'filt_w3': nrm((L, FILTER_HIDDEN, HYENA_ORDER * 2 * HYENA_WIDTH), 0.02),
        'filt_freq': 1.0 + nrm((L, FILTER_HIDDEN), 0.1),
        'hyena_skip': nrm((L, HYENA_ORDER, HYENA_WIDTH), 0.5),
        'w_branch_gate': nrm((L, D, 2 * D), D ** -0.5),
        'b_branch_gate': nrm((L, 2 * D), 0.02),
        'w_hy_o': nrm((L, HYENA_WIDTH, D), HYENA_WIDTH ** -0.5),
        'w_at_o': nrm((L, ATTN_OUT_WIDTH, D), ATTN_OUT_WIDTH ** -0.5),
        'w_out': nrm((L, D, D), D ** -0.5),
        'w_group': nrm((L, D, N_EXPERT_GROUPS), D ** -0.5),
        'b_group': nrm((L, N_EXPERT_GROUPS), 0.01),
        'w_expert': nrm((L, N_EXPERT_GROUPS, D, EXPERTS_PER_GROUP), D ** -0.5),
        'b_expert': nrm((L, N_EXPERT_GROUPS, EXPERTS_PER_GROUP), 0.01),
        'w1_exp': nrm((L, N_EXPERTS, D, EXPERT_FF), D ** -0.5),
        'w3_exp': nrm((L, N_EXPERTS, D, EXPERT_FF), D ** -0.5),
        'w2_exp': nrm((L, N_EXPERTS, EXPERT_FF, D), EXPERT_FF ** -0.5),
    }


def reference(x, c, positions, w_ada, b_ada, g_mix_pre, g_mix_post, g_ffn_pre, g_ffn_post,
              w_in, conv_w, conv_b, filt_w1, filt_b1, filt_w2, filt_b2, filt_w3, filt_freq,
              hyena_skip, w_branch_gate, b_branch_gate, w_hy_o, w_at_o, w_out,
              w_group, b_group, w_expert, b_expert, w1_exp, w3_exp, w2_exp):
    B, S, D = x.shape
    cond = jax.nn.silu(c)
    for l in range(DEPTH):
        mod = (cond @ w_ada[l] + b_ada[l]).reshape(B, 6, 1, D)
        shift_m, scale_m, gate_m, shift_f, scale_f, gate_f = (mod[:, i] for i in range(6))
        h = rmsnorm(x, g_mix_pre[l]) * (1.0 + scale_m) + shift_m
        y = token_mixer(h, positions, w_in[l], conv_w[l], conv_b[l], filt_w1[l], filt_b1[l],
                        filt_w2[l], filt_b2[l], filt_w3[l], filt_freq[l], hyena_skip[l],
                        w_branch_gate[l], b_branch_gate[l], w_hy_o[l], w_at_o[l], w_out[l])
        x = x + gate_m * rmsnorm(y, g_mix_post[l])
        h = rmsnorm(x, g_ffn_pre[l]) * (1.0 + scale_f) + shift_f
        y = hierarchical_moe(h, w_group[l], b_group[l], w_expert[l], b_expert[l],
                             w1_exp[l], w3_exp[l], w2_exp[l])
        x = x + gate_f * rmsnorm(y, g_ffn_post[l])
    return x
```

```cpp
#include <hip/hip_runtime.h>
#include <cstdio>
#include <cstdint>
namespace pg8 {
#define PG8_LAS __attribute__((address_space(3)))
typedef unsigned short bf16_t;
typedef short bf16x8 __attribute__((ext_vector_type(8)));
typedef float f32x4 __attribute__((ext_vector_type(4)));
typedef unsigned u32x4 __attribute__((ext_vector_type(4)));
constexpr int BM = 256, BK = 64, HALF = 128, HTB = HALF * BK * 2  , STAGE_BYTES = 8 * HTB, NXCD = 8, WGM = 8;

__host__ __device__ __forceinline__ int lds_byte(int r, int c) { const int st = (r >> 4) * 2 + (c >> 5), rr = r & 15, cc = c & 31, ob = rr * 64 + cc * 2; return st * 1024 + (ob ^ (((ob >> 9) & 1) << 5)); }
__host__ __device__ __forceinline__ void stage_rc(int b, int& R, int& C) { const int st = b / 1024, sb = b % 1024, swz = sb ^ (((sb >> 9) & 1) << 5); R = (st >> 1) * 16 + swz / 64; C = (st & 1) * 32 + (swz % 64) / 2; }
__host__ __device__ __forceinline__ int perm32(int rho) { const int n = rho >> 4, i = rho & 15; return 8 * (i >> 2) + 4 * n + (i & 3); }

struct Unit { int pm, pn; };
struct Gemm { const bf16_t* A; const bf16_t* Bt; int M, N, K; };

struct StaticOrder {
    int nM, nN, nwg, G, c;
    __host__ __device__ void init(int M, int N, int G_, int c_) { nM = M / BM; nN = N / BM; nwg = nM * nN; G = G_; c = c_; }
    __host__ __device__ bool next(int i, Unit& u) const {
        const long L = (long)i * G + c; if (L >= nwg) return false;
        int wgid = (int)L; { const int q = nwg / NXCD, r = nwg % NXCD, xcd = wgid % NXCD, off = wgid / NXCD; wgid = (xcd < r ? xcd * (q + 1) : r * (q + 1) + (xcd - r) * q) + off; }
        const int nig = WGM * nN, gid = wgid / nig, fm = gid * WGM, gsz = (nM - fm) < WGM ? (nM - fm) : WGM;
        u.pm = fm + ((wgid % nig) % gsz); u.pn = (wgid % nig) / gsz; return true;
    }
    __device__ __forceinline__ void a_ready(const Unit&) const {}
    __device__ __forceinline__ void done(const Unit&) const {}
};

__device__ __forceinline__ unsigned cvt_pk_bf16(float lo, float hi) { unsigned r; asm volatile("v_cvt_pk_bf16_f32 %0, %1, %2" : "=v"(r) : "v"(lo), "v"(hi)); return r; }
typedef float f32x2 __attribute__((ext_vector_type(2)));
template <class Epi, class Sched, bool ALIGN_EPI = false, bool SP2 = false>
__device__ __forceinline__ void gemm_phase(PG8_LAS unsigned char* lds, const Gemm g, const Sched& S, const Epi& E) {
    const int tid = threadIdx.x, wid = __builtin_amdgcn_readfirstlane(tid >> 6), lane = tid & 63, wr = wid >> 2, wc = wid & 3, fr = lane & 15, fq = lane >> 4;
    const int K = g.K, nt = K / BK;
    unsigned voffA[2], voffB[2];
#pragma unroll
    for (int i = 0; i < 2; ++i) { int R, C; stage_rc(tid * 16 + i * 8192, R, C); const int Rb = Epi::PERM ? ((R & ~31) + perm32(R & 31)) : R;
        voffA[i] = (unsigned)(R * K + C) * 2u; voffB[i] = (unsigned)(Rb * K + C) * 2u; }
    const size_t kstep = (size_t)(BK * 2);
    const size_t hstep = (size_t)HALF * K * 2;
    const size_t tstep = 2 * hstep;
    const unsigned ldsw = (unsigned)wid * 1024u;
    const int aoff = lds_byte(wr * 64 + fr, fq * 8), boff = lds_byte(wc * 32 + fr, fq * 8);
#define PG8_SA(b, h) (((b) * 2 + (h)) * HTB)
#define PG8_SB(b, h) ((4 + (b) * 2 + (h)) * HTB)
#define PG8_STAGE(bufoff, gbase, voff) do { _Pragma("unroll") for (int _i = 0; _i < 2; ++_i) \
        __builtin_amdgcn_global_load_lds((const unsigned*)((const char*)(gbase) + (voff)[_i]), (PG8_LAS unsigned*)(lds + (bufoff) + ldsw + _i * 8192), 16, 0, 0); } while (0)
#define PG8_LDA(dst, b, h) do { _Pragma("unroll") for (int m = 0; m < 4; ++m) _Pragma("unroll") for (int k = 0; k < 2; ++k) dst[m][k] = *(const PG8_LAS bf16x8*)(lds + PG8_SA(b, h) + aoff + m * 2048 + k * 1024); } while (0)
#define PG8_LDB(dst, b, h) do { _Pragma("unroll") for (int n = 0; n < 2; ++n) _Pragma("unroll") for (int k = 0; k < 2; ++k) dst[n][k] = *(const PG8_LAS bf16x8*)(lds + PG8_SB(b, h) + boff + n * 2048 + k * 1024); } while (0)
#define PG8_MMA(ai, bj, At, Bt) do { __builtin_amdgcn_s_setprio(1); _Pragma("unroll") for (int m = 0; m < 4; ++m) _Pragma("unroll") for (int n = 0; n < 2; ++n) _Pragma("unroll") for (int k = 0; k < 2; ++k) \
        acc[ai][bj][m][n] = __builtin_amdgcn_mfma_f32_16x16x32_bf16(Bt[n][k], At[m][k], acc[ai][bj][m][n], 0, 0, 0); __builtin_amdgcn_s_setprio(0); } while (0)
#define PG8_WAIT_V(n) asm volatile("s_waitcnt vmcnt(" #n ")" ::: "memory")
#define PG8_WAIT_L(n) asm volatile("s_waitcnt lgkmcnt(" #n ")" ::: "memory")
#define PG8_BAR __builtin_amdgcn_s_barrier()
#define PG8_SCHED __builtin_amdgcn_sched_barrier(0)
    Unit cur, nxt; int ui = 0;
    if (!S.next(0, cur)) return;
    f32x4 acc[2][2][4][2];
#pragma unroll
    for (int a = 0; a < 2; ++a)
#pragma unroll
        for (int b = 0; b < 2; ++b)
#pragma unroll
            for (int m = 0; m < 4; ++m)
#pragma unroll
                for (int n = 0; n < 2; ++n) acc[a][b][m][n] = (f32x4){0.f, 0.f, 0.f, 0.f};
    bf16x8 At[4][2], B0[2][2], B1[2][2];
    const char* cA = (const char*)g.A + (size_t)cur.pm * tstep; const char* cB = (const char*)g.Bt + (size_t)cur.pn * tstep;
    S.a_ready(cur);
    if constexpr (SP2) {
        PG8_STAGE(PG8_SB(0, 0), cB, voffB); PG8_STAGE(PG8_SB(0, 1), cB + hstep, voffB); PG8_STAGE(PG8_SA(0, 0), cA, voffA); PG8_STAGE(PG8_SA(0, 1), cA + hstep, voffA);
        if (wr == 1) PG8_BAR;
        PG8_WAIT_V(2); PG8_BAR;
        PG8_STAGE(PG8_SB(1, 0), cB + kstep, voffB); PG8_STAGE(PG8_SA(1, 0), cA + kstep, voffA); PG8_STAGE(PG8_SB(1, 1), cB + hstep + kstep, voffB);
        PG8_WAIT_V(6); PG8_BAR;
    } else {
        PG8_STAGE(PG8_SB(0, 0), cB, voffB); PG8_STAGE(PG8_SA(0, 0), cA, voffA); PG8_STAGE(PG8_SB(0, 1), cB + hstep, voffB); PG8_STAGE(PG8_SA(0, 1), cA + hstep, voffA);
        if (wr == 1) PG8_BAR;
        PG8_WAIT_V(4); PG8_BAR;
        PG8_STAGE(PG8_SB(1, 0), cB + kstep, voffB); PG8_STAGE(PG8_SA(1, 0), cA + kstep, voffA); PG8_STAGE(PG8_SB(1, 1), cB + hstep + kstep, voffB);
        PG8_WAIT_V(6); PG8_BAR;
    }
    for (;;) {
        const bool has_next = S.next(ui + 1, nxt);
        const char* nA = has_next ? (const char*)g.A + (size_t)nxt.pm * tstep : cA; const char* nB = has_next ? (const char*)g.Bt + (size_t)nxt.pn * tstep : cB;
        for (int t = 0; t < nt; t += 2) {
            const bool last = (t == nt - 2);
            const char* a1 = cA + (size_t)(t + 1) * kstep;
            const char* a2 = last ? nA : cA + (size_t)(t + 2) * kstep; const char* b2 = last ? nB : cB + (size_t)(t + 2) * kstep;
            const char* a3 = a2 + kstep; const char* b3 = b2 + kstep;
            if (last && has_next) S.a_ready(nxt);
            if constexpr (SP2) {
            PG8_LDB(B0, 0, 0); PG8_LDB(B1, 0, 1); PG8_SCHED; PG8_LDA(At, 0, 0); PG8_STAGE(PG8_SA(1, 1), a1 + hstep, voffA);
            PG8_WAIT_V(8); PG8_WAIT_L(0); PG8_BAR; PG8_MMA(0, 0, At, B0); PG8_MMA(0, 1, At, B1); PG8_BAR; PG8_SCHED;
            PG8_LDA(At, 0, 1); PG8_STAGE(PG8_SB(0, 0), b2, voffB); PG8_STAGE(PG8_SB(0, 1), b2 + hstep, voffB); PG8_STAGE(PG8_SA(0, 0), a2, voffA);
            PG8_WAIT_V(8); PG8_WAIT_L(0); PG8_BAR; PG8_MMA(1, 0, At, B0); PG8_MMA(1, 1, At, B1); PG8_BAR; PG8_SCHED;
            PG8_LDB(B0, 1, 0); PG8_LDB(B1, 1, 1); PG8_SCHED; PG8_LDA(At, 1, 0); PG8_STAGE(PG8_SA(0, 1), a2 + hstep, voffA);
            PG8_WAIT_V(8); PG8_WAIT_L(0); PG8_BAR; PG8_MMA(0, 0, At, B0); PG8_MMA(0, 1, At, B1); PG8_BAR; PG8_SCHED;
            PG8_LDA(At, 1, 1); PG8_STAGE(PG8_SB(1, 0), b3, voffB); PG8_STAGE(PG8_SB(1, 1), b3 + hstep, voffB); PG8_STAGE(PG8_SA(1, 0), a3, voffA);
            PG8_WAIT_V(8); PG8_WAIT_L(0); PG8_BAR; PG8_MMA(1, 0, At, B0); PG8_MMA(1, 1, At, B1); PG8_BAR; PG8_SCHED;
            } else {
            PG8_LDB(B0, 0, 0); PG8_SCHED; PG8_LDA(At, 0, 0); PG8_STAGE(PG8_SA(1, 1), a1 + hstep, voffA);
            PG8_WAIT_L(8); PG8_BAR; PG8_WAIT_L(0); PG8_MMA(0, 0, At, B0); PG8_BAR; PG8_SCHED;
            PG8_LDB(B1, 0, 1); PG8_STAGE(PG8_SB(0, 0), b2, voffB);
            PG8_BAR; PG8_WAIT_L(0); PG8_MMA(0, 1, At, B1); PG8_BAR;
            PG8_LDA(At, 0, 1); PG8_STAGE(PG8_SA(0, 0), a2, voffA);
            PG8_BAR; PG8_WAIT_L(0); PG8_MMA(1, 0, At, B0); PG8_BAR; PG8_SCHED;
            PG8_STAGE(PG8_SB(0, 1), b2 + hstep, voffB);
            PG8_WAIT_V(6); PG8_BAR; PG8_MMA(1, 1, At, B1); PG8_BAR;
            PG8_LDB(B0, 1, 0); PG8_SCHED; PG8_LDA(At, 1, 0); PG8_STAGE(PG8_SA(0, 1), a2 + hstep, voffA);
            PG8_WAIT_L(8); PG8_BAR; PG8_WAIT_L(0); PG8_MMA(0, 0, At, B0); PG8_BAR; PG8_SCHED;
            PG8_LDB(B1, 1, 1); PG8_STAGE(PG8_SB(1, 0), b3, voffB);
            PG8_BAR; PG8_WAIT_L(0); PG8_MMA(0, 1, At, B1); PG8_BAR;
            PG8_LDA(At, 1, 1); PG8_STAGE(PG8_SA(1, 0), a3, voffA);
            PG8_BAR; PG8_WAIT_L(0); PG8_MMA(1, 0, At, B0); PG8_BAR; PG8_SCHED;
            PG8_STAGE(PG8_SB(1, 1), b3 + hstep, voffB);
            PG8_WAIT_V(6); PG8_BAR; PG8_MMA(1, 1, At, B1); PG8_BAR;
            }
        }
        if constexpr (ALIGN_EPI) { if (wr == 0) PG8_BAR; }
        if constexpr (!Epi::AFTER_DRAIN) { E(acc, cur, wr, wc, fr, fq); S.done(cur); }
        if (!has_next) break;
#pragma unroll
        for (int a = 0; a < 2; ++a)
#pragma unroll
            for (int b = 0; b < 2; ++b)
#pragma unroll
                for (int m = 0; m < 4; ++m)
#pragma unroll
                    for (int n = 0; n < 2; ++n) acc[a][b][m][n] = (f32x4){0.f, 0.f, 0.f, 0.f};
        cur = nxt; cA = nA; cB = nB; ++ui;
        if constexpr (ALIGN_EPI) { if (wr == 1) PG8_BAR; }
    }
    PG8_WAIT_V(0);
    if constexpr (!ALIGN_EPI) { if (wr == 0) PG8_BAR; }
    PG8_BAR;
    if constexpr (Epi::AFTER_DRAIN) { E.fused(acc, cur, wr, wc, fr, fq, lds, wid, lane); S.done(cur); }
#undef PG8_SA
#undef PG8_SB
#undef PG8_STAGE
#undef PG8_LDA
#undef PG8_LDB
#undef PG8_MMA
#undef PG8_WAIT_V
#undef PG8_WAIT_L
#undef PG8_BAR
#undef PG8_SCHED
}
}


#ifndef N_LAUNCH_MODE
#define N_LAUNCH_MODE 0
#endif
#ifndef SIMPLE_GEMM
#define SIMPLE_GEMM 0
#endif

constexpr int D = 2048, BATCH = 2, SEQ = 4096, T = BATCH * SEQ;
constexpr int HW = 1024;
constexpr int NH = 12, HD = 128, QKVW = 3 * NH * HD;
constexpr int INW = 3 * HW + QKVW;
constexpr int N1 = INW + 2 * D;
constexpr int NE = 64, FF = 512;
constexpr float RMS_EPS = 1e-6f;
constexpr int NWAVES = 8, NTHR = 512;
constexpr int NPHASE = 11;

constexpr size_t MiB = 1u << 20;
constexpr size_t WS_CTL = 0, CTL_ZERO_BYTES = 1 * MiB;
constexpr size_t WS_MODP = 1 * MiB;
constexpr size_t WS_HID2 = 2 * MiB;
constexpr size_t WS_ROT = 3 * MiB;
constexpr size_t WS_W3T = 4 * MiB;
constexpr size_t WS_ROUTE = 5 * MiB;
constexpr size_t WS_LISTT = 6 * MiB;
constexpr size_t WS_LISTG = 8 * MiB;
constexpr size_t WS_W1T = 16 * MiB;
constexpr size_t WS_WHYOT = 64 * MiB;
constexpr size_t WS_WATOT = 68 * MiB;
constexpr size_t WS_WOUTT = 70 * MiB;
constexpr size_t WS_KF = 80 * MiB;
constexpr size_t WS_H = 144 * MiB;
constexpr size_t WS_PHY = 176 * MiB;
constexpr size_t WS_QKV = 224 * MiB;
constexpr size_t WS_G = 296 * MiB;
constexpr size_t WS_YHY = 360 * MiB;
constexpr size_t WS_YAT = 376 * MiB;
constexpr size_t WS_TMP = 384 * MiB;
constexpr size_t WS_MERGED = 448 * MiB;
constexpr size_t WS_Y = 480 * MiB;
constexpr size_t WS_X1 = 544 * MiB;
constexpr size_t WS_H2 = 608 * MiB;
constexpr size_t WS_ACT = 640 * MiB;
constexpr size_t WS_YB = 672 * MiB;
constexpr size_t WS_END = 800 * MiB;
constexpr int CW_BAR = 4096;
constexpr int CW_CNT = 16384;

constexpr int RING_BYTES = 131072;
constexpr int MISC_OFF = RING_BYTES + 320;
constexpr int LDS_BYTES = 147456;

#define GAS __attribute__((address_space(1)))
#define LAS __attribute__((address_space(3)))
typedef unsigned short bf16;
typedef unsigned v4u __attribute__((ext_vector_type(4)));
typedef unsigned v2u __attribute__((ext_vector_type(2)));
typedef float f32x4 __attribute__((ext_vector_type(4)));
typedef LAS float lfloat;

__device__ __forceinline__ unsigned f2bf(float f) { unsigned u = __builtin_bit_cast(unsigned, f); return (u + 0x7fffu + ((u >> 16) & 1u)) >> 16; }
__device__ __forceinline__ unsigned pk2(float lo, float hi) { return f2bf(lo) | (f2bf(hi) << 16); }
__device__ __forceinline__ float bf2f(unsigned short b) { return __builtin_bit_cast(float, ((unsigned)b) << 16); }
__device__ __forceinline__ float bflo(unsigned w) { return __builtin_bit_cast(float, w << 16); }
__device__ __forceinline__ float bfhi(unsigned w) { return __builtin_bit_cast(float, w & 0xffff0000u); }

#define XB_TMO      128
#define XB_XCNT(j)  (256  + 64 * (j))
#define XB_XSUB(j)  (1280 + 64 * (j))
#define XB_XGEN(j)  (2304 + 64 * (j))
#define XB_TOP      3328
#define XB_TOPGEN   3392
#define XCD_BAR_WORDS 3456
#define XB_SPIN_CAP (1u << 18)
__device__ __forceinline__ unsigned xb_ld(unsigned* p)              { return __hip_atomic_load(p, __ATOMIC_RELAXED, __HIP_MEMORY_SCOPE_AGENT); }
__device__ __forceinline__ unsigned xb_add(unsigned* p, unsigned v) { return __hip_atomic_fetch_add(p, v, __ATOMIC_RELAXED, __HIP_MEMORY_SCOPE_AGENT); }
__device__ __forceinline__ unsigned xb_xcc_id() { return (unsigned)__builtin_amdgcn_s_getreg((3 << 11) | 20) & 0xFu; }
#define XB_SPIN(cond, bar) do { unsigned _sp = 0; while (cond) { __builtin_amdgcn_s_sleep(1); \
    if ((++_sp & 255u) == 0u) { if (xb_ld(&(bar)[XB_TMO])) break; if (_sp > XB_SPIN_CAP) { atomicAdd(&(bar)[XB_TMO], 1u); break; } } } } while (0)
struct XcdBarrier { unsigned* bar; unsigned x; volatile LAS unsigned* st; };
__device__ __forceinline__ XcdBarrier xcd_barrier_post(unsigned* bar, volatile LAS unsigned* st) {
    XcdBarrier b; b.bar = bar; b.x = xb_xcc_id(); b.st = st;
    if (threadIdx.x == 0) (void)xb_add(&bar[XB_XCNT(b.x)], 1u);
    return b;
}
__device__ __forceinline__ void xcd_barrier_complete(unsigned* bar, unsigned x, unsigned& nloc, unsigned& nx) {
    const unsigned G = gridDim.x * gridDim.y * gridDim.z;
    unsigned sum, cnt, mine, sp = 0u;
    for (;;) {
        sum = 0u; cnt = 0u; mine = 0u;
#pragma unroll
        for (unsigned j = 0; j < 16; ++j) { const unsigned c = xb_ld(&bar[XB_XCNT(j)]); sum += c; cnt += (c > 0u) ? 1u : 0u; mine = (j == x) ? c : mine; }
        if (sum == G) break;
        __builtin_amdgcn_s_sleep(1);
        if ((++sp & 255u) == 0u) { if (xb_ld(&bar[XB_TMO])) break; if (sp > XB_SPIN_CAP) { atomicAdd(&bar[XB_TMO], 1u); break; } }
    }
    nloc = mine > 0u ? mine : 1u; nx = cnt > 0u ? cnt : 1u;
}
__device__ __forceinline__ void xcd_barrier(const XcdBarrier& b) {
    asm volatile("s_waitcnt vmcnt(0)" ::: "memory");
    __syncthreads();
    if (threadIdx.x == 0) {
        unsigned* bar = b.bar;
        __builtin_amdgcn_s_waitcnt(0);
        unsigned nloc = b.st[0], nx = b.st[1];
        if (nloc == 0u) { xcd_barrier_complete(bar, b.x, nloc, nx); b.st[0] = nloc; b.st[1] = nx; }
        const unsigned old = xb_add(&bar[XB_XSUB(b.x)], 1u);
        const unsigned gen = old / nloc;
        if (old + 1u == (gen + 1u) * nloc) {
            __builtin_amdgcn_fence(__ATOMIC_RELEASE, "agent");
            asm volatile("s_waitcnt vmcnt(0)" ::: "memory");
            const unsigned og = xb_add(&bar[XB_TOP], 1u);
            const unsigned tg = og / nx;
            if (og + 1u == (tg + 1u) * nx) xb_add(&bar[XB_TOPGEN], 1u);
            else XB_SPIN(xb_ld(&bar[XB_TOPGEN]) == tg, bar);
            __builtin_amdgcn_fence(__ATOMIC_ACQUIRE, "agent");
            xb_add(&bar[XB_XGEN(b.x)], 1u);
            asm volatile("s_waitcnt vmcnt(0)" ::: "memory");
        } else {
            XB_SPIN(xb_ld(&bar[XB_XGEN(b.x)]) == gen, bar);
            __builtin_amdgcn_fence(__ATOMIC_ACQUIRE, "agent");
            asm volatile("s_waitcnt vmcnt(0)" ::: "memory");
        }
    }
    __syncthreads();
}

struct Args { const void* in[31]; float* out; unsigned char* ws; int ph_lo, ph_hi; };
struct Frame {
    LAS unsigned char* lds;
    int tid, lane, wave, G, bid;
    const float *x, *c, *w_ada, *b_ada, *g_mix_pre, *g_mix_post, *g_ffn_pre, *g_ffn_post, *w_in, *conv_w, *conv_b, *fw1, *fb1, *fw2, *fb2, *fw3, *ffreq, *hskip,
        *w_bg, *b_bg, *w_hy_o, *w_at_o, *w_out, *w_group, *b_group, *w_expert, *b_expert, *w1e, *w3e, *w2e;
    const int* positions;
    float* out;
    unsigned* ctl; float *MODP, *HID2, *ROT, *W3T, *KF, *TMP, *Y, *X1, *ACT, *YB, *LISTG;
    unsigned* ROUTE; int* LISTT;
    bf16 *W1T, *WHYOT, *WATOT, *WOUTT, *H, *PHY, *QKV, *GT, *YHY, *YAT, *MERGED, *H2;
};

__device__ __forceinline__ float wave_sum(float v) {
#pragma unroll
    for (int o = 1; o < 64; o <<= 1) v += __shfl_xor(v, o);
    return v;
}
__device__ __forceinline__ float wave_max(float v) {
#pragma unroll
    for (int o = 1; o < 64; o <<= 1) v = fmaxf(v, __shfl_xor(v, o));
    return v;
}

__device__ __forceinline__ void p0_transpose_item(const float* W, int K, int N, bf16* WT, int row_off, LAS float* scr, int item, int lane) {
    const int nblk = N / 32, kb = item / nblk, nb = item % nblk, k0 = 64 * kb, n0 = 32 * nb;
#pragma unroll 8
    for (int i = 0; i < 32; ++i) { const int kk = 2 * i + (lane >> 5); scr[kk * 33 + (lane & 31)] = W[(size_t)(k0 + kk) * N + n0 + (lane & 31)]; }
    asm volatile("s_waitcnt lgkmcnt(0)" ::: "memory");
    const int c = lane & 7;
#pragma unroll
    for (int j = 0; j < 4; ++j) { const int n = (lane >> 3) + 8 * j; const LAS float* s = scr + (8 * c) * 33 + n;
        v4u o; o.x = pk2(s[0 * 33], s[1 * 33]); o.y = pk2(s[2 * 33], s[3 * 33]); o.z = pk2(s[4 * 33], s[5 * 33]); o.w = pk2(s[6 * 33], s[7 * 33]);
        *(v4u*)(WT + (size_t)(row_off + n0 + n) * K + k0 + 8 * c) = o; }
    asm volatile("s_waitcnt lgkmcnt(0)" ::: "memory");
}

__device__ __forceinline__ void load_mod(Frame& F, LAS float* dst, int which) {
    for (int i = F.tid; i < 2 * D; i += NTHR) { const int b = i / D, d = i % D; float s = F.b_ada[which * D + d];
#pragma unroll
        for (int ks = 0; ks < 8; ++ks) s += F.MODP[(size_t)(ks * 2 + b) * (6 * D) + which * D + d];
        dst[i] = s; }
}

__device__ __forceinline__ void p0_prologue(Frame& F) {
    LAS float* L = (LAS float*)F.lds;
    {
        LAS float* sc = L;
        LAS float* red = L + 512;
        for (int u = F.bid; u < 48 * 8; u += F.G) {
            const int chunk = u % 48, ks = u / 48;
            { const int b = F.tid >> 8, i = F.tid & 255; const float cv = F.c[b * D + ks * 256 + i]; sc[b * 256 + i] = cv / (1.f + __expf(-cv)); }
            __syncthreads();
            f32x4 a0 = {0.f, 0.f, 0.f, 0.f}, a1 = {0.f, 0.f, 0.f, 0.f};
            const float* wp = F.w_ada + (size_t)(ks * 256 + F.wave * 32) * (6 * D) + chunk * 256 + F.lane * 4;
#pragma unroll 8
            for (int r = 0; r < 32; ++r) { const f32x4 w = *(const f32x4*)(wp + (size_t)r * (6 * D)); const float s0 = sc[F.wave * 32 + r], s1 = sc[256 + F.wave * 32 + r]; a0 += w * s0; a1 += w * s1; }
            *(LAS f32x4*)(red + (F.wave * 2 + 0) * 256 + F.lane * 4) = a0;
            *(LAS f32x4*)(red + (F.wave * 2 + 1) * 256 + F.lane * 4) = a1;
            __syncthreads();
            { const int b = F.tid >> 8, col = F.tid & 255; float s = 0.f;
#pragma unroll
              for (int w = 0; w < 8; ++w) s += red[(w * 2 + b) * 256 + col];
              F.MODP[(size_t)(ks * 2 + b) * (6 * D) + chunk * 256 + col] = s; }
            __syncthreads();
        }
    }
    const int gw = F.bid * NWAVES + F.wave, NGW = F.G * NWAVES;
    {
        LAS float* scr = (LAS float*)(F.lds + F.wave * 16384);
        constexpr int I_IN = (D / 64) * (INW / 32), I_BG = (D / 64) * (2 * D / 32), I_HY = (HW / 64) * (D / 32), I_AT = (512 / 64) * (D / 32), I_OUT = (D / 64) * (D / 32);
        constexpr int NITEMS = I_IN + I_BG + I_HY + I_AT + I_OUT;
        for (int it = gw; it < NITEMS; it += NGW) {
            int r = it;
            if (r < I_IN) { p0_transpose_item(F.w_in, D, INW, F.W1T, 0, scr, r, F.lane); continue; } r -= I_IN;
            if (r < I_BG) { p0_transpose_item(F.w_bg, D, 2 * D, F.W1T, INW, scr, r, F.lane); continue; } r -= I_BG;
            if (r < I_HY) { p0_transpose_item(F.w_hy_o, HW, D, F.WHYOT, 0, scr, r, F.lane); continue; } r -= I_HY;
            if (r < I_AT) { p0_transpose_item(F.w_at_o, 512, D, F.WATOT, 0, scr, r, F.lane); continue; } r -= I_AT;
            p0_transpose_item(F.w_out, D, D, F.WOUTT, 0, scr, r, F.lane);
        }
    }
    for (int i = F.bid * NTHR + F.tid; i < 64 * 4096; i += F.G * NTHR) { const int n = i >> 6, j = i & 63; F.W3T[i] = F.fw3[j * 4096 + n]; }
    for (int t = gw; t < SEQ; t += NGW) {
        const int j = F.lane;
        const float tn = (float)t * (1.0f / (float)(SEQ - 1));
        const float w = 6.283185307179586f * (float)t / (float)SEQ;
        float feat = 0.f;
        if (j == 0) feat = tn;
        else if (j <= 16) { const float band = 1e-4f + (float)(j - 1) * ((15.0f - 1e-4f) / 15.0f); feat = cosf(band * w); }
        else if (j <= 32) { const float band = 1e-4f + (float)(j - 17) * ((15.0f - 1e-4f) / 15.0f); feat = -sinf(band * w); }
        float a = F.fb1[j];
        for (int i = 0; i < 33; ++i) a += __shfl(feat, i) * F.fw1[i * 64 + j];
        const float fr = F.ffreq[j];
        const float h1 = sinf(fr * a);
        float a2 = F.fb2[j];
        for (int i = 0; i < 64; ++i) a2 += __shfl(h1, i) * F.fw2[i * 64 + j];
        F.HID2[t * 64 + j] = sinf(fr * a2);
    }
    for (int i = F.bid * NTHR + F.tid; i < T * 16; i += F.G * NTHR) {
        const int tok = i >> 4, k = i & 15;
        const float inv = powf(500000.0f, -(float)k * (1.0f / 16.0f));
        const float ang = (float)F.positions[tok] * inv;
        F.ROT[tok * 32 + k] = cosf(ang); F.ROT[tok * 32 + 16 + k] = sinf(ang);
    }
}

__device__ __forceinline__ void p1_rows_filters(Frame& F) {
    LAS float* L = (LAS float*)F.lds;
    LAS float* shiftv = L;
    LAS float* scalev = L + 2 * D;
    load_mod(F, shiftv, 0); load_mod(F, scalev, 1);
    __syncthreads();
    const int gw = F.bid * NWAVES + F.wave, NGW = F.G * NWAVES;
    for (int m = gw; m < T; m += NGW) {
        const int b = m / SEQ;
        const f32x4* xr = (const f32x4*)(F.x + (size_t)m * D) + F.lane;
        f32x4 v[8]; float s = 0.f;
#pragma unroll
        for (int j = 0; j < 8; ++j) { v[j] = xr[64 * j]; s += (v[j].x * v[j].x + v[j].y * v[j].y) + (v[j].z * v[j].z + v[j].w * v[j].w); }
        const float rstd = 1.0f / sqrtf(wave_sum(s) * (1.f / D) + RMS_EPS);
        v2u* o8 = (v2u*)(F.H + (size_t)m * D) + F.lane;
#pragma unroll
        for (int j = 0; j < 8; ++j) { const int d = 256 * j + 4 * F.lane;
            const f32x4 g = *(const f32x4*)(F.g_mix_pre + d); const f32x4 sc = *(LAS f32x4*)(scalev + b * D + d), sh = *(LAS f32x4*)(shiftv + b * D + d);
            f32x4 h; h = (v[j] * rstd) * g; h = h * (sc + 1.0f) + sh;
            v2u w; w.x = pk2(h.x, h.y); w.y = pk2(h.z, h.w); o8[64 * j] = w; }
    }
    for (int u = gw; u < 64 * 64; u += NGW) {
        const int tc = u & 63, nc = u >> 6; const int t = tc * 64 + F.lane;
        float hreg[64];
#pragma unroll
        for (int j4 = 0; j4 < 16; ++j4) { const f32x4 q = *(const f32x4*)(F.HID2 + (size_t)t * 64 + 4 * j4); hreg[4 * j4] = q.x; hreg[4 * j4 + 1] = q.y; hreg[4 * j4 + 2] = q.z; hreg[4 * j4 + 3] = q.w; }
        const float tn = (float)t * (1.0f / (float)(SEQ - 1));
        for (int nn = 0; nn < 64; ++nn) {
            const int n = __builtin_amdgcn_readfirstlane(nc * 64 + nn);
            const float* wr = F.W3T + (size_t)n * 64;
            float a = 0.f;
#pragma unroll
            for (int j = 0; j < 64; ++j) a += hreg[j] * wr[j];
            const int c = n & (HW - 1);
            const float mind = -3.0701134573253945f, maxd = -15.350567286626972f;
            const float delta = fabsf(mind + (float)c * ((maxd - mind) / (float)(HW - 1)));
            F.KF[(size_t)n * SEQ + t] = a * expf(-tn * delta);
        }
    }
}

template <int NB, class LA, class LB, class EP>
__device__ __forceinline__ void simt_tile(LAS float* L, int K, int tid, const LA& la, const LB& lb, const EP& ep) {
    LAS float* As = L;
    LAS float* Bs = L + 32 * 68;
    const int ty = tid >> 4, tx = tid & 15;
    float acc[NB][2][4];
#pragma unroll
    for (int q = 0; q < NB; ++q)
#pragma unroll
        for (int i = 0; i < 2; ++i)
#pragma unroll
            for (int j = 0; j < 4; ++j) acc[q][i][j] = 0.f;
    for (int k0 = 0; k0 < K; k0 += 32) {
        __syncthreads();
        for (int e = tid; e < 64 * 32; e += NTHR) { const int r = e >> 5, kk = e & 31; As[kk * 68 + r] = la(r, k0 + kk); }
#pragma unroll
        for (int q = 0; q < NB; ++q)
            for (int e = tid; e < 32 * 64; e += NTHR) { const int kk = e >> 6, cc = e & 63; Bs[(q * 32 + kk) * 68 + cc] = lb(q, k0 + kk, cc); }
        __syncthreads();
#pragma unroll 8
        for (int kk = 0; kk < 32; ++kk) {
            const float a0 = As[kk * 68 + 2 * ty], a1 = As[kk * 68 + 2 * ty + 1];
#pragma unroll
            for (int q = 0; q < NB; ++q) { const f32x4 b = *(LAS f32x4*)(Bs + (q * 32 + kk) * 68 + 4 * tx);
                acc[q][0][0] += a0 * b.x; acc[q][0][1] += a0 * b.y; acc[q][0][2] += a0 * b.z; acc[q][0][3] += a0 * b.w;
                acc[q][1][0] += a1 * b.x; acc[q][1][1] += a1 * b.y; acc[q][1][2] += a1 * b.z; acc[q][1][3] += a1 * b.w; }
        }
    }
#pragma unroll
    for (int i = 0; i < 2; ++i)
#pragma unroll
        for (int j = 0; j < 4; ++j) { float v[NB];
#pragma unroll
            for (int q = 0; q < NB; ++q) v[q] = acc[q][i][j];
            ep(2 * ty + i, 4 * tx + j, v); }
}

struct EpiProj {
    static constexpr bool PERM = true, AFTER_DRAIN = false;
    bf16* QKVp; bf16* Gp; const float* ROT; const float* bias;
    __device__ __forceinline__ void operator()(const pg8::f32x4 (&acc)[2][2][4][2], const pg8::Unit& u, int wr, int wc, int fr, int fq) const {
        using namespace pg8;
        const int row0 = u.pm * BM + wr * 64 + fr;
        const int colt = u.pn * BM;
        if (colt < QKVW) {
            const bool rot = (colt < 2 * NH * HD) && (wc == 0);
#pragma unroll
            for (int ai = 0; ai < 2; ++ai)
#pragma unroll
                for (int m = 0; m < 4; ++m) { const int row = row0 + ai * HALF + m * 16;
                    bf16* rowp = QKVp + (size_t)row * QKVW + colt + wc * 32 + 8 * fq;
                    f32x4 cs0, cs1, sn0, sn1;
                    if (rot) { const float* rp = ROT + (size_t)row * 32 + 8 * (fq & 1); cs0 = *(const f32x4*)rp; cs1 = *(const f32x4*)(rp + 4); sn0 = *(const f32x4*)(rp + 16); sn1 = *(const f32x4*)(rp + 20); }
#pragma unroll
                    for (int bj = 0; bj < 2; ++bj) { f32x4 v0 = acc[ai][bj][m][0], v1 = acc[ai][bj][m][1];
                        if (rot) {
                            f32x4 o0, o1;
#pragma unroll
                            for (int j = 0; j < 4; ++j) { o0[j] = __shfl_xor(v0[j], 32); o1[j] = __shfl_xor(v1[j], 32); }
                            if (fq < 2) { v0 = v0 * cs0 - o0 * sn0; v1 = v1 * cs1 - o1 * sn1; }
                            else        { v0 = v0 * cs0 + o0 * sn0; v1 = v1 * cs1 + o1 * sn1; }
                        }
                        u32x4 w; w.x = cvt_pk_bf16(v0[0], v0[1]); w.y = cvt_pk_bf16(v0[2], v0[3]); w.z = cvt_pk_bf16(v1[0], v1[1]); w.w = cvt_pk_bf16(v1[2], v1[3]);
                        *(u32x4*)(rowp + bj * HALF) = w; } }
        } else {
            const int gc = colt - QKVW + wc * 32 + 8 * fq;
            f32x4 bv[2][2];
#pragma unroll
            for (int bj = 0; bj < 2; ++bj)
#pragma unroll
                for (int n = 0; n < 2; ++n) bv[bj][n] = *(const f32x4*)(bias + gc + bj * HALF + 4 * n);
#pragma unroll
            for (int ai = 0; ai < 2; ++ai)
#pragma unroll
                for (int m = 0; m < 4; ++m) { bf16* rowp = Gp + (size_t)(row0 + ai * HALF + m * 16) * (2 * D) + gc;
#pragma unroll
                    for (int bj = 0; bj < 2; ++bj) { f32x4 v0 = acc[ai][bj][m][0] + bv[bj][0], v1 = acc[ai][bj][m][1] + bv[bj][1];
#pragma unroll
                        for (int j = 0; j < 4; ++j) { v0[j] = 1.0f / (1.0f + __expf(-v0[j])); v1[j] = 1.0f / (1.0f + __expf(-v1[j])); }
                        u32x4 w; w.x = cvt_pk_bf16(v0[0], v0[1]); w.y = cvt_pk_bf16(v0[2], v0[3]); w.z = cvt_pk_bf16(v1[0], v1[1]); w.w = cvt_pk_bf16(v1[2], v1[3]);
                        *(u32x4*)(rowp + bj * HALF) = w; } }
        }
    }
};
struct EpiPlainBf16 {
    static constexpr bool PERM = true, AFTER_DRAIN = false;
    bf16* O; int ldc;
    __device__ __forceinline__ void operator()(const pg8::f32x4 (&acc)[2][2][4][2], const pg8::Unit& u, int wr, int wc, int fr, int fq) const {
        using namespace pg8;
        const int row0 = u.pm * BM + wr * 64 + fr, col0 = u.pn * BM + wc * 32 + 8 * fq;
#pragma unroll
        for (int ai = 0; ai < 2; ++ai)
#pragma unroll
            for (int m = 0; m < 4; ++m) { bf16* rowp = O + (size_t)(row0 + ai * HALF + m * 16) * ldc + col0;
#pragma unroll
                for (int bj = 0; bj < 2; ++bj) { const f32x4 v0 = acc[ai][bj][m][0], v1 = acc[ai][bj][m][1];
                    u32x4 w; w.x = cvt_pk_bf16(v0[0], v0[1]); w.y = cvt_pk_bf16(v0[2], v0[3]); w.z = cvt_pk_bf16(v1[0], v1[1]); w.w = cvt_pk_bf16(v1[2], v1[3]);
                    *(u32x4*)(rowp + bj * HALF) = w; } }
    }
};
template <int STAGE> struct EpiGate {
    static constexpr bool PERM = true, AFTER_DRAIN = false;
    const bf16* Gp; int goff; float* TMPp; bf16* Mp;
    __device__ __forceinline__ void operator()(const pg8::f32x4 (&acc)[2][2][4][2], const pg8::Unit& u, int wr, int wc, int fr, int fq) const {
        using namespace pg8;
        const int row0 = u.pm * BM + wr * 64 + fr, col0 = u.pn * BM + wc * 32 + 8 * fq;
#pragma unroll
        for (int ai = 0; ai < 2; ++ai)
#pragma unroll
            for (int m = 0; m < 4; ++m) { const size_t row = (size_t)(row0 + ai * HALF + m * 16);
#pragma unroll
                for (int bj = 0; bj < 2; ++bj) { const int col = col0 + bj * HALF;
                    const u32x4 gw = *(const u32x4*)(Gp + row * (2 * D) + goff + col);
                    f32x4 g0 = {bflo(gw.x), bfhi(gw.x), bflo(gw.y), bfhi(gw.y)}, g1 = {bflo(gw.z), bfhi(gw.z), bflo(gw.w), bfhi(gw.w)};
                    f32x4 v0 = acc[ai][bj][m][0] * g0, v1 = acc[ai][bj][m][1] * g1;
                    float* tp = TMPp + row * D + col;
                    if (STAGE == 0) { *(f32x4*)tp = v0; *(f32x4*)(tp + 4) = v1; }
                    else { v0 += *(const f32x4*)tp; v1 += *(const f32x4*)(tp + 4);
                        u32x4 w; w.x = cvt_pk_bf16(v0[0], v0[1]); w.y = cvt_pk_bf16(v0[2], v0[3]); w.z = cvt_pk_bf16(v1[0], v1[1]); w.w = cvt_pk_bf16(v1[2], v1[3]);
                        *(u32x4*)(Mp + row * D + col) = w; } } }
    }
};
struct EpiF32 {
    static constexpr bool PERM = false, AFTER_DRAIN = false;
    float* C; int ldc;
    __device__ __forceinline__ void operator()(const pg8::f32x4 (&acc)[2][2][4][2], const pg8::Unit& u, int wr, int wc, int fr, int fq) const {
        using namespace pg8;
        const int row0 = u.pm * BM + wr * 64 + fr, col0 = u.pn * BM + wc * 32 + 4 * fq;
#pragma unroll
        for (int ai = 0; ai < 2; ++ai)
#pragma unroll
            for (int m = 0; m < 4; ++m) { float* rowp = C + (size_t)(row0 + ai * HALF + m * 16) * ldc + col0;
#pragma unroll
                for (int bj = 0; bj < 2; ++bj)
#pragma unroll
                    for (int n = 0; n < 2; ++n) *(f32x4*)(rowp + bj * HALF + n * 16) = acc[ai][bj][m][n]; }
    }
};

template <class Epi>
__device__ __forceinline__ void run_gemm(Frame& F, const bf16* A, const bf16* Bt, int M, int N, int K, const Epi& E) {
    pg8::Gemm g{A, Bt, M, N, K}; pg8::StaticOrder S; S.init(M, N, F.G, F.bid);
    pg8::gemm_phase<Epi, pg8::StaticOrder, true, true>(F.lds, g, S, E);
}

__device__ __forceinline__ float sconv_at(const bf16* rowp, int t, float w0, float w1, float w2, float bias) {
    const float um = t > 0 ? bf2f(rowp[t - 1]) : 0.f, u0 = bf2f(rowp[t]), up = t < SEQ - 1 ? bf2f(rowp[t + 1]) : 0.f;
    return um * w0 + u0 * w1 + up * w2 + bias;
}
__device__ __forceinline__ void conv8(const LAS float* kk, const LAS float* z, int t0, float (&acc)[2][8]) {
#pragma unroll
    for (int b = 0; b < 2; ++b)
#pragma unroll
        for (int j = 0; j < 8; ++j) acc[b][j] = 0.f;
    for (int s8 = 0; s8 < SEQ; s8 += 8) {
        const int base = t0 - s8 + (SEQ - 1);
        float kw[15];
#pragma unroll
        for (int i = 0; i < 15; ++i) kw[i] = kk[base - 7 + i];
        float zz[2][8];
#pragma unroll
        for (int b = 0; b < 2; ++b) { const f32x4 q0 = *(const LAS f32x4*)(z + b * SEQ + s8), q1 = *(const LAS f32x4*)(z + b * SEQ + s8 + 4);
            zz[b][0] = q0.x; zz[b][1] = q0.y; zz[b][2] = q0.z; zz[b][3] = q0.w; zz[b][4] = q1.x; zz[b][5] = q1.y; zz[b][6] = q1.z; zz[b][7] = q1.w; }
#pragma unroll
        for (int ds = 0; ds < 8; ++ds)
#pragma unroll
            for (int j = 0; j < 8; ++j) { const float k = kw[7 + j - ds]; acc[0][j] += k * zz[0][ds]; acc[1][j] += k * zz[1][ds]; }
    }
}
__device__ __forceinline__ void p3_hyena_naive(Frame& F) {
    LAS float* L = (LAS float*)F.lds;
    LAS float* zin = L;
    LAS float* kk = L + 2 * SEQ;
    LAS float* zmid = L + 4 * SEQ;
    for (int c = F.bid; c < HW; c += F.G) {
        __syncthreads();
        const float cw[3][3] = {{F.conv_w[c], F.conv_w[3 * HW + c], F.conv_w[6 * HW + c]},
                                {F.conv_w[HW + c], F.conv_w[3 * HW + HW + c], F.conv_w[6 * HW + HW + c]},
                                {F.conv_w[2 * HW + c], F.conv_w[3 * HW + 2 * HW + c], F.conv_w[6 * HW + 2 * HW + c]}};
        const float cb[3] = {F.conv_b[c], F.conv_b[HW + c], F.conv_b[2 * HW + c]};
        const bf16* pv = F.PHY + (size_t)c * T; const bf16* px1 = F.PHY + (size_t)(HW + c) * T; const bf16* px2 = F.PHY + (size_t)(2 * HW + c) * T;
        for (int i = F.tid; i < T; i += NTHR) { const int b = i / SEQ, t = i % SEQ; zin[i] = sconv_at(pv + b * SEQ, t, cw[0][0], cw[0][1], cw[0][2], cb[0]); }
        for (int i = F.tid; i < 2 * SEQ; i += NTHR) { const int d = i - (SEQ - 1);
            kk[i] = (i == 2 * SEQ - 1) ? 0.f : (d >= 0 ? F.KF[(size_t)(0 * HW + c) * SEQ + d] : F.KF[(size_t)(1 * HW + c) * SEQ - d]); }
        __syncthreads();
        const int t0 = F.tid * 8; float acc[2][8];
        conv8(kk, zin, t0, acc);
        const float sk0 = F.hskip[c], sk1 = F.hskip[HW + c];
#pragma unroll
        for (int b = 0; b < 2; ++b)
#pragma unroll
            for (int j = 0; j < 8; ++j) { const float x1 = sconv_at(px1 + b * SEQ, t0 + j, cw[1][0], cw[1][1], cw[1][2], cb[1]);
                zmid[b * SEQ + t0 + j] = x1 * (acc[b][j] + sk0 * zin[b * SEQ + t0 + j]); }
        __syncthreads();
        for (int i = F.tid; i < 2 * SEQ; i += NTHR) { const int d = i - (SEQ - 1);
            kk[i] = (i == 2 * SEQ - 1) ? 0.f : (d >= 0 ? F.KF[(size_t)(2 * HW + c) * SEQ + d] : F.KF[(size_t)(3 * HW + c) * SEQ - d]); }
        __syncthreads();
        conv8(kk, zmid, t0, acc);
#pragma unroll
        for (int b = 0; b < 2; ++b)
#pragma unroll
            for (int j = 0; j < 8; ++j) { const float x2 = sconv_at(px2 + b * SEQ, t0 + j, cw[2][0], cw[2][1], cw[2][2], cb[2]);
                const float z2 = x2 * (acc[b][j] + sk1 * zmid[b * SEQ + t0 + j]);
                F.YHY[(size_t)(b * SEQ + t0 + j) * HW + c] = (bf16)f2bf(z2); }
    }
}
__device__ __forceinline__ void p3_attn_naive(Frame& F) {
    LAS float* qs = (LAS float*)F.lds + F.wave * 128;
    const int gw = F.bid * NWAVES + F.wave, NGW = F.G * NWAVES;
    const float scale = 0.08838834764831845f;
    for (int u = gw; u < T * 4; u += NGW) {
        const int m = u >> 2, hh = u & 3, b = m / SEQ, s = m % SEQ;
        float Mrun = -3.0e38f, Lrun = 0.f, o0 = 0.f, o1 = 0.f;
#pragma unroll 1
        for (int g = 0; g < 3; ++g) {
            const int head = g * 4 + hh, dil = (g == 0) ? 1 : (g == 1 ? 4 : 16);
            const bf16* qp = F.QKV + (size_t)m * QKVW + head * HD;
            { const unsigned qq = *(const unsigned*)(qp + 2 * F.lane); qs[2 * F.lane] = bflo(qq); qs[2 * F.lane + 1] = bfhi(qq); }
            asm volatile("s_waitcnt lgkmcnt(0)" ::: "memory");
            float sc[3];
#pragma unroll
            for (int p = 0; p < 3; ++p) {
                const int j = (p == 0) ? F.lane - 64 : (p == 1 ? F.lane : 64);
                const int ks = s + j * dil; const bool valid = (ks >= 0) && (ks < SEQ) && (p < 2 || F.lane == 0);
                float dot = 0.f;
                if (valid) { const v4u* kp = (const v4u*)(F.QKV + (size_t)(b * SEQ + ks) * QKVW + NH * HD + head * HD);
#pragma unroll 4
                    for (int c8 = 0; c8 < 16; ++c8) { const v4u kv = kp[c8]; const LAS float* q8 = qs + 8 * c8;
                        dot += bflo(kv.x) * q8[0] + bfhi(kv.x) * q8[1] + bflo(kv.y) * q8[2] + bfhi(kv.y) * q8[3] + bflo(kv.z) * q8[4] + bfhi(kv.z) * q8[5] + bflo(kv.w) * q8[6] + bfhi(kv.w) * q8[7]; } }
                sc[p] = valid ? dot * scale : -1.0e30f;
            }
            const float mg = wave_max(fmaxf(fmaxf(sc[0], sc[1]), sc[2]));
            const float mnew = fmaxf(Mrun, mg), resc = __expf(Mrun - mnew);
            float pr[3];
#pragma unroll
            for (int p = 0; p < 3; ++p) pr[p] = (sc[p] > -1.0e29f) ? __expf(sc[p] - mnew) : 0.f;
            Lrun = Lrun * resc + wave_sum(pr[0] + pr[1] + pr[2]); o0 *= resc; o1 *= resc; Mrun = mnew;
            const bf16* vbase = F.QKV + 2 * NH * HD + head * HD + 2 * F.lane;
            for (int jj = 0; jj < 129; ++jj) {
                const int j = jj - 64, ks = s + j * dil;
                if (ks < 0 || ks >= SEQ) continue;
                const float pk = (jj < 64) ? __shfl(pr[0], jj) : (jj < 128 ? __shfl(pr[1], jj - 64) : __shfl(pr[2], 0));
                const unsigned vv = *(const unsigned*)(vbase + (size_t)(b * SEQ + ks) * QKVW);
                o0 += pk * bflo(vv); o1 += pk * bfhi(vv);
            }
        }
        const float inv = 1.0f / Lrun;
        *(unsigned*)(F.YAT + (size_t)m * 512 + hh * HD + 2 * F.lane) = pk2(o0 * inv, o1 * inv);
    }
}

__device__ __forceinline__ void p6_rows_router(Frame& F) {
    LAS float* L = (LAS float*)F.lds;
    LAS float* gatem = L, *shiftf = L + 2 * D, *scalef = L + 4 * D;
    load_mod(F, gatem, 2); load_mod(F, shiftf, 3); load_mod(F, scalef, 4);
    __syncthreads();
    const int gw = F.bid * NWAVES + F.wave, NGW = F.G * NWAVES;
    LAS float* hs = L + 6 * D + F.wave * D;
    for (int m = gw; m < T; m += NGW) {
        const int b = m / SEQ;
        const f32x4* yr = (const f32x4*)(F.Y + (size_t)m * D) + F.lane; const f32x4* xr = (const f32x4*)(F.x + (size_t)m * D) + F.lane;
        f32x4 v[8]; float s = 0.f;
#pragma unroll
        for (int j = 0; j < 8; ++j) { v[j] = yr[64 * j]; s += (v[j].x * v[j].x + v[j].y * v[j].y) + (v[j].z * v[j].z + v[j].w * v[j].w); }
        const float rstd = 1.0f / sqrtf(wave_sum(s) * (1.f / D) + RMS_EPS);
        float s1 = 0.f;
        f32x4* x1r = (f32x4*)(F.X1 + (size_t)m * D) + F.lane;
#pragma unroll
        for (int j = 0; j < 8; ++j) { const int d = 256 * j + 4 * F.lane;
            const f32x4 g = *(const f32x4*)(F.g_mix_post + d), gm = *(LAS f32x4*)(gatem + b * D + d);
            const f32x4 x1 = xr[64 * j] + gm * ((v[j] * rstd) * g);
            x1r[64 * j] = x1; v[j] = x1; s1 += (x1.x * x1.x + x1.y * x1.y) + (x1.z * x1.z + x1.w * x1.w); }
        const float rstd1 = 1.0f / sqrtf(wave_sum(s1) * (1.f / D) + RMS_EPS);
        v2u* o8 = (v2u*)(F.H2 + (size_t)m * D) + F.lane;
#pragma unroll
        for (int j = 0; j < 8; ++j) { const int d = 256 * j + 4 * F.lane;
            const f32x4 g = *(const f32x4*)(F.g_ffn_pre + d), sc = *(LAS f32x4*)(scalef + b * D + d), sh = *(LAS f32x4*)(shiftf + b * D + d);
            f32x4 h = (v[j] * rstd1) * g; h = h * (sc + 1.0f) + sh; *(LAS f32x4*)(hs + d) = h;
            v2u w; w.x = pk2(h.x, h.y); w.y = pk2(h.z, h.w); o8[64 * j] = w; }
        asm volatile("s_waitcnt lgkmcnt(0)" ::: "memory");
        float gl[8];
#pragma unroll
        for (int g = 0; g < 8; ++g) gl[g] = 0.f;
#pragma unroll 1
        for (int j = 0; j < 8; ++j) { const int d0 = 256 * j + 4 * F.lane; const f32x4 hq = *(LAS f32x4*)(hs + d0); const float* wp = F.w_group + (size_t)d0 * 8;
#pragma unroll
            for (int e = 0; e < 4; ++e) { const f32x4 w0 = *(const f32x4*)(wp + e * 8), w1 = *(const f32x4*)(wp + e * 8 + 4); const float hv = hq[e];
                gl[0] += hv * w0.x; gl[1] += hv * w0.y; gl[2] += hv * w0.z; gl[3] += hv * w0.w; gl[4] += hv * w1.x; gl[5] += hv * w1.y; gl[6] += hv * w1.z; gl[7] += hv * w1.w; } }
        float gmax = -3.0e38f; int gi = 0;
#pragma unroll
        for (int g = 0; g < 8; ++g) { gl[g] = wave_sum(gl[g]) + F.b_group[g]; if (gl[g] > gmax) { gmax = gl[g]; gi = g; } }
        float gden = 0.f;
#pragma unroll
        for (int g = 0; g < 8; ++g) gden += expf(gl[g] - gmax);
        const float gval = 1.0f / gden;
        gi = __builtin_amdgcn_readfirstlane(gi);
        const float* we = F.w_expert + (size_t)gi * D * 8;
        float el[8];
#pragma unroll
        for (int g = 0; g < 8; ++g) el[g] = 0.f;
#pragma unroll 1
        for (int j = 0; j < 8; ++j) { const int d0 = 256 * j + 4 * F.lane; const f32x4 hq = *(LAS f32x4*)(hs + d0); const float* wp = we + (size_t)d0 * 8;
#pragma unroll
            for (int e = 0; e < 4; ++e) { const f32x4 w0 = *(const f32x4*)(wp + e * 8), w1 = *(const f32x4*)(wp + e * 8 + 4); const float hv = hq[e];
                el[0] += hv * w0.x; el[1] += hv * w0.y; el[2] += hv * w0.z; el[3] += hv * w0.w; el[4] += hv * w1.x; el[5] += hv * w1.y; el[6] += hv * w1.z; el[7] += hv * w1.w; } }
        float e0v = -3.0e38f, e1v = -3.0e38f; int e0i = 0, e1i = 0;
#pragma unroll
        for (int g = 0; g < 8; ++g) { el[g] = wave_sum(el[g]) + F.b_expert[gi * 8 + g];
            if (el[g] > e0v) { e1v = e0v; e1i = e0i; e0v = el[g]; e0i = g; } else if (el[g] > e1v) { e1v = el[g]; e1i = g; } }
        const float p1 = expf(e1v - e0v), den = 1.0f + p1;
        const float gate0 = gval / den, gate1 = gval * p1 / den;
        if (F.lane == 0) {
            const int ex0 = gi * 8 + e0i, ex1 = gi * 8 + e1i;
            const unsigned pos0 = atomicAdd(F.ctl + CW_CNT + ex0, 1u), pos1 = atomicAdd(F.ctl + CW_CNT + ex1, 1u);
            F.LISTT[ex0 * T + pos0] = m; F.LISTG[ex0 * T + pos0] = gate0;
            F.LISTT[ex1 * T + pos1] = m; F.LISTG[ex1 * T + pos1] = gate1;
            F.ROUTE[m * 4 + 0] = (unsigned)(ex0 * T) + pos0; F.ROUTE[m * 4 + 1] = (unsigned)(ex1 * T) + pos1;
        }
    }
}

__device__ __forceinline__ void moe_offsets(Frame& F, LAS int* offs  , LAS int* toff  ) {
    if (F.tid == 0) { int a = 0, tacc = 0; for (int e = 0; e < NE; ++e) { offs[e] = a; toff[e] = tacc; const int n = (int)__hip_atomic_load(F.ctl + CW_CNT + e, __ATOMIC_RELAXED, __HIP_MEMORY_SCOPE_AGENT); a += n; tacc += (n + 63) / 64; } offs[NE] = a; toff[NE] = tacc; }
    __syncthreads();
}
__device__ __forceinline__ void p7_moe1(Frame& F) {
    LAS float* L = (LAS float*)F.lds;
    LAS int* offs = (LAS int*)(L + 8192 * 3); LAS int* toff = offs + 80;
    moe_offsets(F, offs, toff);
    const int ntiles = toff[NE];
    for (int u = F.bid; u < ntiles * 8; u += F.G) {
        const int rt = u >> 3, ct = u & 7;
        int e = 0; while (toff[e + 1] <= rt) ++e;
        const int r0 = (rt - toff[e]) * 64, ne = offs[e + 1] - offs[e];
        const int* lt = F.LISTT + e * T + r0;
        const float* W1 = F.w1e + (size_t)e * D * FF + ct * 64; const float* W3 = F.w3e + (size_t)e * D * FF + ct * 64;
        const bf16* H2 = F.H2;
        auto la = [&](int r, int k) -> float { return (r0 + r < ne) ? bf2f(H2[(size_t)lt[r] * D + k]) : 0.f; };
        auto lb = [&](int q, int k, int c) -> float { return (q == 0 ? W1 : W3)[(size_t)k * FF + c]; };
        float* ACT = F.ACT + (size_t)(offs[e] + r0) * FF + ct * 64;
        auto ep = [&](int r, int c, const float (&v)[2]) { if (r0 + r < ne) { const float a = v[0], bb = v[1]; ACT[(size_t)r * FF + c] = (a / (1.0f + __expf(-a))) * bb; } };
        simt_tile<2>(L, D, F.tid, la, lb, ep);
    }
}
__device__ __forceinline__ void p8_moe2(Frame& F) {
    LAS float* L = (LAS float*)F.lds;
    LAS int* offs = (LAS int*)(L + 8192 * 3); LAS int* toff = offs + 80;
    moe_offsets(F, offs, toff);
    const int ntiles = toff[NE];
    for (int u = F.bid; u < ntiles * 32; u += F.G) {
        const int rt = u >> 5, ct = u & 31;
        int e = 0; while (toff[e + 1] <= rt) ++e;
        const int r0 = (rt - toff[e]) * 64, ne = offs[e + 1] - offs[e];
        const float* A = F.ACT + (size_t)(offs[e] + r0) * FF;
        const float* W2 = F.w2e + (size_t)e * FF * D + ct * 64;
        const float* lg = F.LISTG + e * T + r0;
        auto la = [&](int r, int k) -> float { return (r0 + r < ne) ? A[(size_t)r * FF + k] : 0.f; };
        auto lb = [&](int q, int k, int c) -> float { return W2[(size_t)k * D + c]; };
        float* YB = F.YB + (size_t)(offs[e] + r0) * D + ct * 64;
        auto ep = [&](int r, int c, const float (&v)[1]) { if (r0 + r < ne) YB[(size_t)r * D + c] = v[0] * lg[r]; };
        simt_tile<1>(L, FF, F.tid, la, lb, ep);
    }
}
__device__ __forceinline__ void p9_final(Frame& F) {
    LAS float* L = (LAS float*)F.lds;
    LAS float* gatef = L;
    LAS int* offs = (LAS int*)(L + 8192 * 3); LAS int* toff = offs + 80;
    load_mod(F, gatef, 5);
    moe_offsets(F, offs, toff);
    const int gw = F.bid * NWAVES + F.wave, NGW = F.G * NWAVES;
    for (int m = gw; m < T; m += NGW) {
        const int b = m / SEQ;
        const unsigned s0 = F.ROUTE[m * 4 + 0], s1 = F.ROUTE[m * 4 + 1];
        const size_t r0 = (size_t)offs[s0 / T] + (s0 % T), r1 = (size_t)offs[s1 / T] + (s1 % T);
        const f32x4* y0 = (const f32x4*)(F.YB + r0 * D) + F.lane; const f32x4* y1 = (const f32x4*)(F.YB + r1 * D) + F.lane;
        f32x4 v[8]; float s = 0.f;
#pragma unroll
        for (int j = 0; j < 8; ++j) { v[j] = y0[64 * j] + y1[64 * j]; s += (v[j].x * v[j].x + v[j].y * v[j].y) + (v[j].z * v[j].z + v[j].w * v[j].w); }
        const float rstd = 1.0f / sqrtf(wave_sum(s) * (1.f / D) + RMS_EPS);
        const f32x4* x1r = (const f32x4*)(F.X1 + (size_t)m * D) + F.lane; f32x4* outr = (f32x4*)(F.out + (size_t)m * D) + F.lane;
#pragma unroll
        for (int j = 0; j < 8; ++j) { const int d = 256 * j + 4 * F.lane;
            const f32x4 g = *(const f32x4*)(F.g_ffn_post + d), gf = *(LAS f32x4*)(gatef + b * D + d);
            outr[64 * j] = x1r[64 * j] + gf * ((v[j] * rstd) * g); }
    }
}

#if SIMPLE_GEMM
template <class EP>
__device__ __forceinline__ void simple_gemm(Frame& F, const bf16* A, const bf16* Bt, int M, int N, int K, const EP& ep) {
    LAS float* L = (LAS float*)F.lds;
    const int tn = N / 64, nt = (M / 64) * tn;
    for (int u = F.bid; u < nt; u += F.G) {
        const int r0 = (u / tn) * 64, c0 = (u % tn) * 64;
        auto la = [&](int r, int k) -> float { return bf2f(A[(size_t)(r0 + r) * K + k]); };
        auto lb = [&](int q, int k, int c) -> float { return bf2f(Bt[(size_t)(c0 + c) * K + k]); };
        auto e2 = [&](int r, int c, const float (&v)[1]) { ep(r0 + r, c0 + c, v[0]); };
        simt_tile<1>(L, K, F.tid, la, lb, e2);
    }
}
#endif

__global__ void __launch_bounds__(NTHR, 2) fwd_kernel(Args args) {
    extern __shared__ __attribute__((aligned(16))) unsigned char lds_raw[];
    Frame F;
    F.lds = (LAS unsigned char*)lds_raw;
    F.tid = threadIdx.x; F.lane = F.tid & 63; F.wave = __builtin_amdgcn_readfirstlane(F.tid >> 6); F.G = gridDim.x; F.bid = blockIdx.x;
    F.x = (const float*)args.in[0]; F.c = (const float*)args.in[1]; F.positions = (const int*)args.in[2]; F.w_ada = (const float*)args.in[3]; F.b_ada = (const float*)args.in[4];
    F.g_mix_pre = (const float*)args.in[5]; F.g_mix_post = (const float*)args.in[6]; F.g_ffn_pre = (const float*)args.in[7]; F.g_ffn_post = (const float*)args.in[8];
    F.w_in = (const float*)args.in[9]; F.conv_w = (const float*)args.in[10]; F.conv_b = (const float*)args.in[11]; F.fw1 = (const float*)args.in[12]; F.fb1 = (const float*)args.in[13];
    F.fw2 = (const float*)args.in[14]; F.fb2 = (const float*)args.in[15]; F.fw3 = (const float*)args.in[16]; F.ffreq = (const float*)args.in[17]; F.hskip = (const float*)args.in[18];
    F.w_bg = (const float*)args.in[19]; F.b_bg = (const float*)args.in[20]; F.w_hy_o = (const float*)args.in[21]; F.w_at_o = (const float*)args.in[22]; F.w_out = (const float*)args.in[23];
    F.w_group = (const float*)args.in[24]; F.b_group = (const float*)args.in[25]; F.w_expert = (const float*)args.in[26]; F.b_expert = (const float*)args.in[27];
    F.w1e = (const float*)args.in[28]; F.w3e = (const float*)args.in[29]; F.w2e = (const float*)args.in[30];
    F.out = args.out;
    unsigned char* ws = args.ws;
    F.ctl = (unsigned*)(ws + WS_CTL); F.MODP = (float*)(ws + WS_MODP); F.HID2 = (float*)(ws + WS_HID2); F.ROT = (float*)(ws + WS_ROT); F.W3T = (float*)(ws + WS_W3T);
    F.ROUTE = (unsigned*)(ws + WS_ROUTE); F.LISTT = (int*)(ws + WS_LISTT); F.LISTG = (float*)(ws + WS_LISTG);
    F.W1T = (bf16*)(ws + WS_W1T); F.WHYOT = (bf16*)(ws + WS_WHYOT); F.WATOT = (bf16*)(ws + WS_WATOT); F.WOUTT = (bf16*)(ws + WS_WOUTT);
    F.KF = (float*)(ws + WS_KF); F.H = (bf16*)(ws + WS_H); F.PHY = (bf16*)(ws + WS_PHY); F.QKV = (bf16*)(ws + WS_QKV); F.GT = (bf16*)(ws + WS_G);
    F.YHY = (bf16*)(ws + WS_YHY); F.YAT = (bf16*)(ws + WS_YAT); F.TMP = (float*)(ws + WS_TMP); F.MERGED = (bf16*)(ws + WS_MERGED); F.Y = (float*)(ws + WS_Y);
    F.X1 = (float*)(ws + WS_X1); F.H2 = (bf16*)(ws + WS_H2); F.ACT = (float*)(ws + WS_ACT); F.YB = (float*)(ws + WS_YB);

    volatile LAS unsigned* MISC = (volatile LAS unsigned*)(F.lds + MISC_OFF);
    if (F.tid < 32) MISC[F.tid] = 0u;
    __syncthreads();
    const int lo = args.ph_lo, hi = args.ph_hi;
    const bool multi = (hi - lo) > 1;
    XcdBarrier bar; bar.bar = F.ctl + CW_BAR; bar.x = 0; bar.st = nullptr;
    if (multi) bar = xcd_barrier_post(F.ctl + CW_BAR, MISC + 8);
#ifndef PHASE_MASK
#define PHASE_MASK 0xFFFF
#endif
#define IN(k) ((((PHASE_MASK) >> (k)) & 1) && lo <= (k) && (k) < hi)
#define SEAM(k) do { if (IN(k) && IN((k) + 1)) xcd_barrier(bar); } while (0)

    if (IN(0)) { p0_prologue(F); } SEAM(0);
    if (IN(1)) { p1_rows_filters(F); } SEAM(1);
    if (IN(2)) {
#if SIMPLE_GEMM
        { bf16* PHY = F.PHY; simple_gemm(F, F.W1T, F.H, 3 * HW, T, D, [&](int r, int c, float v) { PHY[(size_t)r * T + c] = (bf16)f2bf(v); }); }
        __syncthreads();
        { bf16* QKVp = F.QKV; bf16* Gp = F.GT; const float* bias = F.b_bg;
          simple_gemm(F, F.H, F.W1T + (size_t)(3 * HW) * D, T, QKVW + 2 * D, D, [&](int r, int c, float v) {
              if (c < QKVW) QKVp[(size_t)r * QKVW + c] = (bf16)f2bf(v); else Gp[(size_t)r * (2 * D) + (c - QKVW)] = (bf16)f2bf(1.0f / (1.0f + __expf(-(v + bias[c - QKVW])))); }); }
#else
        { EpiPlainBf16 E{F.PHY, T}; run_gemm(F, F.W1T, F.H, 3 * HW, T, D, E); }
        { EpiProj E{F.QKV, F.GT, F.ROT, F.b_bg}; run_gemm(F, F.H, F.W1T + (size_t)(3 * HW) * D, T, QKVW + 2 * D, D, E); }
#endif
    } SEAM(2);
    if (IN(3)) {
#if SIMPLE_GEMM
        for (int i = F.bid * NTHR + F.tid; i < T * 24 * 16; i += F.G * NTHR) { const int k = i & 15, hd = (i >> 4) % 24, tok = (i >> 4) / 24;
            bf16* p = F.QKV + (size_t)tok * QKVW + hd * HD; const float a = bf2f(p[k]), b2 = bf2f(p[k + 16]), cs = F.ROT[tok * 32 + k], sn = F.ROT[tok * 32 + 16 + k];
            p[k] = (bf16)f2bf(a * cs - b2 * sn); p[k + 16] = (bf16)f2bf(b2 * cs + a * sn); }
#endif
    } SEAM(3);
    if (IN(4)) { p3_hyena_naive(F); __syncthreads(); p3_attn_naive(F); } SEAM(4);
    if (IN(5)) {
#if SIMPLE_GEMM
        { float* TMP = F.TMP; const bf16* G = F.GT; simple_gemm(F, F.YHY, F.WHYOT, T, D, HW, [&](int r, int c, float v) { TMP[(size_t)r * D + c] = v * bf2f(G[(size_t)r * (2 * D) + c]); }); }
        __syncthreads();
        { float* TMP = F.TMP; const bf16* G = F.GT; bf16* Mp = F.MERGED; simple_gemm(F, F.YAT, F.WATOT, T, D, 512, [&](int r, int c, float v) { Mp[(size_t)r * D + c] = (bf16)f2bf(TMP[(size_t)r * D + c] + v * bf2f(G[(size_t)r * (2 * D) + D + c])); }); }
#else
        { EpiGate<0> E{F.GT, 0, F.TMP, F.MERGED}; run_gemm(F, F.YHY, F.WHYOT, T, D, HW, E); }
        { EpiGate<1> E{F.GT, D, F.TMP, F.MERGED}; run_gemm(F, F.YAT, F.WATOT, T, D, 512, E); }
#endif
    } SEAM(5);
    if (IN(6)) {
#if SIMPLE_GEMM
        { float* Y = F.Y; simple_gemm(F, F.MERGED, F.WOUTT, T, D, D, [&](int r, int c, float v) { Y[(size_t)r * D + c] = v; }); }
#else
        { EpiF32 E{F.Y, D}; run_gemm(F, F.MERGED, F.WOUTT, T, D, D, E); }
#endif
    } SEAM(6);
    if (IN(7)) { p6_rows_router(F); } SEAM(7);
    if (IN(8)) { p7_moe1(F); } SEAM(8);
    if (IN(9)) { p8_moe2(F); } SEAM(9);
    if (IN(10)) { p9_final(F); }
#undef IN
#undef SEAM
}

extern "C" void kernel_launch(void* const* d_in, const int* in_sizes, int n_in, void* d_out, int out_size, void* d_ws, size_t ws_size, hipStream_t stream) {
    static int grid = 0;
    if (grid == 0) {
        if (n_in != 31 || out_size != T * D || ws_size < WS_END) { fprintf(stderr, "kernel_launch: unexpected shapes (n_in %d out %d ws %zu)\n", n_in, out_size, ws_size); grid = -1; return; }
        int dev = 0, cus = 0, per_cu = 0;
        if (hipGetDevice(&dev) != hipSuccess || hipDeviceGetAttribute(&cus, hipDeviceAttributeMultiprocessorCount, dev) != hipSuccess) { grid = -1; return; }
        if (hipFuncSetAttribute((const void*)fwd_kernel, hipFuncAttributeMaxDynamicSharedMemorySize, LDS_BYTES) != hipSuccess) { fprintf(stderr, "kernel_launch: hipFuncSetAttribute failed\n"); grid = -1; return; }
        if (hipOccupancyMaxActiveBlocksPerMultiprocessor(&per_cu, (const void*)fwd_kernel, NTHR, LDS_BYTES) != hipSuccess || per_cu < 1) fprintf(stderr, "kernel_launch: occupancy query says %d\n", per_cu);
        (void)hipGetLastError();
        grid = cus;
    }
    if (grid < 0) return;
    if (hipMemsetAsync((char*)d_ws + WS_CTL, 0, CTL_ZERO_BYTES, stream) != hipSuccess) return;
    Args a{};
    for (int i = 0; i < 31; ++i) a.in[i] = d_in[i];
    a.out = (float*)d_out; a.ws = (unsigned char*)d_ws;
#if N_LAUNCH_MODE == 1
    a.ph_lo = 0; a.ph_hi = NPHASE;
    hipLaunchKernelGGL(fwd_kernel, dim3(grid), dim3(NTHR), LDS_BYTES, stream, a);
#else
    for (int p = 0; p < NPHASE; ++p) { if (p == 3 && !SIMPLE_GEMM) continue; a.ph_lo = p; a.ph_hi = p + 1; hipLaunchKernelGGL(fwd_kernel, dim3(grid), dim3(NTHR), LDS_BYTES, stream, a); }
#endif
}
```

```cpp
#include <hip/hip_runtime.h>
#include <cstdio>
#include <cstdint>
namespace pg8 {
#define PG8_LAS __attribute__((address_space(3)))
typedef unsigned short bf16_t;
typedef short bf16x8 __attribute__((ext_vector_type(8)));
typedef float f32x4 __attribute__((ext_vector_type(4)));
typedef unsigned u32x4 __attribute__((ext_vector_type(4)));
constexpr int BM = 256, BK = 64, HALF = 128, HTB = HALF * BK * 2  , STAGE_BYTES = 8 * HTB, NXCD = 8, WGM = 8;

__host__ __device__ __forceinline__ int lds_byte(int r, int c) { const int st = (r >> 4) * 2 + (c >> 5), rr = r & 15, cc = c & 31, ob = rr * 64 + cc * 2; return st * 1024 + (ob ^ (((ob >> 9) & 1) << 5)); }
__host__ __device__ __forceinline__ void stage_rc(int b, int& R, int& C) { const int st = b / 1024, sb = b % 1024, swz = sb ^ (((sb >> 9) & 1) << 5); R = (st >> 1) * 16 + swz / 64; C = (st & 1) * 32 + (swz % 64) / 2; }
__host__ __device__ __forceinline__ int perm32(int rho) { const int n = rho >> 4, i = rho & 15; return 8 * (i >> 2) + 4 * n + (i & 3); }

struct Unit { int pm, pn; };
struct Gemm { const bf16_t* A; const bf16_t* Bt; int M, N, K; };

struct StaticOrder {
    int nM, nN, nwg, G, c;
    __host__ __device__ void init(int M, int N, int G_, int c_) { nM = M / BM; nN = N / BM; nwg = nM * nN; G = G_; c = c_; }
    __host__ __device__ bool next(int i, Unit& u) const {
        const long L = (long)i * G + c; if (L >= nwg) return false;
        int wgid = (int)L; { const int q = nwg / NXCD, r = nwg % NXCD, xcd = wgid % NXCD, off = wgid / NXCD; wgid = (xcd < r ? xcd * (q + 1) : r * (q + 1) + (xcd - r) * q) + off; }
        const int nig = WGM * nN, gid = wgid / nig, fm = gid * WGM, gsz = (nM - fm) < WGM ? (nM - fm) : WGM;
        u.pm = fm + ((wgid % nig) % gsz); u.pn = (wgid % nig) / gsz; return true;
    }
    __device__ __forceinline__ void a_ready(const Unit&) const {}
    __device__ __forceinline__ void done(const Unit&) const {}
};

__device__ __forceinline__ unsigned cvt_pk_bf16(float lo, float hi) { unsigned r; asm volatile("v_cvt_pk_bf16_f32 %0, %1, %2" : "=v"(r) : "v"(lo), "v"(hi)); return r; }
typedef float f32x2 __attribute__((ext_vector_type(2)));
template <class Epi, class Sched, bool ALIGN_EPI = false, bool SP2 = false>
__device__ __forceinline__ void gemm_phase(PG8_LAS unsigned char* lds, const Gemm g, const Sched& S, const Epi& E) {
    const int tid = threadIdx.x, wid = __builtin_amdgcn_readfirstlane(tid >> 6), lane = tid & 63, wr = wid >> 2, wc = wid & 3, fr = lane & 15, fq = lane >> 4;
    const int K = g.K, nt = K / BK;
    unsigned voffA[2], voffB[2];
#pragma unroll
    for (int i = 0; i < 2; ++i) { int R, C; stage_rc(tid * 16 + i * 8192, R, C); const int Rb = Epi::PERM ? ((R & ~31) + perm32(R & 31)) : R;
        voffA[i] = (unsigned)(R * K + C) * 2u; voffB[i] = (unsigned)(Rb * K + C) * 2u; }
    const size_t kstep = (size_t)(BK * 2);
    const size_t hstep = (size_t)HALF * K * 2;
    const size_t tstep = 2 * hstep;
    const unsigned ldsw = (unsigned)wid * 1024u;
    const int aoff = lds_byte(wr * 64 + fr, fq * 8), boff = lds_byte(wc * 32 + fr, fq * 8);
#define PG8_SA(b, h) (((b) * 2 + (h)) * HTB)
#define PG8_SB(b, h) ((4 + (b) * 2 + (h)) * HTB)
#define PG8_STAGE(bufoff, gbase, voff) do { _Pragma("unroll") for (int _i = 0; _i < 2; ++_i) \
        __builtin_amdgcn_global_load_lds((const unsigned*)((const char*)(gbase) + (voff)[_i]), (PG8_LAS unsigned*)(lds + (bufoff) + ldsw + _i * 8192), 16, 0, 0); } while (0)
#define PG8_LDA(dst, b, h) do { _Pragma("unroll") for (int m = 0; m < 4; ++m) _Pragma("unroll") for (int k = 0; k < 2; ++k) dst[m][k] = *(const PG8_LAS bf16x8*)(lds + PG8_SA(b, h) + aoff + m * 2048 + k * 1024); } while (0)
#define PG8_LDB(dst, b, h) do { _Pragma("unroll") for (int n = 0; n < 2; ++n) _Pragma("unroll") for (int k = 0; k < 2; ++k) dst[n][k] = *(const PG8_LAS bf16x8*)(lds + PG8_SB(b, h) + boff + n * 2048 + k * 1024); } while (0)
#define PG8_MMA(ai, bj, At, Bt) do { __builtin_amdgcn_s_setprio(1); _Pragma("unroll") for (int m = 0; m < 4; ++m) _Pragma("unroll") for (int n = 0; n < 2; ++n) _Pragma("unroll") for (int k = 0; k < 2; ++k) \
        acc[ai][bj][m][n] = __builtin_amdgcn_mfma_f32_16x16x32_bf16(Bt[n][k], At[m][k], acc[ai][bj][m][n], 0, 0, 0); __builtin_amdgcn_s_setprio(0); } while (0)
#define PG8_WAIT_V(n) asm volatile("s_waitcnt vmcnt(" #n ")" ::: "memory")
#define PG8_WAIT_L(n) asm volatile("s_waitcnt lgkmcnt(" #n ")" ::: "memory")
#define PG8_BAR __builtin_amdgcn_s_barrier()
#define PG8_SCHED __builtin_amdgcn_sched_barrier(0)
    Unit cur, nxt; int ui = 0;
    if (!S.next(0, cur)) return;
    f32x4 acc[2][2][4][2];
#pragma unroll
    for (int a = 0; a < 2; ++a)
#pragma unroll
        for (int b = 0; b < 2; ++b)
#pragma unroll
            for (int m = 0; m < 4; ++m)
#pragma unroll
                for (int n = 0; n < 2; ++n) acc[a][b][m][n] = (f32x4){0.f, 0.f, 0.f, 0.f};
    bf16x8 At[4][2], B0[2][2], B1[2][2];
    const char* cA = (const char*)g.A + (size_t)cur.pm * tstep; const char* cB = (const char*)g.Bt + (size_t)cur.pn * tstep;
    S.a_ready(cur);
    if constexpr (SP2) {
        PG8_STAGE(PG8_SB(0, 0), cB, voffB); PG8_STAGE(PG8_SB(0, 1), cB + hstep, voffB); PG8_STAGE(PG8_SA(0, 0), cA, voffA); PG8_STAGE(PG8_SA(0, 1), cA + hstep, voffA);
        if (wr == 1) PG8_BAR;
        PG8_WAIT_V(2); PG8_BAR;
        PG8_STAGE(PG8_SB(1, 0), cB + kstep, voffB); PG8_STAGE(PG8_SA(1, 0), cA + kstep, voffA); PG8_STAGE(PG8_SB(1, 1), cB + hstep + kstep, voffB);
        PG8_WAIT_V(6); PG8_BAR;
    } else {
        PG8_STAGE(PG8_SB(0, 0), cB, voffB); PG8_STAGE(PG8_SA(0, 0), cA, voffA); PG8_STAGE(PG8_SB(0, 1), cB + hstep, voffB); PG8_STAGE(PG8_SA(0, 1), cA + hstep, voffA);
        if (wr == 1) PG8_BAR;
        PG8_WAIT_V(4); PG8_BAR;
        PG8_STAGE(PG8_SB(1, 0), cB + kstep, voffB); PG8_STAGE(PG8_SA(1, 0), cA + kstep, voffA); PG8_STAGE(PG8_SB(1, 1), cB + hstep + kstep, voffB);
        PG8_WAIT_V(6); PG8_BAR;
    }
    for (;;) {
        const bool has_next = S.next(ui + 1, nxt);
        const char* nA = has_next ? (const char*)g.A + (size_t)nxt.pm * tstep : cA; const char* nB = has_next ? (const char*)g.Bt + (size_t)nxt.pn * tstep : cB;
        for (int t = 0; t < nt; t += 2) {
            const bool last = (t == nt - 2);
            const char* a1 = cA + (size_t)(t + 1) * kstep;
            const char* a2 = last ? nA : cA + (size_t)(t + 2) * kstep; const char* b2 = last ? nB : cB + (size_t)(t + 2) * kstep;
            const char* a3 = a2 + kstep; const char* b3 = b2 + kstep;
            if (last && has_next) S.a_ready(nxt);
            if constexpr (SP2) {
            PG8_LDB(B0, 0, 0); PG8_LDB(B1, 0, 1); PG8_SCHED; PG8_LDA(At, 0, 0); PG8_STAGE(PG8_SA(1, 1), a1 + hstep, voffA);
            PG8_WAIT_V(8); PG8_WAIT_L(0); PG8_BAR; PG8_MMA(0, 0, At, B0); PG8_MMA(0, 1, At, B1); PG8_BAR; PG8_SCHED;
            PG8_LDA(At, 0, 1); PG8_STAGE(PG8_SB(0, 0), b2, voffB); PG8_STAGE(PG8_SB(0, 1), b2 + hstep, voffB); PG8_STAGE(PG8_SA(0, 0), a2, voffA);
            PG8_WAIT_V(8); PG8_WAIT_L(0); PG8_BAR; PG8_MMA(1, 0, At, B0); PG8_MMA(1, 1, At, B1); PG8_BAR; PG8_SCHED;
            PG8_LDB(B0, 1, 0); PG8_LDB(B1, 1, 1); PG8_SCHED; PG8_LDA(At, 1, 0); PG8_STAGE(PG8_SA(0, 1), a2 + hstep, voffA);
            PG8_WAIT_V(8); PG8_WAIT_L(0); PG8_BAR; PG8_MMA(0, 0, At, B0); PG8_MMA(0, 1, At, B1); PG8_BAR; PG8_SCHED;
            PG8_LDA(At, 1, 1); PG8_STAGE(PG8_SB(1, 0), b3, voffB); PG8_STAGE(PG8_SB(1, 1), b3 + hstep, voffB); PG8_STAGE(PG8_SA(1, 0), a3, voffA);
            PG8_WAIT_V(8); PG8_WAIT_L(0); PG8_BAR; PG8_MMA(1, 0, At, B0); PG8_MMA(1, 1, At, B1); PG8_BAR; PG8_SCHED;
            } else {
            PG8_LDB(B0, 0, 0); PG8_SCHED; PG8_LDA(At, 0, 0); PG8_STAGE(PG8_SA(1, 1), a1 + hstep, voffA);
            PG8_WAIT_L(8); PG8_BAR; PG8_WAIT_L(0); PG8_MMA(0, 0, At, B0); PG8_BAR; PG8_SCHED;
            PG8_LDB(B1, 0, 1); PG8_STAGE(PG8_SB(0, 0), b2, voffB);
            PG8_BAR; PG8_WAIT_L(0); PG8_MMA(0, 1, At, B1); PG8_BAR;
            PG8_LDA(At, 0, 1); PG8_STAGE(PG8_SA(0, 0), a2, voffA);
            PG8_BAR; PG8_WAIT_L(0); PG8_MMA(1, 0, At, B0); PG8_BAR; PG8_SCHED;
            PG8_STAGE(PG8_SB(0, 1), b2 + hstep, voffB);
            PG8_WAIT_V(6); PG8_BAR; PG8_MMA(1, 1, At, B1); PG8_BAR;
            PG8_LDB(B0, 1, 0); PG8_SCHED; PG8_LDA(At, 1, 0); PG8_STAGE(PG8_SA(0, 1), a2 + hstep, voffA);
            PG8_WAIT_L(8); PG8_BAR; PG8_WAIT_L(0); PG8_MMA(0, 0, At, B0); PG8_BAR; PG8_SCHED;
            PG8_LDB(B1, 1, 1); PG8_STAGE(PG8_SB(1, 0), b3, voffB);
            PG8_BAR; PG8_WAIT_L(0); PG8_MMA(0, 1, At, B1); PG8_BAR;
            PG8_LDA(At, 1, 1); PG8_STAGE(PG8_SA(1, 0), a3, voffA);
            PG8_BAR; PG8_WAIT_L(0); PG8_MMA(1, 0, At, B0); PG8_BAR; PG8_SCHED;
            PG8_STAGE(PG8_SB(1, 1), b3 + hstep, voffB);
            PG8_WAIT_V(6); PG8_BAR; PG8_MMA(1, 1, At, B1); PG8_BAR;
            }
        }
        if constexpr (ALIGN_EPI) { if (wr == 0) PG8_BAR; }
        if constexpr (!Epi::AFTER_DRAIN) { E(acc, cur, wr, wc, fr, fq); S.done(cur); }
        if (!has_next) break;
#pragma unroll
        for (int a = 0; a < 2; ++a)
#pragma unroll
            for (int b = 0; b < 2; ++b)
#pragma unroll
                for (int m = 0; m < 4; ++m)
#pragma unroll
                    for (int n = 0; n < 2; ++n) acc[a][b][m][n] = (f32x4){0.f, 0.f, 0.f, 0.f};
        cur = nxt; cA = nA; cB = nB; ++ui;
        if constexpr (ALIGN_EPI) { if (wr == 1) PG8_BAR; }
    }
    PG8_WAIT_V(0);
    if constexpr (!ALIGN_EPI) { if (wr == 0) PG8_BAR; }
    PG8_BAR;
    if constexpr (Epi::AFTER_DRAIN) { E.fused(acc, cur, wr, wc, fr, fq, lds, wid, lane); S.done(cur); }
#undef PG8_SA
#undef PG8_SB
#undef PG8_STAGE
#undef PG8_LDA
#undef PG8_LDB
#undef PG8_MMA
#undef PG8_WAIT_V
#undef PG8_WAIT_L
#undef PG8_BAR
#undef PG8_SCHED
}
}


#ifndef N_LAUNCH_MODE
#define N_LAUNCH_MODE 1
#endif
#ifndef SIMPLE_GEMM
#define SIMPLE_GEMM 0
#endif

constexpr int D = 2048, BATCH = 2, SEQ = 4096, T = BATCH * SEQ;
constexpr int HW = 1024;
constexpr int NH = 12, HD = 128, QKVW = 3 * NH * HD;
constexpr int INW = 3 * HW + QKVW;
constexpr int N1 = INW + 2 * D;
constexpr int NE = 64, FF = 512;
constexpr float RMS_EPS = 1e-6f;
constexpr int NWAVES = 8, NTHR = 512;
constexpr int NPHASE = 11;

constexpr size_t MiB = 1u << 20;
constexpr size_t WS_CTL = 0, CTL_ZERO_BYTES = 1 * MiB;
constexpr size_t WS_MODP = 1 * MiB;
constexpr size_t WS_HID2 = 2 * MiB;
constexpr size_t WS_ROT = 3 * MiB;
constexpr size_t WS_W3T = 4 * MiB;
constexpr size_t WS_ROUTE = 5 * MiB;
constexpr size_t WS_LISTT = 6 * MiB;
constexpr size_t WS_LISTG = 8 * MiB;
constexpr size_t WS_W1T = 16 * MiB;
constexpr size_t WS_WHYOT = 64 * MiB;
constexpr size_t WS_WATOT = 68 * MiB;
constexpr size_t WS_WOUTT = 70 * MiB;
constexpr size_t WS_KF = 80 * MiB;
constexpr size_t WS_H = 144 * MiB;
constexpr size_t WS_PHY = 176 * MiB;
constexpr size_t WS_QKV = 224 * MiB;
constexpr size_t WS_G = 296 * MiB;
constexpr size_t WS_YHY = 360 * MiB;
constexpr size_t WS_YAT = 376 * MiB;
constexpr size_t WS_TMP = 384 * MiB;
constexpr size_t WS_MERGED = 448 * MiB;
constexpr size_t WS_Y = 480 * MiB;
constexpr size_t WS_X1 = 544 * MiB;
constexpr size_t WS_H2 = 608 * MiB;
constexpr size_t WS_ACT = 640 * MiB;
constexpr size_t WS_YB = 672 * MiB;
constexpr size_t WS_END = 800 * MiB;
constexpr int CW_BAR = 4096;
constexpr int CW_CNT = 16384;

constexpr int RING_BYTES = 131072;
constexpr int MISC_OFF = RING_BYTES + 320;
constexpr int LDS_BYTES = 147456;

#define GAS __attribute__((address_space(1)))
#define LAS __attribute__((address_space(3)))
typedef unsigned short bf16;
typedef unsigned v4u __attribute__((ext_vector_type(4)));
typedef unsigned v2u __attribute__((ext_vector_type(2)));
typedef float f32x4 __attribute__((ext_vector_type(4)));
typedef LAS float lfloat;

__device__ __forceinline__ unsigned f2bf(float f) { unsigned u = __builtin_bit_cast(unsigned, f); return (u + 0x7fffu + ((u >> 16) & 1u)) >> 16; }
__device__ __forceinline__ unsigned pk2(float lo, float hi) { return f2bf(lo) | (f2bf(hi) << 16); }
__device__ __forceinline__ float bf2f(unsigned short b) { return __builtin_bit_cast(float, ((unsigned)b) << 16); }
__device__ __forceinline__ float bflo(unsigned w) { return __builtin_bit_cast(float, w << 16); }
__device__ __forceinline__ float bfhi(unsigned w) { return __builtin_bit_cast(float, w & 0xffff0000u); }

#define XB_TMO      128
#define XB_XCNT(j)  (256  + 64 * (j))
#define XB_XSUB(j)  (1280 + 64 * (j))
#define XB_XGEN(j)  (2304 + 64 * (j))
#define XB_TOP      3328
#define XB_TOPGEN   3392
#define XCD_BAR_WORDS 3456
#define XB_SPIN_CAP (1u << 18)
__device__ __forceinline__ unsigned xb_ld(unsigned* p)              { return __hip_atomic_load(p, __ATOMIC_RELAXED, __HIP_MEMORY_SCOPE_AGENT); }
__device__ __forceinline__ unsigned xb_add(unsigned* p, unsigned v) { return __hip_atomic_fetch_add(p, v, __ATOMIC_RELAXED, __HIP_MEMORY_SCOPE_AGENT); }
__device__ __forceinline__ unsigned xb_xcc_id() { return (unsigned)__builtin_amdgcn_s_getreg((3 << 11) | 20) & 0xFu; }
#define XB_SPIN(cond, bar) do { unsigned _sp = 0; while (cond) { __builtin_amdgcn_s_sleep(1); \
    if ((++_sp & 255u) == 0u) { if (xb_ld(&(bar)[XB_TMO])) break; if (_sp > XB_SPIN_CAP) { atomicAdd(&(bar)[XB_TMO], 1u); break; } } } } while (0)
struct XcdBarrier { unsigned* bar; unsigned x; volatile LAS unsigned* st; };
__device__ __forceinline__ XcdBarrier xcd_barrier_post(unsigned* bar, volatile LAS unsigned* st) {
    XcdBarrier b; b.bar = bar; b.x = xb_xcc_id(); b.st = st;
    if (threadIdx.x == 0) (void)xb_add(&bar[XB_XCNT(b.x)], 1u);
    return b;
}
__device__ __forceinline__ void xcd_barrier_complete(unsigned* bar, unsigned x, unsigned& nloc, unsigned& nx) {
    const unsigned G = gridDim.x * gridDim.y * gridDim.z;
    unsigned sum, cnt, mine, sp = 0u;
    for (;;) {
        sum = 0u; cnt = 0u; mine = 0u;
#pragma unroll
        for (unsigned j = 0; j < 16; ++j) { const unsigned c = xb_ld(&bar[XB_XCNT(j)]); sum += c; cnt += (c > 0u) ? 1u : 0u; mine = (j == x) ? c : mine; }
        if (sum == G) break;
        __builtin_amdgcn_s_sleep(1);
        if ((++sp & 255u) == 0u) { if (xb_ld(&bar[XB_TMO])) break; if (sp > XB_SPIN_CAP) { atomicAdd(&bar[XB_TMO], 1u); break; } }
    }
    nloc = mine > 0u ? mine : 1u; nx = cnt > 0u ? cnt : 1u;
}
__device__ __forceinline__ void xcd_barrier(const XcdBarrier& b) {
    asm volatile("s_waitcnt vmcnt(0)" ::: "memory");
    __syncthreads();
    if (threadIdx.x == 0) {
        unsigned* bar = b.bar;
        __builtin_amdgcn_s_waitcnt(0);
        unsigned nloc = b.st[0], nx = b.st[1];
        if (nloc == 0u) { xcd_barrier_complete(bar, b.x, nloc, nx); b.st[0] = nloc; b.st[1] = nx; }
        const unsigned old = xb_add(&bar[XB_XSUB(b.x)], 1u);
        const unsigned gen = old / nloc;
        if (old + 1u == (gen + 1u) * nloc) {
            __builtin_amdgcn_fence(__ATOMIC_RELEASE, "agent");
            asm volatile("s_waitcnt vmcnt(0)" ::: "memory");
            const unsigned og = xb_add(&bar[XB_TOP], 1u);
            const unsigned tg = og / nx;
            if (og + 1u == (tg + 1u) * nx) xb_add(&bar[XB_TOPGEN], 1u);
            else XB_SPIN(xb_ld(&bar[XB_TOPGEN]) == tg, bar);
            __builtin_amdgcn_fence(__ATOMIC_ACQUIRE, "agent");
            xb_add(&bar[XB_XGEN(b.x)], 1u);
            asm volatile("s_waitcnt vmcnt(0)" ::: "memory");
        } else {
            XB_SPIN(xb_ld(&bar[XB_XGEN(b.x)]) == gen, bar);
            __builtin_amdgcn_fence(__ATOMIC_ACQUIRE, "agent");
            asm volatile("s_waitcnt vmcnt(0)" ::: "memory");
        }
    }
    __syncthreads();
}

struct Args { const void* in[31]; float* out; unsigned char* ws; int ph_lo, ph_hi; };
struct Frame {
    LAS unsigned char* lds;
    int tid, lane, wave, G, bid;
    const float *x, *c, *w_ada, *b_ada, *g_mix_pre, *g_mix_post, *g_ffn_pre, *g_ffn_post, *w_in, *conv_w, *conv_b, *fw1, *fb1, *fw2, *fb2, *fw3, *ffreq, *hskip,
        *w_bg, *b_bg, *w_hy_o, *w_at_o, *w_out, *w_group, *b_group, *w_expert, *b_expert, *w1e, *w3e, *w2e;
    const int* positions;
    float* out;
    unsigned* ctl; float *MODP, *HID2, *ROT, *W3T, *KF, *TMP, *Y, *X1, *ACT, *YB, *LISTG;
    unsigned* ROUTE; int* LISTT;
    bf16 *W1T, *WHYOT, *WATOT, *WOUTT, *H, *PHY, *QKV, *GT, *YHY, *YAT, *MERGED, *H2;
};

__device__ __forceinline__ float wave_sum(float v) {
#pragma unroll
    for (int o = 1; o < 64; o <<= 1) v += __shfl_xor(v, o);
    return v;
}
__device__ __forceinline__ float wave_max(float v) {
#pragma unroll
    for (int o = 1; o < 64; o <<= 1) v = fmaxf(v, __shfl_xor(v, o));
    return v;
}

__device__ __forceinline__ void p0_transpose_item(const float* W, int K, int N, bf16* WT, int row_off, LAS float* scr, int item, int lane) {
    const int nblk = N / 32, kb = item / nblk, nb = item % nblk, k0 = 64 * kb, n0 = 32 * nb;
#pragma unroll 8
    for (int i = 0; i < 32; ++i) { const int kk = 2 * i + (lane >> 5); scr[kk * 33 + (lane & 31)] = W[(size_t)(k0 + kk) * N + n0 + (lane & 31)]; }
    asm volatile("s_waitcnt lgkmcnt(0)" ::: "memory");
    const int c = lane & 7;
#pragma unroll
    for (int j = 0; j < 4; ++j) { const int n = (lane >> 3) + 8 * j; const LAS float* s = scr + (8 * c) * 33 + n;
        v4u o; o.x = pk2(s[0 * 33], s[1 * 33]); o.y = pk2(s[2 * 33], s[3 * 33]); o.z = pk2(s[4 * 33], s[5 * 33]); o.w = pk2(s[6 * 33], s[7 * 33]);
        *(v4u*)(WT + (size_t)(row_off + n0 + n) * K + k0 + 8 * c) = o; }
    asm volatile("s_waitcnt lgkmcnt(0)" ::: "memory");
}

__device__ __forceinline__ void load_mod(Frame& F, LAS float* dst, int which) {
    for (int i = F.tid; i < 2 * D; i += NTHR) { const int b = i / D, d = i % D; float s = F.b_ada[which * D + d];
#pragma unroll
        for (int ks = 0; ks < 8; ++ks) s += F.MODP[(size_t)(ks * 2 + b) * (6 * D) + which * D + d];
        dst[i] = s; }
}

__device__ __forceinline__ void p0_prologue(Frame& F) {
    LAS float* L = (LAS float*)F.lds;
    {
        LAS float* sc = L;
        LAS float* red = L + 512;
        for (int u = F.bid; u < 48 * 8; u += F.G) {
            const int chunk = u % 48, ks = u / 48;
            { const int b = F.tid >> 8, i = F.tid & 255; const float cv = F.c[b * D + ks * 256 + i]; sc[b * 256 + i] = cv / (1.f + __expf(-cv)); }
            __syncthreads();
            f32x4 a0 = {0.f, 0.f, 0.f, 0.f}, a1 = {0.f, 0.f, 0.f, 0.f};
            const float* wp = F.w_ada + (size_t)(ks * 256 + F.wave * 32) * (6 * D) + chunk * 256 + F.lane * 4;
#pragma unroll 8
            for (int r = 0; r < 32; ++r) { const f32x4 w = *(const f32x4*)(wp + (size_t)r * (6 * D)); const float s0 = sc[F.wave * 32 + r], s1 = sc[256 + F.wave * 32 + r]; a0 += w * s0; a1 += w * s1; }
            *(LAS f32x4*)(red + (F.wave * 2 + 0) * 256 + F.lane * 4) = a0;
            *(LAS f32x4*)(red + (F.wave * 2 + 1) * 256 + F.lane * 4) = a1;
            __syncthreads();
            { const int b = F.tid >> 8, col = F.tid & 255; float s = 0.f;
#pragma unroll
              for (int w = 0; w < 8; ++w) s += red[(w * 2 + b) * 256 + col];
              F.MODP[(size_t)(ks * 2 + b) * (6 * D) + chunk * 256 + col] = s; }
            __syncthreads();
        }
    }
    const int gw = F.bid * NWAVES + F.wave, NGW = F.G * NWAVES;
    {
        LAS float* scr = (LAS float*)(F.lds + F.wave * 16384);
        constexpr int I_IN = (D / 64) * (INW / 32), I_BG = (D / 64) * (2 * D / 32), I_HY = (HW / 64) * (D / 32), I_AT = (512 / 64) * (D / 32), I_OUT = (D / 64) * (D / 32);
        constexpr int NITEMS = I_IN + I_BG + I_HY + I_AT + I_OUT;
        for (int it = gw; it < NITEMS; it += NGW) {
            int r = it;
            if (r < I_IN) { p0_transpose_item(F.w_in, D, INW, F.W1T, 0, scr, r, F.lane); continue; } r -= I_IN;
            if (r < I_BG) { p0_transpose_item(F.w_bg, D, 2 * D, F.W1T, INW, scr, r, F.lane); continue; } r -= I_BG;
            if (r < I_HY) { p0_transpose_item(F.w_hy_o, HW, D, F.WHYOT, 0, scr, r, F.lane); continue; } r -= I_HY;
            if (r < I_AT) { p0_transpose_item(F.w_at_o, 512, D, F.WATOT, 0, scr, r, F.lane); continue; } r -= I_AT;
            p0_transpose_item(F.w_out, D, D, F.WOUTT, 0, scr, r, F.lane);
        }
    }
    for (int i = F.bid * NTHR + F.tid; i < 64 * 4096; i += F.G * NTHR) { const int n = i >> 6, j = i & 63; F.W3T[i] = F.fw3[j * 4096 + n]; }
    for (int t = gw; t < SEQ; t += NGW) {
        const int j = F.lane;
        const float tn = (float)t * (1.0f / (float)(SEQ - 1));
        const float w = 6.283185307179586f * (float)t / (float)SEQ;
        float feat = 0.f;
        if (j == 0) feat = tn;
        else if (j <= 16) { const float band = 1e-4f + (float)(j - 1) * ((15.0f - 1e-4f) / 15.0f); feat = cosf(band * w); }
        else if (j <= 32) { const float band = 1e-4f + (float)(j - 17) * ((15.0f - 1e-4f) / 15.0f); feat = -sinf(band * w); }
        float a = F.fb1[j];
        for (int i = 0; i < 33; ++i) a += __shfl(feat, i) * F.fw1[i * 64 + j];
        const float fr = F.ffreq[j];
        const float h1 = sinf(fr * a);
        float a2 = F.fb2[j];
        for (int i = 0; i < 64; ++i) a2 += __shfl(h1, i) * F.fw2[i * 64 + j];
        F.HID2[t * 64 + j] = sinf(fr * a2);
    }
    for (int i = F.bid * NTHR + F.tid; i < T * 16; i += F.G * NTHR) {
        const int tok = i >> 4, k = i & 15;
        const float inv = powf(500000.0f, -(float)k * (1.0f / 16.0f));
        const float ang = (float)F.positions[tok] * inv;
        F.ROT[tok * 32 + k] = cosf(ang); F.ROT[tok * 32 + 16 + k] = sinf(ang);
    }
}

__device__ __forceinline__ void p1_rows_filters(Frame& F) {
    LAS float* L = (LAS float*)F.lds;
    LAS float* shiftv = L;
    LAS float* scalev = L + 2 * D;
    load_mod(F, shiftv, 0); load_mod(F, scalev, 1);
    __syncthreads();
    const int gw = F.bid * NWAVES + F.wave, NGW = F.G * NWAVES;
    for (int m = gw; m < T; m += NGW) {
        const int b = m / SEQ;
        const f32x4* xr = (const f32x4*)(F.x + (size_t)m * D) + F.lane;
        f32x4 v[8]; float s = 0.f;
#pragma unroll
        for (int j = 0; j < 8; ++j) { v[j] = xr[64 * j]; s += (v[j].x * v[j].x + v[j].y * v[j].y) + (v[j].z * v[j].z + v[j].w * v[j].w); }
        const float rstd = 1.0f / sqrtf(wave_sum(s) * (1.f / D) + RMS_EPS);
        v2u* o8 = (v2u*)(F.H + (size_t)m * D) + F.lane;
#pragma unroll
        for (int j = 0; j < 8; ++j) { const int d = 256 * j + 4 * F.lane;
            const f32x4 g = *(const f32x4*)(F.g_mix_pre + d); const f32x4 sc = *(LAS f32x4*)(scalev + b * D + d), sh = *(LAS f32x4*)(shiftv + b * D + d);
            f32x4 h; h = (v[j] * rstd) * g; h = h * (sc + 1.0f) + sh;
            v2u w; w.x = pk2(h.x, h.y); w.y = pk2(h.z, h.w); o8[64 * j] = w; }
    }
    for (int u = gw; u < 64 * 64; u += NGW) {
        const int tc = u & 63, nc = u >> 6; const int t = tc * 64 + F.lane;
        float hreg[64];
#pragma unroll
        for (int j4 = 0; j4 < 16; ++j4) { const f32x4 q = *(const f32x4*)(F.HID2 + (size_t)t * 64 + 4 * j4); hreg[4 * j4] = q.x; hreg[4 * j4 + 1] = q.y; hreg[4 * j4 + 2] = q.z; hreg[4 * j4 + 3] = q.w; }
        const float tn = (float)t * (1.0f / (float)(SEQ - 1));
        for (int nn = 0; nn < 64; ++nn) {
            const int n = __builtin_amdgcn_readfirstlane(nc * 64 + nn);
            const float* wr = F.W3T + (size_t)n * 64;
            float a = 0.f;
#pragma unroll
            for (int j = 0; j < 64; ++j) a += hreg[j] * wr[j];
            const int c = n & (HW - 1);
            const float mind = -3.0701134573253945f, maxd = -15.350567286626972f;
            const float delta = fabsf(mind + (float)c * ((maxd - mind) / (float)(HW - 1)));
            F.KF[(size_t)n * SEQ + t] = a * expf(-tn * delta);
        }
    }
}

template <int NB, class LA, class LB, class EP>
__device__ __forceinline__ void simt_tile(LAS float* L, int K, int tid, const LA& la, const LB& lb, const EP& ep) {
    LAS float* As = L;
    LAS float* Bs = L + 32 * 68;
    const int ty = tid >> 4, tx = tid & 15;
    float acc[NB][2][4];
#pragma unroll
    for (int q = 0; q < NB; ++q)
#pragma unroll
        for (int i = 0; i < 2; ++i)
#pragma unroll
            for (int j = 0; j < 4; ++j) acc[q][i][j] = 0.f;
    for (int k0 = 0; k0 < K; k0 += 32) {
        __syncthreads();
        for (int e = tid; e < 64 * 32; e += NTHR) { const int r = e >> 5, kk = e & 31; As[kk * 68 + r] = la(r, k0 + kk); }
#pragma unroll
        for (int q = 0; q < NB; ++q)
            for (int e = tid; e < 32 * 64; e += NTHR) { const int kk = e >> 6, cc = e & 63; Bs[(q * 32 + kk) * 68 + cc] = lb(q, k0 + kk, cc); }
        __syncthreads();
#pragma unroll 8
        for (int kk = 0; kk < 32; ++kk) {
            const float a0 = As[kk * 68 + 2 * ty], a1 = As[kk * 68 + 2 * ty + 1];
#pragma unroll
            for (int q = 0; q < NB; ++q) { const f32x4 b = *(LAS f32x4*)(Bs + (q * 32 + kk) * 68 + 4 * tx);
                acc[q][0][0] += a0 * b.x; acc[q][0][1] += a0 * b.y; acc[q][0][2] += a0 * b.z; acc[q][0][3] += a0 * b.w;
                acc[q][1][0] += a1 * b.x; acc[q][1][1] += a1 * b.y; acc[q][1][2] += a1 * b.z; acc[q][1][3] += a1 * b.w; }
        }
    }
#pragma unroll
    for (int i = 0; i < 2; ++i)
#pragma unroll
        for (int j = 0; j < 4; ++j) { float v[NB];
#pragma unroll
            for (int q = 0; q < NB; ++q) v[q] = acc[q][i][j];
            ep(2 * ty + i, 4 * tx + j, v); }
}

struct EpiProj {
    static constexpr bool PERM = true, AFTER_DRAIN = false;
    bf16* QKVp; bf16* Gp; const float* ROT; const float* bias;
    __device__ __forceinline__ void operator()(const pg8::f32x4 (&acc)[2][2][4][2], const pg8::Unit& u, int wr, int wc, int fr, int fq) const {
        using namespace pg8;
        const int row0 = u.pm * BM + wr * 64 + fr;
        const int colt = u.pn * BM;
        if (colt < QKVW) {
            const bool rot = (colt < 2 * NH * HD) && (wc == 0);
#pragma unroll
            for (int ai = 0; ai < 2; ++ai)
#pragma unroll
                for (int m = 0; m < 4; ++m) { const int row = row0 + ai * HALF + m * 16;
                    bf16* rowp = QKVp + (size_t)row * QKVW + colt + wc * 32 + 8 * fq;
                    f32x4 cs0, cs1, sn0, sn1;
                    if (rot) { const float* rp = ROT + (size_t)row * 32 + 8 * (fq & 1); cs0 = *(const f32x4*)rp; cs1 = *(const f32x4*)(rp + 4); sn0 = *(const f32x4*)(rp + 16); sn1 = *(const f32x4*)(rp + 20); }
#pragma unroll
                    for (int bj = 0; bj < 2; ++bj) { f32x4 v0 = acc[ai][bj][m][0], v1 = acc[ai][bj][m][1];
                        if (rot) {
                            f32x4 o0, o1;
#pragma unroll
                            for (int j = 0; j < 4; ++j) { o0[j] = __shfl_xor(v0[j], 32); o1[j] = __shfl_xor(v1[j], 32); }
                            if (fq < 2) { v0 = v0 * cs0 - o0 * sn0; v1 = v1 * cs1 - o1 * sn1; }
                            else        { v0 = v0 * cs0 + o0 * sn0; v1 = v1 * cs1 + o1 * sn1; }
                        }
                        u32x4 w; w.x = cvt_pk_bf16(v0[0], v0[1]); w.y = cvt_pk_bf16(v0[2], v0[3]); w.z = cvt_pk_bf16(v1[0], v1[1]); w.w = cvt_pk_bf16(v1[2], v1[3]);
                        *(u32x4*)(rowp + bj * HALF) = w; } }
        } else {
            const int gc = colt - QKVW + wc * 32 + 8 * fq;
            f32x4 bv[2][2];
#pragma unroll
            for (int bj = 0; bj < 2; ++bj)
#pragma unroll
                for (int n = 0; n < 2; ++n) bv[bj][n] = *(const f32x4*)(bias + gc + bj * HALF + 4 * n);
#pragma unroll
            for (int ai = 0; ai < 2; ++ai)
#pragma unroll
                for (int m = 0; m < 4; ++m) { bf16* rowp = Gp + (size_t)(row0 + ai * HALF + m * 16) * (2 * D) + gc;
#pragma unroll
                    for (int bj = 0; bj < 2; ++bj) { f32x4 v0 = acc[ai][bj][m][0] + bv[bj][0], v1 = acc[ai][bj][m][1] + bv[bj][1];
#pragma unroll
                        for (int j = 0; j < 4; ++j) { v0[j] = 1.0f / (1.0f + __expf(-v0[j])); v1[j] = 1.0f / (1.0f + __expf(-v1[j])); }
                        u32x4 w; w.x = cvt_pk_bf16(v0[0], v0[1]); w.y = cvt_pk_bf16(v0[2], v0[3]); w.z = cvt_pk_bf16(v1[0], v1[1]); w.w = cvt_pk_bf16(v1[2], v1[3]);
                        *(u32x4*)(rowp + bj * HALF) = w; } }
        }
    }
};
struct EpiPlainBf16 {
    static constexpr bool PERM = true, AFTER_DRAIN = false;
    bf16* O; int ldc;
    __device__ __forceinline__ void operator()(const pg8::f32x4 (&acc)[2][2][4][2], const pg8::Unit& u, int wr, int wc, int fr, int fq) const {
        using namespace pg8;
        const int row0 = u.pm * BM + wr * 64 + fr, col0 = u.pn * BM + wc * 32 + 8 * fq;
#pragma unroll
        for (int ai = 0; ai < 2; ++ai)
#pragma unroll
            for (int m = 0; m < 4; ++m) { bf16* rowp = O + (size_t)(row0 + ai * HALF + m * 16) * ldc + col0;
#pragma unroll
                for (int bj = 0; bj < 2; ++bj) { const f32x4 v0 = acc[ai][bj][m][0], v1 = acc[ai][bj][m][1];
                    u32x4 w; w.x = cvt_pk_bf16(v0[0], v0[1]); w.y = cvt_pk_bf16(v0[2], v0[3]); w.z = cvt_pk_bf16(v1[0], v1[1]); w.w = cvt_pk_bf16(v1[2], v1[3]);
                    *(u32x4*)(rowp + bj * HALF) = w; } }
    }
};
template <int STAGE> struct EpiGate {
    static constexpr bool PERM = true, AFTER_DRAIN = false;
    const bf16* Gp; int goff; float* TMPp; bf16* Mp;
    __device__ __forceinline__ void operator()(const pg8::f32x4 (&acc)[2][2][4][2], const pg8::Unit& u, int wr, int wc, int fr, int fq) const {
        using namespace pg8;
        const int row0 = u.pm * BM + wr * 64 + fr, col0 = u.pn * BM + wc * 32 + 8 * fq;
#pragma unroll
        for (int ai = 0; ai < 2; ++ai)
#pragma unroll
            for (int m = 0; m < 4; ++m) { const size_t row = (size_t)(row0 + ai * HALF + m * 16);
#pragma unroll
                for (int bj = 0; bj < 2; ++bj) { const int col = col0 + bj * HALF;
                    const u32x4 gw = *(const u32x4*)(Gp + row * (2 * D) + goff + col);
                    f32x4 g0 = {bflo(gw.x), bfhi(gw.x), bflo(gw.y), bfhi(gw.y)}, g1 = {bflo(gw.z), bfhi(gw.z), bflo(gw.w), bfhi(gw.w)};
                    f32x4 v0 = acc[ai][bj][m][0] * g0, v1 = acc[ai][bj][m][1] * g1;
                    float* tp = TMPp + row * D + col;
                    if (STAGE == 0) { *(f32x4*)tp = v0; *(f32x4*)(tp + 4) = v1; }
                    else { v0 += *(const f32x4*)tp; v1 += *(const f32x4*)(tp + 4);
                        u32x4 w; w.x = cvt_pk_bf16(v0[0], v0[1]); w.y = cvt_pk_bf16(v0[2], v0[3]); w.z = cvt_pk_bf16(v1[0], v1[1]); w.w = cvt_pk_bf16(v1[2], v1[3]);
                        *(u32x4*)(Mp + row * D + col) = w; } } }
    }
};
struct EpiF32 {
    static constexpr bool PERM = false, AFTER_DRAIN = false;
    float* C; int ldc;
    __device__ __forceinline__ void operator()(const pg8::f32x4 (&acc)[2][2][4][2], const pg8::Unit& u, int wr, int wc, int fr, int fq) const {
        using namespace pg8;
        const int row0 = u.pm * BM + wr * 64 + fr, col0 = u.pn * BM + wc * 32 + 4 * fq;
#pragma unroll
        for (int ai = 0; ai < 2; ++ai)
#pragma unroll
            for (int m = 0; m < 4; ++m) { float* rowp = C + (size_t)(row0 + ai * HALF + m * 16) * ldc + col0;
#pragma unroll
                for (int bj = 0; bj < 2; ++bj)
#pragma unroll
                    for (int n = 0; n < 2; ++n) *(f32x4*)(rowp + bj * HALF + n * 16) = acc[ai][bj][m][n]; }
    }
};

template <class Epi>
__device__ __forceinline__ void run_gemm(Frame& F, const bf16* A, const bf16* Bt, int M, int N, int K, const Epi& E) {
    pg8::Gemm g{A, Bt, M, N, K}; pg8::StaticOrder S; S.init(M, N, F.G, F.bid);
    pg8::gemm_phase<Epi, pg8::StaticOrder, true, true>(F.lds, g, S, E);
}

__device__ __forceinline__ float sconv_at(const bf16* rowp, int t, float w0, float w1, float w2, float bias) {
    const float um = t > 0 ? bf2f(rowp[t - 1]) : 0.f, u0 = bf2f(rowp[t]), up = t < SEQ - 1 ? bf2f(rowp[t + 1]) : 0.f;
    return um * w0 + u0 * w1 + up * w2 + bias;
}
__device__ __forceinline__ void conv8(const LAS float* kk, const LAS float* z, int t0, float (&acc)[2][8]) {
#pragma unroll
    for (int b = 0; b < 2; ++b)
#pragma unroll
        for (int j = 0; j < 8; ++j) acc[b][j] = 0.f;
    for (int s8 = 0; s8 < SEQ; s8 += 8) {
        const int base = t0 - s8 + (SEQ - 1);
        float kw[15];
#pragma unroll
        for (int i = 0; i < 15; ++i) kw[i] = kk[base - 7 + i];
        float zz[2][8];
#pragma unroll
        for (int b = 0; b < 2; ++b) { const f32x4 q0 = *(const LAS f32x4*)(z + b * SEQ + s8), q1 = *(const LAS f32x4*)(z + b * SEQ + s8 + 4);
            zz[b][0] = q0.x; zz[b][1] = q0.y; zz[b][2] = q0.z; zz[b][3] = q0.w; zz[b][4] = q1.x; zz[b][5] = q1.y; zz[b][6] = q1.z; zz[b][7] = q1.w; }
#pragma unroll
        for (int ds = 0; ds < 8; ++ds)
#pragma unroll
            for (int j = 0; j < 8; ++j) { const float k = kw[7 + j - ds]; acc[0][j] += k * zz[0][ds]; acc[1][j] += k * zz[1][ds]; }
    }
}
__device__ __forceinline__ void p3_hyena_naive(Frame& F) {
    LAS float* L = (LAS float*)F.lds;
    LAS float* zin = L;
    LAS float* kk = L + 2 * SEQ;
    LAS float* zmid = L + 4 * SEQ;
    for (int c = F.bid; c < HW; c += F.G) {
        __syncthreads();
        const float cw[3][3] = {{F.conv_w[c], F.conv_w[3 * HW + c], F.conv_w[6 * HW + c]},
                                {F.conv_w[HW + c], F.conv_w[3 * HW + HW + c], F.conv_w[6 * HW + HW + c]},
                                {F.conv_w[2 * HW + c], F.conv_w[3 * HW + 2 * HW + c], F.conv_w[6 * HW + 2 * HW + c]}};
        const float cb[3] = {F.conv_b[c], F.conv_b[HW + c], F.conv_b[2 * HW + c]};
        const bf16* pv = F.PHY + (size_t)c * T; const bf16* px1 = F.PHY + (size_t)(HW + c) * T; const bf16* px2 = F.PHY + (size_t)(2 * HW + c) * T;
        for (int i = F.tid; i < T; i += NTHR) { const int b = i / SEQ, t = i % SEQ; zin[i] = sconv_at(pv + b * SEQ, t, cw[0][0], cw[0][1], cw[0][2], cb[0]); }
        for (int i = F.tid; i < 2 * SEQ; i += NTHR) { const int d = i - (SEQ - 1);
            kk[i] = (i == 2 * SEQ - 1) ? 0.f : (d >= 0 ? F.KF[(size_t)(0 * HW + c) * SEQ + d] : F.KF[(size_t)(1 * HW + c) * SEQ - d]); }
        __syncthreads();
        const int t0 = F.tid * 8; float acc[2][8];
        conv8(kk, zin, t0, acc);
        const float sk0 = F.hskip[c], sk1 = F.hskip[HW + c];
#pragma unroll
        for (int b = 0; b < 2; ++b)
#pragma unroll
            for (int j = 0; j < 8; ++j) { const float x1 = sconv_at(px1 + b * SEQ, t0 + j, cw[1][0], cw[1][1], cw[1][2], cb[1]);
                zmid[b * SEQ + t0 + j] = x1 * (acc[b][j] + sk0 * zin[b * SEQ + t0 + j]); }
        __syncthreads();
        for (int i = F.tid; i < 2 * SEQ; i += NTHR) { const int d = i - (SEQ - 1);
            kk[i] = (i == 2 * SEQ - 1) ? 0.f : (d >= 0 ? F.KF[(size_t)(2 * HW + c) * SEQ + d] : F.KF[(size_t)(3 * HW + c) * SEQ - d]); }
        __syncthreads();
        conv8(kk, zmid, t0, acc);
#pragma unroll
        for (int b = 0; b < 2; ++b)
#pragma unroll
            for (int j = 0; j < 8; ++j) { const float x2 = sconv_at(px2 + b * SEQ, t0 + j, cw[2][0], cw[2][1], cw[2][2], cb[2]);
                const float z2 = x2 * (acc[b][j] + sk1 * zmid[b * SEQ + t0 + j]);
                F.YHY[(size_t)(b * SEQ + t0 + j) * HW + c] = (bf16)f2bf(z2); }
    }
}
__device__ __forceinline__ void p3_attn_naive(Frame& F) {
    LAS float* qs = (LAS float*)F.lds + F.wave * 128;
    const int gw = F.bid * NWAVES + F.wave, NGW = F.G * NWAVES;
    const float scale = 0.08838834764831845f;
    for (int u = gw; u < T * 4; u += NGW) {
        const int m = u >> 2, hh = u & 3, b = m / SEQ, s = m % SEQ;
        float Mrun = -3.0e38f, Lrun = 0.f, o0 = 0.f, o1 = 0.f;
#pragma unroll 1
        for (int g = 0; g < 3; ++g) {
            const int head = g * 4 + hh, dil = (g == 0) ? 1 : (g == 1 ? 4 : 16);
            const bf16* qp = F.QKV + (size_t)m * QKVW + head * HD;
            { const unsigned qq = *(const unsigned*)(qp + 2 * F.lane); qs[2 * F.lane] = bflo(qq); qs[2 * F.lane + 1] = bfhi(qq); }
            asm volatile("s_waitcnt lgkmcnt(0)" ::: "memory");
            float sc[3];
#pragma unroll
            for (int p = 0; p < 3; ++p) {
                const int j = (p == 0) ? F.lane - 64 : (p == 1 ? F.lane : 64);
                const int ks = s + j * dil; const bool valid = (ks >= 0) && (ks < SEQ) && (p < 2 || F.lane == 0);
                float dot = 0.f;
                if (valid) { const v4u* kp = (const v4u*)(F.QKV + (size_t)(b * SEQ + ks) * QKVW + NH * HD + head * HD);
#pragma unroll 4
                    for (int c8 = 0; c8 < 16; ++c8) { const v4u kv = kp[c8]; const LAS float* q8 = qs + 8 * c8;
                        dot += bflo(kv.x) * q8[0] + bfhi(kv.x) * q8[1] + bflo(kv.y) * q8[2] + bfhi(kv.y) * q8[3] + bflo(kv.z) * q8[4] + bfhi(kv.z) * q8[5] + bflo(kv.w) * q8[6] + bfhi(kv.w) * q8[7]; } }
                sc[p] = valid ? dot * scale : -1.0e30f;
            }
            const float mg = wave_max(fmaxf(fmaxf(sc[0], sc[1]), sc[2]));
            const float mnew = fmaxf(Mrun, mg), resc = __expf(Mrun - mnew);
            float pr[3];
#pragma unroll
            for (int p = 0; p < 3; ++p) pr[p] = (sc[p] > -1.0e29f) ? __expf(sc[p] - mnew) : 0.f;
            Lrun = Lrun * resc + wave_sum(pr[0] + pr[1] + pr[2]); o0 *= resc; o1 *= resc; Mrun = mnew;
            const bf16* vbase = F.QKV + 2 * NH * HD + head * HD + 2 * F.lane;
            for (int jj = 0; jj < 129; ++jj) {
                const int j = jj - 64, ks = s + j * dil;
                if (ks < 0 || ks >= SEQ) continue;
                const float pk = (jj < 64) ? __shfl(pr[0], jj) : (jj < 128 ? __shfl(pr[1], jj - 64) : __shfl(pr[2], 0));
                const unsigned vv = *(const unsigned*)(vbase + (size_t)(b * SEQ + ks) * QKVW);
                o0 += pk * bflo(vv); o1 += pk * bfhi(vv);
            }
        }
        const float inv = 1.0f / Lrun;
        *(unsigned*)(F.YAT + (size_t)m * 512 + hh * HD + 2 * F.lane) = pk2(o0 * inv, o1 * inv);
    }
}

__device__ __forceinline__ void p6_rows_router(Frame& F) {
    LAS float* L = (LAS float*)F.lds;
    LAS float* gatem = L, *shiftf = L + 2 * D, *scalef = L + 4 * D;
    load_mod(F, gatem, 2); load_mod(F, shiftf, 3); load_mod(F, scalef, 4);
    __syncthreads();
    const int gw = F.bid * NWAVES + F.wave, NGW = F.G * NWAVES;
    LAS float* hs = L + 6 * D + F.wave * D;
    for (int m = gw; m < T; m += NGW) {
        const int b = m / SEQ;
        const f32x4* yr = (const f32x4*)(F.Y + (size_t)m * D) + F.lane; const f32x4* xr = (const f32x4*)(F.x + (size_t)m * D) + F.lane;
        f32x4 v[8]; float s = 0.f;
#pragma unroll
        for (int j = 0; j < 8; ++j) { v[j] = yr[64 * j]; s += (v[j].x * v[j].x + v[j].y * v[j].y) + (v[j].z * v[j].z + v[j].w * v[j].w); }
        const float rstd = 1.0f / sqrtf(wave_sum(s) * (1.f / D) + RMS_EPS);
        float s1 = 0.f;
        f32x4* x1r = (f32x4*)(F.X1 + (size_t)m * D) + F.lane;
#pragma unroll
        for (int j = 0; j < 8; ++j) { const int d = 256 * j + 4 * F.lane;
            const f32x4 g = *(const f32x4*)(F.g_mix_post + d), gm = *(LAS f32x4*)(gatem + b * D + d);
            const f32x4 x1 = xr[64 * j] + gm * ((v[j] * rstd) * g);
            x1r[64 * j] = x1; v[j] = x1; s1 += (x1.x * x1.x + x1.y * x1.y) + (x1.z * x1.z + x1.w * x1.w); }
        const float rstd1 = 1.0f / sqrtf(wave_sum(s1) * (1.f / D) + RMS_EPS);
        v2u* o8 = (v2u*)(F.H2 + (size_t)m * D) + F.lane;
#pragma unroll
        for (int j = 0; j < 8; ++j) { const int d = 256 * j + 4 * F.lane;
            const f32x4 g = *(const f32x4*)(F.g_ffn_pre + d), sc = *(LAS f32x4*)(scalef + b * D + d), sh = *(LAS f32x4*)(shiftf + b * D + d);
            f32x4 h = (v[j] * rstd1) * g; h = h * (sc + 1.0f) + sh; *(LAS f32x4*)(hs + d) = h;
            v2u w; w.x = pk2(h.x, h.y); w.y = pk2(h.z, h.w); o8[64 * j] = w; }
        asm volatile("s_waitcnt lgkmcnt(0)" ::: "memory");
        float gl[8];
#pragma unroll
        for (int g = 0; g < 8; ++g) gl[g] = 0.f;
#pragma unroll 1
        for (int j = 0; j < 8; ++j) { const int d0 = 256 * j + 4 * F.lane; const f32x4 hq = *(LAS f32x4*)(hs + d0); const float* wp = F.w_group + (size_t)d0 * 8;
#pragma unroll
            for (int e = 0; e < 4; ++e) { const f32x4 w0 = *(const f32x4*)(wp + e * 8), w1 = *(const f32x4*)(wp + e * 8 + 4); const float hv = hq[e];
                gl[0] += hv * w0.x; gl[1] += hv * w0.y; gl[2] += hv * w0.z; gl[3] += hv * w0.w; gl[4] += hv * w1.x; gl[5] += hv * w1.y; gl[6] += hv * w1.z; gl[7] += hv * w1.w; } }
        float gmax = -3.0e38f; int gi = 0;
#pragma unroll
        for (int g = 0; g < 8; ++g) { gl[g] = wave_sum(gl[g]) + F.b_group[g]; if (gl[g] > gmax) { gmax = gl[g]; gi = g; } }
        float gden = 0.f;
#pragma unroll
        for (int g = 0; g < 8; ++g) gden += expf(gl[g] - gmax);
        const float gval = 1.0f / gden;
        gi = __builtin_amdgcn_readfirstlane(gi);
        const float* we = F.w_expert + (size_t)gi * D * 8;
        float el[8];
#pragma unroll
        for (int g = 0; g < 8; ++g) el[g] = 0.f;
#pragma unroll 1
        for (int j = 0; j < 8; ++j) { const int d0 = 256 * j + 4 * F.lane; const f32x4 hq = *(LAS f32x4*)(hs + d0); const float* wp = we + (size_t)d0 * 8;
#pragma unroll
            for (int e = 0; e < 4; ++e) { const f32x4 w0 = *(const f32x4*)(wp + e * 8), w1 = *(const f32x4*)(wp + e * 8 + 4); const float hv = hq[e];
                el[0] += hv * w0.x; el[1] += hv * w0.y; el[2] += hv * w0.z; el[3] += hv * w0.w; el[4] += hv * w1.x; el[5] += hv * w1.y; el[6] += hv * w1.z; el[7] += hv * w1.w; } }
        float e0v = -3.0e38f, e1v = -3.0e38f; int e0i = 0, e1i = 0;
#pragma unroll
        for (int g = 0; g < 8; ++g) { el[g] = wave_sum(el[g]) + F.b_expert[gi * 8 + g];
            if (el[g] > e0v) { e1v = e0v; e1i = e0i; e0v = el[g]; e0i = g; } else if (el[g] > e1v) { e1v = el[g]; e1i = g; } }
        const float p1 = expf(e1v - e0v), den = 1.0f + p1;
        const float gate0 = gval / den, gate1 = gval * p1 / den;
        if (F.lane == 0) {
            const int ex0 = gi * 8 + e0i, ex1 = gi * 8 + e1i;
            const unsigned pos0 = atomicAdd(F.ctl + CW_CNT + ex0, 1u), pos1 = atomicAdd(F.ctl + CW_CNT + ex1, 1u);
            F.LISTT[ex0 * T + pos0] = m; F.LISTG[ex0 * T + pos0] = gate0;
            F.LISTT[ex1 * T + pos1] = m; F.LISTG[ex1 * T + pos1] = gate1;
            F.ROUTE[m * 4 + 0] = (unsigned)(ex0 * T) + pos0; F.ROUTE[m * 4 + 1] = (unsigned)(ex1 * T) + pos1;
        }
    }
}

__device__ __forceinline__ void moe_offsets(Frame& F, LAS int* offs  , LAS int* toff  ) {
    if (F.tid == 0) { int a = 0, tacc = 0; for (int e = 0; e < NE; ++e) { offs[e] = a; toff[e] = tacc; const int n = (int)__hip_atomic_load(F.ctl + CW_CNT + e, __ATOMIC_RELAXED, __HIP_MEMORY_SCOPE_AGENT); a += n; tacc += (n + 63) / 64; } offs[NE] = a; toff[NE] = tacc; }
    __syncthreads();
}
__device__ __forceinline__ void p7_moe1(Frame& F) {
    LAS float* L = (LAS float*)F.lds;
    LAS int* offs = (LAS int*)(L + 8192 * 3); LAS int* toff = offs + 80;
    moe_offsets(F, offs, toff);
    const int ntiles = toff[NE];
    for (int u = F.bid; u < ntiles * 8; u += F.G) {
        const int rt = u >> 3, ct = u & 7;
        int e = 0; while (toff[e + 1] <= rt) ++e;
        const int r0 = (rt - toff[e]) * 64, ne = offs[e + 1] - offs[e];
        const int* lt = F.LISTT + e * T + r0;
        const float* W1 = F.w1e + (size_t)e * D * FF + ct * 64; const float* W3 = F.w3e + (size_t)e * D * FF + ct * 64;
        const bf16* H2 = F.H2;
        auto la = [&](int r, int k) -> float { return (r0 + r < ne) ? bf2f(H2[(size_t)lt[r] * D + k]) : 0.f; };
        auto lb = [&](int q, int k, int c) -> float { return (q == 0 ? W1 : W3)[(size_t)k * FF + c]; };
        float* ACT = F.ACT + (size_t)(offs[e] + r0) * FF + ct * 64;
        auto ep = [&](int r, int c, const float (&v)[2]) { if (r0 + r < ne) { const float a = v[0], bb = v[1]; ACT[(size_t)r * FF + c] = (a / (1.0f + __expf(-a))) * bb; } };
        simt_tile<2>(L, D, F.tid, la, lb, ep);
    }
}
__device__ __forceinline__ void p8_moe2(Frame& F) {
    LAS float* L = (LAS float*)F.lds;
    LAS int* offs = (LAS int*)(L + 8192 * 3); LAS int* toff = offs + 80;
    moe_offsets(F, offs, toff);
    const int ntiles = toff[NE];
    for (int u = F.bid; u < ntiles * 32; u += F.G) {
        const int rt = u >> 5, ct = u & 31;
        int e = 0; while (toff[e + 1] <= rt) ++e;
        const int r0 = (rt - toff[e]) * 64, ne = offs[e + 1] - offs[e];
        const float* A = F.ACT + (size_t)(offs[e] + r0) * FF;
        const float* W2 = F.w2e + (size_t)e * FF * D + ct * 64;
        const float* lg = F.LISTG + e * T + r0;
        auto la = [&](int r, int k) -> float { return (r0 + r < ne) ? A[(size_t)r * FF + k] : 0.f; };
        auto lb = [&](int q, int k, int c) -> float { return W2[(size_t)k * D + c]; };
        float* YB = F.YB + (size_t)(offs[e] + r0) * D + ct * 64;
        auto ep = [&](int r, int c, const float (&v)[1]) { if (r0 + r < ne) YB[(size_t)r * D + c] = v[0] * lg[r]; };
        simt_tile<1>(L, FF, F.tid, la, lb, ep);
    }
}
__device__ __forceinline__ void p9_final(Frame& F) {
    LAS float* L = (LAS float*)F.lds;
    LAS float* gatef = L;
    LAS int* offs = (LAS int*)(L + 8192 * 3); LAS int* toff = offs + 80;
    load_mod(F, gatef, 5);
    moe_offsets(F, offs, toff);
    const int gw = F.bid * NWAVES + F.wave, NGW = F.G * NWAVES;
    for (int m = gw; m < T; m += NGW) {
        const int b = m / SEQ;
        const unsigned s0 = F.ROUTE[m * 4 + 0], s1 = F.ROUTE[m * 4 + 1];
        const size_t r0 = (size_t)offs[s0 / T] + (s0 % T), r1 = (size_t)offs[s1 / T] + (s1 % T);
        const f32x4* y0 = (const f32x4*)(F.YB + r0 * D) + F.lane; const f32x4* y1 = (const f32x4*)(F.YB + r1 * D) + F.lane;
        f32x4 v[8]; float s = 0.f;
#pragma unroll
        for (int j = 0; j < 8; ++j) { v[j] = y0[64 * j] + y1[64 * j]; s += (v[j].x * v[j].x + v[j].y * v[j].y) + (v[j].z * v[j].z + v[j].w * v[j].w); }
        const float rstd = 1.0f / sqrtf(wave_sum(s) * (1.f / D) + RMS_EPS);
        const f32x4* x1r = (const f32x4*)(F.X1 + (size_t)m * D) + F.lane; f32x4* outr = (f32x4*)(F.out + (size_t)m * D) + F.lane;
#pragma unroll
        for (int j = 0; j < 8; ++j) { const int d = 256 * j + 4 * F.lane;
            const f32x4 g = *(const f32x4*)(F.g_ffn_post + d), gf = *(LAS f32x4*)(gatef + b * D + d);
            outr[64 * j] = x1r[64 * j] + gf * ((v[j] * rstd) * g); }
    }
}

#if SIMPLE_GEMM
template <class EP>
__device__ __forceinline__ void simple_gemm(Frame& F, const bf16* A, const bf16* Bt, int M, int N, int K, const EP& ep) {
    LAS float* L = (LAS float*)F.lds;
    const int tn = N / 64, nt = (M / 64) * tn;
    for (int u = F.bid; u < nt; u += F.G) {
        const int r0 = (u / tn) * 64, c0 = (u % tn) * 64;
        auto la = [&](int r, int k) -> float { return bf2f(A[(size_t)(r0 + r) * K + k]); };
        auto lb = [&](int q, int k, int c) -> float { return bf2f(Bt[(size_t)(c0 + c) * K + k]); };
        auto e2 = [&](int r, int c, const float (&v)[1]) { ep(r0 + r, c0 + c, v[0]); };
        simt_tile<1>(L, K, F.tid, la, lb, e2);
    }
}
#endif

__global__ void __launch_bounds__(NTHR, 2) fwd_kernel(Args args) {
    extern __shared__ __attribute__((aligned(16))) unsigned char lds_raw[];
    Frame F;
    F.lds = (LAS unsigned char*)lds_raw;
    F.tid = threadIdx.x; F.lane = F.tid & 63; F.wave = __builtin_amdgcn_readfirstlane(F.tid >> 6); F.G = gridDim.x; F.bid = blockIdx.x;
    F.x = (const float*)args.in[0]; F.c = (const float*)args.in[1]; F.positions = (const int*)args.in[2]; F.w_ada = (const float*)args.in[3]; F.b_ada = (const float*)args.in[4];
    F.g_mix_pre = (const float*)args.in[5]; F.g_mix_post = (const float*)args.in[6]; F.g_ffn_pre = (const float*)args.in[7]; F.g_ffn_post = (const float*)args.in[8];
    F.w_in = (const float*)args.in[9]; F.conv_w = (const float*)args.in[10]; F.conv_b = (const float*)args.in[11]; F.fw1 = (const float*)args.in[12]; F.fb1 = (const float*)args.in[13];
    F.fw2 = (const float*)args.in[14]; F.fb2 = (const float*)args.in[15]; F.fw3 = (const float*)args.in[16]; F.ffreq = (const float*)args.in[17]; F.hskip = (const float*)args.in[18];
    F.w_bg = (const float*)args.in[19]; F.b_bg = (const float*)args.in[20]; F.w_hy_o = (const float*)args.in[21]; F.w_at_o = (const float*)args.in[22]; F.w_out = (const float*)args.in[23];
    F.w_group = (const float*)args.in[24]; F.b_group = (const float*)args.in[25]; F.w_expert = (const float*)args.in[26]; F.b_expert = (const float*)args.in[27];
    F.w1e = (const float*)args.in[28]; F.w3e = (const float*)args.in[29]; F.w2e = (const float*)args.in[30];
    F.out = args.out;
    unsigned char* ws = args.ws;
    F.ctl = (unsigned*)(ws + WS_CTL); F.MODP = (float*)(ws + WS_MODP); F.HID2 = (float*)(ws + WS_HID2); F.ROT = (float*)(ws + WS_ROT); F.W3T = (float*)(ws + WS_W3T);
    F.ROUTE = (unsigned*)(ws + WS_ROUTE); F.LISTT = (int*)(ws + WS_LISTT); F.LISTG = (float*)(ws + WS_LISTG);
    F.W1T = (bf16*)(ws + WS_W1T); F.WHYOT = (bf16*)(ws + WS_WHYOT); F.WATOT = (bf16*)(ws + WS_WATOT); F.WOUTT = (bf16*)(ws + WS_WOUTT);
    F.KF = (float*)(ws + WS_KF); F.H = (bf16*)(ws + WS_H); F.PHY = (bf16*)(ws + WS_PHY); F.QKV = (bf16*)(ws + WS_QKV); F.GT = (bf16*)(ws + WS_G);
    F.YHY = (bf16*)(ws + WS_YHY); F.YAT = (bf16*)(ws + WS_YAT); F.TMP = (float*)(ws + WS_TMP); F.MERGED = (bf16*)(ws + WS_MERGED); F.Y = (float*)(ws + WS_Y);
    F.X1 = (float*)(ws + WS_X1); F.H2 = (bf16*)(ws + WS_H2); F.ACT = (float*)(ws + WS_ACT); F.YB = (float*)(ws + WS_YB);

    volatile LAS unsigned* MISC = (volatile LAS unsigned*)(F.lds + MISC_OFF);
    if (F.tid < 32) MISC[F.tid] = 0u;
    __syncthreads();
    const int lo = args.ph_lo, hi = args.ph_hi;
    const bool multi = (hi - lo) > 1;
    XcdBarrier bar; bar.bar = F.ctl + CW_BAR; bar.x = 0; bar.st = nullptr;
    if (multi) bar = xcd_barrier_post(F.ctl + CW_BAR, MISC + 8);
#ifndef PHASE_MASK
#define PHASE_MASK 0xFFFF
#endif
#define IN(k) ((((PHASE_MASK) >> (k)) & 1) && lo <= (k) && (k) < hi)
#define SEAM(k) do { if (IN(k) && IN((k) + 1)) xcd_barrier(bar); } while (0)

    if (IN(0)) { p0_prologue(F); } SEAM(0);
    if (IN(1)) { p1_rows_filters(F); } SEAM(1);
    if (IN(2)) {
#if SIMPLE_GEMM
        { bf16* PHY = F.PHY; simple_gemm(F, F.W1T, F.H, 3 * HW, T, D, [&](int r, int c, float v) { PHY[(size_t)r * T + c] = (bf16)f2bf(v); }); }
        __syncthreads();
        { bf16* QKVp = F.QKV; bf16* Gp = F.GT; const float* bias = F.b_bg;
          simple_gemm(F, F.H, F.W1T + (size_t)(3 * HW) * D, T, QKVW + 2 * D, D, [&](int r, int c, float v) {
              if (c < QKVW) QKVp[(size_t)r * QKVW + c] = (bf16)f2bf(v); else Gp[(size_t)r * (2 * D) + (c - QKVW)] = (bf16)f2bf(1.0f / (1.0f + __expf(-(v + bias[c - QKVW])))); }); }
#else
        { EpiPlainBf16 E{F.PHY, T}; run_gemm(F, F.W1T, F.H, 3 * HW, T, D, E); }
        { EpiProj E{F.QKV, F.GT, F.ROT, F.b_bg}; run_gemm(F, F.H, F.W1T + (size_t)(3 * HW) * D, T, QKVW + 2 * D, D, E); }
#endif
    } SEAM(2);
    if (IN(3)) {
#if SIMPLE_GEMM
        for (int i = F.bid * NTHR + F.tid; i < T * 24 * 16; i += F.G * NTHR) { const int k = i & 15, hd = (i >> 4) % 24, tok = (i >> 4) / 24;
            bf16* p = F.QKV + (size_t)tok * QKVW + hd * HD; const float a = bf2f(p[k]), b2 = bf2f(p[k + 16]), cs = F.ROT[tok * 32 + k], sn = F.ROT[tok * 32 + 16 + k];
            p[k] = (bf16)f2bf(a * cs - b2 * sn); p[k + 16] = (bf16)f2bf(b2 * cs + a * sn); }
#endif
    } SEAM(3);
    if (IN(4)) { p3_hyena_naive(F); __syncthreads(); p3_attn_naive(F); } SEAM(4);
    if (IN(5)) {
#if SIMPLE_GEMM
        { float* TMP = F.TMP; const bf16* G = F.GT; simple_gemm(F, F.YHY, F.WHYOT, T, D, HW, [&](int r, int c, float v) { TMP[(size_t)r * D + c] = v * bf2f(G[(size_t)r * (2 * D) + c]); }); }
        __syncthreads();
        { float* TMP = F.TMP; const bf16* G = F.GT; bf16* Mp = F.MERGED; simple_gemm(F, F.YAT, F.WATOT, T, D, 512, [&](int r, int c, float v) { Mp[(size_t)r * D + c] = (bf16)f2bf(TMP[(size_t)r * D + c] + v * bf2f(G[(size_t)r * (2 * D) + D + c])); }); }
#else
        { EpiGate<0> E{F.GT, 0, F.TMP, F.MERGED}; run_gemm(F, F.YHY, F.WHYOT, T, D, HW, E); }
        { EpiGate<1> E{F.GT, D, F.TMP, F.MERGED}; run_gemm(F, F.YAT, F.WATOT, T, D, 512, E); }
#endif
    } SEAM(5);
    if (IN(6)) {
#if SIMPLE_GEMM
        { float* Y = F.Y; simple_gemm(F, F.MERGED, F.WOUTT, T, D, D, [&](int r, int c, float v) { Y[(size_t)r * D + c] = v; }); }
#else
        { EpiF32 E{F.Y, D}; run_gemm(F, F.MERGED, F.WOUTT, T, D, D, E); }
#endif
    } SEAM(6);
    if (IN(7)) { p6_rows_router(F); } SEAM(7);
    if (IN(8)) { p7_moe1(F); } SEAM(8);
    if (IN(9)) { p8_moe2(F); } SEAM(9);
    if (IN(10)) { p9_final(F); }
#undef IN
#undef SEAM
}

extern "C" void kernel_launch(void* const* d_in, const int* in_sizes, int n_in, void* d_out, int out_size, void* d_ws, size_t ws_size, hipStream_t stream) {
    static int grid = 0;
    if (grid == 0) {
        if (n_in != 31 || out_size != T * D || ws_size < WS_END) { fprintf(stderr, "kernel_launch: unexpected shapes (n_in %d out %d ws %zu)\n", n_in, out_size, ws_size); grid = -1; return; }
        int dev = 0, cus = 0, per_cu = 0;
        if (hipGetDevice(&dev) != hipSuccess || hipDeviceGetAttribute(&cus, hipDeviceAttributeMultiprocessorCount, dev) != hipSuccess) { grid = -1; return; }
        if (hipFuncSetAttribute((const void*)fwd_kernel, hipFuncAttributeMaxDynamicSharedMemorySize, LDS_BYTES) != hipSuccess) { fprintf(stderr, "kernel_launch: hipFuncSetAttribute failed\n"); grid = -1; return; }
        if (hipOccupancyMaxActiveBlocksPerMultiprocessor(&per_cu, (const void*)fwd_kernel, NTHR, LDS_BYTES) != hipSuccess || per_cu < 1) fprintf(stderr, "kernel_launch: occupancy query says %d\n", per_cu);
        (void)hipGetLastError();
        grid = cus;
    }
    if (grid < 0) return;
    if (hipMemsetAsync((char*)d_ws + WS_CTL, 0, CTL_ZERO_BYTES, stream) != hipSuccess) return;
    Args a{};
    for (int i = 0; i < 31; ++i) a.in[i] = d_in[i];
    a.out = (float*)d_out; a.ws = (unsigned char*)d_ws;
#if N_LAUNCH_MODE == 1
    a.ph_lo = 0; a.ph_hi = NPHASE;
    hipLaunchKernelGGL(fwd_kernel, dim3(grid), dim3(NTHR), LDS_BYTES, stream, a);
#else
    for (int p = 0; p < NPHASE; ++p) { if (p == 3 && !SIMPLE_GEMM) continue; a.ph_lo = p; a.ph_hi = p + 1; hipLaunchKernelGGL(fwd_kernel, dim3(grid), dim3(NTHR), LDS_BYTES, stream, a); }
#endif
}
```

```cpp
#include <hip/hip_runtime.h>
#include <cstdio>
#include <cstdint>
namespace pg8 {
#define PG8_LAS __attribute__((address_space(3)))
typedef unsigned short bf16_t;
typedef short bf16x8 __attribute__((ext_vector_type(8)));
typedef float f32x4 __attribute__((ext_vector_type(4)));
typedef unsigned u32x4 __attribute__((ext_vector_type(4)));
constexpr int BM = 256, BK = 64, HALF = 128, HTB = HALF * BK * 2  , STAGE_BYTES = 8 * HTB, NXCD = 8, WGM = 8;

__host__ __device__ __forceinline__ int lds_byte(int r, int c) { const int st = (r >> 4) * 2 + (c >> 5), rr = r & 15, cc = c & 31, ob = rr * 64 + cc * 2; return st * 1024 + (ob ^ (((ob >> 9) & 1) << 5)); }
__host__ __device__ __forceinline__ void stage_rc(int b, int& R, int& C) { const int st = b / 1024, sb = b % 1024, swz = sb ^ (((sb >> 9) & 1) << 5); R = (st >> 1) * 16 + swz / 64; C = (st & 1) * 32 + (swz % 64) / 2; }
__host__ __device__ __forceinline__ int perm32(int rho) { const int n = rho >> 4, i = rho & 15; return 8 * (i >> 2) + 4 * n + (i & 3); }

struct Unit { int pm, pn; };
struct Gemm { const bf16_t* A; const bf16_t* Bt; int M, N, K; };

struct StaticOrder {
    int nM, nN, nwg, G, c;
    __host__ __device__ void init(int M, int N, int G_, int c_) { nM = M / BM; nN = N / BM; nwg = nM * nN; G = G_; c = c_; }
    __host__ __device__ bool next(int i, Unit& u) const {
        const long L = (long)i * G + c; if (L >= nwg) return false;
        int wgid = (int)L; { const int q = nwg / NXCD, r = nwg % NXCD, xcd = wgid % NXCD, off = wgid / NXCD; wgid = (xcd < r ? xcd * (q + 1) : r * (q + 1) + (xcd - r) * q) + off; }
        const int nig = WGM * nN, gid = wgid / nig, fm = gid * WGM, gsz = (nM - fm) < WGM ? (nM - fm) : WGM;
        u.pm = fm + ((wgid % nig) % gsz); u.pn = (wgid % nig) / gsz; return true;
    }
    __device__ __forceinline__ void a_ready(const Unit&) const {}
    __device__ __forceinline__ void done(const Unit&) const {}
};

__device__ __forceinline__ unsigned cvt_pk_bf16(float lo, float hi) { unsigned r; asm volatile("v_cvt_pk_bf16_f32 %0, %1, %2" : "=v"(r) : "v"(lo), "v"(hi)); return r; }
typedef float f32x2 __attribute__((ext_vector_type(2)));
template <class Epi, class Sched, bool ALIGN_EPI = false, bool SP2 = false>
__device__ __forceinline__ void gemm_phase(PG8_LAS unsigned char* lds, const Gemm g, const Sched& S, const Epi& E) {
    const int tid = threadIdx.x, wid = __builtin_amdgcn_readfirstlane(tid >> 6), lane = tid & 63, wr = wid >> 2, wc = wid & 3, fr = lane & 15, fq = lane >> 4;
    const int K = g.K, nt = K / BK;
    unsigned voffA[2], voffB[2];
#pragma unroll
    for (int i = 0; i < 2; ++i) { int R, C; stage_rc(tid * 16 + i * 8192, R, C); const int Rb = Epi::PERM ? ((R & ~31) + perm32(R & 31)) : R;
        voffA[i] = (unsigned)(R * K + C) * 2u; voffB[i] = (unsigned)(Rb * K + C) * 2u; }
    const size_t kstep = (size_t)(BK * 2);
    const size_t hstep = (size_t)HALF * K * 2;
    const size_t tstep = 2 * hstep;
    const unsigned ldsw = (unsigned)wid * 1024u;
    const int aoff = lds_byte(wr * 64 + fr, fq * 8), boff = lds_byte(wc * 32 + fr, fq * 8);
#define PG8_SA(b, h) (((b) * 2 + (h)) * HTB)
#define PG8_SB(b, h) ((4 + (b) * 2 + (h)) * HTB)
#define PG8_STAGE(bufoff, gbase, voff) do { _Pragma("unroll") for (int _i = 0; _i < 2; ++_i) \
        __builtin_amdgcn_global_load_lds((const unsigned*)((const char*)(gbase) + (voff)[_i]), (PG8_LAS unsigned*)(lds + (bufoff) + ldsw + _i * 8192), 16, 0, 0); } while (0)
#define PG8_LDA(dst, b, h) do { _Pragma("unroll") for (int m = 0; m < 4; ++m) _Pragma("unroll") for (int k = 0; k < 2; ++k) dst[m][k] = *(const PG8_LAS bf16x8*)(lds + PG8_SA(b, h) + aoff + m * 2048 + k * 1024); } while (0)
#define PG8_LDB(dst, b, h) do { _Pragma("unroll") for (int n = 0; n < 2; ++n) _Pragma("unroll") for (int k = 0; k < 2; ++k) dst[n][k] = *(const PG8_LAS bf16x8*)(lds + PG8_SB(b, h) + boff + n * 2048 + k * 1024); } while (0)
#define PG8_MMA(ai, bj, At, Bt) do { __builtin_amdgcn_s_setprio(1); _Pragma("unroll") for (int m = 0; m < 4; ++m) _Pragma("unroll") for (int n = 0; n < 2; ++n) _Pragma("unroll") for (int k = 0; k < 2; ++k) \
        acc[ai][bj][m][n] = __builtin_amdgcn_mfma_f32_16x16x32_bf16(Bt[n][k], At[m][k], acc[ai][bj][m][n], 0, 0, 0); __builtin_amdgcn_s_setprio(0); } while (0)
#define PG8_WAIT_V(n) asm volatile("s_waitcnt vmcnt(" #n ")" ::: "memory")
#define PG8_WAIT_L(n) asm volatile("s_waitcnt lgkmcnt(" #n ")" ::: "memory")
#define PG8_BAR __builtin_amdgcn_s_barrier()
#define PG8_SCHED __builtin_amdgcn_sched_barrier(0)
    Unit cur, nxt; int ui = 0;
    if (!S.next(0, cur)) return;
    f32x4 acc[2][2][4][2];
#pragma unroll
    for (int a = 0; a < 2; ++a)
#pragma unroll
        for (int b = 0; b < 2; ++b)
#pragma unroll
            for (int m = 0; m < 4; ++m)
#pragma unroll
                for (int n = 0; n < 2; ++n) acc[a][b][m][n] = (f32x4){0.f, 0.f, 0.f, 0.f};
    bf16x8 At[4][2], B0[2][2], B1[2][2];
    const char* cA = (const char*)g.A + (size_t)cur.pm * tstep; const char* cB = (const char*)g.Bt + (size_t)cur.pn * tstep;
    S.a_ready(cur);
    if constexpr (SP2) {
        PG8_STAGE(PG8_SB(0, 0), cB, voffB); PG8_STAGE(PG8_SB(0, 1), cB + hstep, voffB); PG8_STAGE(PG8_SA(0, 0), cA, voffA); PG8_STAGE(PG8_SA(0, 1), cA + hstep, voffA);
        if (wr == 1) PG8_BAR;
        PG8_WAIT_V(2); PG8_BAR;
        PG8_STAGE(PG8_SB(1, 0), cB + kstep, voffB); PG8_STAGE(PG8_SA(1, 0), cA + kstep, voffA); PG8_STAGE(PG8_SB(1, 1), cB + hstep + kstep, voffB);
        PG8_WAIT_V(6); PG8_BAR;
    } else {
        PG8_STAGE(PG8_SB(0, 0), cB, voffB); PG8_STAGE(PG8_SA(0, 0), cA, voffA); PG8_STAGE(PG8_SB(0, 1), cB + hstep, voffB); PG8_STAGE(PG8_SA(0, 1), cA + hstep, voffA);
        if (wr == 1) PG8_BAR;
        PG8_WAIT_V(4); PG8_BAR;
        PG8_STAGE(PG8_SB(1, 0), cB + kstep, voffB); PG8_STAGE(PG8_SA(1, 0), cA + kstep, voffA); PG8_STAGE(PG8_SB(1, 1), cB + hstep + kstep, voffB);
        PG8_WAIT_V(6); PG8_BAR;
    }
    for (;;) {
        const bool has_next = S.next(ui + 1, nxt);
        const char* nA = has_next ? (const char*)g.A + (size_t)nxt.pm * tstep : cA; const char* nB = has_next ? (const char*)g.Bt + (size_t)nxt.pn * tstep : cB;
        for (int t = 0; t < nt; t += 2) {
            const bool last = (t == nt - 2);
            const char* a1 = cA + (size_t)(t + 1) * kstep;
            const char* a2 = last ? nA : cA + (size_t)(t + 2) * kstep; const char* b2 = last ? nB : cB + (size_t)(t + 2) * kstep;
            const char* a3 = a2 + kstep; const char* b3 = b2 + kstep;
            if (last && has_next) S.a_ready(nxt);
            if constexpr (SP2) {
            PG8_LDB(B0, 0, 0); PG8_LDB(B1, 0, 1); PG8_SCHED; PG8_LDA(At, 0, 0); PG8_STAGE(PG8_SA(1, 1), a1 + hstep, voffA);
            PG8_WAIT_V(8); PG8_WAIT_L(0); PG8_BAR; PG8_MMA(0, 0, At, B0); PG8_MMA(0, 1, At, B1); PG8_BAR; PG8_SCHED;
            PG8_LDA(At, 0, 1); PG8_STAGE(PG8_SB(0, 0), b2, voffB); PG8_STAGE(PG8_SB(0, 1), b2 + hstep, voffB); PG8_STAGE(PG8_SA(0, 0), a2, voffA);
            PG8_WAIT_V(8); PG8_WAIT_L(0); PG8_BAR; PG8_MMA(1, 0, At, B0); PG8_MMA(1, 1, At, B1); PG8_BAR; PG8_SCHED;
            PG8_LDB(B0, 1, 0); PG8_LDB(B1, 1, 1); PG8_SCHED; PG8_LDA(At, 1, 0); PG8_STAGE(PG8_SA(0, 1), a2 + hstep, voffA);
            PG8_WAIT_V(8); PG8_WAIT_L(0); PG8_BAR; PG8_MMA(0, 0, At, B0); PG8_MMA(0, 1, At, B1); PG8_BAR; PG8_SCHED;
            PG8_LDA(At, 1, 1); PG8_STAGE(PG8_SB(1, 0), b3, voffB); PG8_STAGE(PG8_SB(1, 1), b3 + hstep, voffB); PG8_STAGE(PG8_SA(1, 0), a3, voffA);
            PG8_WAIT_V(8); PG8_WAIT_L(0); PG8_BAR; PG8_MMA(1, 0, At, B0); PG8_MMA(1, 1, At, B1); PG8_BAR; PG8_SCHED;
            } else {
            PG8_LDB(B0, 0, 0); PG8_SCHED; PG8_LDA(At, 0, 0); PG8_STAGE(PG8_SA(1, 1), a1 + hstep, voffA);
            PG8_WAIT_L(8); PG8_BAR; PG8_WAIT_L(0); PG8_MMA(0, 0, At, B0); PG8_BAR; PG8_SCHED;
            PG8_LDB(B1, 0, 1); PG8_STAGE(PG8_SB(0, 0), b2, voffB);
            PG8_BAR; PG8_WAIT_L(0); PG8_MMA(0, 1, At, B1); PG8_BAR;
            PG8_LDA(At, 0, 1); PG8_STAGE(PG8_SA(0, 0), a2, voffA);
            PG8_BAR; PG8_WAIT_L(0); PG8_MMA(1, 0, At, B0); PG8_BAR; PG8_SCHED;
            PG8_STAGE(PG8_SB(0, 1), b2 + hstep, voffB);
            PG8_WAIT_V(6); PG8_BAR; PG8_MMA(1, 1, At, B1); PG8_BAR;
            PG8_LDB(B0, 1, 0); PG8_SCHED; PG8_LDA(At, 1, 0); PG8_STAGE(PG8_SA(0, 1), a2 + hstep, voffA);
            PG8_WAIT_L(8); PG8_BAR; PG8_WAIT_L(0); PG8_MMA(0, 0, At, B0); PG8_BAR; PG8_SCHED;
            PG8_LDB(B1, 1, 1); PG8_STAGE(PG8_SB(1, 0), b3, voffB);
            PG8_BAR; PG8_WAIT_L(0); PG8_MMA(0, 1, At, B1); PG8_BAR;
            PG8_LDA(At, 1, 1); PG8_STAGE(PG8_SA(1, 0), a3, voffA);
            PG8_BAR; PG8_WAIT_L(0); PG8_MMA(1, 0, At, B0); PG8_BAR; PG8_SCHED;
            PG8_STAGE(PG8_SB(1, 1), b3 + hstep, voffB);
            PG8_WAIT_V(6); PG8_BAR; PG8_MMA(1, 1, At, B1); PG8_BAR;
            }
        }
        if constexpr (ALIGN_EPI) { if (wr == 0) PG8_BAR; }
        if constexpr (!Epi::AFTER_DRAIN) { E(acc, cur, wr, wc, fr, fq); S.done(cur); }
        if (!has_next) break;
#pragma unroll
        for (int a = 0; a < 2; ++a)
#pragma unroll
            for (int b = 0; b < 2; ++b)
#pragma unroll
                for (int m = 0; m < 4; ++m)
#pragma unroll
                    for (int n = 0; n < 2; ++n) acc[a][b][m][n] = (f32x4){0.f, 0.f, 0.f, 0.f};
        cur = nxt; cA = nA; cB = nB; ++ui;
        if constexpr (ALIGN_EPI) { if (wr == 1) PG8_BAR; }
    }
    PG8_WAIT_V(0);
    if constexpr (!ALIGN_EPI) { if (wr == 0) PG8_BAR; }
    PG8_BAR;
    if constexpr (Epi::AFTER_DRAIN) { E.fused(acc, cur, wr, wc, fr, fq, lds, wid, lane); S.done(cur); }
#undef PG8_SA
#undef PG8_SB
#undef PG8_STAGE
#undef PG8_LDA
#undef PG8_LDB
#undef PG8_MMA
#undef PG8_WAIT_V
#undef PG8_WAIT_L
#undef PG8_BAR
#undef PG8_SCHED
}
}


#ifndef N_LAUNCH_MODE
#define N_LAUNCH_MODE 1
#endif
#ifndef MOE_SIMT
#define MOE_SIMT 0
#endif
#ifndef HYENA_NAIVE
#define HYENA_NAIVE 0
#endif
#ifndef ATTN_NAIVE
#define ATTN_NAIVE 0
#endif
#ifndef SIMPLE_GEMM
#define SIMPLE_GEMM 0
#endif

constexpr int D = 2048, BATCH = 2, SEQ = 4096, T = BATCH * SEQ;
constexpr int HW = 1024;
constexpr int NH = 12, HD = 128, QKVW = 3 * NH * HD;
constexpr int INW = 3 * HW + QKVW;
constexpr int N1 = INW + 2 * D;
constexpr int NE = 64, FF = 512;
constexpr float RMS_EPS = 1e-6f;
constexpr int NWAVES = 8, NTHR = 512;
constexpr int NPHASE = 12;

constexpr size_t MiB = 1u << 20;
constexpr size_t WS_CTL = 0, CTL_ZERO_BYTES = 1 * MiB;
constexpr size_t WS_MODP = 1 * MiB;
constexpr size_t WS_HID2 = 2 * MiB;
constexpr size_t WS_ROT = 3 * MiB;
constexpr size_t WS_W3T = 4 * MiB;
constexpr size_t WS_ROUTE = 5 * MiB;
constexpr size_t WS_LISTT = 6 * MiB;
constexpr size_t WS_LISTG = 8 * MiB;
constexpr size_t WS_W1T = 16 * MiB;
constexpr size_t WS_WHYOT = 64 * MiB;
constexpr size_t WS_WATOT = 68 * MiB;
constexpr size_t WS_WOUTT = 70 * MiB;
constexpr size_t WS_KF = 80 * MiB;
constexpr size_t WS_H = 144 * MiB;
constexpr size_t WS_PHY = 176 * MiB;
constexpr size_t WS_QKV = 224 * MiB;
constexpr size_t WS_G = 296 * MiB;
constexpr size_t WS_YHY = 360 * MiB;
constexpr size_t WS_YAT = 376 * MiB;
constexpr size_t WS_TMP = 384 * MiB;
constexpr size_t WS_MERGED = 448 * MiB;
constexpr size_t WS_Y = 480 * MiB;
constexpr size_t WS_X1 = 544 * MiB;
constexpr size_t WS_H2 = 608 * MiB;
constexpr size_t WS_ACT = 640 * MiB;
constexpr size_t WS_YB = 672 * MiB;
constexpr size_t WS_END = 800 * MiB;
constexpr int CW_BAR = 4096;
constexpr int CW_CNT = 16384;

constexpr int RING_BYTES = 131072;
constexpr int LDS_BYTES = 163840;
constexpr int MISC_OFF = LDS_BYTES - 256;
constexpr int MOE_OFFS_OFF = LDS_BYTES - 1024;

#define GAS __attribute__((address_space(1)))
#define LAS __attribute__((address_space(3)))
typedef unsigned short bf16;
typedef unsigned v4u __attribute__((ext_vector_type(4)));
typedef unsigned v2u __attribute__((ext_vector_type(2)));
typedef float f32x4 __attribute__((ext_vector_type(4)));
typedef LAS float lfloat;

__device__ __forceinline__ unsigned f2bf(float f) { unsigned u = __builtin_bit_cast(unsigned, f); return (u + 0x7fffu + ((u >> 16) & 1u)) >> 16; }
__device__ __forceinline__ unsigned pk2(float lo, float hi) { return f2bf(lo) | (f2bf(hi) << 16); }
__device__ __forceinline__ float bf2f(unsigned short b) { return __builtin_bit_cast(float, ((unsigned)b) << 16); }
__device__ __forceinline__ float bflo(unsigned w) { return __builtin_bit_cast(float, w << 16); }
__device__ __forceinline__ float bfhi(unsigned w) { return __builtin_bit_cast(float, w & 0xffff0000u); }

#define XB_TMO      128
#define XB_XCNT(j)  (256  + 64 * (j))
#define XB_XSUB(j)  (1280 + 64 * (j))
#define XB_XGEN(j)  (2304 + 64 * (j))
#define XB_TOP      3328
#define XB_TOPGEN   3392
#define XCD_BAR_WORDS 3456
#define XB_SPIN_CAP (1u << 18)
__device__ __forceinline__ unsigned xb_ld(unsigned* p)              { return __hip_atomic_load(p, __ATOMIC_RELAXED, __HIP_MEMORY_SCOPE_AGENT); }
__device__ __forceinline__ unsigned xb_add(unsigned* p, unsigned v) { return __hip_atomic_fetch_add(p, v, __ATOMIC_RELAXED, __HIP_MEMORY_SCOPE_AGENT); }
__device__ __forceinline__ unsigned xb_xcc_id() { return (unsigned)__builtin_amdgcn_s_getreg((3 << 11) | 20) & 0xFu; }
#define XB_SPIN(cond, bar) do { unsigned _sp = 0; while (cond) { __builtin_amdgcn_s_sleep(1); \
    if ((++_sp & 255u) == 0u) { if (xb_ld(&(bar)[XB_TMO])) break; if (_sp > XB_SPIN_CAP) { atomicAdd(&(bar)[XB_TMO], 1u); break; } } } } while (0)
struct XcdBarrier { unsigned* bar; unsigned x; volatile LAS unsigned* st; };
__device__ __forceinline__ XcdBarrier xcd_barrier_post(unsigned* bar, volatile LAS unsigned* st) {
    XcdBarrier b; b.bar = bar; b.x = xb_xcc_id(); b.st = st;
    if (threadIdx.x == 0) (void)xb_add(&bar[XB_XCNT(b.x)], 1u);
    return b;
}
__device__ __forceinline__ void xcd_barrier_complete(unsigned* bar, unsigned x, unsigned& nloc, unsigned& nx) {
    const unsigned G = gridDim.x * gridDim.y * gridDim.z;
    unsigned sum, cnt, mine, sp = 0u;
    for (;;) {
        sum = 0u; cnt = 0u; mine = 0u;
#pragma unroll
        for (unsigned j = 0; j < 16; ++j) { const unsigned c = xb_ld(&bar[XB_XCNT(j)]); sum += c; cnt += (c > 0u) ? 1u : 0u; mine = (j == x) ? c : mine; }
        if (sum == G) break;
        __builtin_amdgcn_s_sleep(1);
        if ((++sp & 255u) == 0u) { if (xb_ld(&bar[XB_TMO])) break; if (sp > XB_SPIN_CAP) { atomicAdd(&bar[XB_TMO], 1u); break; } }
    }
    nloc = mine > 0u ? mine : 1u; nx = cnt > 0u ? cnt : 1u;
}
__device__ __forceinline__ void xcd_barrier(const XcdBarrier& b) {
    asm volatile("s_waitcnt vmcnt(0)" ::: "memory");
    __syncthreads();
    if (threadIdx.x == 0) {
        unsigned* bar = b.bar;
        __builtin_amdgcn_s_waitcnt(0);
        unsigned nloc = b.st[0], nx = b.st[1];
        if (nloc == 0u) { xcd_barrier_complete(bar, b.x, nloc, nx); b.st[0] = nloc; b.st[1] = nx; }
        const unsigned old = xb_add(&bar[XB_XSUB(b.x)], 1u);
        const unsigned gen = old / nloc;
        if (old + 1u == (gen + 1u) * nloc) {
            __builtin_amdgcn_fence(__ATOMIC_RELEASE, "agent");
            asm volatile("s_waitcnt vmcnt(0)" ::: "memory");
            const unsigned og = xb_add(&bar[XB_TOP], 1u);
            const unsigned tg = og / nx;
            if (og + 1u == (tg + 1u) * nx) xb_add(&bar[XB_TOPGEN], 1u);
            else XB_SPIN(xb_ld(&bar[XB_TOPGEN]) == tg, bar);
            __builtin_amdgcn_fence(__ATOMIC_ACQUIRE, "agent");
            xb_add(&bar[XB_XGEN(b.x)], 1u);
            asm volatile("s_waitcnt vmcnt(0)" ::: "memory");
        } else {
            XB_SPIN(xb_ld(&bar[XB_XGEN(b.x)]) == gen, bar);
            __builtin_amdgcn_fence(__ATOMIC_ACQUIRE, "agent");
            asm volatile("s_waitcnt vmcnt(0)" ::: "memory");
        }
    }
    __syncthreads();
}

struct Args { const void* in[31]; float* out; unsigned char* ws; int ph_lo, ph_hi; };
struct Frame {
    LAS unsigned char* lds;
    int tid, lane, wave, G, bid;
    const float *x, *c, *w_ada, *b_ada, *g_mix_pre, *g_mix_post, *g_ffn_pre, *g_ffn_post, *w_in, *conv_w, *conv_b, *fw1, *fb1, *fw2, *fb2, *fw3, *ffreq, *hskip,
        *w_bg, *b_bg, *w_hy_o, *w_at_o, *w_out, *w_group, *b_group, *w_expert, *b_expert, *w1e, *w3e, *w2e;
    const int* positions;
    float* out;
    unsigned* ctl; float *MODP, *HID2, *ROT, *W3T, *TMP, *Y, *X1, *ACT, *YB, *LISTG; bf16* KF;
    unsigned* ROUTE; int* LISTT;
    bf16 *W1T, *WHYOT, *WATOT, *WOUTT, *H, *PHY, *QKV, *GT, *YHY, *YAT, *MERGED, *H2, *ACTB, *YBB;
};

__device__ __forceinline__ float wave_sum(float v) {
#pragma unroll
    for (int o = 1; o < 64; o <<= 1) v += __shfl_xor(v, o);
    return v;
}
__device__ __forceinline__ float wave_max(float v) {
#pragma unroll
    for (int o = 1; o < 64; o <<= 1) v = fmaxf(v, __shfl_xor(v, o));
    return v;
}

__device__ __forceinline__ void p0_transpose_item(const float* W, int K, int N, bf16* WT, int row_off, LAS float* scr, int item, int lane) {
    const int nblk = N / 32, kb = item / nblk, nb = item % nblk, k0 = 64 * kb, n0 = 32 * nb;
#pragma unroll 8
    for (int i = 0; i < 32; ++i) { const int kk = 2 * i + (lane >> 5); scr[kk * 33 + (lane & 31)] = W[(size_t)(k0 + kk) * N + n0 + (lane & 31)]; }
    asm volatile("s_waitcnt lgkmcnt(0)" ::: "memory");
    const int c = lane & 7;
#pragma unroll
    for (int j = 0; j < 4; ++j) { const int n = (lane >> 3) + 8 * j; const LAS float* s = scr + (8 * c) * 33 + n;
        v4u o; o.x = pk2(s[0 * 33], s[1 * 33]); o.y = pk2(s[2 * 33], s[3 * 33]); o.z = pk2(s[4 * 33], s[5 * 33]); o.w = pk2(s[6 * 33], s[7 * 33]);
        *(v4u*)(WT + (size_t)(row_off + n0 + n) * K + k0 + 8 * c) = o; }
    asm volatile("s_waitcnt lgkmcnt(0)" ::: "memory");
}

__device__ __forceinline__ void load_mod(Frame& F, LAS float* dst, int which) {
    for (int i = F.tid; i < 2 * D; i += NTHR) { const int b = i / D, d = i % D; float s = F.b_ada[which * D + d];
#pragma unroll
        for (int ks = 0; ks < 8; ++ks) s += F.MODP[(size_t)(ks * 2 + b) * (6 * D) + which * D + d];
        dst[i] = s; }
}

__device__ __forceinline__ void p0_prologue(Frame& F) {
    LAS float* L = (LAS float*)F.lds;
    {
        LAS float* sc = L;
        LAS float* red = L + 512;
        for (int u = F.bid; u < 48 * 8; u += F.G) {
            const int chunk = u % 48, ks = u / 48;
            { const int b = F.tid >> 8, i = F.tid & 255; const float cv = F.c[b * D + ks * 256 + i]; sc[b * 256 + i] = cv / (1.f + __expf(-cv)); }
            __syncthreads();
            f32x4 a0 = {0.f, 0.f, 0.f, 0.f}, a1 = {0.f, 0.f, 0.f, 0.f};
            const float* wp = F.w_ada + (size_t)(ks * 256 + F.wave * 32) * (6 * D) + chunk * 256 + F.lane * 4;
#pragma unroll 8
            for (int r = 0; r < 32; ++r) { const f32x4 w = *(const f32x4*)(wp + (size_t)r * (6 * D)); const float s0 = sc[F.wave * 32 + r], s1 = sc[256 + F.wave * 32 + r]; a0 += w * s0; a1 += w * s1; }
            *(LAS f32x4*)(red + (F.wave * 2 + 0) * 256 + F.lane * 4) = a0;
            *(LAS f32x4*)(red + (F.wave * 2 + 1) * 256 + F.lane * 4) = a1;
            __syncthreads();
            { const int b = F.tid >> 8, col = F.tid & 255; float s = 0.f;
#pragma unroll
              for (int w = 0; w < 8; ++w) s += red[(w * 2 + b) * 256 + col];
              F.MODP[(size_t)(ks * 2 + b) * (6 * D) + chunk * 256 + col] = s; }
            __syncthreads();
        }
    }
    const int gw = F.bid * NWAVES + F.wave, NGW = F.G * NWAVES;
    {
        LAS float* scr = (LAS float*)(F.lds + F.wave * 16384);
        constexpr int I_IN = (D / 64) * (INW / 32), I_BG = (D / 64) * (2 * D / 32), I_HY = (HW / 64) * (D / 32), I_AT = (512 / 64) * (D / 32), I_OUT = (D / 64) * (D / 32);
        constexpr int NITEMS = I_IN + I_BG + I_HY + I_AT + I_OUT;
        for (int it = gw; it < NITEMS; it += NGW) {
            int r = it;
            if (r < I_IN) { p0_transpose_item(F.w_in, D, INW, F.W1T, 0, scr, r, F.lane); continue; } r -= I_IN;
            if (r < I_BG) { p0_transpose_item(F.w_bg, D, 2 * D, F.W1T, INW, scr, r, F.lane); continue; } r -= I_BG;
            if (r < I_HY) { p0_transpose_item(F.w_hy_o, HW, D, F.WHYOT, 0, scr, r, F.lane); continue; } r -= I_HY;
            if (r < I_AT) { p0_transpose_item(F.w_at_o, 512, D, F.WATOT, 0, scr, r, F.lane); continue; } r -= I_AT;
            p0_transpose_item(F.w_out, D, D, F.WOUTT, 0, scr, r, F.lane);
        }
    }
    for (int i = F.bid * NTHR + F.tid; i < 64 * 4096; i += F.G * NTHR) { const int n = i >> 6, j = i & 63; F.W3T[i] = F.fw3[j * 4096 + n]; }
    for (int t = gw; t < SEQ; t += NGW) {
        const int j = F.lane;
        const float tn = (float)t * (1.0f / (float)(SEQ - 1));
        const float w = 6.283185307179586f * (float)t / (float)SEQ;
        float feat = 0.f;
        if (j == 0) feat = tn;
        else if (j <= 16) { const float band = 1e-4f + (float)(j - 1) * ((15.0f - 1e-4f) / 15.0f); feat = cosf(band * w); }
        else if (j <= 32) { const float band = 1e-4f + (float)(j - 17) * ((15.0f - 1e-4f) / 15.0f); feat = -sinf(band * w); }
        float a = F.fb1[j];
        for (int i = 0; i < 33; ++i) a += __shfl(feat, i) * F.fw1[i * 64 + j];
        const float fr = F.ffreq[j];
        const float h1 = sinf(fr * a);
        float a2 = F.fb2[j];
        for (int i = 0; i < 64; ++i) a2 += __shfl(h1, i) * F.fw2[i * 64 + j];
        F.HID2[t * 64 + j] = sinf(fr * a2);
    }
    for (int i = F.bid * NTHR + F.tid; i < T * 16; i += F.G * NTHR) {
        const int tok = i >> 4, k = i & 15;
        const float inv = powf(500000.0f, -(float)k * (1.0f / 16.0f));
        const float ang = (float)F.positions[tok] * inv;
        F.ROT[tok * 32 + k] = cosf(ang); F.ROT[tok * 32 + 16 + k] = sinf(ang);
    }
}

__device__ __forceinline__ void p1_rows_filters(Frame& F) {
    LAS float* L = (LAS float*)F.lds;
    LAS float* shiftv = L;
    LAS float* scalev = L + 2 * D;
    load_mod(F, shiftv, 0); load_mod(F, scalev, 1);
    __syncthreads();
    const int gw = F.bid * NWAVES + F.wave, NGW = F.G * NWAVES;
    for (int m = gw; m < T; m += NGW) {
        const int b = m / SEQ;
        const f32x4* xr = (const f32x4*)(F.x + (size_t)m * D) + F.lane;
        f32x4 v[8]; float s = 0.f;
#pragma unroll
        for (int j = 0; j < 8; ++j) { v[j] = xr[64 * j]; s += (v[j].x * v[j].x + v[j].y * v[j].y) + (v[j].z * v[j].z + v[j].w * v[j].w); }
        const float rstd = 1.0f / sqrtf(wave_sum(s) * (1.f / D) + RMS_EPS);
        v2u* o8 = (v2u*)(F.H + (size_t)m * D) + F.lane;
#pragma unroll
        for (int j = 0; j < 8; ++j) { const int d = 256 * j + 4 * F.lane;
            const f32x4 g = *(const f32x4*)(F.g_mix_pre + d); const f32x4 sc = *(LAS f32x4*)(scalev + b * D + d), sh = *(LAS f32x4*)(shiftv + b * D + d);
            f32x4 h; h = (v[j] * rstd) * g; h = h * (sc + 1.0f) + sh;
            v2u w; w.x = pk2(h.x, h.y); w.y = pk2(h.z, h.w); o8[64 * j] = w; }
    }
    for (int u = gw; u < 64 * 64; u += NGW) {
        const int tc = u & 63, nc = u >> 6; const int t = tc * 64 + F.lane;
        float hreg[64];
#pragma unroll
        for (int j4 = 0; j4 < 16; ++j4) { const f32x4 q = *(const f32x4*)(F.HID2 + (size_t)t * 64 + 4 * j4); hreg[4 * j4] = q.x; hreg[4 * j4 + 1] = q.y; hreg[4 * j4 + 2] = q.z; hreg[4 * j4 + 3] = q.w; }
        const float tn = (float)t * (1.0f / (float)(SEQ - 1));
        for (int nn = 0; nn < 64; ++nn) {
            const int n = __builtin_amdgcn_readfirstlane(nc * 64 + nn);
            const float* wr = F.W3T + (size_t)n * 64;
            float a = 0.f;
#pragma unroll
            for (int j = 0; j < 64; ++j) a += hreg[j] * wr[j];
            const int c = n & (HW - 1);
            const float mind = -3.0701134573253945f, maxd = -15.350567286626972f;
            const float delta = fabsf(mind + (float)c * ((maxd - mind) / (float)(HW - 1)));
            F.KF[(size_t)n * SEQ + t] = (bf16)f2bf(a * expf(-tn * delta));
        }
    }
}

template <int NB, class LA, class LB, class EP>
__device__ __forceinline__ void simt_tile(LAS float* L, int K, int tid, const LA& la, const LB& lb, const EP& ep) {
    LAS float* As = L;
    LAS float* Bs = L + 32 * 68;
    const int ty = tid >> 4, tx = tid & 15;
    float acc[NB][2][4];
#pragma unroll
    for (int q = 0; q < NB; ++q)
#pragma unroll
        for (int i = 0; i < 2; ++i)
#pragma unroll
            for (int j = 0; j < 4; ++j) acc[q][i][j] = 0.f;
    for (int k0 = 0; k0 < K; k0 += 32) {
        __syncthreads();
        for (int e = tid; e < 64 * 32; e += NTHR) { const int r = e >> 5, kk = e & 31; As[kk * 68 + r] = la(r, k0 + kk); }
#pragma unroll
        for (int q = 0; q < NB; ++q)
            for (int e = tid; e < 32 * 64; e += NTHR) { const int kk = e >> 6, cc = e & 63; Bs[(q * 32 + kk) * 68 + cc] = lb(q, k0 + kk, cc); }
        __syncthreads();
#pragma unroll 8
        for (int kk = 0; kk < 32; ++kk) {
            const float a0 = As[kk * 68 + 2 * ty], a1 = As[kk * 68 + 2 * ty + 1];
#pragma unroll
            for (int q = 0; q < NB; ++q) { const f32x4 b = *(LAS f32x4*)(Bs + (q * 32 + kk) * 68 + 4 * tx);
                acc[q][0][0] += a0 * b.x; acc[q][0][1] += a0 * b.y; acc[q][0][2] += a0 * b.z; acc[q][0][3] += a0 * b.w;
                acc[q][1][0] += a1 * b.x; acc[q][1][1] += a1 * b.y; acc[q][1][2] += a1 * b.z; acc[q][1][3] += a1 * b.w; }
        }
    }
#pragma unroll
    for (int i = 0; i < 2; ++i)
#pragma unroll
        for (int j = 0; j < 4; ++j) { float v[NB];
#pragma unroll
            for (int q = 0; q < NB; ++q) v[q] = acc[q][i][j];
            ep(2 * ty + i, 4 * tx + j, v); }
}

struct EpiProj {
    static constexpr bool PERM = true, AFTER_DRAIN = false;
    bf16* QKVp; bf16* Gp; const float* ROT; const float* bias;
    __device__ __forceinline__ void operator()(const pg8::f32x4 (&acc)[2][2][4][2], const pg8::Unit& u, int wr, int wc, int fr, int fq) const {
        using namespace pg8;
        const int row0 = u.pm * BM + wr * 64 + fr;
        const int colt = u.pn * BM;
        if (colt < QKVW) {
            const bool rot = (colt < 2 * NH * HD) && (wc == 0);
#pragma unroll
            for (int ai = 0; ai < 2; ++ai)
#pragma unroll
                for (int m = 0; m < 4; ++m) { const int row = row0 + ai * HALF + m * 16;
                    bf16* rowp = QKVp + (size_t)row * QKVW + colt + wc * 32 + 8 * fq;
                    f32x4 cs0, cs1, sn0, sn1;
                    if (rot) { const float* rp = ROT + (size_t)row * 32 + 8 * (fq & 1); cs0 = *(const f32x4*)rp; cs1 = *(const f32x4*)(rp + 4); sn0 = *(const f32x4*)(rp + 16); sn1 = *(const f32x4*)(rp + 20); }
#pragma unroll
                    for (int bj = 0; bj < 2; ++bj) { f32x4 v0 = acc[ai][bj][m][0], v1 = acc[ai][bj][m][1];
                        if (rot) {
                            f32x4 o0, o1;
#pragma unroll
                            for (int j = 0; j < 4; ++j) { o0[j] = __shfl_xor(v0[j], 32); o1[j] = __shfl_xor(v1[j], 32); }
                            if (fq < 2) { v0 = v0 * cs0 - o0 * sn0; v1 = v1 * cs1 - o1 * sn1; }
                            else        { v0 = v0 * cs0 + o0 * sn0; v1 = v1 * cs1 + o1 * sn1; }
                        }
                        u32x4 w; w.x = cvt_pk_bf16(v0[0], v0[1]); w.y = cvt_pk_bf16(v0[2], v0[3]); w.z = cvt_pk_bf16(v1[0], v1[1]); w.w = cvt_pk_bf16(v1[2], v1[3]);
                        *(u32x4*)(rowp + bj * HALF) = w; } }
        } else {
            const int gc = colt - QKVW + wc * 32 + 8 * fq;
            f32x4 bv[2][2];
#pragma unroll
            for (int bj = 0; bj < 2; ++bj)
#pragma unroll
                for (int n = 0; n < 2; ++n) bv[bj][n] = *(const f32x4*)(bias + gc + bj * HALF + 4 * n);
#pragma unroll
            for (int ai = 0; ai < 2; ++ai)
#pragma unroll
                for (int m = 0; m < 4; ++m) { bf16* rowp = Gp + (size_t)(row0 + ai * HALF + m * 16) * (2 * D) + gc;
#pragma unroll
                    for (int bj = 0; bj < 2; ++bj) { f32x4 v0 = acc[ai][bj][m][0] + bv[bj][0], v1 = acc[ai][bj][m][1] + bv[bj][1];
#pragma unroll
                        for (int j = 0; j < 4; ++j) { v0[j] = 1.0f / (1.0f + __expf(-v0[j])); v1[j] = 1.0f / (1.0f + __expf(-v1[j])); }
                        u32x4 w; w.x = cvt_pk_bf16(v0[0], v0[1]); w.y = cvt_pk_bf16(v0[2], v0[3]); w.z = cvt_pk_bf16(v1[0], v1[1]); w.w = cvt_pk_bf16(v1[2], v1[3]);
                        *(u32x4*)(rowp + bj * HALF) = w; } }
        }
    }
};
struct EpiPlainBf16 {
    static constexpr bool PERM = true, AFTER_DRAIN = false;
    bf16* O; int ldc;
    __device__ __forceinline__ void operator()(const pg8::f32x4 (&acc)[2][2][4][2], const pg8::Unit& u, int wr, int wc, int fr, int fq) const {
        using namespace pg8;
        const int row0 = u.pm * BM + wr * 64 + fr, col0 = u.pn * BM + wc * 32 + 8 * fq;
#pragma unroll
        for (int ai = 0; ai < 2; ++ai)
#pragma unroll
            for (int m = 0; m < 4; ++m) { bf16* rowp = O + (size_t)(row0 + ai * HALF + m * 16) * ldc + col0;
#pragma unroll
                for (int bj = 0; bj < 2; ++bj) { const f32x4 v0 = acc[ai][bj][m][0], v1 = acc[ai][bj][m][1];
                    u32x4 w; w.x = cvt_pk_bf16(v0[0], v0[1]); w.y = cvt_pk_bf16(v0[2], v0[3]); w.z = cvt_pk_bf16(v1[0], v1[1]); w.w = cvt_pk_bf16(v1[2], v1[3]);
                    *(u32x4*)(rowp + bj * HALF) = w; } }
    }
};
template <int STAGE> struct EpiGate {
    static constexpr bool PERM = true, AFTER_DRAIN = false;
    const bf16* Gp; int goff; float* TMPp; bf16* Mp;
    __device__ __forceinline__ void operator()(const pg8::f32x4 (&acc)[2][2][4][2], const pg8::Unit& u, int wr, int wc, int fr, int fq) const {
        using namespace pg8;
        const int row0 = u.pm * BM + wr * 64 + fr, col0 = u.pn * BM + wc * 32 + 8 * fq;
#pragma unroll
        for (int ai = 0; ai < 2; ++ai)
#pragma unroll
            for (int m = 0; m < 4; ++m) { const size_t row = (size_t)(row0 + ai * HALF + m * 16);
#pragma unroll
                for (int bj = 0; bj < 2; ++bj) { const int col = col0 + bj * HALF;
                    const u32x4 gw = *(const u32x4*)(Gp + row * (2 * D) + goff + col);
                    f32x4 g0 = {bflo(gw.x), bfhi(gw.x), bflo(gw.y), bfhi(gw.y)}, g1 = {bflo(gw.z), bfhi(gw.z), bflo(gw.w), bfhi(gw.w)};
                    f32x4 v0 = acc[ai][bj][m][0] * g0, v1 = acc[ai][bj][m][1] * g1;
                    float* tp = TMPp + row * D + col;
                    if (STAGE == 0) { *(f32x4*)tp = v0; *(f32x4*)(tp + 4) = v1; }
                    else { v0 += *(const f32x4*)tp; v1 += *(const f32x4*)(tp + 4);
                        u32x4 w; w.x = cvt_pk_bf16(v0[0], v0[1]); w.y = cvt_pk_bf16(v0[2], v0[3]); w.z = cvt_pk_bf16(v1[0], v1[1]); w.w = cvt_pk_bf16(v1[2], v1[3]);
                        *(u32x4*)(Mp + row * D + col) = w; } } }
    }
};
struct EpiF32 {
    static constexpr bool PERM = false, AFTER_DRAIN = false;
    float* C; int ldc;
    __device__ __forceinline__ void operator()(const pg8::f32x4 (&acc)[2][2][4][2], const pg8::Unit& u, int wr, int wc, int fr, int fq) const {
        using namespace pg8;
        const int row0 = u.pm * BM + wr * 64 + fr, col0 = u.pn * BM + wc * 32 + 4 * fq;
#pragma unroll
        for (int ai = 0; ai < 2; ++ai)
#pragma unroll
            for (int m = 0; m < 4; ++m) { float* rowp = C + (size_t)(row0 + ai * HALF + m * 16) * ldc + col0;
#pragma unroll
                for (int bj = 0; bj < 2; ++bj)
#pragma unroll
                    for (int n = 0; n < 2; ++n) *(f32x4*)(rowp + bj * HALF + n * 16) = acc[ai][bj][m][n]; }
    }
};

template <class Epi>
__device__ __forceinline__ void run_gemm(Frame& F, const bf16* A, const bf16* Bt, int M, int N, int K, const Epi& E) {
    pg8::Gemm g{A, Bt, M, N, K}; pg8::StaticOrder S; S.init(M, N, F.G, F.bid);
    pg8::gemm_phase<Epi, pg8::StaticOrder, true, true>(F.lds, g, S, E);
}

__device__ __forceinline__ float sconv_at(const bf16* rowp, int t, float w0, float w1, float w2, float bias) {
    const float um = t > 0 ? bf2f(rowp[t - 1]) : 0.f, u0 = bf2f(rowp[t]), up = t < SEQ - 1 ? bf2f(rowp[t + 1]) : 0.f;
    return um * w0 + u0 * w1 + up * w2 + bias;
}
__device__ __forceinline__ void conv8(const LAS float* kk, const LAS float* z, int t0, float (&acc)[2][8]) {
#pragma unroll
    for (int b = 0; b < 2; ++b)
#pragma unroll
        for (int j = 0; j < 8; ++j) acc[b][j] = 0.f;
    for (int s8 = 0; s8 < SEQ; s8 += 8) {
        const int base = t0 - s8 + (SEQ - 1);
        float kw[15];
#pragma unroll
        for (int i = 0; i < 15; ++i) kw[i] = kk[base - 7 + i];
        float zz[2][8];
#pragma unroll
        for (int b = 0; b < 2; ++b) { const f32x4 q0 = *(const LAS f32x4*)(z + b * SEQ + s8), q1 = *(const LAS f32x4*)(z + b * SEQ + s8 + 4);
            zz[b][0] = q0.x; zz[b][1] = q0.y; zz[b][2] = q0.z; zz[b][3] = q0.w; zz[b][4] = q1.x; zz[b][5] = q1.y; zz[b][6] = q1.z; zz[b][7] = q1.w; }
#pragma unroll
        for (int ds = 0; ds < 8; ++ds)
#pragma unroll
            for (int j = 0; j < 8; ++j) { const float k = kw[7 + j - ds]; acc[0][j] += k * zz[0][ds]; acc[1][j] += k * zz[1][ds]; }
    }
}
__device__ __forceinline__ void p3_hyena_naive(Frame& F) {
    LAS float* L = (LAS float*)F.lds;
    LAS float* zin = L;
    LAS float* kk = L + 2 * SEQ;
    LAS float* zmid = L + 4 * SEQ;
    for (int c = F.bid; c < HW; c += F.G) {
        __syncthreads();
        const float cw[3][3] = {{F.conv_w[c], F.conv_w[3 * HW + c], F.conv_w[6 * HW + c]},
                                {F.conv_w[HW + c], F.conv_w[3 * HW + HW + c], F.conv_w[6 * HW + HW + c]},
                                {F.conv_w[2 * HW + c], F.conv_w[3 * HW + 2 * HW + c], F.conv_w[6 * HW + 2 * HW + c]}};
        const float cb[3] = {F.conv_b[c], F.conv_b[HW + c], F.conv_b[2 * HW + c]};
        const bf16* pv = F.PHY + (size_t)c * T; const bf16* px1 = F.PHY + (size_t)(HW + c) * T; const bf16* px2 = F.PHY + (size_t)(2 * HW + c) * T;
        for (int i = F.tid; i < T; i += NTHR) { const int b = i / SEQ, t = i % SEQ; zin[i] = sconv_at(pv + b * SEQ, t, cw[0][0], cw[0][1], cw[0][2], cb[0]); }
        for (int i = F.tid; i < 2 * SEQ; i += NTHR) { const int d = i - (SEQ - 1);
            kk[i] = (i == 2 * SEQ - 1) ? 0.f : bf2f(d >= 0 ? F.KF[(size_t)(0 * HW + c) * SEQ + d] : F.KF[(size_t)(1 * HW + c) * SEQ - d]); }
        __syncthreads();
        const int t0 = F.tid * 8; float acc[2][8];
        conv8(kk, zin, t0, acc);
        const float sk0 = F.hskip[c], sk1 = F.hskip[HW + c];
#pragma unroll
        for (int b = 0; b < 2; ++b)
#pragma unroll
            for (int j = 0; j < 8; ++j) { const float x1 = sconv_at(px1 + b * SEQ, t0 + j, cw[1][0], cw[1][1], cw[1][2], cb[1]);
                zmid[b * SEQ + t0 + j] = x1 * (acc[b][j] + sk0 * zin[b * SEQ + t0 + j]); }
        __syncthreads();
        for (int i = F.tid; i < 2 * SEQ; i += NTHR) { const int d = i - (SEQ - 1);
            kk[i] = (i == 2 * SEQ - 1) ? 0.f : bf2f(d >= 0 ? F.KF[(size_t)(2 * HW + c) * SEQ + d] : F.KF[(size_t)(3 * HW + c) * SEQ - d]); }
        __syncthreads();
        conv8(kk, zmid, t0, acc);
#pragma unroll
        for (int b = 0; b < 2; ++b)
#pragma unroll
            for (int j = 0; j < 8; ++j) { const float x2 = sconv_at(px2 + b * SEQ, t0 + j, cw[2][0], cw[2][1], cw[2][2], cb[2]);
                const float z2 = x2 * (acc[b][j] + sk1 * zmid[b * SEQ + t0 + j]);
                F.YHY[(size_t)(b * SEQ + t0 + j) * HW + c] = (bf16)f2bf(z2); }
    }
}

constexpr int HY_KCOPY = 16448;
constexpr int HY_K_OFF = 0;
constexpr int HY_ZIN_OFF = 4 * HY_KCOPY;
constexpr int HY_ZBYTES = 160 * 2 * 80;
constexpr int HY_ZMID_OFF = HY_ZIN_OFF + HY_ZBYTES;
constexpr int HY_X1_OFF = HY_ZMID_OFF + HY_ZBYTES;
constexpr int HY_X2_OFF = HY_X1_OFF + 2 * SEQ * 2;
static_assert(HY_X2_OFF + 2 * SEQ * 2 <= MOE_OFFS_OFF, "hyena LDS map");
__device__ __forceinline__ unsigned hy_zaddr(int b, int t) { return (unsigned)((((t >> 5) + 16) * 2 + b) * 80 + (t & 31) * 2); }
__device__ __forceinline__ void hy_build_k(Frame& F, const bf16* hf, const bf16* hb) {
    LAS unsigned char* lds = F.lds + HY_K_OFF;
#pragma unroll 1
    for (int x = F.tid; x < 2 * SEQ + 4; x += NTHR) {
        unsigned short v = 0;
        if (x >= 1 && x <= SEQ) v = hf[SEQ - x]; else if (x > SEQ && x <= 2 * SEQ - 1) v = hb[x - SEQ];
#pragma unroll
        for (int s = 0; s < 4; ++s) { const int y = x - s; if (y >= 0 && y < 2 * SEQ) *(LAS unsigned short*)(lds + s * HY_KCOPY + 2 * y) = v; }
    }
}
__device__ __forceinline__ void hy_conv(Frame& F, unsigned zoff, pg8::f32x4 (&acc)[4]) {
    typedef short bf16x8 __attribute__((ext_vector_type(8)));
    typedef float f32x16 __attribute__((ext_vector_type(16)));
    const int lane = F.lane, q = F.wave, r = lane & 31, hh = lane >> 5, sg = (4 - (r & 3)) & 3, nn = r >> 1, b = r & 1;
    const int d0 = 16 * q - 127;
    unsigned aaddr = (unsigned)(HY_K_OFF + sg * HY_KCOPY + 2 * (SEQ - 32 * d0 - r + 8 * hh - sg));
    unsigned baddr = zoff + (unsigned)(((16 * q + nn - d0 + 16) * 2 + b) * 80 + 16 * hh);
    f32x16 c;
#pragma unroll
    for (int i = 0; i < 16; ++i) c[i] = 0.f;
#define HY_STEP(AO, BO) do { union { bf16x8 v; v2u h[2]; } a0, a1; \
        a0.h[0] = *(volatile LAS v2u*)(F.lds + aaddr + (AO));      a0.h[1] = *(volatile LAS v2u*)(F.lds + aaddr + (AO) + 8); \
        a1.h[0] = *(volatile LAS v2u*)(F.lds + aaddr + (AO) + 32); a1.h[1] = *(volatile LAS v2u*)(F.lds + aaddr + (AO) + 40); \
        const bf16x8 b0 = *(const LAS bf16x8*)(F.lds + baddr + (BO)), b1 = *(const LAS bf16x8*)(F.lds + baddr + (BO) + 32); \
        c = __builtin_amdgcn_mfma_f32_32x32x16_bf16(a0.v, b0, c, 0, 0, 0); \
        c = __builtin_amdgcn_mfma_f32_32x32x16_bf16(a1.v, b1, c, 0, 0, 0); } while (0)
    HY_STEP(0, 0);
#pragma clang loop unroll(disable)
    for (int it = 0; it < 71; ++it) {
        aaddr -= 128; baddr -= 320;
        asm volatile("" : "+v"(aaddr), "+v"(baddr));
        HY_STEP(64, 160);
        HY_STEP(0, 0);
    }
#undef HY_STEP
#pragma unroll
    for (int g = 0; g < 4; ++g) acc[g] = (pg8::f32x4){c[4 * g], c[4 * g + 1], c[4 * g + 2], c[4 * g + 3]};
}
__device__ __forceinline__ void p3_hyena_mfma(Frame& F) {
    LAS unsigned char* lds = F.lds;
    for (int i = F.tid; i < 2 * HY_ZBYTES / 4; i += NTHR) *(LAS unsigned*)(lds + HY_ZIN_OFF + 4 * i) = 0u;
    const int lane = F.lane, q = F.wave, r = lane & 31, hh = lane >> 5, nn = r >> 1, b = r & 1;
    for (int c = F.bid; c < HW; c += F.G) {
        __syncthreads();
        const float cw[3][3] = {{F.conv_w[c], F.conv_w[3 * HW + c], F.conv_w[6 * HW + c]},
                                {F.conv_w[HW + c], F.conv_w[3 * HW + HW + c], F.conv_w[6 * HW + HW + c]},
                                {F.conv_w[2 * HW + c], F.conv_w[3 * HW + 2 * HW + c], F.conv_w[6 * HW + 2 * HW + c]}};
        const float cb[3] = {F.conv_b[c], F.conv_b[HW + c], F.conv_b[2 * HW + c]};
        const bf16* pv = F.PHY + (size_t)c * T; const bf16* px1 = F.PHY + (size_t)(HW + c) * T; const bf16* px2 = F.PHY + (size_t)(2 * HW + c) * T;
#pragma unroll 2
        for (int i = F.tid; i < T; i += NTHR) { const int bb = i / SEQ, t = i % SEQ;
            *(LAS unsigned short*)(lds + HY_ZIN_OFF + hy_zaddr(bb, t)) = (unsigned short)f2bf(sconv_at(pv + bb * SEQ, t, cw[0][0], cw[0][1], cw[0][2], cb[0]));
            *(LAS unsigned short*)(lds + HY_X1_OFF + 2 * i) = (unsigned short)f2bf(sconv_at(px1 + bb * SEQ, t, cw[1][0], cw[1][1], cw[1][2], cb[1]));
            *(LAS unsigned short*)(lds + HY_X2_OFF + 2 * i) = (unsigned short)f2bf(sconv_at(px2 + bb * SEQ, t, cw[2][0], cw[2][1], cw[2][2], cb[2])); }
        hy_build_k(F, F.KF + (size_t)(0 * HW + c) * SEQ, F.KF + (size_t)(1 * HW + c) * SEQ);
        __syncthreads();
        pg8::f32x4 acc[4];
        hy_conv(F, HY_ZIN_OFF, acc);
        const float sk0 = F.hskip[c], sk1 = F.hskip[HW + c];
        {
            unsigned zb = (unsigned)(((16 * q + nn + 16) * 2 + b) * 80 + 8 * hh), xb = (unsigned)(2 * (b * SEQ + 32 * (16 * q + nn) + 4 * hh));
            asm volatile("" : "+v"(zb), "+v"(xb));
#pragma unroll
            for (int g = 0; g < 4; ++g)
#pragma unroll
                for (int e = 0; e < 4; ++e) { const unsigned o = (unsigned)(16 * g + 2 * e);
                    const float vz = bf2f(*(LAS unsigned short*)(lds + HY_ZIN_OFF + zb + o)), x1 = bf2f(*(LAS unsigned short*)(lds + HY_X1_OFF + xb + o));
                    *(LAS unsigned short*)(lds + HY_ZMID_OFF + zb + o) = (unsigned short)f2bf(x1 * (acc[g][e] + sk0 * vz)); }
        }
        __syncthreads();
        hy_build_k(F, F.KF + (size_t)(2 * HW + c) * SEQ, F.KF + (size_t)(3 * HW + c) * SEQ);
        __syncthreads();
        hy_conv(F, HY_ZMID_OFF, acc);
        {
            unsigned zb = (unsigned)(((16 * q + nn + 16) * 2 + b) * 80 + 8 * hh), xb = (unsigned)(2 * (b * SEQ + 32 * (16 * q + nn) + 4 * hh));
            asm volatile("" : "+v"(zb), "+v"(xb));
            bf16* yp = F.YHY + (size_t)(b * SEQ + 32 * (16 * q + nn) + 4 * hh) * HW + c;
#pragma unroll
            for (int g = 0; g < 4; ++g)
#pragma unroll
                for (int e = 0; e < 4; ++e) { const unsigned o = (unsigned)(16 * g + 2 * e);
                    const float z1 = bf2f(*(LAS unsigned short*)(lds + HY_ZMID_OFF + zb + o)), x2 = bf2f(*(LAS unsigned short*)(lds + HY_X2_OFF + xb + o));
                    yp[(size_t)(8 * g + e) * HW] = (bf16)f2bf(x2 * (acc[g][e] + sk1 * z1)); }
        }
    }
}
__device__ __forceinline__ void p3_attn_naive(Frame& F) {
    LAS float* qs = (LAS float*)F.lds + F.wave * 128;
    const int gw = F.bid * NWAVES + F.wave, NGW = F.G * NWAVES;
    const float scale = 0.08838834764831845f;
    for (int u = gw; u < T * 4; u += NGW) {
        const int m = u >> 2, hh = u & 3, b = m / SEQ, s = m % SEQ;
        float Mrun = -3.0e38f, Lrun = 0.f, o0 = 0.f, o1 = 0.f;
#pragma unroll 1
        for (int g = 0; g < 3; ++g) {
            const int head = g * 4 + hh, dil = (g == 0) ? 1 : (g == 1 ? 4 : 16);
            const bf16* qp = F.QKV + (size_t)m * QKVW + head * HD;
            { const unsigned qq = *(const unsigned*)(qp + 2 * F.lane); qs[2 * F.lane] = bflo(qq); qs[2 * F.lane + 1] = bfhi(qq); }
            asm volatile("s_waitcnt lgkmcnt(0)" ::: "memory");
            float sc[3];
#pragma unroll
            for (int p = 0; p < 3; ++p) {
                const int j = (p == 0) ? F.lane - 64 : (p == 1 ? F.lane : 64);
                const int ks = s + j * dil; const bool valid = (ks >= 0) && (ks < SEQ) && (p < 2 || F.lane == 0);
                float dot = 0.f;
                if (valid) { const v4u* kp = (const v4u*)(F.QKV + (size_t)(b * SEQ + ks) * QKVW + NH * HD + head * HD);
#pragma unroll 4
                    for (int c8 = 0; c8 < 16; ++c8) { const v4u kv = kp[c8]; const LAS float* q8 = qs + 8 * c8;
                        dot += bflo(kv.x) * q8[0] + bfhi(kv.x) * q8[1] + bflo(kv.y) * q8[2] + bfhi(kv.y) * q8[3] + bflo(kv.z) * q8[4] + bfhi(kv.z) * q8[5] + bflo(kv.w) * q8[6] + bfhi(kv.w) * q8[7]; } }
                sc[p] = valid ? dot * scale : -1.0e30f;
            }
            const float mg = wave_max(fmaxf(fmaxf(sc[0], sc[1]), sc[2]));
            const float mnew = fmaxf(Mrun, mg), resc = __expf(Mrun - mnew);
            float pr[3];
#pragma unroll
            for (int p = 0; p < 3; ++p) pr[p] = (sc[p] > -1.0e29f) ? __expf(sc[p] - mnew) : 0.f;
            Lrun = Lrun * resc + wave_sum(pr[0] + pr[1] + pr[2]); o0 *= resc; o1 *= resc; Mrun = mnew;
            const bf16* vbase = F.QKV + 2 * NH * HD + head * HD + 2 * F.lane;
            for (int jj = 0; jj < 129; ++jj) {
                const int j = jj - 64, ks = s + j * dil;
                if (ks < 0 || ks >= SEQ) continue;
                const float pk = (jj < 64) ? __shfl(pr[0], jj) : (jj < 128 ? __shfl(pr[1], jj - 64) : __shfl(pr[2], 0));
                const unsigned vv = *(const unsigned*)(vbase + (size_t)(b * SEQ + ks) * QKVW);
                o0 += pk * bflo(vv); o1 += pk * bfhi(vv);
            }
        }
        const float inv = 1.0f / Lrun;
        *(unsigned*)(F.YAT + (size_t)m * 512 + hh * HD + 2 * F.lane) = pk2(o0 * inv, o1 * inv);
    }
}


constexpr int AT_VPITCH = 320, AT_VBYTES = 32 * AT_VPITCH;
typedef short s16x4 __attribute__((ext_vector_type(4)));
#define AT_TR8(S, VB, R) asm volatile( \
    "ds_read_b64_tr_b16 %0, %8 offset:%9\n\tds_read_b64_tr_b16 %1, %8 offset:%10\n\tds_read_b64_tr_b16 %2, %8 offset:%11\n\tds_read_b64_tr_b16 %3, %8 offset:%12\n\t" \
    "ds_read_b64_tr_b16 %4, %8 offset:%13\n\tds_read_b64_tr_b16 %5, %8 offset:%14\n\tds_read_b64_tr_b16 %6, %8 offset:%15\n\tds_read_b64_tr_b16 %7, %8 offset:%16\n\ts_waitcnt lgkmcnt(0)" \
    : "=&v"(R[0]), "=&v"(R[1]), "=&v"(R[2]), "=&v"(R[3]), "=&v"(R[4]), "=&v"(R[5]), "=&v"(R[6]), "=&v"(R[7]) \
    : "v"(VB), "i"((16 * (S)) * AT_VPITCH), "i"((16 * (S) + 8) * AT_VPITCH), "i"((16 * (S)) * AT_VPITCH + 64), "i"((16 * (S) + 8) * AT_VPITCH + 64), \
      "i"((16 * (S)) * AT_VPITCH + 128), "i"((16 * (S) + 8) * AT_VPITCH + 128), "i"((16 * (S)) * AT_VPITCH + 192), "i"((16 * (S) + 8) * AT_VPITCH + 192) : "memory")
__device__ __forceinline__ void p4_attn_mfma(Frame& F) {
    typedef short bf16x8 __attribute__((ext_vector_type(8)));
    typedef float f32x16 __attribute__((ext_vector_type(16)));
    typedef float f32x2 __attribute__((ext_vector_type(2)));
    typedef __bf16 bf16x2v __attribute__((ext_vector_type(2)));
    const int lane = F.lane, w = F.wave, r31 = lane & 31, hh = lane >> 5;
    LAS unsigned char* vimg = F.lds + w * AT_VBYTES;
    const unsigned vb = (unsigned)(size_t)vimg + (unsigned)((4 * hh + ((lane & 15) >> 2)) * AT_VPITCH + 32 * ((lane >> 4) & 1) + 8 * (lane & 3));
    const int gw = F.bid * NWAVES + w, NGW = F.G * NWAVES;
    const float scale = 0.08838834764831845f;
    bf16* AO = (bf16*)F.YB; float* LSE = (float*)((unsigned char*)F.YB + 32 * MiB);
    for (int u = gw; u < 2 * NH * 128; u += NGW) {
        const int b = u / (NH * 128), rem = u % (NH * 128), head = rem >> 7, blk = rem & 127, g = head >> 2, hs = head & 3;
        const int dl = (g == 0) ? 0 : (g == 1 ? 2 : 4), dil = 1 << dl, res = blk & (dil - 1), q0 = (blk >> dl) * 32, n = SEQ >> dl;
        const size_t tokq = (size_t)(b * SEQ + res + dil * (q0 + r31));
        bf16x8 qf[8];
        { const bf16* qrow = F.QKV + tokq * QKVW + head * HD + 8 * hh;
#pragma unroll
          for (int s = 0; s < 8; ++s) qf[s] = *(const bf16x8*)(qrow + 16 * s); }
        f32x16 o[4];
#pragma unroll
        for (int dt = 0; dt < 4; ++dt)
#pragma unroll
            for (int i = 0; i < 16; ++i) o[dt][i] = 0.f;
        float mrun = -3.0e38f, lrun = 0.f;
#pragma unroll 1
        for (int kt = 0; kt < 5; ++kt) {
            const int kt0 = q0 - 64 + 32 * kt;
            if (kt0 < 0 || kt0 >= n) continue;
            bf16x8 kf[8];
            { const bf16* krow = F.QKV + (size_t)(b * SEQ + res + dil * (kt0 + r31)) * QKVW + NH * HD + head * HD + 8 * hh;
#pragma unroll
              for (int s = 0; s < 8; ++s) kf[s] = *(const bf16x8*)(krow + 16 * s); }
            {
                const bf16* vsrc = F.QKV + (size_t)(b * SEQ + res + dil * (kt0 + (lane >> 4))) * QKVW + 2 * NH * HD + head * HD + (lane & 15) * 8;
                bf16x8 vv[8];
#pragma unroll
                for (int i = 0; i < 8; ++i) vv[i] = *(const bf16x8*)(vsrc + (size_t)(4 * i * dil) * QKVW);
#pragma unroll
                for (int i = 0; i < 8; ++i) *(LAS bf16x8*)(vimg + (4 * i + (lane >> 4)) * AT_VPITCH + (lane & 15) * 16) = vv[i];
            }
            f32x16 sacc;
#pragma unroll
            for (int i = 0; i < 16; ++i) sacc[i] = 0.f;
#pragma unroll
            for (int s = 0; s < 8; ++s) sacc = __builtin_amdgcn_mfma_f32_32x32x16_bf16(kf[s], qf[s], sacc, 0, 0, 0);
            float p[16]; float mx = -3.0e38f;
            const bool edge = (kt == 0) || (kt == 4);
#pragma unroll
            for (int i = 0; i < 16; ++i) { float sv = sacc[i] * scale;
                if (edge) { const int diff = (q0 + r31) - (kt0 + (i & 3) + 8 * (i >> 2) + 4 * hh); if (diff > 64 || diff < -64) sv = -1.0e30f; }
                p[i] = sv; mx = fmaxf(mx, sv); }
            mx = fmaxf(mx, __shfl_xor(mx, 32));
            const float mnew = fmaxf(mrun, mx), resc = __expf(mrun - mnew);
            float ps = 0.f;
#pragma unroll
            for (int i = 0; i < 16; ++i) { p[i] = (p[i] > -1.0e29f) ? __expf(p[i] - mnew) : 0.f; ps += p[i]; }
            ps += __shfl_xor(ps, 32);
            lrun = lrun * resc + ps; mrun = mnew;
#pragma unroll
            for (int dt = 0; dt < 4; ++dt)
#pragma unroll
                for (int i = 0; i < 16; ++i) o[dt][i] *= resc;
            bf16x8 pf[2];
#pragma unroll
            for (int s = 0; s < 2; ++s) { union { bf16x8 v; bf16x2v h[4]; } cv;
#pragma unroll
                for (int j = 0; j < 4; ++j) cv.h[j] = __builtin_convertvector((f32x2){p[8 * s + 2 * j], p[8 * s + 2 * j + 1]}, bf16x2v);
                pf[s] = cv.v; }
            asm volatile("s_waitcnt lgkmcnt(0)" ::: "memory");
            { s16x4 tr[8]; AT_TR8(0, vb, tr);
#pragma unroll
              for (int dt = 0; dt < 4; ++dt) { const bf16x8 va = __builtin_shufflevector(tr[2 * dt], tr[2 * dt + 1], 0, 1, 2, 3, 4, 5, 6, 7); o[dt] = __builtin_amdgcn_mfma_f32_32x32x16_bf16(va, pf[0], o[dt], 0, 0, 0); } }
            { s16x4 tr[8]; AT_TR8(1, vb, tr);
#pragma unroll
              for (int dt = 0; dt < 4; ++dt) { const bf16x8 va = __builtin_shufflevector(tr[2 * dt], tr[2 * dt + 1], 0, 1, 2, 3, 4, 5, 6, 7); o[dt] = __builtin_amdgcn_mfma_f32_32x32x16_bf16(va, pf[1], o[dt], 0, 0, 0); } }
        }
        const float inv = 1.0f / lrun;
        bf16* op = AO + ((size_t)g * T + tokq) * 512 + hs * HD + 4 * hh;
#pragma unroll
        for (int dt = 0; dt < 4; ++dt)
#pragma unroll
            for (int a = 0; a < 4; ++a) { v2u ov; ov.x = pk2(o[dt][4 * a] * inv, o[dt][4 * a + 1] * inv); ov.y = pk2(o[dt][4 * a + 2] * inv, o[dt][4 * a + 3] * inv);
                *(v2u*)(op + 32 * dt + 8 * a) = ov; }
        if (hh == 0) LSE[((size_t)g * T + tokq) * 4 + hs] = mrun + logf(lrun);
    }
}
__device__ __forceinline__ void p4b_combine(Frame& F) {
    const bf16* AO = (const bf16*)F.YB; const float* LSE = (const float*)((const unsigned char*)F.YB + 32 * MiB);
    const int gw = F.bid * NWAVES + F.wave, NGW = F.G * NWAVES, lane = F.lane, hs = lane >> 4;
    for (int m = gw; m < T; m += NGW) {
        float l[3];
#pragma unroll
        for (int g = 0; g < 3; ++g) l[g] = LSE[((size_t)g * T + m) * 4 + hs];
        const float mx = fmaxf(fmaxf(l[0], l[1]), l[2]);
        float wg[3], den = 0.f;
#pragma unroll
        for (int g = 0; g < 3; ++g) { wg[g] = __expf(l[g] - mx); den += wg[g]; }
        const float inv = 1.0f / den;
        float acc[8];
#pragma unroll
        for (int j = 0; j < 8; ++j) acc[j] = 0.f;
#pragma unroll
        for (int g = 0; g < 3; ++g) { const v4u q = *(const v4u*)(AO + ((size_t)g * T + m) * 512 + 8 * lane); const float ww = wg[g] * inv;
            acc[0] += ww * bflo(q.x); acc[1] += ww * bfhi(q.x); acc[2] += ww * bflo(q.y); acc[3] += ww * bfhi(q.y); acc[4] += ww * bflo(q.z); acc[5] += ww * bfhi(q.z); acc[6] += ww * bflo(q.w); acc[7] += ww * bfhi(q.w); }
        v4u ov; ov.x = pk2(acc[0], acc[1]); ov.y = pk2(acc[2], acc[3]); ov.z = pk2(acc[4], acc[5]); ov.w = pk2(acc[6], acc[7]);
        *(v4u*)(F.YAT + (size_t)m * 512 + 8 * lane) = ov;
    }
}
__device__ __forceinline__ void p6_rows_router(Frame& F) {
    LAS float* L = (LAS float*)F.lds;
    LAS float* gatem = L, *shiftf = L + 2 * D, *scalef = L + 4 * D;
    load_mod(F, gatem, 2); load_mod(F, shiftf, 3); load_mod(F, scalef, 4);
    __syncthreads();
    const int gw = F.bid * NWAVES + F.wave, NGW = F.G * NWAVES;
    LAS float* hs = L + 6 * D + F.wave * D;
    for (int m = gw; m < T; m += NGW) {
        const int b = m / SEQ;
        const f32x4* yr = (const f32x4*)(F.Y + (size_t)m * D) + F.lane; const f32x4* xr = (const f32x4*)(F.x + (size_t)m * D) + F.lane;
        f32x4 v[8]; float s = 0.f;
#pragma unroll
        for (int j = 0; j < 8; ++j) { v[j] = yr[64 * j]; s += (v[j].x * v[j].x + v[j].y * v[j].y) + (v[j].z * v[j].z + v[j].w * v[j].w); }
        const float rstd = 1.0f / sqrtf(wave_sum(s) * (1.f / D) + RMS_EPS);
        float s1 = 0.f;
        f32x4* x1r = (f32x4*)(F.X1 + (size_t)m * D) + F.lane;
#pragma unroll
        for (int j = 0; j < 8; ++j) { const int d = 256 * j + 4 * F.lane;
            const f32x4 g = *(const f32x4*)(F.g_mix_post + d), gm = *(LAS f32x4*)(gatem + b * D + d);
            const f32x4 x1 = xr[64 * j] + gm * ((v[j] * rstd) * g);
            x1r[64 * j] = x1; v[j] = x1; s1 += (x1.x * x1.x + x1.y * x1.y) + (x1.z * x1.z + x1.w * x1.w); }
        const float rstd1 = 1.0f / sqrtf(wave_sum(s1) * (1.f / D) + RMS_EPS);
        v2u* o8 = (v2u*)(F.H2 + (size_t)m * D) + F.lane;
#pragma unroll
        for (int j = 0; j < 8; ++j) { const int d = 256 * j + 4 * F.lane;
            const f32x4 g = *(const f32x4*)(F.g_ffn_pre + d), sc = *(LAS f32x4*)(scalef + b * D + d), sh = *(LAS f32x4*)(shiftf + b * D + d);
            f32x4 h = (v[j] * rstd1) * g; h = h * (sc + 1.0f) + sh; *(LAS f32x4*)(hs + d) = h;
            v2u w; w.x = pk2(h.x, h.y); w.y = pk2(h.z, h.w); o8[64 * j] = w; }
        asm volatile("s_waitcnt lgkmcnt(0)" ::: "memory");
        float gl[8];
#pragma unroll
        for (int g = 0; g < 8; ++g) gl[g] = 0.f;
#pragma unroll 1
        for (int j = 0; j < 8; ++j) { const int d0 = 256 * j + 4 * F.lane; const f32x4 hq = *(LAS f32x4*)(hs + d0); const float* wp = F.w_group + (size_t)d0 * 8;
#pragma unroll
            for (int e = 0; e < 4; ++e) { const f32x4 w0 = *(const f32x4*)(wp + e * 8), w1 = *(const f32x4*)(wp + e * 8 + 4); const float hv = hq[e];
                gl[0] += hv * w0.x; gl[1] += hv * w0.y; gl[2] += hv * w0.z; gl[3] += hv * w0.w; gl[4] += hv * w1.x; gl[5] += hv * w1.y; gl[6] += hv * w1.z; gl[7] += hv * w1.w; } }
        float gmax = -3.0e38f; int gi = 0;
#pragma unroll
        for (int g = 0; g < 8; ++g) { gl[g] = wave_sum(gl[g]) + F.b_group[g]; if (gl[g] > gmax) { gmax = gl[g]; gi = g; } }
        float gden = 0.f;
#pragma unroll
        for (int g = 0; g < 8; ++g) gden += expf(gl[g] - gmax);
        const float gval = 1.0f / gden;
        gi = __builtin_amdgcn_readfirstlane(gi);
        const float* we = F.w_expert + (size_t)gi * D * 8;
        float el[8];
#pragma unroll
        for (int g = 0; g < 8; ++g) el[g] = 0.f;
#pragma unroll 1
        for (int j = 0; j < 8; ++j) { const int d0 = 256 * j + 4 * F.lane; const f32x4 hq = *(LAS f32x4*)(hs + d0); const float* wp = we + (size_t)d0 * 8;
#pragma unroll
            for (int e = 0; e < 4; ++e) { const f32x4 w0 = *(const f32x4*)(wp + e * 8), w1 = *(const f32x4*)(wp + e * 8 + 4); const float hv = hq[e];
                el[0] += hv * w0.x; el[1] += hv * w0.y; el[2] += hv * w0.z; el[3] += hv * w0.w; el[4] += hv * w1.x; el[5] += hv * w1.y; el[6] += hv * w1.z; el[7] += hv * w1.w; } }
        float e0v = -3.0e38f, e1v = -3.0e38f; int e0i = 0, e1i = 0;
#pragma unroll
        for (int g = 0; g < 8; ++g) { el[g] = wave_sum(el[g]) + F.b_expert[gi * 8 + g];
            if (el[g] > e0v) { e1v = e0v; e1i = e0i; e0v = el[g]; e0i = g; } else if (el[g] > e1v) { e1v = el[g]; e1i = g; } }
        const float p1 = expf(e1v - e0v), den = 1.0f + p1;
        const float gate0 = gval / den, gate1 = gval * p1 / den;
        if (F.lane == 0) {
            const int ex0 = gi * 8 + e0i, ex1 = gi * 8 + e1i;
            const unsigned pos0 = atomicAdd(F.ctl + CW_CNT + ex0, 1u), pos1 = atomicAdd(F.ctl + CW_CNT + ex1, 1u);
            F.LISTT[ex0 * T + pos0] = m; F.LISTG[ex0 * T + pos0] = gate0;
            F.LISTT[ex1 * T + pos1] = m; F.LISTG[ex1 * T + pos1] = gate1;
            F.ROUTE[m * 4 + 0] = (unsigned)(ex0 * T) + pos0; F.ROUTE[m * 4 + 1] = (unsigned)(ex1 * T) + pos1;
        }
    }
}

__device__ __forceinline__ void moe_offsets(Frame& F, LAS int* offs  , LAS int* toff  ) {
    if (F.tid < 64) { const int c = (int)__hip_atomic_load(F.ctl + CW_CNT + F.tid, __ATOMIC_RELAXED, __HIP_MEMORY_SCOPE_AGENT); const int tc = (c + 63) / 64; int incl = c, tincl = tc;
#pragma unroll
        for (int o = 1; o < 64; o <<= 1) { const int v = __shfl_up(incl, o), tv = __shfl_up(tincl, o); if (F.tid >= o) { incl += v; tincl += tv; } }
        offs[F.tid] = incl - c; toff[F.tid] = tincl - tc; if (F.tid == 63) { offs[NE] = incl; toff[NE] = tincl; } }
    __syncthreads();
}
__device__ __forceinline__ void p7_moe1(Frame& F) {
    LAS float* L = (LAS float*)F.lds;
    LAS int* offs = (LAS int*)(L + 8192 * 3); LAS int* toff = offs + 80;
    moe_offsets(F, offs, toff);
    const int ntiles = toff[NE];
    for (int u = F.bid; u < ntiles * 8; u += F.G) {
        const int rt = u >> 3, ct = u & 7;
        int e = 0; while (toff[e + 1] <= rt) ++e;
        const int r0 = (rt - toff[e]) * 64, ne = offs[e + 1] - offs[e];
        const int* lt = F.LISTT + e * T + r0;
        const float* W1 = F.w1e + (size_t)e * D * FF + ct * 64; const float* W3 = F.w3e + (size_t)e * D * FF + ct * 64;
        const bf16* H2 = F.H2;
        auto la = [&](int r, int k) -> float { return (r0 + r < ne) ? bf2f(H2[(size_t)lt[r] * D + k]) : 0.f; };
        auto lb = [&](int q, int k, int c) -> float { return (q == 0 ? W1 : W3)[(size_t)k * FF + c]; };
        float* ACT = F.ACT + (size_t)(offs[e] + r0) * FF + ct * 64;
        auto ep = [&](int r, int c, const float (&v)[2]) { if (r0 + r < ne) { const float a = v[0], bb = v[1]; ACT[(size_t)r * FF + c] = (a / (1.0f + __expf(-a))) * bb; } };
        simt_tile<2>(L, D, F.tid, la, lb, ep);
    }
}
__device__ __forceinline__ void p8_moe2(Frame& F) {
    LAS float* L = (LAS float*)F.lds;
    LAS int* offs = (LAS int*)(L + 8192 * 3); LAS int* toff = offs + 80;
    moe_offsets(F, offs, toff);
    const int ntiles = toff[NE];
    for (int u = F.bid; u < ntiles * 32; u += F.G) {
        const int rt = u >> 5, ct = u & 31;
        int e = 0; while (toff[e + 1] <= rt) ++e;
        const int r0 = (rt - toff[e]) * 64, ne = offs[e + 1] - offs[e];
        const float* A = F.ACT + (size_t)(offs[e] + r0) * FF;
        const float* W2 = F.w2e + (size_t)e * FF * D + ct * 64;
        const float* lg = F.LISTG + e * T + r0;
        auto la = [&](int r, int k) -> float { return (r0 + r < ne) ? A[(size_t)r * FF + k] : 0.f; };
        auto lb = [&](int q, int k, int c) -> float { return W2[(size_t)k * D + c]; };
        float* YB = F.YB + (size_t)(offs[e] + r0) * D + ct * 64;
        auto ep = [&](int r, int c, const float (&v)[1]) { if (r0 + r < ne) YB[(size_t)r * D + c] = v[0] * lg[r]; };
        simt_tile<1>(L, FF, F.tid, la, lb, ep);
    }
}

template <int MODE>
__device__ __forceinline__ void moe_mfma(Frame& F) {
    constexpr int K = MODE == 0 ? D : FF, LDW = MODE == 0 ? FF : D, NSL = MODE == 0 ? 8 : 16, NK = K / 32;
    constexpr int RPP = 368, NT = 23, S = 4, WST = 16384, XST = NT * 1024, STB = WST + XST;
    static_assert(S * STB <= MOE_OFFS_OFF, "MoE stage ring vs LDS map");
    typedef short bf16x8 __attribute__((ext_vector_type(8)));
    LAS unsigned char* lds = F.lds;
    LAS int* offs = (LAS int*)(lds + MOE_OFFS_OFF);
    __syncthreads();
    if (F.tid < 64) { const int c = (int)__hip_atomic_load(F.ctl + CW_CNT + F.tid, __ATOMIC_RELAXED, __HIP_MEMORY_SCOPE_AGENT); int incl = c;
#pragma unroll
        for (int o = 1; o < 64; o <<= 1) { const int v = __shfl_up(incl, o); if (F.tid >= o) incl += v; }
        offs[F.tid] = incl - c; if (F.tid == 63) offs[NE] = incl; }
    __syncthreads();
    const int lane = F.lane, w = F.wave, cq = w & 3, rh = w >> 2;
    const int vcu = (F.G % 8 == 0) ? (F.bid % 8) * (F.G / 8) + F.bid / 8 : F.bid;
    for (int u = vcu; u < NE * NSL; u += F.G) {
        const int e = u / NSL, sl = u % NSL;
        const int oe = offs[e], ne = offs[e + 1] - oe;
        if (ne == 0) continue;
        const float* Wm0; const float* Wm1;
        if (MODE == 0) { Wm0 = F.w1e + (size_t)e * D * FF + sl * 64; Wm1 = F.w3e + (size_t)e * D * FF + sl * 64; }
        else { Wm0 = F.w2e + (size_t)e * FF * D + sl * 128; Wm1 = Wm0 + 64; }
        for (int r0 = 0; r0 < ne; r0 += RPP) {
            const int nr = (ne - r0) < RPP ? (ne - r0) : RPP, ntile = (nr + 15) >> 4;
            const char* xsrc[3]; unsigned xdst[3];
#pragma unroll
            for (int i = 0; i < 3; ++i) { int tile = 3 * w + i; if (tile > NT - 1) tile = NT - 1;
                int row = r0 + 16 * tile + (lane >> 2); if (row > ne - 1) row = ne - 1;
                const size_t srow = (MODE == 0) ? (size_t)F.LISTT[e * T + row] : (size_t)(oe + row);
                xsrc[i] = (const char*)(MODE == 0 ? (const void*)F.H2 : (const void*)F.ACTB) + srow * (size_t)(K * 2) + (lane & 3) * 16;
                xdst[i] = (unsigned)(WST + tile * 1024); }
            const char* wsrc[2]; unsigned wdst[2];
#pragma unroll
            for (int i = 0; i < 2; ++i) { const int kr = 8 * (w & 3) + 4 * i;
                wsrc[i] = (const char*)((w >> 2) ? Wm1 : Wm0) + ((size_t)(kr + (lane >> 4)) * LDW) * 4 + (lane & 15) * 16;
                wdst[i] = (unsigned)((w >> 2) * 8192 + kr * 256); }
            asm volatile("s_waitcnt vmcnt(0)" ::: "memory");
#define MOE_ISSUE(stage, ks) do { const unsigned _sb = (unsigned)(stage) * STB; const size_t _kx = (size_t)(ks) * 64, _kw = (size_t)(ks) * 32 * LDW * 4; \
            _Pragma("unroll") for (int _i = 0; _i < 3; ++_i) __builtin_amdgcn_global_load_lds((const unsigned*)(xsrc[_i] + _kx), (LAS unsigned*)(lds + _sb + xdst[_i]), 16, 0, 0); \
            _Pragma("unroll") for (int _i = 0; _i < 2; ++_i) __builtin_amdgcn_global_load_lds((const unsigned*)(wsrc[_i] + _kw), (LAS unsigned*)(lds + _sb + wdst[_i]), 16, 0, 0); } while (0)
            f32x4 acc[2][12];
#pragma unroll
            for (int m = 0; m < 2; ++m)
#pragma unroll
                for (int j = 0; j < 12; ++j) acc[m][j] = (f32x4){0.f, 0.f, 0.f, 0.f};
#pragma unroll
            for (int s = 0; s < S - 1; ++s) MOE_ISSUE(s, s);
            const unsigned wrd = (unsigned)((8 * (lane >> 4)) * 256 + (16 * cq + (lane & 15)) * 4);
            const unsigned xrd = (unsigned)(WST + (lane & 15) * 64 + (lane >> 4) * 16);
#pragma unroll 1
            for (int t = 0; t < NK; ++t) {
                asm volatile("s_waitcnt vmcnt(10)" ::: "memory");
                __builtin_amdgcn_s_barrier();
                asm volatile("" ::: "memory");
                { const int tn = t + S - 1; MOE_ISSUE(tn & (S - 1), tn < NK ? tn : 0); }
                const unsigned sb = (unsigned)(t & (S - 1)) * STB;
                bf16x8 af[2];
#pragma unroll
                for (int m = 0; m < 2; ++m) { float f[8];
#pragma unroll
                    for (int j = 0; j < 8; ++j) f[j] = *(const LAS float*)(lds + sb + m * 8192 + wrd + j * 256);
                    union { bf16x8 v; unsigned u[4]; } cv;
#pragma unroll
                    for (int p = 0; p < 4; ++p) cv.u[p] = pg8::cvt_pk_bf16(f[2 * p], f[2 * p + 1]);
                    af[m] = cv.v; }
#pragma unroll
                for (int jb = 0; jb < 12; jb += 6) { bf16x8 xb[6];
#pragma unroll
                    for (int q = 0; q < 6; ++q) { int tile = 2 * (jb + q) + rh; if (tile > NT - 1) tile = NT - 1; xb[q] = *(const LAS bf16x8*)(lds + sb + xrd + tile * 1024); }
#pragma unroll
                    for (int q = 0; q < 6; ++q) { const int j = jb + q;
                        if (2 * j + rh < ntile) {
                            acc[0][j] = __builtin_amdgcn_mfma_f32_16x16x32_bf16(af[0], xb[q], acc[0][j], 0, 0, 0);
                            acc[1][j] = __builtin_amdgcn_mfma_f32_16x16x32_bf16(af[1], xb[q], acc[1][j], 0, 0, 0); } } }
            }
            asm volatile("s_waitcnt vmcnt(0)" ::: "memory");
            __builtin_amdgcn_s_barrier();
            asm volatile("" ::: "memory");
#undef MOE_ISSUE
#pragma unroll
            for (int j = 0; j < 12; ++j) { const int tile = 2 * j + rh, row = r0 + 16 * tile + (lane & 15);
                if (tile < ntile && row < ne) {
                    if (MODE == 0) { const f32x4 a = acc[0][j], b = acc[1][j]; f32x4 v;
#pragma unroll
                        for (int i = 0; i < 4; ++i) v[i] = (a[i] / (1.0f + __expf(-a[i]))) * b[i];
                        v2u o; o.x = pk2(v[0], v[1]); o.y = pk2(v[2], v[3]);
                        *(v2u*)(F.ACTB + (size_t)(oe + row) * FF + sl * 64 + 16 * cq + 4 * (lane >> 4)) = o; }
                    else { const float g = F.LISTG[e * T + row]; const f32x4 a = acc[0][j] * g, b = acc[1][j] * g;
                        bf16* yp = F.YBB + (size_t)(oe + row) * D + sl * 128 + 16 * cq + 4 * (lane >> 4);
                        v2u o0; o0.x = pk2(a[0], a[1]); o0.y = pk2(a[2], a[3]); *(v2u*)yp = o0;
                        v2u o1; o1.x = pk2(b[0], b[1]); o1.y = pk2(b[2], b[3]); *(v2u*)(yp + 64) = o1; }
                } }
        }
    }
}
__device__ __forceinline__ void p9_final(Frame& F) {
    LAS float* L = (LAS float*)F.lds;
    LAS float* gatef = L;
    LAS int* offs = (LAS int*)(L + 8192 * 3); LAS int* toff = offs + 80;
    load_mod(F, gatef, 5);
    moe_offsets(F, offs, toff);
    const int gw = F.bid * NWAVES + F.wave, NGW = F.G * NWAVES;
    for (int m = gw; m < T; m += NGW) {
        const int b = m / SEQ;
        const unsigned s0 = F.ROUTE[m * 4 + 0], s1 = F.ROUTE[m * 4 + 1];
        const size_t r0 = (size_t)offs[s0 / T] + (s0 % T), r1 = (size_t)offs[s1 / T] + (s1 % T);
        f32x4 v[8]; float s = 0.f;
#if MOE_SIMT
        const f32x4* y0 = (const f32x4*)(F.YB + r0 * D) + F.lane; const f32x4* y1 = (const f32x4*)(F.YB + r1 * D) + F.lane;
#pragma unroll
        for (int j = 0; j < 8; ++j) { v[j] = y0[64 * j] + y1[64 * j]; s += (v[j].x * v[j].x + v[j].y * v[j].y) + (v[j].z * v[j].z + v[j].w * v[j].w); }
#else
        const v2u* y0 = (const v2u*)(F.YBB + r0 * D) + F.lane; const v2u* y1 = (const v2u*)(F.YBB + r1 * D) + F.lane;
#pragma unroll
        for (int j = 0; j < 8; ++j) { const v2u a = y0[64 * j], b2 = y1[64 * j];
            v[j] = (f32x4){bflo(a.x) + bflo(b2.x), bfhi(a.x) + bfhi(b2.x), bflo(a.y) + bflo(b2.y), bfhi(a.y) + bfhi(b2.y)};
            s += (v[j].x * v[j].x + v[j].y * v[j].y) + (v[j].z * v[j].z + v[j].w * v[j].w); }
#endif
        const float rstd = 1.0f / sqrtf(wave_sum(s) * (1.f / D) + RMS_EPS);
        const f32x4* x1r = (const f32x4*)(F.X1 + (size_t)m * D) + F.lane; f32x4* outr = (f32x4*)(F.out + (size_t)m * D) + F.lane;
#pragma unroll
        for (int j = 0; j < 8; ++j) { const int d = 256 * j + 4 * F.lane;
            const f32x4 g = *(const f32x4*)(F.g_ffn_post + d), gf = *(LAS f32x4*)(gatef + b * D + d);
            outr[64 * j] = x1r[64 * j] + gf * ((v[j] * rstd) * g); }
    }
}

#if SIMPLE_GEMM
template <class EP>
__device__ __forceinline__ void simple_gemm(Frame& F, const bf16* A, const bf16* Bt, int M, int N, int K, const EP& ep) {
    LAS float* L = (LAS float*)F.lds;
    const int tn = N / 64, nt = (M / 64) * tn;
    for (int u = F.bid; u < nt; u += F.G) {
        const int r0 = (u / tn) * 64, c0 = (u % tn) * 64;
        auto la = [&](int r, int k) -> float { return bf2f(A[(size_t)(r0 + r) * K + k]); };
        auto lb = [&](int q, int k, int c) -> float { return bf2f(Bt[(size_t)(c0 + c) * K + k]); };
        auto e2 = [&](int r, int c, const float (&v)[1]) { ep(r0 + r, c0 + c, v[0]); };
        simt_tile<1>(L, K, F.tid, la, lb, e2);
    }
}
#endif

__global__ void __launch_bounds__(NTHR, 2) fwd_kernel(Args args) {
    extern __shared__ __attribute__((aligned(16))) unsigned char lds_raw[];
    Frame F;
    F.lds = (LAS unsigned char*)lds_raw;
    F.tid = threadIdx.x; F.lane = F.tid & 63; F.wave = __builtin_amdgcn_readfirstlane(F.tid >> 6); F.G = gridDim.x; F.bid = blockIdx.x;
    F.x = (const float*)args.in[0]; F.c = (const float*)args.in[1]; F.positions = (const int*)args.in[2]; F.w_ada = (const float*)args.in[3]; F.b_ada = (const float*)args.in[4];
    F.g_mix_pre = (const float*)args.in[5]; F.g_mix_post = (const float*)args.in[6]; F.g_ffn_pre = (const float*)args.in[7]; F.g_ffn_post = (const float*)args.in[8];
    F.w_in = (const float*)args.in[9]; F.conv_w = (const float*)args.in[10]; F.conv_b = (const float*)args.in[11]; F.fw1 = (const float*)args.in[12]; F.fb1 = (const float*)args.in[13];
    F.fw2 = (const float*)args.in[14]; F.fb2 = (const float*)args.in[15]; F.fw3 = (const float*)args.in[16]; F.ffreq = (const float*)args.in[17]; F.hskip = (const float*)args.in[18];
    F.w_bg = (const float*)args.in[19]; F.b_bg = (const float*)args.in[20]; F.w_hy_o = (const float*)args.in[21]; F.w_at_o = (const float*)args.in[22]; F.w_out = (const float*)args.in[23];
    F.w_group = (const float*)args.in[24]; F.b_group = (const float*)args.in[25]; F.w_expert = (const float*)args.in[26]; F.b_expert = (const float*)args.in[27];
    F.w1e = (const float*)args.in[28]; F.w3e = (const float*)args.in[29]; F.w2e = (const float*)args.in[30];
    F.out = args.out;
    unsigned char* ws = args.ws;
    F.ctl = (unsigned*)(ws + WS_CTL); F.MODP = (float*)(ws + WS_MODP); F.HID2 = (float*)(ws + WS_HID2); F.ROT = (float*)(ws + WS_ROT); F.W3T = (float*)(ws + WS_W3T);
    F.ROUTE = (unsigned*)(ws + WS_ROUTE); F.LISTT = (int*)(ws + WS_LISTT); F.LISTG = (float*)(ws + WS_LISTG);
    F.W1T = (bf16*)(ws + WS_W1T); F.WHYOT = (bf16*)(ws + WS_WHYOT); F.WATOT = (bf16*)(ws + WS_WATOT); F.WOUTT = (bf16*)(ws + WS_WOUTT);
    F.KF = (bf16*)(ws + WS_KF); F.H = (bf16*)(ws + WS_H); F.PHY = (bf16*)(ws + WS_PHY); F.QKV = (bf16*)(ws + WS_QKV); F.GT = (bf16*)(ws + WS_G);
    F.YHY = (bf16*)(ws + WS_YHY); F.YAT = (bf16*)(ws + WS_YAT); F.TMP = (float*)(ws + WS_TMP); F.MERGED = (bf16*)(ws + WS_MERGED); F.Y = (float*)(ws + WS_Y);
    F.X1 = (float*)(ws + WS_X1); F.H2 = (bf16*)(ws + WS_H2); F.ACT = (float*)(ws + WS_ACT); F.YB = (float*)(ws + WS_YB); F.ACTB = (bf16*)(ws + WS_ACT); F.YBB = (bf16*)(ws + WS_YB);

    volatile LAS unsigned* MISC = (volatile LAS unsigned*)(F.lds + MISC_OFF);
    if (F.tid < 32) MISC[F.tid] = 0u;
    __syncthreads();
    const int lo = args.ph_lo, hi = args.ph_hi;
    const bool multi = (hi - lo) > 1;
    XcdBarrier bar; bar.bar = F.ctl + CW_BAR; bar.x = 0; bar.st = nullptr;
    if (multi) bar = xcd_barrier_post(F.ctl + CW_BAR, MISC + 8);
#ifndef PHASE_MASK
#define PHASE_MASK 0xFFFF
#endif
#define IN(k) ((((PHASE_MASK) >> (k)) & 1) && lo <= (k) && (k) < hi)
#define SEAM(k) do { if (IN(k) && IN((k) + 1)) xcd_barrier(bar); } while (0)

    if (IN(0)) { p0_prologue(F); } SEAM(0);
    if (IN(1)) { p1_rows_filters(F); } SEAM(1);
    if (IN(2)) {
#if SIMPLE_GEMM
        { bf16* PHY = F.PHY; simple_gemm(F, F.W1T, F.H, 3 * HW, T, D, [&](int r, int c, float v) { PHY[(size_t)r * T + c] = (bf16)f2bf(v); }); }
        __syncthreads();
        { bf16* QKVp = F.QKV; bf16* Gp = F.GT; const float* bias = F.b_bg;
          simple_gemm(F, F.H, F.W1T + (size_t)(3 * HW) * D, T, QKVW + 2 * D, D, [&](int r, int c, float v) {
              if (c < QKVW) QKVp[(size_t)r * QKVW + c] = (bf16)f2bf(v); else Gp[(size_t)r * (2 * D) + (c - QKVW)] = (bf16)f2bf(1.0f / (1.0f + __expf(-(v + bias[c - QKVW])))); }); }
#else
        { EpiPlainBf16 E{F.PHY, T}; run_gemm(F, F.W1T, F.H, 3 * HW, T, D, E); }
        { EpiProj E{F.QKV, F.GT, F.ROT, F.b_bg}; run_gemm(F, F.H, F.W1T + (size_t)(3 * HW) * D, T, QKVW + 2 * D, D, E); }
#endif
    } SEAM(2);
    if (IN(3)) {
#if SIMPLE_GEMM
        for (int i = F.bid * NTHR + F.tid; i < T * 24 * 16; i += F.G * NTHR) { const int k = i & 15, hd = (i >> 4) % 24, tok = (i >> 4) / 24;
            bf16* p = F.QKV + (size_t)tok * QKVW + hd * HD; const float a = bf2f(p[k]), b2 = bf2f(p[k + 16]), cs = F.ROT[tok * 32 + k], sn = F.ROT[tok * 32 + 16 + k];
            p[k] = (bf16)f2bf(a * cs - b2 * sn); p[k + 16] = (bf16)f2bf(b2 * cs + a * sn); }
#endif
    }
#if SIMPLE_GEMM
    SEAM(3);
#endif
#if HYENA_NAIVE
    if (IN(4)) { p3_hyena_naive(F); __syncthreads(); p3_attn_naive(F); } SEAM(4);
#elif ATTN_NAIVE
    if (IN(4)) { p3_hyena_mfma(F); __syncthreads(); p3_attn_naive(F); } SEAM(4);
#else
    if (IN(4)) { p3_hyena_mfma(F); __syncthreads(); p4_attn_mfma(F); } SEAM(4);
    if (IN(5)) { p4b_combine(F); } SEAM(5);
#endif
    if (IN(6)) {
#if SIMPLE_GEMM
        { float* TMP = F.TMP; const bf16* G = F.GT; simple_gemm(F, F.YHY, F.WHYOT, T, D, HW, [&](int r, int c, float v) { TMP[(size_t)r * D + c] = v * bf2f(G[(size_t)r * (2 * D) + c]); }); }
        __syncthreads();
        { float* TMP = F.TMP; const bf16* G = F.GT; bf16* Mp = F.MERGED; simple_gemm(F, F.YAT, F.WATOT, T, D, 512, [&](int r, int c, float v) { Mp[(size_t)r * D + c] = (bf16)f2bf(TMP[(size_t)r * D + c] + v * bf2f(G[(size_t)r * (2 * D) + D + c])); }); }
#else
        { EpiGate<0> E{F.GT, 0, F.TMP, F.MERGED}; run_gemm(F, F.YHY, F.WHYOT, T, D, HW, E); }
        { EpiGate<1> E{F.GT, D, F.TMP, F.MERGED}; run_gemm(F, F.YAT, F.WATOT, T, D, 512, E); }
#endif
    } SEAM(6);
    if (IN(7)) {
#if SIMPLE_GEMM
        { float* Y = F.Y; simple_gemm(F, F.MERGED, F.WOUTT, T, D, D, [&](int r, int c, float v) { Y[(size_t)r * D + c] = v; }); }
#else
        { EpiF32 E{F.Y, D}; run_gemm(F, F.MERGED, F.WOUTT, T, D, D, E); }
#endif
    } SEAM(7);
    if (IN(8)) { p6_rows_router(F); } SEAM(8);
#if MOE_SIMT
    if (IN(9)) { p7_moe1(F); } SEAM(9);
    if (IN(10)) { p8_moe2(F); } SEAM(10);
#else
    if (IN(9)) { moe_mfma<0>(F); } SEAM(9);
    if (IN(10)) { moe_mfma<1>(F); } SEAM(10);
#endif
    if (IN(11)) { p9_final(F); }
#undef IN
#undef SEAM
}

extern "C" void kernel_launch(void* const* d_in, const int* in_sizes, int n_in, void* d_out, int out_size, void* d_ws, size_t ws_size, hipStream_t stream) {
    static int grid = 0;
    if (grid == 0) {
        if (n_in != 31 || out_size != T * D || ws_size < WS_END) { fprintf(stderr, "kernel_launch: unexpected shapes (n_in %d out %d ws %zu)\n", n_in, out_size, ws_size); grid = -1; return; }
        int dev = 0, cus = 0, per_cu = 0;
        if (hipGetDevice(&dev) != hipSuccess || hipDeviceGetAttribute(&cus, hipDeviceAttributeMultiprocessorCount, dev) != hipSuccess) { grid = -1; return; }
        if (hipFuncSetAttribute((const void*)fwd_kernel, hipFuncAttributeMaxDynamicSharedMemorySize, LDS_BYTES) != hipSuccess) { fprintf(stderr, "kernel_launch: hipFuncSetAttribute failed\n"); grid = -1; return; }
        if (hipOccupancyMaxActiveBlocksPerMultiprocessor(&per_cu, (const void*)fwd_kernel, NTHR, LDS_BYTES) != hipSuccess || per_cu < 1) fprintf(stderr, "kernel_launch: occupancy query says %d\n", per_cu);
        (void)hipGetLastError();
        grid = cus;
    }
    if (grid < 0) return;
    if (hipMemsetAsync((char*)d_ws + WS_CTL, 0, CTL_ZERO_BYTES, stream) != hipSuccess) return;
    Args a{};
    for (int i = 0; i < 31; ++i) a.in[i] = d_in[i];
    a.out = (float*)d_out; a.ws = (unsigned char*)d_ws;
#if N_LAUNCH_MODE == 1
    a.ph_lo = 0; a.ph_hi = NPHASE;
    hipLaunchKernelGGL(fwd_kernel, dim3(grid), dim3(NTHR), LDS_BYTES, stream, a);
#else
    for (int p = 0; p < NPHASE; ++p) { if (p == 3 && !SIMPLE_GEMM) continue; if (p == 5 && (HYENA_NAIVE || ATTN_NAIVE)) continue; a.ph_lo = p; a.ph_hi = p + 1; hipLaunchKernelGGL(fwd_kernel, dim3(grid), dim3(NTHR), LDS_BYTES, stream, a); }
#endif
}
```

```cpp
#include <hip/hip_runtime.h>
#include <cstdio>
#include <cstdint>
namespace pg8 {
#define PG8_LAS __attribute__((address_space(3)))
typedef unsigned short bf16_t;
typedef short bf16x8 __attribute__((ext_vector_type(8)));
typedef float f32x4 __attribute__((ext_vector_type(4)));
typedef unsigned u32x4 __attribute__((ext_vector_type(4)));
constexpr int BM = 256, BK = 64, HALF = 128, HTB = HALF * BK * 2  , STAGE_BYTES = 8 * HTB, NXCD = 8, WGM = 8;

__host__ __device__ __forceinline__ int lds_byte(int r, int c) { const int st = (r >> 4) * 2 + (c >> 5), rr = r & 15, cc = c & 31, ob = rr * 64 + cc * 2; return st * 1024 + (ob ^ (((ob >> 9) & 1) << 5)); }
__host__ __device__ __forceinline__ void stage_rc(int b, int& R, int& C) { const int st = b / 1024, sb = b % 1024, swz = sb ^ (((sb >> 9) & 1) << 5); R = (st >> 1) * 16 + swz / 64; C = (st & 1) * 32 + (swz % 64) / 2; }
__host__ __device__ __forceinline__ int perm32(int rho) { const int n = rho >> 4, i = rho & 15; return 8 * (i >> 2) + 4 * n + (i & 3); }

struct Unit { int pm, pn; };
struct Gemm { const bf16_t* A; const bf16_t* Bt; int M, N, K; };

struct StaticOrder {
    int nM, nN, nwg, G, c;
    __host__ __device__ void init(int M, int N, int G_, int c_) { nM = M / BM; nN = N / BM; nwg = nM * nN; G = G_; c = c_; }
    __host__ __device__ bool next(int i, Unit& u) const {
        const long L = (long)i * G + c; if (L >= nwg) return false;
        int wgid = (int)L; { const int q = nwg / NXCD, r = nwg % NXCD, xcd = wgid % NXCD, off = wgid / NXCD; wgid = (xcd < r ? xcd * (q + 1) : r * (q + 1) + (xcd - r) * q) + off; }
        const int nig = WGM * nN, gid = wgid / nig, fm = gid * WGM, gsz = (nM - fm) < WGM ? (nM - fm) : WGM;
        u.pm = fm + ((wgid % nig) % gsz); u.pn = (wgid % nig) / gsz; return true;
    }
    __device__ __forceinline__ void a_ready(const Unit&) const {}
    __device__ __forceinline__ void done(const Unit&) const {}
};

__device__ __forceinline__ unsigned cvt_pk_bf16(float lo, float hi) { unsigned r; asm volatile("v_cvt_pk_bf16_f32 %0, %1, %2" : "=v"(r) : "v"(lo), "v"(hi)); return r; }
typedef float f32x2 __attribute__((ext_vector_type(2)));
template <class Epi, class Sched, bool ALIGN_EPI = false, bool SP2 = false>
__device__ __forceinline__ void gemm_phase(PG8_LAS unsigned char* lds, const Gemm g, const Sched& S, const Epi& E) {
    const int tid = threadIdx.x, wid = __builtin_amdgcn_readfirstlane(tid >> 6), lane = tid & 63, wr = wid >> 2, wc = wid & 3, fr = lane & 15, fq = lane >> 4;
    const int K = g.K, nt = K / BK;
    unsigned voffA[2], voffB[2];
#pragma unroll
    for (int i = 0; i < 2; ++i) { int R, C; stage_rc(tid * 16 + i * 8192, R, C); const int Rb = Epi::PERM ? ((R & ~31) + perm32(R & 31)) : R;
        voffA[i] = (unsigned)(R * K + C) * 2u; voffB[i] = (unsigned)(Rb * K + C) * 2u; }
    const size_t kstep = (size_t)(BK * 2);
    const size_t hstep = (size_t)HALF * K * 2;
    const size_t tstep = 2 * hstep;
    const unsigned ldsw = (unsigned)wid * 1024u;
    const int aoff = lds_byte(wr * 64 + fr, fq * 8), boff = lds_byte(wc * 32 + fr, fq * 8);
#define PG8_SA(b, h) (((b) * 2 + (h)) * HTB)
#define PG8_SB(b, h) ((4 + (b) * 2 + (h)) * HTB)
#define PG8_STAGE(bufoff, gbase, voff) do { _Pragma("unroll") for (int _i = 0; _i < 2; ++_i) \
        __builtin_amdgcn_global_load_lds((const unsigned*)((const char*)(gbase) + (voff)[_i]), (PG8_LAS unsigned*)(lds + (bufoff) + ldsw + _i * 8192), 16, 0, 0); } while (0)
#define PG8_LDA(dst, b, h) do { _Pragma("unroll") for (int m = 0; m < 4; ++m) _Pragma("unroll") for (int k = 0; k < 2; ++k) dst[m][k] = *(const PG8_LAS bf16x8*)(lds + PG8_SA(b, h) + aoff + m * 2048 + k * 1024); } while (0)
#define PG8_LDB(dst, b, h) do { _Pragma("unroll") for (int n = 0; n < 2; ++n) _Pragma("unroll") for (int k = 0; k < 2; ++k) dst[n][k] = *(const PG8_LAS bf16x8*)(lds + PG8_SB(b, h) + boff + n * 2048 + k * 1024); } while (0)
#define PG8_MMA(ai, bj, At, Bt) do { __builtin_amdgcn_s_setprio(1); _Pragma("unroll") for (int m = 0; m < 4; ++m) _Pragma("unroll") for (int n = 0; n < 2; ++n) _Pragma("unroll") for (int k = 0; k < 2; ++k) \
        acc[ai][bj][m][n] = __builtin_amdgcn_mfma_f32_16x16x32_bf16(Bt[n][k], At[m][k], acc[ai][bj][m][n], 0, 0, 0); __builtin_amdgcn_s_setprio(0); } while (0)
#define PG8_WAIT_V(n) asm volatile("s_waitcnt vmcnt(" #n ")" ::: "memory")
#define PG8_WAIT_L(n) asm volatile("s_waitcnt lgkmcnt(" #n ")" ::: "memory")
#define PG8_BAR __builtin_amdgcn_s_barrier()
#define PG8_SCHED __builtin_amdgcn_sched_barrier(0)
    Unit cur, nxt; int ui = 0;
    if (!S.next(0, cur)) return;
    f32x4 acc[2][2][4][2];
#pragma unroll
    for (int a = 0; a < 2; ++a)
#pragma unroll
        for (int b = 0; b < 2; ++b)
#pragma unroll
            for (int m = 0; m < 4; ++m)
#pragma unroll
                for (int n = 0; n < 2; ++n) acc[a][b][m][n] = (f32x4){0.f, 0.f, 0.f, 0.f};
    bf16x8 At[4][2], B0[2][2], B1[2][2];
    const char* cA = (const char*)g.A + (size_t)cur.pm * tstep; const char* cB = (const char*)g.Bt + (size_t)cur.pn * tstep;
    S.a_ready(cur);
    if constexpr (SP2) {
        PG8_STAGE(PG8_SB(0, 0), cB, voffB); PG8_STAGE(PG8_SB(0, 1), cB + hstep, voffB); PG8_STAGE(PG8_SA(0, 0), cA, voffA); PG8_STAGE(PG8_SA(0, 1), cA + hstep, voffA);
        if (wr == 1) PG8_BAR;
        PG8_WAIT_V(2); PG8_BAR;
        PG8_STAGE(PG8_SB(1, 0), cB + kstep, voffB); PG8_STAGE(PG8_SA(1, 0), cA + kstep, voffA); PG8_STAGE(PG8_SB(1, 1), cB + hstep + kstep, voffB);
        PG8_WAIT_V(6); PG8_BAR;
    } else {
        PG8_STAGE(PG8_SB(0, 0), cB, voffB); PG8_STAGE(PG8_SA(0, 0), cA, voffA); PG8_STAGE(PG8_SB(0, 1), cB + hstep, voffB); PG8_STAGE(PG8_SA(0, 1), cA + hstep, voffA);
        if (wr == 1) PG8_BAR;
        PG8_WAIT_V(4); PG8_BAR;
        PG8_STAGE(PG8_SB(1, 0), cB + kstep, voffB); PG8_STAGE(PG8_SA(1, 0), cA + kstep, voffA); PG8_STAGE(PG8_SB(1, 1), cB + hstep + kstep, voffB);
        PG8_WAIT_V(6); PG8_BAR;
    }
    for (;;) {
        const bool has_next = S.next(ui + 1, nxt);
        const char* nA = has_next ? (const char*)g.A + (size_t)nxt.pm * tstep : cA; const char* nB = has_next ? (const char*)g.Bt + (size_t)nxt.pn * tstep : cB;
        for (int t = 0; t < nt; t += 2) {
            const bool last = (t == nt - 2);
            const char* a1 = cA + (size_t)(t + 1) * kstep;
            const char* a2 = last ? nA : cA + (size_t)(t + 2) * kstep; const char* b2 = last ? nB : cB + (size_t)(t + 2) * kstep;
            const char* a3 = a2 + kstep; const char* b3 = b2 + kstep;
            if (last && has_next) S.a_ready(nxt);
            if constexpr (SP2) {
            PG8_LDB(B0, 0, 0); PG8_LDB(B1, 0, 1); PG8_SCHED; PG8_LDA(At, 0, 0); PG8_STAGE(PG8_SA(1, 1), a1 + hstep, voffA);
            PG8_WAIT_V(8); PG8_WAIT_L(0); PG8_BAR; PG8_MMA(0, 0, At, B0); PG8_MMA(0, 1, At, B1); PG8_BAR; PG8_SCHED;
            PG8_LDA(At, 0, 1); PG8_STAGE(PG8_SB(0, 0), b2, voffB); PG8_STAGE(PG8_SB(0, 1), b2 + hstep, voffB); PG8_STAGE(PG8_SA(0, 0), a2, voffA);
            PG8_WAIT_V(8); PG8_WAIT_L(0); PG8_BAR; PG8_MMA(1, 0, At, B0); PG8_MMA(1, 1, At, B1); PG8_BAR; PG8_SCHED;
            PG8_LDB(B0, 1, 0); PG8_LDB(B1, 1, 1); PG8_SCHED; PG8_LDA(At, 1, 0); PG8_STAGE(PG8_SA(0, 1), a2 + hstep, voffA);
            PG8_WAIT_V(8); PG8_WAIT_L(0); PG8_BAR; PG8_MMA(0, 0, At, B0); PG8_MMA(0, 1, At, B1); PG8_BAR; PG8_SCHED;
            PG8_LDA(At, 1, 1); PG8_STAGE(PG8_SB(1, 0), b3, voffB); PG8_STAGE(PG8_SB(1, 1), b3 + hstep, voffB); PG8_STAGE(PG8_SA(1, 0), a3, voffA);
            PG8_WAIT_V(8); PG8_WAIT_L(0); PG8_BAR; PG8_MMA(1, 0, At, B0); PG8_MMA(1, 1, At, B1); PG8_BAR; PG8_SCHED;
            } else {
            PG8_LDB(B0, 0, 0); PG8_SCHED; PG8_LDA(At, 0, 0); PG8_STAGE(PG8_SA(1, 1), a1 + hstep, voffA);
            PG8_WAIT_L(8); PG8_BAR; PG8_WAIT_L(0); PG8_MMA(0, 0, At, B0); PG8_BAR; PG8_SCHED;
            PG8_LDB(B1, 0, 1); PG8_STAGE(PG8_SB(0, 0), b2, voffB);
            PG8_BAR; PG8_WAIT_L(0); PG8_MMA(0, 1, At, B1); PG8_BAR;
            PG8_LDA(At, 0, 1); PG8_STAGE(PG8_SA(0, 0), a2, voffA);
            PG8_BAR; PG8_WAIT_L(0); PG8_MMA(1, 0, At, B0); PG8_BAR; PG8_SCHED;
            PG8_STAGE(PG8_SB(0, 1), b2 + hstep, voffB);
            PG8_WAIT_V(6); PG8_BAR; PG8_MMA(1, 1, At, B1); PG8_BAR;
            PG8_LDB(B0, 1, 0); PG8_SCHED; PG8_LDA(At, 1, 0); PG8_STAGE(PG8_SA(0, 1), a2 + hstep, voffA);
            PG8_WAIT_L(8); PG8_BAR; PG8_WAIT_L(0); PG8_MMA(0, 0, At, B0); PG8_BAR; PG8_SCHED;
            PG8_LDB(B1, 1, 1); PG8_STAGE(PG8_SB(1, 0), b3, voffB);
            PG8_BAR; PG8_WAIT_L(0); PG8_MMA(0, 1, At, B1); PG8_BAR;
            PG8_LDA(At, 1, 1); PG8_STAGE(PG8_SA(1, 0), a3, voffA);
            PG8_BAR; PG8_WAIT_L(0); PG8_MMA(1, 0, At, B0); PG8_BAR; PG8_SCHED;
            PG8_STAGE(PG8_SB(1, 1), b3 + hstep, voffB);
            PG8_WAIT_V(6); PG8_BAR; PG8_MMA(1, 1, At, B1); PG8_BAR;
            }
        }
        if constexpr (ALIGN_EPI) { if (wr == 0) PG8_BAR; }
        if constexpr (!Epi::AFTER_DRAIN) { E(acc, cur, wr, wc, fr, fq); S.done(cur); }
        if (!has_next) break;
#pragma unroll
        for (int a = 0; a < 2; ++a)
#pragma unroll
            for (int b = 0; b < 2; ++b)
#pragma unroll
                for (int m = 0; m < 4; ++m)
#pragma unroll
                    for (int n = 0; n < 2; ++n) acc[a][b][m][n] = (f32x4){0.f, 0.f, 0.f, 0.f};
        cur = nxt; cA = nA; cB = nB; ++ui;
        if constexpr (ALIGN_EPI) { if (wr == 1) PG8_BAR; }
    }
    PG8_WAIT_V(0);
    if constexpr (!ALIGN_EPI) { if (wr == 0) PG8_BAR; }
    PG8_BAR;
    if constexpr (Epi::AFTER_DRAIN) { E.fused(acc, cur, wr, wc, fr, fq, lds, wid, lane); S.done(cur); }
#undef PG8_SA
#undef PG8_SB
#undef PG8_STAGE
#undef PG8_LDA
#undef PG8_LDB
#undef PG8_MMA
#undef PG8_WAIT_V
#undef PG8_WAIT_L
#undef PG8_BAR
#undef PG8_SCHED
}
}


#ifndef N_LAUNCH_MODE
#define N_LAUNCH_MODE 1
#endif
#ifndef MOE_SIMT
#define MOE_SIMT 0
#endif
#ifndef HYENA_NAIVE
#define HYENA_NAIVE 0
#endif
#ifndef ATTN_NAIVE
#define ATTN_NAIVE 0
#endif
#ifndef SIMPLE_GEMM
#define SIMPLE_GEMM 0
#endif

constexpr int D = 2048, BATCH = 2, SEQ = 4096, T = BATCH * SEQ;
constexpr int HW = 1024;
constexpr int NH = 12, HD = 128, QKVW = 3 * NH * HD;
constexpr int INW = 3 * HW + QKVW;
constexpr int N1 = INW + 2 * D;
constexpr int NE = 64, FF = 512;
constexpr float RMS_EPS = 1e-6f;
constexpr int NWAVES = 8, NTHR = 512;
constexpr int NPHASE = 12;

constexpr size_t MiB = 1u << 20;
constexpr size_t WS_CTL = 0, CTL_ZERO_BYTES = 1 * MiB;
constexpr size_t WS_MODP = 1 * MiB;
constexpr size_t WS_HID2 = 2 * MiB;
constexpr size_t WS_ROT = 3 * MiB;
constexpr size_t WS_W3T = 4 * MiB;
constexpr size_t WS_ROUTE = 5 * MiB;
constexpr size_t WS_LISTT = 6 * MiB;
constexpr size_t WS_LISTG = 8 * MiB;
constexpr size_t WS_WGT = 10 * MiB;
constexpr size_t WS_WET = 11 * MiB;
constexpr size_t WS_HID2B = 12 * MiB;
constexpr size_t WS_W3TB = 13 * MiB;
constexpr size_t WS_W1T = 16 * MiB;
constexpr size_t WS_WHYOT = 64 * MiB;
constexpr size_t WS_WATOT = 68 * MiB;
constexpr size_t WS_WOUTT = 70 * MiB;
constexpr size_t WS_KF = 80 * MiB;
constexpr size_t WS_H = 144 * MiB;
constexpr size_t WS_PHY = 176 * MiB;
constexpr size_t WS_QKV = 224 * MiB;
constexpr size_t WS_G = 296 * MiB;
constexpr size_t WS_YHY = 360 * MiB;
constexpr size_t WS_YAT = 376 * MiB;
constexpr size_t WS_TMP = 384 * MiB;
constexpr size_t WS_MERGED = 448 * MiB;
constexpr size_t WS_Y = 480 * MiB;
constexpr size_t WS_X1 = 544 * MiB;
constexpr size_t WS_H2 = 608 * MiB;
constexpr size_t WS_ACT = 640 * MiB;
constexpr size_t WS_YB = 672 * MiB;
constexpr size_t WS_END = 800 * MiB;
constexpr int CW_BAR = 4096;
constexpr int CW_CNT = 16384;

constexpr int RING_BYTES = 131072;
constexpr int LDS_BYTES = 163840;
constexpr int MISC_OFF = LDS_BYTES - 256;
constexpr int MOE_OFFS_OFF = LDS_BYTES - 1024;

#define GAS __attribute__((address_space(1)))
#define LAS __attribute__((address_space(3)))
typedef unsigned short bf16;
typedef unsigned v4u __attribute__((ext_vector_type(4)));
typedef unsigned v2u __attribute__((ext_vector_type(2)));
typedef float f32x4 __attribute__((ext_vector_type(4)));
typedef LAS float lfloat;

__device__ __forceinline__ unsigned f2bf(float f) { unsigned u = __builtin_bit_cast(unsigned, f); return (u + 0x7fffu + ((u >> 16) & 1u)) >> 16; }
__device__ __forceinline__ unsigned pk2(float lo, float hi) { return f2bf(lo) | (f2bf(hi) << 16); }
__device__ __forceinline__ float bf2f(unsigned short b) { return __builtin_bit_cast(float, ((unsigned)b) << 16); }
__device__ __forceinline__ float bflo(unsigned w) { return __builtin_bit_cast(float, w << 16); }
__device__ __forceinline__ float bfhi(unsigned w) { return __builtin_bit_cast(float, w & 0xffff0000u); }

#define XB_TMO      128
#define XB_XCNT(j)  (256  + 64 * (j))
#define XB_XSUB(j)  (1280 + 64 * (j))
#define XB_XGEN(j)  (2304 + 64 * (j))
#define XB_TOP      3328
#define XB_TOPGEN   3392
#define XCD_BAR_WORDS 3456
#define XB_SPIN_CAP (1u << 18)
__device__ __forceinline__ unsigned xb_ld(unsigned* p)              { return __hip_atomic_load(p, __ATOMIC_RELAXED, __HIP_MEMORY_SCOPE_AGENT); }
__device__ __forceinline__ unsigned xb_add(unsigned* p, unsigned v) { return __hip_atomic_fetch_add(p, v, __ATOMIC_RELAXED, __HIP_MEMORY_SCOPE_AGENT); }
__device__ __forceinline__ unsigned xb_xcc_id() { return (unsigned)__builtin_amdgcn_s_getreg((3 << 11) | 20) & 0xFu; }
#define XB_SPIN(cond, bar) do { unsigned _sp = 0; while (cond) { __builtin_amdgcn_s_sleep(1); \
    if ((++_sp & 255u) == 0u) { if (xb_ld(&(bar)[XB_TMO])) break; if (_sp > XB_SPIN_CAP) { atomicAdd(&(bar)[XB_TMO], 1u); break; } } } } while (0)
struct XcdBarrier { unsigned* bar; unsigned x; volatile LAS unsigned* st; };
__device__ __forceinline__ XcdBarrier xcd_barrier_post(unsigned* bar, volatile LAS unsigned* st) {
    XcdBarrier b; b.bar = bar; b.x = xb_xcc_id(); b.st = st;
    if (threadIdx.x == 0) (void)xb_add(&bar[XB_XCNT(b.x)], 1u);
    return b;
}
__device__ __forceinline__ void xcd_barrier_complete(unsigned* bar, unsigned x, unsigned& nloc, unsigned& nx) {
    const unsigned G = gridDim.x * gridDim.y * gridDim.z;
    unsigned sum, cnt, mine, sp = 0u;
    for (;;) {
        sum = 0u; cnt = 0u; mine = 0u;
#pragma unroll
        for (unsigned j = 0; j < 16; ++j) { const unsigned c = xb_ld(&bar[XB_XCNT(j)]); sum += c; cnt += (c > 0u) ? 1u : 0u; mine = (j == x) ? c : mine; }
        if (sum == G) break;
        __builtin_amdgcn_s_sleep(1);
        if ((++sp & 255u) == 0u) { if (xb_ld(&bar[XB_TMO])) break; if (sp > XB_SPIN_CAP) { atomicAdd(&bar[XB_TMO], 1u); break; } }
    }
    nloc = mine > 0u ? mine : 1u; nx = cnt > 0u ? cnt : 1u;
}
__device__ __forceinline__ void xcd_barrier(const XcdBarrier& b) {
    asm volatile("s_waitcnt vmcnt(0)" ::: "memory");
    __syncthreads();
    if (threadIdx.x == 0) {
        unsigned* bar = b.bar;
        __builtin_amdgcn_s_waitcnt(0);
        unsigned nloc = b.st[0], nx = b.st[1];
        if (nloc == 0u) { xcd_barrier_complete(bar, b.x, nloc, nx); b.st[0] = nloc; b.st[1] = nx; }
        const unsigned old = xb_add(&bar[XB_XSUB(b.x)], 1u);
        const unsigned gen = old / nloc;
        if (old + 1u == (gen + 1u) * nloc) {
            __builtin_amdgcn_fence(__ATOMIC_RELEASE, "agent");
            asm volatile("s_waitcnt vmcnt(0)" ::: "memory");
            const unsigned og = xb_add(&bar[XB_TOP], 1u);
            const unsigned tg = og / nx;
            if (og + 1u == (tg + 1u) * nx) xb_add(&bar[XB_TOPGEN], 1u);
            else XB_SPIN(xb_ld(&bar[XB_TOPGEN]) == tg, bar);
            __builtin_amdgcn_fence(__ATOMIC_ACQUIRE, "agent");
            xb_add(&bar[XB_XGEN(b.x)], 1u);
            asm volatile("s_waitcnt vmcnt(0)" ::: "memory");
        } else {
            XB_SPIN(xb_ld(&bar[XB_XGEN(b.x)]) == gen, bar);
            __builtin_amdgcn_fence(__ATOMIC_ACQUIRE, "agent");
            asm volatile("s_waitcnt vmcnt(0)" ::: "memory");
        }
    }
    __syncthreads();
}

struct Args { const void* in[31]; float* out; unsigned char* ws; int ph_lo, ph_hi; };
struct Frame {
    LAS unsigned char* lds;
    int tid, lane, wave, G, bid;
    const float *x, *c, *w_ada, *b_ada, *g_mix_pre, *g_mix_post, *g_ffn_pre, *g_ffn_post, *w_in, *conv_w, *conv_b, *fw1, *fb1, *fw2, *fb2, *fw3, *ffreq, *hskip,
        *w_bg, *b_bg, *w_hy_o, *w_at_o, *w_out, *w_group, *b_group, *w_expert, *b_expert, *w1e, *w3e, *w2e;
    const int* positions;
    float* out;
    unsigned* ctl; float *MODP, *HID2, *ROT, *W3T, *TMP, *Y, *X1, *ACT, *YB, *LISTG, *WGT, *WET; bf16 *KF, *HID2B, *W3TB;
    unsigned* ROUTE; int* LISTT;
    bf16 *W1T, *WHYOT, *WATOT, *WOUTT, *H, *PHY, *QKV, *GT, *YHY, *YAT, *MERGED, *H2, *ACTB, *YBB;
};

__device__ __forceinline__ float wave_sum(float v) {
#pragma unroll
    for (int o = 1; o < 64; o <<= 1) v += __shfl_xor(v, o);
    return v;
}
__device__ __forceinline__ float wave_max(float v) {
#pragma unroll
    for (int o = 1; o < 64; o <<= 1) v = fmaxf(v, __shfl_xor(v, o));
    return v;
}

__device__ __forceinline__ void p0_transpose_item(const float* W, int K, int N, bf16* WT, int row_off, LAS float* scr, int item, int lane) {
    const int nblk = N / 32, kb = item / nblk, nb = item % nblk, k0 = 64 * kb, n0 = 32 * nb;
#pragma unroll 8
    for (int i = 0; i < 32; ++i) { const int kk = 2 * i + (lane >> 5); scr[kk * 33 + (lane & 31)] = W[(size_t)(k0 + kk) * N + n0 + (lane & 31)]; }
    asm volatile("s_waitcnt lgkmcnt(0)" ::: "memory");
    const int c = lane & 7;
#pragma unroll
    for (int j = 0; j < 4; ++j) { const int n = (lane >> 3) + 8 * j; const LAS float* s = scr + (8 * c) * 33 + n;
        v4u o; o.x = pk2(s[0 * 33], s[1 * 33]); o.y = pk2(s[2 * 33], s[3 * 33]); o.z = pk2(s[4 * 33], s[5 * 33]); o.w = pk2(s[6 * 33], s[7 * 33]);
        *(v4u*)(WT + (size_t)(row_off + n0 + n) * K + k0 + 8 * c) = o; }
    asm volatile("s_waitcnt lgkmcnt(0)" ::: "memory");
}

__device__ __forceinline__ void load_mod(Frame& F, LAS float* dst, int which) {
    for (int i = F.tid; i < 2 * D / 4; i += NTHR) { const int b = i / (D / 4), d4 = i % (D / 4);
        *(LAS f32x4*)(dst + 4 * i) = *(const f32x4*)(F.MODP + (size_t)b * (6 * D) + which * D + 4 * d4); }
}
__device__ __forceinline__ void load_mod1(Frame& F, LAS float* dst, int which, int b) {
    for (int i = F.tid; i < D / 4; i += NTHR) *(LAS f32x4*)(dst + 4 * i) = *(const f32x4*)(F.MODP + (size_t)b * (6 * D) + which * D + 4 * i);
}

__device__ __forceinline__ void p0_prologue(Frame& F) {
    LAS float* L = (LAS float*)F.lds;
    {
        LAS float* sc = L;
        LAS float* red = L + 2 * D;
        for (int i = F.tid; i < 2 * D; i += NTHR) { const float cv = F.c[i]; sc[i] = cv / (1.f + __expf(-cv)); }
        __syncthreads();
        for (int u = F.bid; u < 6 * D / 64; u += F.G) {
            float a0 = 0.f, a1 = 0.f;
            const float* wp = F.w_ada + (size_t)(F.wave * 256) * (6 * D) + u * 64 + F.lane;
#pragma unroll 16
            for (int r = 0; r < 256; ++r) { const float w = wp[(size_t)r * (6 * D)]; a0 += w * sc[F.wave * 256 + r]; a1 += w * sc[D + F.wave * 256 + r]; }
            red[(F.wave * 2 + 0) * 64 + F.lane] = a0; red[(F.wave * 2 + 1) * 64 + F.lane] = a1;
            __syncthreads();
            if (F.tid < 128) { const int b = F.tid >> 6, col = F.tid & 63; float s = F.b_ada[u * 64 + col];
#pragma unroll
                for (int w = 0; w < 8; ++w) s += red[(w * 2 + b) * 64 + col];
                F.MODP[(size_t)b * (6 * D) + u * 64 + col] = s; }
            __syncthreads();
        }
        __syncthreads();
    }
    const int gw = F.bid * NWAVES + F.wave, NGW = F.G * NWAVES;
    {
        LAS float* scr = (LAS float*)(F.lds + F.wave * 16384);
        constexpr int I_IN = (D / 64) * (INW / 32), I_BG = (D / 64) * (2 * D / 32), I_HY = (HW / 64) * (D / 32), I_AT = (512 / 64) * (D / 32), I_OUT = (D / 64) * (D / 32);
        constexpr int NITEMS = I_IN + I_BG + I_HY + I_AT + I_OUT;
        for (int it = gw; it < NITEMS; it += NGW) {
            int r = it;
            if (r < I_IN) { p0_transpose_item(F.w_in, D, INW, F.W1T, 0, scr, r, F.lane); continue; } r -= I_IN;
            if (r < I_BG) { p0_transpose_item(F.w_bg, D, 2 * D, F.W1T, INW, scr, r, F.lane); continue; } r -= I_BG;
            if (r < I_HY) { p0_transpose_item(F.w_hy_o, HW, D, F.WHYOT, 0, scr, r, F.lane); continue; } r -= I_HY;
            if (r < I_AT) { p0_transpose_item(F.w_at_o, 512, D, F.WATOT, 0, scr, r, F.lane); continue; } r -= I_AT;
            p0_transpose_item(F.w_out, D, D, F.WOUTT, 0, scr, r, F.lane);
        }
    }
    for (int i = F.bid * NTHR + F.tid; i < 64 * 4096; i += F.G * NTHR) { const int n = i >> 6, j = i & 63; F.W3TB[i] = (bf16)f2bf(F.fw3[j * 4096 + n]); }
    for (int i = F.bid * NTHR + F.tid; i < 8 * D; i += F.G * NTHR) { const int n = i / D, d = i % D; F.WGT[i] = F.w_group[d * 8 + n]; }
    for (int i = F.bid * NTHR + F.tid; i < 64 * D; i += F.G * NTHR) { const int ge = i / D, d = i % D, g = ge >> 3, e = ge & 7; F.WET[i] = F.w_expert[((size_t)g * D + d) * 8 + e]; }
    for (int t = gw; t < SEQ; t += NGW) {
        const int j = F.lane;
        const float tn = (float)t * (1.0f / (float)(SEQ - 1));
        const float w = 6.283185307179586f * (float)t / (float)SEQ;
        float feat = 0.f;
        if (j == 0) feat = tn;
        else if (j <= 16) { const float band = 1e-4f + (float)(j - 1) * ((15.0f - 1e-4f) / 15.0f); feat = cosf(band * w); }
        else if (j <= 32) { const float band = 1e-4f + (float)(j - 17) * ((15.0f - 1e-4f) / 15.0f); feat = -sinf(band * w); }
        float a = F.fb1[j];
        for (int i = 0; i < 33; ++i) a += __shfl(feat, i) * F.fw1[i * 64 + j];
        const float fr = F.ffreq[j];
        const float h1 = sinf(fr * a);
        float a2 = F.fb2[j];
        for (int i = 0; i < 64; ++i) a2 += __shfl(h1, i) * F.fw2[i * 64 + j];
        { const float hv = sinf(fr * a2); F.HID2[t * 64 + j] = hv; F.HID2B[t * 64 + j] = (bf16)f2bf(hv); }
    }
    for (int i = F.bid * NTHR + F.tid; i < T * 16; i += F.G * NTHR) {
        const int tok = i >> 4, k = i & 15;
        const float inv = powf(500000.0f, -(float)k * (1.0f / 16.0f));
        const float ang = (float)F.positions[tok] * inv;
        F.ROT[tok * 32 + k] = cosf(ang); F.ROT[tok * 32 + 16 + k] = sinf(ang);
    }
}

__device__ __forceinline__ void p1_rows_filters(Frame& F) {
    LAS float* L = (LAS float*)F.lds;
    LAS float* shiftv = L;
    LAS float* scalev = L + 2 * D;
    load_mod(F, shiftv, 0); load_mod(F, scalev, 1);
    __syncthreads();
    const int gw = F.bid * NWAVES + F.wave, NGW = F.G * NWAVES;
    for (int m = gw; m < T; m += NGW) {
        const int b = m / SEQ;
        const f32x4* xr = (const f32x4*)(F.x + (size_t)m * D) + F.lane;
        f32x4 v[8]; float s = 0.f;
#pragma unroll
        for (int j = 0; j < 8; ++j) { v[j] = xr[64 * j]; s += (v[j].x * v[j].x + v[j].y * v[j].y) + (v[j].z * v[j].z + v[j].w * v[j].w); }
        const float rstd = 1.0f / sqrtf(wave_sum(s) * (1.f / D) + RMS_EPS);
        v2u* o8 = (v2u*)(F.H + (size_t)m * D) + F.lane;
#pragma unroll
        for (int j = 0; j < 8; ++j) { const int d = 256 * j + 4 * F.lane;
            const f32x4 g = *(const f32x4*)(F.g_mix_pre + d); const f32x4 sc = *(LAS f32x4*)(scalev + b * D + d), sh = *(LAS f32x4*)(shiftv + b * D + d);
            f32x4 h; h = (v[j] * rstd) * g; h = h * (sc + 1.0f) + sh;
            v2u w; w.x = pk2(h.x, h.y); w.y = pk2(h.z, h.w); o8[64 * j] = w; }
    }
    {
        typedef short bf16x8 __attribute__((ext_vector_type(8)));
        typedef float f32x16 __attribute__((ext_vector_type(16)));
        const int r31 = F.lane & 31, hh = F.lane >> 5;
        const float mind = -3.0701134573253945f, maxd = -15.350567286626972f;
        for (int u = gw; u < 128 * 32; u += NGW) {
            const int tt = u & 127, ng = u >> 7, t = tt * 32 + r31;
            bf16x8 bq[4];
#pragma unroll
            for (int s = 0; s < 4; ++s) bq[s] = *(const bf16x8*)(F.HID2B + (size_t)t * 64 + 16 * s + 8 * hh);
            const float tn = (float)t * (1.0f / (float)(SEQ - 1));
#pragma unroll 1
            for (int q = 0; q < 4; ++q) {
                const int n0 = (ng * 4 + q) * 32;
                f32x16 c;
#pragma unroll
                for (int i = 0; i < 16; ++i) c[i] = 0.f;
#pragma unroll
                for (int s = 0; s < 4; ++s) { const bf16x8 a = *(const bf16x8*)(F.W3TB + (size_t)(n0 + r31) * 64 + 16 * s + 8 * hh); c = __builtin_amdgcn_mfma_f32_32x32x16_bf16(a, bq[s], c, 0, 0, 0); }
#pragma unroll
                for (int i = 0; i < 16; ++i) { const int n = n0 + (i & 3) + 8 * (i >> 2) + 4 * hh, ch = n & (HW - 1);
                    const float delta = fabsf(mind + (float)ch * ((maxd - mind) / (float)(HW - 1)));
                    F.KF[(size_t)n * SEQ + t] = (bf16)f2bf(c[i] * __expf(-tn * delta)); }
            }
        }
    }
}

template <int NB, class LA, class LB, class EP>
__device__ __forceinline__ void simt_tile(LAS float* L, int K, int tid, const LA& la, const LB& lb, const EP& ep) {
    LAS float* As = L;
    LAS float* Bs = L + 32 * 68;
    const int ty = tid >> 4, tx = tid & 15;
    float acc[NB][2][4];
#pragma unroll
    for (int q = 0; q < NB; ++q)
#pragma unroll
        for (int i = 0; i < 2; ++i)
#pragma unroll
            for (int j = 0; j < 4; ++j) acc[q][i][j] = 0.f;
    for (int k0 = 0; k0 < K; k0 += 32) {
        __syncthreads();
        for (int e = tid; e < 64 * 32; e += NTHR) { const int r = e >> 5, kk = e & 31; As[kk * 68 + r] = la(r, k0 + kk); }
#pragma unroll
        for (int q = 0; q < NB; ++q)
            for (int e = tid; e < 32 * 64; e += NTHR) { const int kk = e >> 6, cc = e & 63; Bs[(q * 32 + kk) * 68 + cc] = lb(q, k0 + kk, cc); }
        __syncthreads();
#pragma unroll 8
        for (int kk = 0; kk < 32; ++kk) {
            const float a0 = As[kk * 68 + 2 * ty], a1 = As[kk * 68 + 2 * ty + 1];
#pragma unroll
            for (int q = 0; q < NB; ++q) { const f32x4 b = *(LAS f32x4*)(Bs + (q * 32 + kk) * 68 + 4 * tx);
                acc[q][0][0] += a0 * b.x; acc[q][0][1] += a0 * b.y; acc[q][0][2] += a0 * b.z; acc[q][0][3] += a0 * b.w;
                acc[q][1][0] += a1 * b.x; acc[q][1][1] += a1 * b.y; acc[q][1][2] += a1 * b.z; acc[q][1][3] += a1 * b.w; }
        }
    }
#pragma unroll
    for (int i = 0; i < 2; ++i)
#pragma unroll
        for (int j = 0; j < 4; ++j) { float v[NB];
#pragma unroll
            for (int q = 0; q < NB; ++q) v[q] = acc[q][i][j];
            ep(2 * ty + i, 4 * tx + j, v); }
}

struct EpiProj {
    static constexpr bool PERM = true, AFTER_DRAIN = false;
    bf16* QKVp; bf16* Gp; const float* ROT; const float* bias;
    __device__ __forceinline__ void operator()(const pg8::f32x4 (&acc)[2][2][4][2], const pg8::Unit& u, int wr, int wc, int fr, int fq) const {
        using namespace pg8;
        const int row0 = u.pm * BM + wr * 64 + fr;
        const int colt = u.pn * BM;
        if (colt < QKVW) {
            const bool rot = (colt < 2 * NH * HD) && (wc == 0);
#pragma unroll
            for (int ai = 0; ai < 2; ++ai)
#pragma unroll
                for (int m = 0; m < 4; ++m) { const int row = row0 + ai * HALF + m * 16;
                    bf16* rowp = QKVp + (size_t)row * QKVW + colt + wc * 32 + 8 * fq;
                    f32x4 cs0, cs1, sn0, sn1;
                    if (rot) { const float* rp = ROT + (size_t)row * 32 + 8 * (fq & 1); cs0 = *(const f32x4*)rp; cs1 = *(const f32x4*)(rp + 4); sn0 = *(const f32x4*)(rp + 16); sn1 = *(const f32x4*)(rp + 20); }
#pragma unroll
                    for (int bj = 0; bj < 2; ++bj) { f32x4 v0 = acc[ai][bj][m][0], v1 = acc[ai][bj][m][1];
                        if (rot) {
                            f32x4 o0, o1;
#pragma unroll
                            for (int j = 0; j < 4; ++j) { o0[j] = __shfl_xor(v0[j], 32); o1[j] = __shfl_xor(v1[j], 32); }
                            if (fq < 2) { v0 = v0 * cs0 - o0 * sn0; v1 = v1 * cs1 - o1 * sn1; }
                            else        { v0 = v0 * cs0 + o0 * sn0; v1 = v1 * cs1 + o1 * sn1; }
                        }
                        u32x4 w; w.x = cvt_pk_bf16(v0[0], v0[1]); w.y = cvt_pk_bf16(v0[2], v0[3]); w.z = cvt_pk_bf16(v1[0], v1[1]); w.w = cvt_pk_bf16(v1[2], v1[3]);
                        *(u32x4*)(rowp + bj * HALF) = w; } }
        } else {
            const int gc = colt - QKVW + wc * 32 + 8 * fq;
            f32x4 bv[2][2];
#pragma unroll
            for (int bj = 0; bj < 2; ++bj)
#pragma unroll
                for (int n = 0; n < 2; ++n) bv[bj][n] = *(const f32x4*)(bias + gc + bj * HALF + 4 * n);
#pragma unroll
            for (int ai = 0; ai < 2; ++ai)
#pragma unroll
                for (int m = 0; m < 4; ++m) { bf16* rowp = Gp + (size_t)(row0 + ai * HALF + m * 16) * (2 * D) + gc;
#pragma unroll
                    for (int bj = 0; bj < 2; ++bj) { f32x4 v0 = acc[ai][bj][m][0] + bv[bj][0], v1 = acc[ai][bj][m][1] + bv[bj][1];
#pragma unroll
                        for (int j = 0; j < 4; ++j) { v0[j] = 1.0f / (1.0f + __expf(-v0[j])); v1[j] = 1.0f / (1.0f + __expf(-v1[j])); }
                        u32x4 w; w.x = cvt_pk_bf16(v0[0], v0[1]); w.y = cvt_pk_bf16(v0[2], v0[3]); w.z = cvt_pk_bf16(v1[0], v1[1]); w.w = cvt_pk_bf16(v1[2], v1[3]);
                        *(u32x4*)(rowp + bj * HALF) = w; } }
        }
    }
};
struct EpiPlainBf16 {
    static constexpr bool PERM = true, AFTER_DRAIN = false;
    bf16* O; int ldc;
    __device__ __forceinline__ void operator()(const pg8::f32x4 (&acc)[2][2][4][2], const pg8::Unit& u, int wr, int wc, int fr, int fq) const {
        using namespace pg8;
        const int row0 = u.pm * BM + wr * 64 + fr, col0 = u.pn * BM + wc * 32 + 8 * fq;
#pragma unroll
        for (int ai = 0; ai < 2; ++ai)
#pragma unroll
            for (int m = 0; m < 4; ++m) { bf16* rowp = O + (size_t)(row0 + ai * HALF + m * 16) * ldc + col0;
#pragma unroll
                for (int bj = 0; bj < 2; ++bj) { const f32x4 v0 = acc[ai][bj][m][0], v1 = acc[ai][bj][m][1];
                    u32x4 w; w.x = cvt_pk_bf16(v0[0], v0[1]); w.y = cvt_pk_bf16(v0[2], v0[3]); w.z = cvt_pk_bf16(v1[0], v1[1]); w.w = cvt_pk_bf16(v1[2], v1[3]);
                    *(u32x4*)(rowp + bj * HALF) = w; } }
    }
};
template <int STAGE> struct EpiGate {
    static constexpr bool PERM = true, AFTER_DRAIN = false;
    const bf16* Gp; int goff; float* TMPp; bf16* Mp;
    __device__ __forceinline__ void operator()(const pg8::f32x4 (&acc)[2][2][4][2], const pg8::Unit& u, int wr, int wc, int fr, int fq) const {
        using namespace pg8;
        const int row0 = u.pm * BM + wr * 64 + fr, col0 = u.pn * BM + wc * 32 + 8 * fq;
#pragma unroll
        for (int ai = 0; ai < 2; ++ai)
#pragma unroll
            for (int m = 0; m < 4; ++m) { const size_t row = (size_t)(row0 + ai * HALF + m * 16);
#pragma unroll
                for (int bj = 0; bj < 2; ++bj) { const int col = col0 + bj * HALF;
                    const u32x4 gw = *(const u32x4*)(Gp + row * (2 * D) + goff + col);
                    f32x4 g0 = {bflo(gw.x), bfhi(gw.x), bflo(gw.y), bfhi(gw.y)}, g1 = {bflo(gw.z), bfhi(gw.z), bflo(gw.w), bfhi(gw.w)};
                    f32x4 v0 = acc[ai][bj][m][0] * g0, v1 = acc[ai][bj][m][1] * g1;
                    float* tp = TMPp + row * D + col;
                    if (STAGE == 0) { *(f32x4*)tp = v0; *(f32x4*)(tp + 4) = v1; }
                    else { v0 += *(const f32x4*)tp; v1 += *(const f32x4*)(tp + 4);
                        u32x4 w; w.x = cvt_pk_bf16(v0[0], v0[1]); w.y = cvt_pk_bf16(v0[2], v0[3]); w.z = cvt_pk_bf16(v1[0], v1[1]); w.w = cvt_pk_bf16(v1[2], v1[3]);
                        *(u32x4*)(Mp + row * D + col) = w; } } }
    }
};
struct EpiF32 {
    static constexpr bool PERM = false, AFTER_DRAIN = false;
    float* C; int ldc;
    __device__ __forceinline__ void operator()(const pg8::f32x4 (&acc)[2][2][4][2], const pg8::Unit& u, int wr, int wc, int fr, int fq) const {
        using namespace pg8;
        const int row0 = u.pm * BM + wr * 64 + fr, col0 = u.pn * BM + wc * 32 + 4 * fq;
#pragma unroll
        for (int ai = 0; ai < 2; ++ai)
#pragma unroll
            for (int m = 0; m < 4; ++m) { float* rowp = C + (size_t)(row0 + ai * HALF + m * 16) * ldc + col0;
#pragma unroll
                for (int bj = 0; bj < 2; ++bj)
#pragma unroll
                    for (int n = 0; n < 2; ++n) *(f32x4*)(rowp + bj * HALF + n * 16) = acc[ai][bj][m][n]; }
    }
};

template <class Epi>
__device__ __forceinline__ void run_gemm(Frame& F, const bf16* A, const bf16* Bt, int M, int N, int K, const Epi& E) {
    pg8::Gemm g{A, Bt, M, N, K}; pg8::StaticOrder S; S.init(M, N, F.G, F.bid);
    pg8::gemm_phase<Epi, pg8::StaticOrder, true, true>(F.lds, g, S, E);
}

__device__ __forceinline__ float sconv_at(const bf16* rowp, int t, float w0, float w1, float w2, float bias) {
    const float um = t > 0 ? bf2f(rowp[t - 1]) : 0.f, u0 = bf2f(rowp[t]), up = t < SEQ - 1 ? bf2f(rowp[t + 1]) : 0.f;
    return um * w0 + u0 * w1 + up * w2 + bias;
}
__device__ __forceinline__ void conv8(const LAS float* kk, const LAS float* z, int t0, float (&acc)[2][8]) {
#pragma unroll
    for (int b = 0; b < 2; ++b)
#pragma unroll
        for (int j = 0; j < 8; ++j) acc[b][j] = 0.f;
    for (int s8 = 0; s8 < SEQ; s8 += 8) {
        const int base = t0 - s8 + (SEQ - 1);
        float kw[15];
#pragma unroll
        for (int i = 0; i < 15; ++i) kw[i] = kk[base - 7 + i];
        float zz[2][8];
#pragma unroll
        for (int b = 0; b < 2; ++b) { const f32x4 q0 = *(const LAS f32x4*)(z + b * SEQ + s8), q1 = *(const LAS f32x4*)(z + b * SEQ + s8 + 4);
            zz[b][0] = q0.x; zz[b][1] = q0.y; zz[b][2] = q0.z; zz[b][3] = q0.w; zz[b][4] = q1.x; zz[b][5] = q1.y; zz[b][6] = q1.z; zz[b][7] = q1.w; }
#pragma unroll
        for (int ds = 0; ds < 8; ++ds)
#pragma unroll
            for (int j = 0; j < 8; ++j) { const float k = kw[7 + j - ds]; acc[0][j] += k * zz[0][ds]; acc[1][j] += k * zz[1][ds]; }
    }
}
__device__ __forceinline__ void p3_hyena_naive(Frame& F) {
    LAS float* L = (LAS float*)F.lds;
    LAS float* zin = L;
    LAS float* kk = L + 2 * SEQ;
    LAS float* zmid = L + 4 * SEQ;
    for (int c = F.bid; c < HW; c += F.G) {
        __syncthreads();
        const float cw[3][3] = {{F.conv_w[c], F.conv_w[3 * HW + c], F.conv_w[6 * HW + c]},
                                {F.conv_w[HW + c], F.conv_w[3 * HW + HW + c], F.conv_w[6 * HW + HW + c]},
                                {F.conv_w[2 * HW + c], F.conv_w[3 * HW + 2 * HW + c], F.conv_w[6 * HW + 2 * HW + c]}};
        const float cb[3] = {F.conv_b[c], F.conv_b[HW + c], F.conv_b[2 * HW + c]};
        const bf16* pv = F.PHY + (size_t)c * T; const bf16* px1 = F.PHY + (size_t)(HW + c) * T; const bf16* px2 = F.PHY + (size_t)(2 * HW + c) * T;
        for (int i = F.tid; i < T; i += NTHR) { const int b = i / SEQ, t = i % SEQ; zin[i] = sconv_at(pv + b * SEQ, t, cw[0][0], cw[0][1], cw[0][2], cb[0]); }
        for (int i = F.tid; i < 2 * SEQ; i += NTHR) { const int d = i - (SEQ - 1);
            kk[i] = (i == 2 * SEQ - 1) ? 0.f : bf2f(d >= 0 ? F.KF[(size_t)(0 * HW + c) * SEQ + d] : F.KF[(size_t)(1 * HW + c) * SEQ - d]); }
        __syncthreads();
        const int t0 = F.tid * 8; float acc[2][8];
        conv8(kk, zin, t0, acc);
        const float sk0 = F.hskip[c], sk1 = F.hskip[HW + c];
#pragma unroll
        for (int b = 0; b < 2; ++b)
#pragma unroll
            for (int j = 0; j < 8; ++j) { const float x1 = sconv_at(px1 + b * SEQ, t0 + j, cw[1][0], cw[1][1], cw[1][2], cb[1]);
                zmid[b * SEQ + t0 + j] = x1 * (acc[b][j] + sk0 * zin[b * SEQ + t0 + j]); }
        __syncthreads();
        for (int i = F.tid; i < 2 * SEQ; i += NTHR) { const int d = i - (SEQ - 1);
            kk[i] = (i == 2 * SEQ - 1) ? 0.f : bf2f(d >= 0 ? F.KF[(size_t)(2 * HW + c) * SEQ + d] : F.KF[(size_t)(3 * HW + c) * SEQ - d]); }
        __syncthreads();
        conv8(kk, zmid, t0, acc);
#pragma unroll
        for (int b = 0; b < 2; ++b)
#pragma unroll
            for (int j = 0; j < 8; ++j) { const float x2 = sconv_at(px2 + b * SEQ, t0 + j, cw[2][0], cw[2][1], cw[2][2], cb[2]);
                const float z2 = x2 * (acc[b][j] + sk1 * zmid[b * SEQ + t0 + j]);
                F.YHY[(size_t)(b * SEQ + t0 + j) * HW + c] = (bf16)f2bf(z2); }
    }
}

constexpr int HY_KCOPY = 16448;
constexpr int HY_K_OFF = 0;
constexpr int HY_ZIN_OFF = 4 * HY_KCOPY;
constexpr int HY_ZBYTES = 160 * 2 * 80;
constexpr int HY_ZMID_OFF = HY_ZIN_OFF + HY_ZBYTES;
constexpr int HY_X1_OFF = HY_ZMID_OFF + HY_ZBYTES;
constexpr int HY_X2_OFF = HY_X1_OFF + 2 * SEQ * 2;
static_assert(HY_X2_OFF + 2 * SEQ * 2 <= MOE_OFFS_OFF, "hyena LDS map");
__device__ __forceinline__ unsigned hy_zaddr(int b, int t) { return (unsigned)((((t >> 5) + 16) * 2 + b) * 80 + (t & 31) * 2); }
__device__ __forceinline__ void hy_build_k(Frame& F, const bf16* hf, const bf16* hb) {
    LAS unsigned char* lds = F.lds + HY_K_OFF;
#pragma unroll 1
    for (int x = F.tid; x < 2 * SEQ + 4; x += NTHR) {
        unsigned short v = 0;
        if (x >= 1 && x <= SEQ) v = hf[SEQ - x]; else if (x > SEQ && x <= 2 * SEQ - 1) v = hb[x - SEQ];
#pragma unroll
        for (int s = 0; s < 4; ++s) { const int y = x - s; if (y >= 0 && y < 2 * SEQ) *(LAS unsigned short*)(lds + s * HY_KCOPY + 2 * y) = v; }
    }
}
__device__ __forceinline__ void hy_conv(Frame& F, unsigned zoff, pg8::f32x4 (&acc)[4]) {
    typedef short bf16x8 __attribute__((ext_vector_type(8)));
    typedef float f32x16 __attribute__((ext_vector_type(16)));
    const int lane = F.lane, q = F.wave, r = lane & 31, hh = lane >> 5, sg = (4 - (r & 3)) & 3, nn = r >> 1, b = r & 1;
    const int d0 = 16 * q - 127;
    unsigned aaddr = (unsigned)(HY_K_OFF + sg * HY_KCOPY + 2 * (SEQ - 32 * d0 - r + 8 * hh - sg));
    unsigned baddr = zoff + (unsigned)(((16 * q + nn - d0 + 16) * 2 + b) * 80 + 16 * hh);
    f32x16 c;
#pragma unroll
    for (int i = 0; i < 16; ++i) c[i] = 0.f;
#define HY_STEP(AO, BO) do { union { bf16x8 v; v2u h[2]; } a0, a1; \
        a0.h[0] = *(volatile LAS v2u*)(F.lds + aaddr + (AO));      a0.h[1] = *(volatile LAS v2u*)(F.lds + aaddr + (AO) + 8); \
        a1.h[0] = *(volatile LAS v2u*)(F.lds + aaddr + (AO) + 32); a1.h[1] = *(volatile LAS v2u*)(F.lds + aaddr + (AO) + 40); \
        const bf16x8 b0 = *(const LAS bf16x8*)(F.lds + baddr + (BO)), b1 = *(const LAS bf16x8*)(F.lds + baddr + (BO) + 32); \
        c = __builtin_amdgcn_mfma_f32_32x32x16_bf16(a0.v, b0, c, 0, 0, 0); \
        c = __builtin_amdgcn_mfma_f32_32x32x16_bf16(a1.v, b1, c, 0, 0, 0); } while (0)
    HY_STEP(0, 0);
#pragma clang loop unroll(disable)
    for (int it = 0; it < 71; ++it) {
        aaddr -= 128; baddr -= 320;
        asm volatile("" : "+v"(aaddr), "+v"(baddr));
        HY_STEP(64, 160);
        HY_STEP(0, 0);
    }
#undef HY_STEP
#pragma unroll
    for (int g = 0; g < 4; ++g) acc[g] = (pg8::f32x4){c[4 * g], c[4 * g + 1], c[4 * g + 2], c[4 * g + 3]};
}
__device__ __forceinline__ void p3_hyena_mfma(Frame& F) {
    LAS unsigned char* lds = F.lds;
    for (int i = F.tid; i < 2 * HY_ZBYTES / 4; i += NTHR) *(LAS unsigned*)(lds + HY_ZIN_OFF + 4 * i) = 0u;
    const int lane = F.lane, q = F.wave, r = lane & 31, hh = lane >> 5, nn = r >> 1, b = r & 1;
    for (int c = F.bid; c < HW; c += F.G) {
        __syncthreads();
        const float cw[3][3] = {{F.conv_w[c], F.conv_w[3 * HW + c], F.conv_w[6 * HW + c]},
                                {F.conv_w[HW + c], F.conv_w[3 * HW + HW + c], F.conv_w[6 * HW + HW + c]},
                                {F.conv_w[2 * HW + c], F.conv_w[3 * HW + 2 * HW + c], F.conv_w[6 * HW + 2 * HW + c]}};
        const float cb[3] = {F.conv_b[c], F.conv_b[HW + c], F.conv_b[2 * HW + c]};
        const bf16* pv = F.PHY + (size_t)c * T; const bf16* px1 = F.PHY + (size_t)(HW + c) * T; const bf16* px2 = F.PHY + (size_t)(2 * HW + c) * T;
#pragma unroll 2
        for (int i = F.tid; i < T; i += NTHR) { const int bb = i / SEQ, t = i % SEQ;
            *(LAS unsigned short*)(lds + HY_ZIN_OFF + hy_zaddr(bb, t)) = (unsigned short)f2bf(sconv_at(pv + bb * SEQ, t, cw[0][0], cw[0][1], cw[0][2], cb[0]));
            *(LAS unsigned short*)(lds + HY_X1_OFF + 2 * i) = (unsigned short)f2bf(sconv_at(px1 + bb * SEQ, t, cw[1][0], cw[1][1], cw[1][2], cb[1]));
            *(LAS unsigned short*)(lds + HY_X2_OFF + 2 * i) = (unsigned short)f2bf(sconv_at(px2 + bb * SEQ, t, cw[2][0], cw[2][1], cw[2][2], cb[2])); }
        hy_build_k(F, F.KF + (size_t)(0 * HW + c) * SEQ, F.KF + (size_t)(1 * HW + c) * SEQ);
        __syncthreads();
        pg8::f32x4 acc[4];
        hy_conv(F, HY_ZIN_OFF, acc);
        const float sk0 = F.hskip[c], sk1 = F.hskip[HW + c];
        {
            unsigned zb = (unsigned)(((16 * q + nn + 16) * 2 + b) * 80 + 8 * hh), xb = (unsigned)(2 * (b * SEQ + 32 * (16 * q + nn) + 4 * hh));
            asm volatile("" : "+v"(zb), "+v"(xb));
#pragma unroll
            for (int g = 0; g < 4; ++g)
#pragma unroll
                for (int e = 0; e < 4; ++e) { const unsigned o = (unsigned)(16 * g + 2 * e);
                    const float vz = bf2f(*(LAS unsigned short*)(lds + HY_ZIN_OFF + zb + o)), x1 = bf2f(*(LAS unsigned short*)(lds + HY_X1_OFF + xb + o));
                    *(LAS unsigned short*)(lds + HY_ZMID_OFF + zb + o) = (unsigned short)f2bf(x1 * (acc[g][e] + sk0 * vz)); }
        }
        __syncthreads();
        hy_build_k(F, F.KF + (size_t)(2 * HW + c) * SEQ, F.KF + (size_t)(3 * HW + c) * SEQ);
        __syncthreads();
        hy_conv(F, HY_ZMID_OFF, acc);
        {
            unsigned zb = (unsigned)(((16 * q + nn + 16) * 2 + b) * 80 + 8 * hh), xb = (unsigned)(2 * (b * SEQ + 32 * (16 * q + nn) + 4 * hh));
            asm volatile("" : "+v"(zb), "+v"(xb));
            bf16* yp = F.YHY + (size_t)(b * SEQ + 32 * (16 * q + nn) + 4 * hh) * HW + c;
#pragma unroll
            for (int g = 0; g < 4; ++g)
#pragma unroll
                for (int e = 0; e < 4; ++e) { const unsigned o = (unsigned)(16 * g + 2 * e);
                    const float z1 = bf2f(*(LAS unsigned short*)(lds + HY_ZMID_OFF + zb + o)), x2 = bf2f(*(LAS unsigned short*)(lds + HY_X2_OFF + xb + o));
                    yp[(size_t)(8 * g + e) * HW] = (bf16)f2bf(x2 * (acc[g][e] + sk1 * z1)); }
        }
    }
}
__device__ __forceinline__ void p3_attn_naive(Frame& F) {
    LAS float* qs = (LAS float*)F.lds + F.wave * 128;
    const int gw = F.bid * NWAVES + F.wave, NGW = F.G * NWAVES;
    const float scale = 0.08838834764831845f;
    for (int u = gw; u < T * 4; u += NGW) {
        const int m = u >> 2, hh = u & 3, b = m / SEQ, s = m % SEQ;
        float Mrun = -3.0e38f, Lrun = 0.f, o0 = 0.f, o1 = 0.f;
#pragma unroll 1
        for (int g = 0; g < 3; ++g) {
            const int head = g * 4 + hh, dil = (g == 0) ? 1 : (g == 1 ? 4 : 16);
            const bf16* qp = F.QKV + (size_t)m * QKVW + head * HD;
            { const unsigned qq = *(const unsigned*)(qp + 2 * F.lane); qs[2 * F.lane] = bflo(qq); qs[2 * F.lane + 1] = bfhi(qq); }
            asm volatile("s_waitcnt lgkmcnt(0)" ::: "memory");
            float sc[3];
#pragma unroll
            for (int p = 0; p < 3; ++p) {
                const int j = (p == 0) ? F.lane - 64 : (p == 1 ? F.lane : 64);
                const int ks = s + j * dil; const bool valid = (ks >= 0) && (ks < SEQ) && (p < 2 || F.lane == 0);
                float dot = 0.f;
                if (valid) { const v4u* kp = (const v4u*)(F.QKV + (size_t)(b * SEQ + ks) * QKVW + NH * HD + head * HD);
#pragma unroll 4
                    for (int c8 = 0; c8 < 16; ++c8) { const v4u kv = kp[c8]; const LAS float* q8 = qs + 8 * c8;
                        dot += bflo(kv.x) * q8[0] + bfhi(kv.x) * q8[1] + bflo(kv.y) * q8[2] + bfhi(kv.y) * q8[3] + bflo(kv.z) * q8[4] + bfhi(kv.z) * q8[5] + bflo(kv.w) * q8[6] + bfhi(kv.w) * q8[7]; } }
                sc[p] = valid ? dot * scale : -1.0e30f;
            }
            const float mg = wave_max(fmaxf(fmaxf(sc[0], sc[1]), sc[2]));
            const float mnew = fmaxf(Mrun, mg), resc = __expf(Mrun - mnew);
            float pr[3];
#pragma unroll
            for (int p = 0; p < 3; ++p) pr[p] = (sc[p] > -1.0e29f) ? __expf(sc[p] - mnew) : 0.f;
            Lrun = Lrun * resc + wave_sum(pr[0] + pr[1] + pr[2]); o0 *= resc; o1 *= resc; Mrun = mnew;
            const bf16* vbase = F.QKV + 2 * NH * HD + head * HD + 2 * F.lane;
            for (int jj = 0; jj < 129; ++jj) {
                const int j = jj - 64, ks = s + j * dil;
                if (ks < 0 || ks >= SEQ) continue;
                const float pk = (jj < 64) ? __shfl(pr[0], jj) : (jj < 128 ? __shfl(pr[1], jj - 64) : __shfl(pr[2], 0));
                const unsigned vv = *(const unsigned*)(vbase + (size_t)(b * SEQ + ks) * QKVW);
                o0 += pk * bflo(vv); o1 += pk * bfhi(vv);
            }
        }
        const float inv = 1.0f / Lrun;
        *(unsigned*)(F.YAT + (size_t)m * 512 + hh * HD + 2 * F.lane) = pk2(o0 * inv, o1 * inv);
    }
}


constexpr int AT_VPITCH = 320, AT_VBYTES = 32 * AT_VPITCH;
typedef short s16x4 __attribute__((ext_vector_type(4)));
#define AT_TR8(S, VB, R) asm volatile( \
    "ds_read_b64_tr_b16 %0, %8 offset:%9\n\tds_read_b64_tr_b16 %1, %8 offset:%10\n\tds_read_b64_tr_b16 %2, %8 offset:%11\n\tds_read_b64_tr_b16 %3, %8 offset:%12\n\t" \
    "ds_read_b64_tr_b16 %4, %8 offset:%13\n\tds_read_b64_tr_b16 %5, %8 offset:%14\n\tds_read_b64_tr_b16 %6, %8 offset:%15\n\tds_read_b64_tr_b16 %7, %8 offset:%16\n\ts_waitcnt lgkmcnt(0)" \
    : "=&v"(R[0]), "=&v"(R[1]), "=&v"(R[2]), "=&v"(R[3]), "=&v"(R[4]), "=&v"(R[5]), "=&v"(R[6]), "=&v"(R[7]) \
    : "v"(VB), "i"((16 * (S)) * AT_VPITCH), "i"((16 * (S) + 8) * AT_VPITCH), "i"((16 * (S)) * AT_VPITCH + 64), "i"((16 * (S) + 8) * AT_VPITCH + 64), \
      "i"((16 * (S)) * AT_VPITCH + 128), "i"((16 * (S) + 8) * AT_VPITCH + 128), "i"((16 * (S)) * AT_VPITCH + 192), "i"((16 * (S) + 8) * AT_VPITCH + 192) : "memory")
__device__ __forceinline__ void p4_attn_mfma(Frame& F) {
    typedef short bf16x8 __attribute__((ext_vector_type(8)));
    typedef float f32x16 __attribute__((ext_vector_type(16)));
    typedef float f32x2 __attribute__((ext_vector_type(2)));
    typedef __bf16 bf16x2v __attribute__((ext_vector_type(2)));
    const int lane = F.lane, w = F.wave, r31 = lane & 31, hh = lane >> 5;
    LAS unsigned char* vimg = F.lds + w * AT_VBYTES;
    const unsigned vb = (unsigned)(size_t)vimg + (unsigned)((4 * hh + ((lane & 15) >> 2)) * AT_VPITCH + 32 * ((lane >> 4) & 1) + 8 * (lane & 3));
    const int gw = F.bid * NWAVES + w, NGW = F.G * NWAVES;
    const float scale = 0.08838834764831845f;
    bf16* AO = (bf16*)F.YB; float* LSE = (float*)((unsigned char*)F.YB + 32 * MiB);
    for (int u = gw; u < 2 * NH * 128; u += NGW) {
        const int b = u / (NH * 128), rem = u % (NH * 128), head = rem >> 7, blk = rem & 127, g = head >> 2, hs = head & 3;
        const int dl = (g == 0) ? 0 : (g == 1 ? 2 : 4), dil = 1 << dl, res = blk & (dil - 1), q0 = (blk >> dl) * 32, n = SEQ >> dl;
        const size_t tokq = (size_t)(b * SEQ + res + dil * (q0 + r31));
        bf16x8 qf[8];
        { const bf16* qrow = F.QKV + tokq * QKVW + head * HD + 8 * hh;
#pragma unroll
          for (int s = 0; s < 8; ++s) qf[s] = *(const bf16x8*)(qrow + 16 * s); }
        f32x16 o[4];
#pragma unroll
        for (int dt = 0; dt < 4; ++dt)
#pragma unroll
            for (int i = 0; i < 16; ++i) o[dt][i] = 0.f;
        float mrun = -3.0e38f, lrun = 0.f;
#pragma unroll 1
        for (int kt = 0; kt < 5; ++kt) {
            const int kt0 = q0 - 64 + 32 * kt;
            if (kt0 < 0 || kt0 >= n) continue;
            bf16x8 kf[8];
            { const bf16* krow = F.QKV + (size_t)(b * SEQ + res + dil * (kt0 + r31)) * QKVW + NH * HD + head * HD + 8 * hh;
#pragma unroll
              for (int s = 0; s < 8; ++s) kf[s] = *(const bf16x8*)(krow + 16 * s); }
            {
                const bf16* vsrc = F.QKV + (size_t)(b * SEQ + res + dil * (kt0 + (lane >> 4))) * QKVW + 2 * NH * HD + head * HD + (lane & 15) * 8;
                bf16x8 vv[8];
#pragma unroll
                for (int i = 0; i < 8; ++i) vv[i] = *(const bf16x8*)(vsrc + (size_t)(4 * i * dil) * QKVW);
#pragma unroll
                for (int i = 0; i < 8; ++i) *(LAS bf16x8*)(vimg + (4 * i + (lane >> 4)) * AT_VPITCH + (lane & 15) * 16) = vv[i];
            }
            f32x16 sacc;
#pragma unroll
            for (int i = 0; i < 16; ++i) sacc[i] = 0.f;
#pragma unroll
            for (int s = 0; s < 8; ++s) sacc = __builtin_amdgcn_mfma_f32_32x32x16_bf16(kf[s], qf[s], sacc, 0, 0, 0);
            float p[16]; float mx = -3.0e38f;
            const bool edge = (kt == 0) || (kt == 4);
#pragma unroll
            for (int i = 0; i < 16; ++i) { float sv = sacc[i] * scale;
                if (edge) { const int diff = (q0 + r31) - (kt0 + (i & 3) + 8 * (i >> 2) + 4 * hh); if (diff > 64 || diff < -64) sv = -1.0e30f; }
                p[i] = sv; mx = fmaxf(mx, sv); }
            mx = fmaxf(mx, __shfl_xor(mx, 32));
            const float mnew = fmaxf(mrun, mx), resc = __expf(mrun - mnew);
            float ps = 0.f;
#pragma unroll
            for (int i = 0; i < 16; ++i) { p[i] = (p[i] > -1.0e29f) ? __expf(p[i] - mnew) : 0.f; ps += p[i]; }
            ps += __shfl_xor(ps, 32);
            lrun = lrun * resc + ps; mrun = mnew;
#pragma unroll
            for (int dt = 0; dt < 4; ++dt)
#pragma unroll
                for (int i = 0; i < 16; ++i) o[dt][i] *= resc;
            bf16x8 pf[2];
#pragma unroll
            for (int s = 0; s < 2; ++s) { union { bf16x8 v; bf16x2v h[4]; } cv;
#pragma unroll
                for (int j = 0; j < 4; ++j) cv.h[j] = __builtin_convertvector((f32x2){p[8 * s + 2 * j], p[8 * s + 2 * j + 1]}, bf16x2v);
                pf[s] = cv.v; }
            asm volatile("s_waitcnt lgkmcnt(0)" ::: "memory");
            { s16x4 tr[8]; AT_TR8(0, vb, tr);
#pragma unroll
              for (int dt = 0; dt < 4; ++dt) { const bf16x8 va = __builtin_shufflevector(tr[2 * dt], tr[2 * dt + 1], 0, 1, 2, 3, 4, 5, 6, 7); o[dt] = __builtin_amdgcn_mfma_f32_32x32x16_bf16(va, pf[0], o[dt], 0, 0, 0); } }
            { s16x4 tr[8]; AT_TR8(1, vb, tr);
#pragma unroll
              for (int dt = 0; dt < 4; ++dt) { const bf16x8 va = __builtin_shufflevector(tr[2 * dt], tr[2 * dt + 1], 0, 1, 2, 3, 4, 5, 6, 7); o[dt] = __builtin_amdgcn_mfma_f32_32x32x16_bf16(va, pf[1], o[dt], 0, 0, 0); } }
        }
        const float inv = 1.0f / lrun;
        bf16* op = AO + ((size_t)g * T + tokq) * 512 + hs * HD + 4 * hh;
#pragma unroll
        for (int dt = 0; dt < 4; ++dt)
#pragma unroll
            for (int a = 0; a < 4; ++a) { v2u ov; ov.x = pk2(o[dt][4 * a] * inv, o[dt][4 * a + 1] * inv); ov.y = pk2(o[dt][4 * a + 2] * inv, o[dt][4 * a + 3] * inv);
                *(v2u*)(op + 32 * dt + 8 * a) = ov; }
        if (hh == 0) LSE[((size_t)g * T + tokq) * 4 + hs] = mrun + logf(lrun);
    }
}
__device__ __forceinline__ void p4b_combine(Frame& F) {
    const bf16* AO = (const bf16*)F.YB; const float* LSE = (const float*)((const unsigned char*)F.YB + 32 * MiB);
    const int gw = F.bid * NWAVES + F.wave, NGW = F.G * NWAVES, lane = F.lane, hs = lane >> 4;
    for (int m = gw; m < T; m += NGW) {
        float l[3];
#pragma unroll
        for (int g = 0; g < 3; ++g) l[g] = LSE[((size_t)g * T + m) * 4 + hs];
        const float mx = fmaxf(fmaxf(l[0], l[1]), l[2]);
        float wg[3], den = 0.f;
#pragma unroll
        for (int g = 0; g < 3; ++g) { wg[g] = __expf(l[g] - mx); den += wg[g]; }
        const float inv = 1.0f / den;
        float acc[8];
#pragma unroll
        for (int j = 0; j < 8; ++j) acc[j] = 0.f;
#pragma unroll
        for (int g = 0; g < 3; ++g) { const v4u q = *(const v4u*)(AO + ((size_t)g * T + m) * 512 + 8 * lane); const float ww = wg[g] * inv;
            acc[0] += ww * bflo(q.x); acc[1] += ww * bfhi(q.x); acc[2] += ww * bflo(q.y); acc[3] += ww * bfhi(q.y); acc[4] += ww * bflo(q.z); acc[5] += ww * bfhi(q.z); acc[6] += ww * bflo(q.w); acc[7] += ww * bfhi(q.w); }
        v4u ov; ov.x = pk2(acc[0], acc[1]); ov.y = pk2(acc[2], acc[3]); ov.z = pk2(acc[4], acc[5]); ov.w = pk2(acc[6], acc[7]);
        *(v4u*)(F.YAT + (size_t)m * 512 + 8 * lane) = ov;
    }
}
constexpr int RT_MOD_OFF = 0;
constexpr int RT_W_OFF = 3 * D * 4;
constexpr int RT_INFO_OFF = RT_W_OFF + 8 * D * 4;
__device__ __forceinline__ void rt_dot8(const f32x4 (&v)[8], const LAS float* W, int lane, float (&out)[8]) {
#pragma unroll
    for (int n = 0; n < 8; ++n) { float a = 0.f;
#pragma unroll
        for (int j = 0; j < 8; ++j) { const f32x4 w = *(const LAS f32x4*)(W + n * D + 256 * j + 4 * lane); a += (v[j].x * w.x + v[j].y * w.y) + (v[j].z * w.z + v[j].w * w.w); }
        out[n] = wave_sum(a); }
}
template <bool DRY> __device__ __forceinline__ void p6_rows_router(Frame& F) {
    LAS float* L = (LAS float*)F.lds;
    LAS float* gatem = L, *shiftf = L + D, *scalef = L + 2 * D;
    LAS float* Wl = (LAS float*)(F.lds + RT_W_OFF);
    LAS float* info = (LAS float*)(F.lds + RT_INFO_OFF);
    const int lane = F.lane;
    for (int blk = F.bid; blk < T / 32; blk += F.G) {
        const int m0 = blk * 32, b = m0 / SEQ;
        __syncthreads();
        load_mod1(F, gatem, 2, b); load_mod1(F, shiftf, 3, b); load_mod1(F, scalef, 4, b);
        for (int i = F.tid; i < 8 * D / 4; i += NTHR) *(LAS f32x4*)(Wl + 4 * i) = *(const f32x4*)(F.WGT + 4 * i);
        __syncthreads();
#pragma unroll 1
        for (int i = 0; i < 4; ++i) {
            const int rl = 4 * F.wave + i, m = m0 + rl;
            const f32x4* yr = (const f32x4*)(F.Y + (size_t)m * D) + lane; const f32x4* xr = (const f32x4*)(F.x + (size_t)m * D) + lane;
            f32x4 v[8]; float s = 0.f;
#pragma unroll
            for (int j = 0; j < 8; ++j) { v[j] = yr[64 * j]; s += (v[j].x * v[j].x + v[j].y * v[j].y) + (v[j].z * v[j].z + v[j].w * v[j].w); }
            const float rstd = 1.0f / sqrtf(wave_sum(s) * (1.f / D) + RMS_EPS);
            float s1 = 0.f;
            f32x4* x1r = (f32x4*)(F.X1 + (size_t)m * D) + lane;
#pragma unroll
            for (int j = 0; j < 8; ++j) { const int d = 256 * j + 4 * lane;
                const f32x4 g = *(const f32x4*)(F.g_mix_post + d), gm = *(LAS f32x4*)(gatem + d);
                const f32x4 x1 = xr[64 * j] + gm * ((v[j] * rstd) * g);
                x1r[64 * j] = x1; v[j] = x1; s1 += (x1.x * x1.x + x1.y * x1.y) + (x1.z * x1.z + x1.w * x1.w); }
            const float rstd1 = 1.0f / sqrtf(wave_sum(s1) * (1.f / D) + RMS_EPS);
            v2u* o8 = (v2u*)(F.H2 + (size_t)m * D) + lane;
#pragma unroll
            for (int j = 0; j < 8; ++j) { const int d = 256 * j + 4 * lane;
                const f32x4 g = *(const f32x4*)(F.g_ffn_pre + d), sc = *(LAS f32x4*)(scalef + d), sh = *(LAS f32x4*)(shiftf + d);
                f32x4 h = (v[j] * rstd1) * g; h = h * (sc + 1.0f) + sh; v[j] = h;
                v2u w; w.x = pk2(h.x, h.y); w.y = pk2(h.z, h.w); o8[64 * j] = w; }
            float gl[8]; rt_dot8(v, Wl, lane, gl);
            float gmax = -3.0e38f; int gi = 0;
#pragma unroll
            for (int g = 0; g < 8; ++g) { gl[g] += F.b_group[g]; if (gl[g] > gmax) { gmax = gl[g]; gi = g; } }
            float gden = 0.f;
#pragma unroll
            for (int g = 0; g < 8; ++g) gden += expf(gl[g] - gmax);
            if (lane == 0) { info[rl] = rstd1; info[32 + rl] = 1.0f / gden; ((LAS int*)info)[64 + rl] = gi; }
        }
        __syncthreads();
#pragma unroll 1
        for (int g = 0; g < 8; ++g) {
            int cnt = 0;
#pragma unroll 1
            for (int rl = 0; rl < 32; ++rl) cnt += (((LAS int*)info)[64 + rl] == g) ? 1 : 0;
            if (cnt == 0) continue;
            for (int i = F.tid; i < 8 * D / 4; i += NTHR) *(LAS f32x4*)(Wl + 4 * i) = *(const f32x4*)(F.WET + (size_t)g * 8 * D + 4 * i);
            __syncthreads();
            int k = 0;
#pragma unroll 1
            for (int rl = 0; rl < 32; ++rl) {
                if (((LAS int*)info)[64 + rl] != g) continue;
                const bool mine = ((k & 7) == F.wave); ++k;
                if (!mine) continue;
                const int m = m0 + rl; const float rstd1 = info[rl], gval = info[32 + rl];
                const f32x4* x1r = (const f32x4*)(F.X1 + (size_t)m * D) + lane;
                f32x4 v[8];
#pragma unroll
                for (int j = 0; j < 8; ++j) { const int d = 256 * j + 4 * lane;
                    const f32x4 gg = *(const f32x4*)(F.g_ffn_pre + d), sc = *(LAS f32x4*)(scalef + d), sh = *(LAS f32x4*)(shiftf + d);
                    f32x4 h = (x1r[64 * j] * rstd1) * gg; v[j] = h * (sc + 1.0f) + sh; }
                float el[8]; rt_dot8(v, Wl, lane, el);
                float e0v = -3.0e38f, e1v = -3.0e38f; int e0i = 0, e1i = 0;
#pragma unroll
                for (int q = 0; q < 8; ++q) { el[q] += F.b_expert[g * 8 + q];
                    if (el[q] > e0v) { e1v = e0v; e1i = e0i; e0v = el[q]; e0i = q; } else if (el[q] > e1v) { e1v = el[q]; e1i = q; } }
                const float p1 = expf(e1v - e0v), den = 1.0f + p1;
                const float gate0 = gval / den, gate1 = gval * p1 / den;
                if (DRY) { if (gate0 + gate1 == 12345.f) F.LISTG[0] = gate0; }
                if (lane == 0 && !DRY) {
                    const int ex0 = g * 8 + e0i, ex1 = g * 8 + e1i;
                    const unsigned pos0 = atomicAdd(F.ctl + CW_CNT + ex0, 1u), pos1 = atomicAdd(F.ctl + CW_CNT + ex1, 1u);
                    F.LISTT[ex0 * T + pos0] = m; F.LISTG[ex0 * T + pos0] = gate0;
                    F.LISTT[ex1 * T + pos1] = m; F.LISTG[ex1 * T + pos1] = gate1;
                    F.ROUTE[m * 4 + 0] = (unsigned)(ex0 * T) + pos0; F.ROUTE[m * 4 + 1] = (unsigned)(ex1 * T) + pos1;
                }
            }
            __syncthreads();
        }
    }
}

__device__ __forceinline__ void moe_offsets(Frame& F, LAS int* offs  , LAS int* toff  ) {
    if (F.tid < 64) { const int c = (int)__hip_atomic_load(F.ctl + CW_CNT + F.tid, __ATOMIC_RELAXED, __HIP_MEMORY_SCOPE_AGENT); const int tc = (c + 63) / 64; int incl = c, tincl = tc;
#pragma unroll
        for (int o = 1; o < 64; o <<= 1) { const int v = __shfl_up(incl, o), tv = __shfl_up(tincl, o); if (F.tid >= o) { incl += v; tincl += tv; } }
        offs[F.tid] = incl - c; toff[F.tid] = tincl - tc; if (F.tid == 63) { offs[NE] = incl; toff[NE] = tincl; } }
    __syncthreads();
}
__device__ __forceinline__ void p7_moe1(Frame& F) {
    LAS float* L = (LAS float*)F.lds;
    LAS int* offs = (LAS int*)(L + 8192 * 3); LAS int* toff = offs + 80;
    moe_offsets(F, offs, toff);
    const int ntiles = toff[NE];
    for (int u = F.bid; u < ntiles * 8; u += F.G) {
        const int rt = u >> 3, ct = u & 7;
        int e = 0; while (toff[e + 1] <= rt) ++e;
        const int r0 = (rt - toff[e]) * 64, ne = offs[e + 1] - offs[e];
        const int* lt = F.LISTT + e * T + r0;
        const float* W1 = F.w1e + (size_t)e * D * FF + ct * 64; const float* W3 = F.w3e + (size_t)e * D * FF + ct * 64;
        const bf16* H2 = F.H2;
        auto la = [&](int r, int k) -> float { return (r0 + r < ne) ? bf2f(H2[(size_t)lt[r] * D + k]) : 0.f; };
        auto lb = [&](int q, int k, int c) -> float { return (q == 0 ? W1 : W3)[(size_t)k * FF + c]; };
        float* ACT = F.ACT + (size_t)(offs[e] + r0) * FF + ct * 64;
        auto ep = [&](int r, int c, const float (&v)[2]) { if (r0 + r < ne) { const float a = v[0], bb = v[1]; ACT[(size_t)r * FF + c] = (a / (1.0f + __expf(-a))) * bb; } };
        simt_tile<2>(L, D, F.tid, la, lb, ep);
    }
}
__device__ __forceinline__ void p8_moe2(Frame& F) {
    LAS float* L = (LAS float*)F.lds;
    LAS int* offs = (LAS int*)(L + 8192 * 3); LAS int* toff = offs + 80;
    moe_offsets(F, offs, toff);
    const int ntiles = toff[NE];
    for (int u = F.bid; u < ntiles * 32; u += F.G) {
        const int rt = u >> 5, ct = u & 31;
        int e = 0; while (toff[e + 1] <= rt) ++e;
        const int r0 = (rt - toff[e]) * 64, ne = offs[e + 1] - offs[e];
        const float* A = F.ACT + (size_t)(offs[e] + r0) * FF;
        const float* W2 = F.w2e + (size_t)e * FF * D + ct * 64;
        const float* lg = F.LISTG + e * T + r0;
        auto la = [&](int r, int k) -> float { return (r0 + r < ne) ? A[(size_t)r * FF + k] : 0.f; };
        auto lb = [&](int q, int k, int c) -> float { return W2[(size_t)k * D + c]; };
        float* YB = F.YB + (size_t)(offs[e] + r0) * D + ct * 64;
        auto ep = [&](int r, int c, const float (&v)[1]) { if (r0 + r < ne) YB[(size_t)r * D + c] = v[0] * lg[r]; };
        simt_tile<1>(L, FF, F.tid, la, lb, ep);
    }
}

template <int MODE>
__device__ __forceinline__ void moe_mfma(Frame& F) {
    constexpr int K = MODE == 0 ? D : FF, LDW = MODE == 0 ? FF : D, NSL = MODE == 0 ? 8 : 16, NK = K / 32;
    constexpr int RPP = 368, NT = 23, S = 4, WST = 16384, XST = NT * 1024, STB = WST + XST;
    static_assert(S * STB <= MOE_OFFS_OFF, "MoE stage ring vs LDS map");
    typedef short bf16x8 __attribute__((ext_vector_type(8)));
    LAS unsigned char* lds = F.lds;
    LAS int* offs = (LAS int*)(lds + MOE_OFFS_OFF);
    __syncthreads();
    if (F.tid < 64) { const int c = (int)__hip_atomic_load(F.ctl + CW_CNT + F.tid, __ATOMIC_RELAXED, __HIP_MEMORY_SCOPE_AGENT); int incl = c;
#pragma unroll
        for (int o = 1; o < 64; o <<= 1) { const int v = __shfl_up(incl, o); if (F.tid >= o) incl += v; }
        offs[F.tid] = incl - c; if (F.tid == 63) offs[NE] = incl; }
    __syncthreads();
    const int lane = F.lane, w = F.wave, cq = w & 3, rh = w >> 2;
    const int vcu = (F.G % 8 == 0) ? (F.bid % 8) * (F.G / 8) + F.bid / 8 : F.bid;
    for (int u = vcu; u < NE * NSL; u += F.G) {
        const int e = u / NSL, sl = u % NSL;
        const int oe = offs[e], ne = offs[e + 1] - oe;
        if (ne == 0) continue;
        const float* Wm0; const float* Wm1;
        if (MODE == 0) { Wm0 = F.w1e + (size_t)e * D * FF + sl * 64; Wm1 = F.w3e + (size_t)e * D * FF + sl * 64; }
        else { Wm0 = F.w2e + (size_t)e * FF * D + sl * 128; Wm1 = Wm0 + 64; }
        for (int r0 = 0; r0 < ne; r0 += RPP) {
            const int nr = (ne - r0) < RPP ? (ne - r0) : RPP, ntile = (nr + 15) >> 4;
            const char* xsrc[3]; unsigned xdst[3];
#pragma unroll
            for (int i = 0; i < 3; ++i) { int tile = 3 * w + i; if (tile > NT - 1) tile = NT - 1;
                int row = r0 + 16 * tile + (lane >> 2); if (row > ne - 1) row = ne - 1;
                const size_t srow = (MODE == 0) ? (size_t)F.LISTT[e * T + row] : (size_t)(oe + row);
                xsrc[i] = (const char*)(MODE == 0 ? (const void*)F.H2 : (const void*)F.ACTB) + srow * (size_t)(K * 2) + (lane & 3) * 16;
                xdst[i] = (unsigned)(WST + tile * 1024); }
            const char* wsrc[2]; unsigned wdst[2];
#pragma unroll
            for (int i = 0; i < 2; ++i) { const int kr = 8 * (w & 3) + 4 * i;
                wsrc[i] = (const char*)((w >> 2) ? Wm1 : Wm0) + ((size_t)(kr + (lane >> 4)) * LDW) * 4 + (lane & 15) * 16;
                wdst[i] = (unsigned)((w >> 2) * 8192 + kr * 256); }
            asm volatile("s_waitcnt vmcnt(0)" ::: "memory");
#define MOE_ISSUE(stage, ks) do { const unsigned _sb = (unsigned)(stage) * STB; const size_t _kx = (size_t)(ks) * 64, _kw = (size_t)(ks) * 32 * LDW * 4; \
            _Pragma("unroll") for (int _i = 0; _i < 3; ++_i) __builtin_amdgcn_global_load_lds((const unsigned*)(xsrc[_i] + _kx), (LAS unsigned*)(lds + _sb + xdst[_i]), 16, 0, 0); \
            _Pragma("unroll") for (int _i = 0; _i < 2; ++_i) __builtin_amdgcn_global_load_lds((const unsigned*)(wsrc[_i] + _kw), (LAS unsigned*)(lds + _sb + wdst[_i]), 16, 0, 0); } while (0)
            f32x4 acc[2][12];
#pragma unroll
            for (int m = 0; m < 2; ++m)
#pragma unroll
                for (int j = 0; j < 12; ++j) acc[m][j] = (f32x4){0.f, 0.f, 0.f, 0.f};
#pragma unroll
            for (int s = 0; s < S - 1; ++s) MOE_ISSUE(s, s);
            const unsigned wrd = (unsigned)((8 * (lane >> 4)) * 256 + (16 * cq + (lane & 15)) * 4);
            const unsigned xrd = (unsigned)(WST + (lane & 15) * 64 + (lane >> 4) * 16);
#pragma unroll 1
            for (int t = 0; t < NK; ++t) {
                asm volatile("s_waitcnt vmcnt(10)" ::: "memory");
                __builtin_amdgcn_s_barrier();
                asm volatile("" ::: "memory");
                { const int tn = t + S - 1; MOE_ISSUE(tn & (S - 1), tn < NK ? tn : 0); }
                const unsigned sb = (unsigned)(t & (S - 1)) * STB;
                bf16x8 af[2];
#pragma unroll
                for (int m = 0; m < 2; ++m) { float f[8];
#pragma unroll
                    for (int j = 0; j < 8; ++j) f[j] = *(const LAS float*)(lds + sb + m * 8192 + wrd + j * 256);
                    union { bf16x8 v; unsigned u[4]; } cv;
#pragma unroll
                    for (int p = 0; p < 4; ++p) cv.u[p] = pg8::cvt_pk_bf16(f[2 * p], f[2 * p + 1]);
                    af[m] = cv.v; }
#pragma unroll
                for (int jb = 0; jb < 12; jb += 6) { bf16x8 xb[6];
#pragma unroll
                    for (int q = 0; q < 6; ++q) { int tile = 2 * (jb + q) + rh; if (tile > NT - 1) tile = NT - 1; xb[q] = *(const LAS bf16x8*)(lds + sb + xrd + tile * 1024); }
#pragma unroll
                    for (int q = 0; q < 6; ++q) { const int j = jb + q;
                        if (2 * j + rh < ntile) {
                            acc[0][j] = __builtin_amdgcn_mfma_f32_16x16x32_bf16(af[0], xb[q], acc[0][j], 0, 0, 0);
                            acc[1][j] = __builtin_amdgcn_mfma_f32_16x16x32_bf16(af[1], xb[q], acc[1][j], 0, 0, 0); } } }
            }
            asm volatile("s_waitcnt vmcnt(0)" ::: "memory");
            __builtin_amdgcn_s_barrier();
            asm volatile("" ::: "memory");
#undef MOE_ISSUE
#pragma unroll
            for (int j = 0; j < 12; ++j) { const int tile = 2 * j + rh, row = r0 + 16 * tile + (lane & 15);
                if (tile < ntile && row < ne) {
                    if (MODE == 0) { const f32x4 a = acc[0][j], b = acc[1][j]; f32x4 v;
#pragma unroll
                        for (int i = 0; i < 4; ++i) v[i] = (a[i] / (1.0f + __expf(-a[i]))) * b[i];
                        v2u o; o.x = pk2(v[0], v[1]); o.y = pk2(v[2], v[3]);
                        *(v2u*)(F.ACTB + (size_t)(oe + row) * FF + sl * 64 + 16 * cq + 4 * (lane >> 4)) = o; }
                    else { const float g = F.LISTG[e * T + row]; const f32x4 a = acc[0][j] * g, b = acc[1][j] * g;
                        bf16* yp = F.YBB + (size_t)(oe + row) * D + sl * 128 + 16 * cq + 4 * (lane >> 4);
                        v2u o0; o0.x = pk2(a[0], a[1]); o0.y = pk2(a[2], a[3]); *(v2u*)yp = o0;
                        v2u o1; o1.x = pk2(b[0], b[1]); o1.y = pk2(b[2], b[3]); *(v2u*)(yp + 64) = o1; }
                } }
        }
    }
}
__device__ __forceinline__ void p9_final(Frame& F) {
    LAS float* L = (LAS float*)F.lds;
    LAS float* gatef = L;
    LAS int* offs = (LAS int*)(L + 8192 * 3); LAS int* toff = offs + 80;
    load_mod(F, gatef, 5);
    moe_offsets(F, offs, toff);
    const int gw = F.bid * NWAVES + F.wave, NGW = F.G * NWAVES;
    for (int m = gw; m < T; m += NGW) {
        const int b = m / SEQ;
        const unsigned s0 = F.ROUTE[m * 4 + 0], s1 = F.ROUTE[m * 4 + 1];
        const size_t r0 = (size_t)offs[s0 / T] + (s0 % T), r1 = (size_t)offs[s1 / T] + (s1 % T);
        f32x4 v[8]; float s = 0.f;
#if MOE_SIMT
        const f32x4* y0 = (const f32x4*)(F.YB + r0 * D) + F.lane; const f32x4* y1 = (const f32x4*)(F.YB + r1 * D) + F.lane;
#pragma unroll
        for (int j = 0; j < 8; ++j) { v[j] = y0[64 * j] + y1[64 * j]; s += (v[j].x * v[j].x + v[j].y * v[j].y) + (v[j].z * v[j].z + v[j].w * v[j].w); }
#else
        const v2u* y0 = (const v2u*)(F.YBB + r0 * D) + F.lane; const v2u* y1 = (const v2u*)(F.YBB + r1 * D) + F.lane;
#pragma unroll
        for (int j = 0; j < 8; ++j) { const v2u a = y0[64 * j], b2 = y1[64 * j];
            v[j] = (f32x4){bflo(a.x) + bflo(b2.x), bfhi(a.x) + bfhi(b2.x), bflo(a.y) + bflo(b2.y), bfhi(a.y) + bfhi(b2.y)};
            s += (v[j].x * v[j].x + v[j].y * v[j].y) + (v[j].z * v[j].z + v[j].w * v[j].w); }
#endif
        const float rstd = 1.0f / sqrtf(wave_sum(s) * (1.f / D) + RMS_EPS);
        const f32x4* x1r = (const f32x4*)(F.X1 + (size_t)m * D) + F.lane; f32x4* outr = (f32x4*)(F.out + (size_t)m * D) + F.lane;
#pragma unroll
        for (int j = 0; j < 8; ++j) { const int d = 256 * j + 4 * F.lane;
            const f32x4 g = *(const f32x4*)(F.g_ffn_post + d), gf = *(LAS f32x4*)(gatef + b * D + d);
            outr[64 * j] = x1r[64 * j] + gf * ((v[j] * rstd) * g); }
    }
}

#if SIMPLE_GEMM
template <class EP>
__device__ __forceinline__ void simple_gemm(Frame& F, const bf16* A, const bf16* Bt, int M, int N, int K, const EP& ep) {
    LAS float* L = (LAS float*)F.lds;
    const int tn = N / 64, nt = (M / 64) * tn;
    for (int u = F.bid; u < nt; u += F.G) {
        const int r0 = (u / tn) * 64, c0 = (u % tn) * 64;
        auto la = [&](int r, int k) -> float { return bf2f(A[(size_t)(r0 + r) * K + k]); };
        auto lb = [&](int q, int k, int c) -> float { return bf2f(Bt[(size_t)(c0 + c) * K + k]); };
        auto e2 = [&](int r, int c, const float (&v)[1]) { ep(r0 + r, c0 + c, v[0]); };
        simt_tile<1>(L, K, F.tid, la, lb, e2);
    }
}
#endif

#ifndef REPEAT_MASK
#define REPEAT_MASK 0
#endif
__device__ __forceinline__ void phase_gemm2(Frame& F) {
#if SIMPLE_GEMM
        { bf16* PHY = F.PHY; simple_gemm(F, F.W1T, F.H, 3 * HW, T, D, [&](int r, int c, float v) { PHY[(size_t)r * T + c] = (bf16)f2bf(v); }); }
        __syncthreads();
        { bf16* QKVp = F.QKV; bf16* Gp = F.GT; const float* bias = F.b_bg;
          simple_gemm(F, F.H, F.W1T + (size_t)(3 * HW) * D, T, QKVW + 2 * D, D, [&](int r, int c, float v) {
              if (c < QKVW) QKVp[(size_t)r * QKVW + c] = (bf16)f2bf(v); else Gp[(size_t)r * (2 * D) + (c - QKVW)] = (bf16)f2bf(1.0f / (1.0f + __expf(-(v + bias[c - QKVW])))); }); }
#else
        { EpiPlainBf16 E{F.PHY, T}; run_gemm(F, F.W1T, F.H, 3 * HW, T, D, E); }
        { EpiProj E{F.QKV, F.GT, F.ROT, F.b_bg}; run_gemm(F, F.H, F.W1T + (size_t)(3 * HW) * D, T, QKVW + 2 * D, D, E); }
#endif
}
__device__ __forceinline__ void phase_gemm6(Frame& F) {
#if SIMPLE_GEMM
        { float* TMP = F.TMP; const bf16* G = F.GT; simple_gemm(F, F.YHY, F.WHYOT, T, D, HW, [&](int r, int c, float v) { TMP[(size_t)r * D + c] = v * bf2f(G[(size_t)r * (2 * D) + c]); }); }
        __syncthreads();
        { float* TMP = F.TMP; const bf16* G = F.GT; bf16* Mp = F.MERGED; simple_gemm(F, F.YAT, F.WATOT, T, D, 512, [&](int r, int c, float v) { Mp[(size_t)r * D + c] = (bf16)f2bf(TMP[(size_t)r * D + c] + v * bf2f(G[(size_t)r * (2 * D) + D + c])); }); }
#else
        { EpiGate<0> E{F.GT, 0, F.TMP, F.MERGED}; run_gemm(F, F.YHY, F.WHYOT, T, D, HW, E); }
        { EpiGate<1> E{F.GT, D, F.TMP, F.MERGED}; run_gemm(F, F.YAT, F.WATOT, T, D, 512, E); }
#endif
}
__device__ __forceinline__ void phase_gemm7(Frame& F) {
#if SIMPLE_GEMM
        { float* Y = F.Y; simple_gemm(F, F.MERGED, F.WOUTT, T, D, D, [&](int r, int c, float v) { Y[(size_t)r * D + c] = v; }); }
#else
        { EpiF32 E{F.Y, D}; run_gemm(F, F.MERGED, F.WOUTT, T, D, D, E); }
#endif
}
__global__ void __launch_bounds__(NTHR, 2) fwd_kernel(Args args) {
    extern __shared__ __attribute__((aligned(16))) unsigned char lds_raw[];
    Frame F;
    F.lds = (LAS unsigned char*)lds_raw;
    F.tid = threadIdx.x; F.lane = F.tid & 63; F.wave = __builtin_amdgcn_readfirstlane(F.tid >> 6); F.G = gridDim.x; F.bid = blockIdx.x;
    F.x = (const float*)args.in[0]; F.c = (const float*)args.in[1]; F.positions = (const int*)args.in[2]; F.w_ada = (const float*)args.in[3]; F.b_ada = (const float*)args.in[4];
    F.g_mix_pre = (const float*)args.in[5]; F.g_mix_post = (const float*)args.in[6]; F.g_ffn_pre = (const float*)args.in[7]; F.g_ffn_post = (const float*)args.in[8];
    F.w_in = (const float*)args.in[9]; F.conv_w = (const float*)args.in[10]; F.conv_b = (const float*)args.in[11]; F.fw1 = (const float*)args.in[12]; F.fb1 = (const float*)args.in[13];
    F.fw2 = (const float*)args.in[14]; F.fb2 = (const float*)args.in[15]; F.fw3 = (const float*)args.in[16]; F.ffreq = (const float*)args.in[17]; F.hskip = (const float*)args.in[18];
    F.w_bg = (const float*)args.in[19]; F.b_bg = (const float*)args.in[20]; F.w_hy_o = (const float*)args.in[21]; F.w_at_o = (const float*)args.in[22]; F.w_out = (const float*)args.in[23];
    F.w_group = (const float*)args.in[24]; F.b_group = (const float*)args.in[25]; F.w_expert = (const float*)args.in[26]; F.b_expert = (const float*)args.in[27];
    F.w1e = (const float*)args.in[28]; F.w3e = (const float*)args.in[29]; F.w2e = (const float*)args.in[30];
    F.out = args.out;
    unsigned char* ws = args.ws;
    F.ctl = (unsigned*)(ws + WS_CTL); F.MODP = (float*)(ws + WS_MODP); F.HID2 = (float*)(ws + WS_HID2); F.ROT = (float*)(ws + WS_ROT); F.W3T = (float*)(ws + WS_W3T);
    F.WGT = (float*)(ws + WS_WGT); F.WET = (float*)(ws + WS_WET); F.HID2B = (bf16*)(ws + WS_HID2B); F.W3TB = (bf16*)(ws + WS_W3TB);
    F.ROUTE = (unsigned*)(ws + WS_ROUTE); F.LISTT = (int*)(ws + WS_LISTT); F.LISTG = (float*)(ws + WS_LISTG);
    F.W1T = (bf16*)(ws + WS_W1T); F.WHYOT = (bf16*)(ws + WS_WHYOT); F.WATOT = (bf16*)(ws + WS_WATOT); F.WOUTT = (bf16*)(ws + WS_WOUTT);
    F.KF = (bf16*)(ws + WS_KF); F.H = (bf16*)(ws + WS_H); F.PHY = (bf16*)(ws + WS_PHY); F.QKV = (bf16*)(ws + WS_QKV); F.GT = (bf16*)(ws + WS_G);
    F.YHY = (bf16*)(ws + WS_YHY); F.YAT = (bf16*)(ws + WS_YAT); F.TMP = (float*)(ws + WS_TMP); F.MERGED = (bf16*)(ws + WS_MERGED); F.Y = (float*)(ws + WS_Y);
    F.X1 = (float*)(ws + WS_X1); F.H2 = (bf16*)(ws + WS_H2); F.ACT = (float*)(ws + WS_ACT); F.YB = (float*)(ws + WS_YB); F.ACTB = (bf16*)(ws + WS_ACT); F.YBB = (bf16*)(ws + WS_YB);

    volatile LAS unsigned* MISC = (volatile LAS unsigned*)(F.lds + MISC_OFF);
    if (F.tid < 32) MISC[F.tid] = 0u;
    __syncthreads();
    const int lo = args.ph_lo, hi = args.ph_hi;
    const bool multi = (hi - lo) > 1;
    XcdBarrier bar; bar.bar = F.ctl + CW_BAR; bar.x = 0; bar.st = nullptr;
    if (multi) bar = xcd_barrier_post(F.ctl + CW_BAR, MISC + 8);
#ifndef PHASE_MASK
#define PHASE_MASK 0xFFFF
#endif
#define IN(k) ((((PHASE_MASK) >> (k)) & 1) && lo <= (k) && (k) < hi)
#ifndef REPEAT_MASK
#define REPEAT_MASK 0
#endif
#define REP(k) for (int _rep = 0; _rep < 1 + (((REPEAT_MASK) >> (k)) & 1); ++_rep)
#define SEAM(k) do { if (IN(k) && IN((k) + 1)) xcd_barrier(bar); } while (0)

    if (IN(0)) REP(0) { __syncthreads(); p0_prologue(F); } SEAM(0);
    if (IN(1)) REP(1) { __syncthreads(); p1_rows_filters(F); } SEAM(1);
    if (IN(2)) { phase_gemm2(F); if (((REPEAT_MASK) >> 2) & 1) { __syncthreads(); phase_gemm2(F); } } SEAM(2);
    if (IN(3)) {
#if SIMPLE_GEMM
        for (int i = F.bid * NTHR + F.tid; i < T * 24 * 16; i += F.G * NTHR) { const int k = i & 15, hd = (i >> 4) % 24, tok = (i >> 4) / 24;
            bf16* p = F.QKV + (size_t)tok * QKVW + hd * HD; const float a = bf2f(p[k]), b2 = bf2f(p[k + 16]), cs = F.ROT[tok * 32 + k], sn = F.ROT[tok * 32 + 16 + k];
            p[k] = (bf16)f2bf(a * cs - b2 * sn); p[k + 16] = (bf16)f2bf(b2 * cs + a * sn); }
#endif
    }
#if SIMPLE_GEMM
    SEAM(3);
#endif
#if HYENA_NAIVE
    if (IN(4)) { p3_hyena_naive(F); __syncthreads(); p3_attn_naive(F); } SEAM(4);
#elif ATTN_NAIVE
    if (IN(4)) { p3_hyena_mfma(F); __syncthreads(); p3_attn_naive(F); } SEAM(4);
#else
#ifndef P4_PARTS
#define P4_PARTS 3
#endif
    if (IN(4)) REP(4) { __syncthreads(); if (P4_PARTS & 1) p3_hyena_mfma(F); __syncthreads(); if (P4_PARTS & 2) p4_attn_mfma(F); } SEAM(4);
    if (IN(5)) REP(5) { p4b_combine(F); } SEAM(5);
#endif
    if (IN(6)) { phase_gemm6(F); if (((REPEAT_MASK) >> 6) & 1) { __syncthreads(); phase_gemm6(F); } } SEAM(6);
    if (IN(7)) { phase_gemm7(F); if (((REPEAT_MASK) >> 7) & 1) { __syncthreads(); phase_gemm7(F); } } SEAM(7);
#ifndef EXTRA_BARRIERS
#define EXTRA_BARRIERS 0
#endif
    if (IN(8)) { if (((REPEAT_MASK) >> 8) & 1) { p6_rows_router<true>(F); __syncthreads(); } for (int _e = 0; _e < EXTRA_BARRIERS; ++_e) xcd_barrier(bar); p6_rows_router<false>(F); } SEAM(8);
#if MOE_SIMT
    if (IN(9)) { p7_moe1(F); } SEAM(9);
    if (IN(10)) { p8_moe2(F); } SEAM(10);
#else
    if (IN(9)) REP(9) { moe_mfma<0>(F); } SEAM(9);
    if (IN(10)) REP(10) { moe_mfma<1>(F); } SEAM(10);
#endif
    if (IN(11)) REP(11) { __syncthreads(); p9_final(F); }
#undef IN
#undef SEAM
}

extern "C" void kernel_launch(void* const* d_in, const int* in_sizes, int n_in, void* d_out, int out_size, void* d_ws, size_t ws_size, hipStream_t stream) {
    static int grid = 0;
    if (grid == 0) {
        if (n_in != 31 || out_size != T * D || ws_size < WS_END) { fprintf(stderr, "kernel_launch: unexpected shapes (n_in %d out %d ws %zu)\n", n_in, out_size, ws_size); grid = -1; return; }
        int dev = 0, cus = 0, per_cu = 0;
        if (hipGetDevice(&dev) != hipSuccess || hipDeviceGetAttribute(&cus, hipDeviceAttributeMultiprocessorCount, dev) != hipSuccess) { grid = -1; return; }
        if (hipFuncSetAttribute((const void*)fwd_kernel, hipFuncAttributeMaxDynamicSharedMemorySize, LDS_BYTES) != hipSuccess) { fprintf(stderr, "kernel_launch: hipFuncSetAttribute failed\n"); grid = -1; return; }
        if (hipOccupancyMaxActiveBlocksPerMultiprocessor(&per_cu, (const void*)fwd_kernel, NTHR, LDS_BYTES) != hipSuccess || per_cu < 1) fprintf(stderr, "kernel_launch: occupancy query says %d\n", per_cu);
        (void)hipGetLastError();
        grid = cus;
    }
    if (grid < 0) return;
    if (hipMemsetAsync((char*)d_ws + WS_CTL, 0, CTL_ZERO_BYTES, stream) != hipSuccess) return;
    Args a{};
    for (int i = 0; i < 31; ++i) a.in[i] = d_in[i];
    a.out = (float*)d_out; a.ws = (unsigned char*)d_ws;
#if N_LAUNCH_MODE == 1
    a.ph_lo = 0; a.ph_hi = NPHASE;
    hipLaunchKernelGGL(fwd_kernel, dim3(grid), dim3(NTHR), LDS_BYTES, stream, a);
#else
    for (int p = 0; p < NPHASE; ++p) { if (p == 3 && !SIMPLE_GEMM) continue; if (p == 5 && (HYENA_NAIVE || ATTN_NAIVE)) continue; a.ph_lo = p; a.ph_hi = p + 1; hipLaunchKernelGGL(fwd_kernel, dim3(grid), dim3(NTHR), LDS_BYTES, stream, a); }
#endif
}
```

```cpp
#include <hip/hip_runtime.h>
#include <cstdio>
#include <cstdint>
namespace pg8 {
#define PG8_LAS __attribute__((address_space(3)))
typedef unsigned short bf16_t;
typedef short bf16x8 __attribute__((ext_vector_type(8)));
typedef float f32x4 __attribute__((ext_vector_type(4)));
typedef unsigned u32x4 __attribute__((ext_vector_type(4)));
constexpr int BM = 256, BK = 64, HALF = 128, HTB = HALF * BK * 2  , STAGE_BYTES = 8 * HTB, NXCD = 8, WGM = 8;

__host__ __device__ __forceinline__ int lds_byte(int r, int c) { const int st = (r >> 4) * 2 + (c >> 5), rr = r & 15, cc = c & 31, ob = rr * 64 + cc * 2; return st * 1024 + (ob ^ (((ob >> 9) & 1) << 5)); }
__host__ __device__ __forceinline__ void stage_rc(int b, int& R, int& C) { const int st = b / 1024, sb = b % 1024, swz = sb ^ (((sb >> 9) & 1) << 5); R = (st >> 1) * 16 + swz / 64; C = (st & 1) * 32 + (swz % 64) / 2; }
__host__ __device__ __forceinline__ int perm32(int rho) { const int n = rho >> 4, i = rho & 15; return 8 * (i >> 2) + 4 * n + (i & 3); }

struct Unit { int pm, pn, kind; };
struct Gemm { const bf16_t* A; const bf16_t* Bt; int M, N, K; };

struct StaticOrder {
    int nM, nN, nwg, G, c;
    __host__ __device__ void init(int M, int N, int G_, int c_) { nM = M / BM; nN = N / BM; nwg = nM * nN; G = G_; c = c_; }
    __host__ __device__ bool next(int i, Unit& u) const {
        const long L = (long)i * G + c; if (L >= nwg) return false;
        int wgid = (int)L; { const int q = nwg / NXCD, r = nwg % NXCD, xcd = wgid % NXCD, off = wgid / NXCD; wgid = (xcd < r ? xcd * (q + 1) : r * (q + 1) + (xcd - r) * q) + off; }
        const int nig = WGM * nN, gid = wgid / nig, fm = gid * WGM, gsz = (nM - fm) < WGM ? (nM - fm) : WGM;
        u.pm = fm + ((wgid % nig) % gsz); u.pn = (wgid % nig) / gsz; u.kind = 0; return true;
    }
    __device__ __forceinline__ void a_ready(const Unit&) const {}
    __device__ __forceinline__ void done(const Unit&) const {}
    __device__ __forceinline__ const bf16_t* abase(const Gemm& g, const Unit&) const { return g.A; }
    __device__ __forceinline__ const bf16_t* bbase(const Gemm& g, const Unit&) const { return g.Bt; }
};

__device__ __forceinline__ unsigned cvt_pk_bf16(float lo, float hi) { unsigned r; asm volatile("v_cvt_pk_bf16_f32 %0, %1, %2" : "=v"(r) : "v"(lo), "v"(hi)); return r; }
typedef float f32x2 __attribute__((ext_vector_type(2)));
template <class Epi, class Sched, bool ALIGN_EPI = false, bool SP2 = false>
__device__ __forceinline__ void gemm_phase(PG8_LAS unsigned char* lds, const Gemm g, const Sched& S, const Epi& E) {
    const int tid = threadIdx.x, wid = __builtin_amdgcn_readfirstlane(tid >> 6), lane = tid & 63, wr = wid >> 2, wc = wid & 3, fr = lane & 15, fq = lane >> 4;
    const int K = g.K, nt = K / BK;
    unsigned voffA[2], voffB[2];
#pragma unroll
    for (int i = 0; i < 2; ++i) { int R, C; stage_rc(tid * 16 + i * 8192, R, C); const int Rb = Epi::PERM ? ((R & ~31) + perm32(R & 31)) : R;
        voffA[i] = (unsigned)(R * K + C) * 2u; voffB[i] = (unsigned)(Rb * K + C) * 2u; }
    const size_t kstep = (size_t)(BK * 2);
    const size_t hstep = (size_t)HALF * K * 2;
    const size_t tstep = 2 * hstep;
    const unsigned ldsw = (unsigned)wid * 1024u;
    const int aoff = lds_byte(wr * 64 + fr, fq * 8), boff = lds_byte(wc * 32 + fr, fq * 8);
#define PG8_SA(b, h) (((b) * 2 + (h)) * HTB)
#define PG8_SB(b, h) ((4 + (b) * 2 + (h)) * HTB)
#define PG8_STAGE(bufoff, gbase, voff) do { _Pragma("unroll") for (int _i = 0; _i < 2; ++_i) \
        __builtin_amdgcn_global_load_lds((const unsigned*)((const char*)(gbase) + (voff)[_i]), (PG8_LAS unsigned*)(lds + (bufoff) + ldsw + _i * 8192), 16, 0, 0); } while (0)
#define PG8_LDA(dst, b, h) do { _Pragma("unroll") for (int m = 0; m < 4; ++m) _Pragma("unroll") for (int k = 0; k < 2; ++k) dst[m][k] = *(const PG8_LAS bf16x8*)(lds + PG8_SA(b, h) + aoff + m * 2048 + k * 1024); } while (0)
#define PG8_LDB(dst, b, h) do { _Pragma("unroll") for (int n = 0; n < 2; ++n) _Pragma("unroll") for (int k = 0; k < 2; ++k) dst[n][k] = *(const PG8_LAS bf16x8*)(lds + PG8_SB(b, h) + boff + n * 2048 + k * 1024); } while (0)
#define PG8_MMA(ai, bj, At, Bt) do { __builtin_amdgcn_s_setprio(1); _Pragma("unroll") for (int m = 0; m < 4; ++m) _Pragma("unroll") for (int n = 0; n < 2; ++n) _Pragma("unroll") for (int k = 0; k < 2; ++k) \
        acc[ai][bj][m][n] = __builtin_amdgcn_mfma_f32_16x16x32_bf16(Bt[n][k], At[m][k], acc[ai][bj][m][n], 0, 0, 0); __builtin_amdgcn_s_setprio(0); } while (0)
#define PG8_WAIT_V(n) asm volatile("s_waitcnt vmcnt(" #n ")" ::: "memory")
#define PG8_WAIT_L(n) asm volatile("s_waitcnt lgkmcnt(" #n ")" ::: "memory")
#define PG8_BAR __builtin_amdgcn_s_barrier()
#define PG8_SCHED __builtin_amdgcn_sched_barrier(0)
    Unit cur, nxt; int ui = 0;
    if (!S.next(0, cur)) return;
    f32x4 acc[2][2][4][2];
#pragma unroll
    for (int a = 0; a < 2; ++a)
#pragma unroll
        for (int b = 0; b < 2; ++b)
#pragma unroll
            for (int m = 0; m < 4; ++m)
#pragma unroll
                for (int n = 0; n < 2; ++n) acc[a][b][m][n] = (f32x4){0.f, 0.f, 0.f, 0.f};
    bf16x8 At[4][2], B0[2][2], B1[2][2];
    const char* cA = (const char*)S.abase(g, cur) + (size_t)cur.pm * tstep; const char* cB = (const char*)S.bbase(g, cur) + (size_t)cur.pn * tstep;
    S.a_ready(cur);
    if constexpr (SP2) {
        PG8_STAGE(PG8_SB(0, 0), cB, voffB); PG8_STAGE(PG8_SB(0, 1), cB + hstep, voffB); PG8_STAGE(PG8_SA(0, 0), cA, voffA); PG8_STAGE(PG8_SA(0, 1), cA + hstep, voffA);
        if (wr == 1) PG8_BAR;
        PG8_WAIT_V(2); PG8_BAR;
        PG8_STAGE(PG8_SB(1, 0), cB + kstep, voffB); PG8_STAGE(PG8_SA(1, 0), cA + kstep, voffA); PG8_STAGE(PG8_SB(1, 1), cB + hstep + kstep, voffB);
        PG8_WAIT_V(6); PG8_BAR;
    } else {
        PG8_STAGE(PG8_SB(0, 0), cB, voffB); PG8_STAGE(PG8_SA(0, 0), cA, voffA); PG8_STAGE(PG8_SB(0, 1), cB + hstep, voffB); PG8_STAGE(PG8_SA(0, 1), cA + hstep, voffA);
        if (wr == 1) PG8_BAR;
        PG8_WAIT_V(4); PG8_BAR;
        PG8_STAGE(PG8_SB(1, 0), cB + kstep, voffB); PG8_STAGE(PG8_SA(1, 0), cA + kstep, voffA); PG8_STAGE(PG8_SB(1, 1), cB + hstep + kstep, voffB);
        PG8_WAIT_V(6); PG8_BAR;
    }
    for (;;) {
        const bool has_next = S.next(ui + 1, nxt);
        const char* nA = has_next ? (const char*)S.abase(g, nxt) + (size_t)nxt.pm * tstep : cA; const char* nB = has_next ? (const char*)S.bbase(g, nxt) + (size_t)nxt.pn * tstep : cB;
        asm volatile(".p2align 8" ::: "memory");
        for (int t = 0; t < nt; t += 2) {
            const bool last = (t == nt - 2);
            const char* a1 = cA + (size_t)(t + 1) * kstep;
            const char* a2 = last ? nA : cA + (size_t)(t + 2) * kstep; const char* b2 = last ? nB : cB + (size_t)(t + 2) * kstep;
            const char* a3 = a2 + kstep; const char* b3 = b2 + kstep;
            if (last && has_next) S.a_ready(nxt);
            if constexpr (SP2) {
            PG8_LDB(B0, 0, 0); PG8_LDB(B1, 0, 1); PG8_SCHED; PG8_LDA(At, 0, 0); PG8_STAGE(PG8_SA(1, 1), a1 + hstep, voffA);
            PG8_WAIT_V(8); PG8_WAIT_L(0); PG8_BAR; PG8_MMA(0, 0, At, B0); PG8_MMA(0, 1, At, B1); PG8_BAR; PG8_SCHED;
            PG8_LDA(At, 0, 1); PG8_STAGE(PG8_SB(0, 0), b2, voffB); PG8_STAGE(PG8_SB(0, 1), b2 + hstep, voffB); PG8_STAGE(PG8_SA(0, 0), a2, voffA);
            PG8_WAIT_V(8); PG8_WAIT_L(0); PG8_BAR; PG8_MMA(1, 0, At, B0); PG8_MMA(1, 1, At, B1); PG8_BAR; PG8_SCHED;
            PG8_LDB(B0, 1, 0); PG8_LDB(B1, 1, 1); PG8_SCHED; PG8_LDA(At, 1, 0); PG8_STAGE(PG8_SA(0, 1), a2 + hstep, voffA);
            PG8_WAIT_V(8); PG8_WAIT_L(0); PG8_BAR; PG8_MMA(0, 0, At, B0); PG8_MMA(0, 1, At, B1); PG8_BAR; PG8_SCHED;
            PG8_LDA(At, 1, 1); PG8_STAGE(PG8_SB(1, 0), b3, voffB); PG8_STAGE(PG8_SB(1, 1), b3 + hstep, voffB); PG8_STAGE(PG8_SA(1, 0), a3, voffA);
            PG8_WAIT_V(8); PG8_WAIT_L(0); PG8_BAR; PG8_MMA(1, 0, At, B0); PG8_MMA(1, 1, At, B1); PG8_BAR; PG8_SCHED;
            } else {
            PG8_LDB(B0, 0, 0); PG8_SCHED; PG8_LDA(At, 0, 0); PG8_STAGE(PG8_SA(1, 1), a1 + hstep, voffA);
            PG8_WAIT_L(8); PG8_BAR; PG8_WAIT_L(0); PG8_MMA(0, 0, At, B0); PG8_BAR; PG8_SCHED;
            PG8_LDB(B1, 0, 1); PG8_STAGE(PG8_SB(0, 0), b2, voffB);
            PG8_BAR; PG8_WAIT_L(0); PG8_MMA(0, 1, At, B1); PG8_BAR;
            PG8_LDA(At, 0, 1); PG8_STAGE(PG8_SA(0, 0), a2, voffA);
            PG8_BAR; PG8_WAIT_L(0); PG8_MMA(1, 0, At, B0); PG8_BAR; PG8_SCHED;
            PG8_STAGE(PG8_SB(0, 1), b2 + hstep, voffB);
            PG8_WAIT_V(6); PG8_BAR; PG8_MMA(1, 1, At, B1); PG8_BAR;
            PG8_LDB(B0, 1, 0); PG8_SCHED; PG8_LDA(At, 1, 0); PG8_STAGE(PG8_SA(0, 1), a2 + hstep, voffA);
            PG8_WAIT_L(8); PG8_BAR; PG8_WAIT_L(0); PG8_MMA(0, 0, At, B0); PG8_BAR; PG8_SCHED;
            PG8_LDB(B1, 1, 1); PG8_STAGE(PG8_SB(1, 0), b3, voffB);
            PG8_BAR; PG8_WAIT_L(0); PG8_MMA(0, 1, At, B1); PG8_BAR;
            PG8_LDA(At, 1, 1); PG8_STAGE(PG8_SA(1, 0), a3, voffA);
            PG8_BAR; PG8_WAIT_L(0); PG8_MMA(1, 0, At, B0); PG8_BAR; PG8_SCHED;
            PG8_STAGE(PG8_SB(1, 1), b3 + hstep, voffB);
            PG8_WAIT_V(6); PG8_BAR; PG8_MMA(1, 1, At, B1); PG8_BAR;
            }
        }
        if constexpr (ALIGN_EPI) { if (wr == 0) PG8_BAR; }
        if constexpr (!Epi::AFTER_DRAIN) { E(acc, cur, wr, wc, fr, fq); S.done(cur); }
        if (!has_next) break;
#pragma unroll
        for (int a = 0; a < 2; ++a)
#pragma unroll
            for (int b = 0; b < 2; ++b)
#pragma unroll
                for (int m = 0; m < 4; ++m)
#pragma unroll
                    for (int n = 0; n < 2; ++n) acc[a][b][m][n] = (f32x4){0.f, 0.f, 0.f, 0.f};
        cur = nxt; cA = nA; cB = nB; ++ui;
        if constexpr (ALIGN_EPI) { if (wr == 1) PG8_BAR; }
    }
    PG8_WAIT_V(0);
    if constexpr (!ALIGN_EPI) { if (wr == 0) PG8_BAR; }
    PG8_BAR;
    if constexpr (Epi::AFTER_DRAIN) { E.fused(acc, cur, wr, wc, fr, fq, lds, wid, lane); S.done(cur); }
#undef PG8_SA
#undef PG8_SB
#undef PG8_STAGE
#undef PG8_LDA
#undef PG8_LDB
#undef PG8_MMA
#undef PG8_WAIT_V
#undef PG8_WAIT_L
#undef PG8_BAR
#undef PG8_SCHED
}
}


#ifndef N_LAUNCH_MODE
#define N_LAUNCH_MODE 1
#endif
#ifndef MOE_SIMT
#define MOE_SIMT 0
#endif
#ifndef HYENA_NAIVE
#define HYENA_NAIVE 0
#endif
#ifndef ATTN_NAIVE
#define ATTN_NAIVE 0
#endif
#ifndef TLB_TOUCH
#define TLB_TOUCH 0
#endif
#ifndef DUAL_BIG_FIRST
#define DUAL_BIG_FIRST 1
#endif
#ifndef MOE_S
#define MOE_S 4
#endif
#ifndef HY_REP
#define HY_REP 0
#endif
#ifndef ATTN_REP
#define ATTN_REP 0
#endif
#ifndef SIMPLE_GEMM
#define SIMPLE_GEMM 0
#endif

constexpr int D = 2048, BATCH = 2, SEQ = 4096, T = BATCH * SEQ;
constexpr int HW = 1024;
constexpr int NH = 12, HD = 128, QKVW = 3 * NH * HD;
constexpr int INW = 3 * HW + QKVW;
constexpr int N1 = INW + 2 * D;
constexpr int NE = 64, FF = 512;
constexpr float RMS_EPS = 1e-6f;
constexpr int NWAVES = 8, NTHR = 512;
constexpr int NPHASE = 12;

constexpr size_t MiB = 1u << 20;
constexpr size_t WS_CTL = 0, CTL_ZERO_BYTES = 128 * 1024;
constexpr size_t WS_MODP = 1 * MiB;
constexpr size_t WS_HID2 = 2 * MiB;
constexpr size_t WS_ROT = 3 * MiB;
constexpr size_t WS_W3T = 4 * MiB;
constexpr size_t WS_ROUTE = 5 * MiB;
constexpr size_t WS_LISTT = 6 * MiB;
constexpr size_t WS_LISTG = 8 * MiB;
constexpr size_t WS_WGT = 10 * MiB;
constexpr size_t WS_WET = 11 * MiB;
constexpr size_t WS_HID2B = 12 * MiB;
constexpr size_t WS_W3TB = 13 * MiB;
constexpr size_t WS_W1T = 16 * MiB;
constexpr size_t WS_WHYOT = 64 * MiB;
constexpr size_t WS_WATOT = 68 * MiB;
constexpr size_t WS_WOUTT = 70 * MiB;
constexpr size_t WS_KF = 80 * MiB;
constexpr size_t WS_H = 144 * MiB;
constexpr size_t WS_PHY = 176 * MiB;
constexpr size_t WS_QKV = 224 * MiB;
constexpr size_t WS_G = 296 * MiB;
constexpr size_t WS_YHY = 360 * MiB;
constexpr size_t WS_YAT = 376 * MiB;
constexpr size_t WS_TMP = 384 * MiB;
constexpr size_t WS_MERGED = 448 * MiB;
constexpr size_t WS_Y = 480 * MiB;
constexpr size_t WS_X1 = 544 * MiB;
constexpr size_t WS_H2 = 608 * MiB;
constexpr size_t WS_ACT = 640 * MiB;
constexpr size_t WS_YB = 672 * MiB;
constexpr size_t WS_END = 800 * MiB;
constexpr int CW_BAR = 4096;
constexpr int CW_CNT = 16384;

constexpr int RING_BYTES = 131072;
constexpr int LDS_BYTES = 163840;
constexpr int MISC_OFF = LDS_BYTES - 256;
constexpr int MOE_OFFS_OFF = LDS_BYTES - 1024;

#define GAS __attribute__((address_space(1)))
#define LAS __attribute__((address_space(3)))
typedef unsigned short bf16;
typedef unsigned v4u __attribute__((ext_vector_type(4)));
typedef unsigned v2u __attribute__((ext_vector_type(2)));
typedef float f32x4 __attribute__((ext_vector_type(4)));
typedef LAS float lfloat;

__device__ __forceinline__ unsigned f2bf(float f) { unsigned u = __builtin_bit_cast(unsigned, f); return (u + 0x7fffu + ((u >> 16) & 1u)) >> 16; }
__device__ __forceinline__ unsigned pk2(float lo, float hi) { return f2bf(lo) | (f2bf(hi) << 16); }
__device__ __forceinline__ float bf2f(unsigned short b) { return __builtin_bit_cast(float, ((unsigned)b) << 16); }
__device__ __forceinline__ float bflo(unsigned w) { return __builtin_bit_cast(float, w << 16); }
__device__ __forceinline__ float bfhi(unsigned w) { return __builtin_bit_cast(float, w & 0xffff0000u); }

#define XB_TMO      128
#define XB_XCNT(j)  (256  + 64 * (j))
#define XB_XSUB(j)  (1280 + 64 * (j))
#define XB_XGEN(j)  (2304 + 64 * (j))
#define XB_TOP      3328
#define XB_TOPGEN   3392
#define XCD_BAR_WORDS 3456
#define XB_SPIN_CAP (1u << 18)
__device__ __forceinline__ unsigned xb_ld(unsigned* p)              { return __hip_atomic_load(p, __ATOMIC_RELAXED, __HIP_MEMORY_SCOPE_AGENT); }
__device__ __forceinline__ unsigned xb_add(unsigned* p, unsigned v) { return __hip_atomic_fetch_add(p, v, __ATOMIC_RELAXED, __HIP_MEMORY_SCOPE_AGENT); }
__device__ __forceinline__ unsigned xb_xcc_id() { return (unsigned)__builtin_amdgcn_s_getreg((3 << 11) | 20) & 0xFu; }
#define XB_SPIN(cond, bar) do { unsigned _sp = 0; while (cond) { __builtin_amdgcn_s_sleep(1); \
    if ((++_sp & 255u) == 0u) { if (xb_ld(&(bar)[XB_TMO])) break; if (_sp > XB_SPIN_CAP) { atomicAdd(&(bar)[XB_TMO], 1u); break; } } } } while (0)
struct XcdBarrier { unsigned* bar; unsigned x; volatile LAS unsigned* st; };
__device__ __forceinline__ XcdBarrier xcd_barrier_post(unsigned* bar, volatile LAS unsigned* st) {
    XcdBarrier b; b.bar = bar; b.x = xb_xcc_id(); b.st = st;
    if (threadIdx.x == 0) (void)xb_add(&bar[XB_XCNT(b.x)], 1u);
    return b;
}
__device__ __forceinline__ void xcd_barrier_complete(unsigned* bar, unsigned x, unsigned& nloc, unsigned& nx) {
    const unsigned G = gridDim.x * gridDim.y * gridDim.z;
    unsigned sum, cnt, mine, sp = 0u;
    for (;;) {
        sum = 0u; cnt = 0u; mine = 0u;
#pragma unroll
        for (unsigned j = 0; j < 16; ++j) { const unsigned c = xb_ld(&bar[XB_XCNT(j)]); sum += c; cnt += (c > 0u) ? 1u : 0u; mine = (j == x) ? c : mine; }
        if (sum == G) break;
        __builtin_amdgcn_s_sleep(1);
        if ((++sp & 255u) == 0u) { if (xb_ld(&bar[XB_TMO])) break; if (sp > XB_SPIN_CAP) { atomicAdd(&bar[XB_TMO], 1u); break; } }
    }
    nloc = mine > 0u ? mine : 1u; nx = cnt > 0u ? cnt : 1u;
}
__device__ __forceinline__ void xcd_barrier(const XcdBarrier& b) {
    asm volatile("s_waitcnt vmcnt(0)" ::: "memory");
    __syncthreads();
    if (threadIdx.x == 0) {
        unsigned* bar = b.bar;
        __builtin_amdgcn_s_waitcnt(0);
        unsigned nloc = b.st[0], nx = b.st[1];
        if (nloc == 0u) { xcd_barrier_complete(bar, b.x, nloc, nx); b.st[0] = nloc; b.st[1] = nx; }
        const unsigned old = xb_add(&bar[XB_XSUB(b.x)], 1u);
        const unsigned gen = old / nloc;
        if (old + 1u == (gen + 1u) * nloc) {
            __builtin_amdgcn_fence(__ATOMIC_RELEASE, "agent");
            asm volatile("s_waitcnt vmcnt(0)" ::: "memory");
            const unsigned og = xb_add(&bar[XB_TOP], 1u);
            const unsigned tg = og / nx;
            if (og + 1u == (tg + 1u) * nx) xb_add(&bar[XB_TOPGEN], 1u);
            else XB_SPIN(xb_ld(&bar[XB_TOPGEN]) == tg, bar);
            __builtin_amdgcn_fence(__ATOMIC_ACQUIRE, "agent");
            xb_add(&bar[XB_XGEN(b.x)], 1u);
            asm volatile("s_waitcnt vmcnt(0)" ::: "memory");
        } else {
            XB_SPIN(xb_ld(&bar[XB_XGEN(b.x)]) == gen, bar);
            __builtin_amdgcn_fence(__ATOMIC_ACQUIRE, "agent");
            asm volatile("s_waitcnt vmcnt(0)" ::: "memory");
        }
    }
    __syncthreads();
}

struct Args { const void* in[31]; float* out; unsigned char* ws; int ph_lo, ph_hi; };
struct Frame {
    LAS unsigned char* lds;
    int tid, lane, wave, G, bid;
    const float *x, *c, *w_ada, *b_ada, *g_mix_pre, *g_mix_post, *g_ffn_pre, *g_ffn_post, *w_in, *conv_w, *conv_b, *fw1, *fb1, *fw2, *fb2, *fw3, *ffreq, *hskip,
        *w_bg, *b_bg, *w_hy_o, *w_at_o, *w_out, *w_group, *b_group, *w_expert, *b_expert, *w1e, *w3e, *w2e;
    const int* positions;
    float* out;
    unsigned* ctl; float *MODP, *HID2, *ROT, *W3T, *TMP, *Y, *X1, *ACT, *YB, *LISTG, *WGT, *WET; bf16 *KF, *HID2B, *W3TB;
    unsigned* ROUTE; int* LISTT;
    bf16 *W1T, *WHYOT, *WATOT, *WOUTT, *H, *PHY, *QKV, *GT, *YHY, *YAT, *MERGED, *H2, *ACTB, *YBB;
};

__device__ __forceinline__ float wave_sum(float v) {
#pragma unroll
    for (int o = 1; o < 64; o <<= 1) v += __shfl_xor(v, o);
    return v;
}
__device__ __forceinline__ float wave_max(float v) {
#pragma unroll
    for (int o = 1; o < 64; o <<= 1) v = fmaxf(v, __shfl_xor(v, o));
    return v;
}

__device__ __forceinline__ void p0_transpose_item(const float* W, int K, int N, bf16* WT, int row_off, LAS float* scr, int item, int lane) {
    const int nblk = N / 32, kb = item / nblk, nb = item % nblk, k0 = 64 * kb, n0 = 32 * nb;
#pragma unroll 8
    for (int i = 0; i < 32; ++i) { const int kk = 2 * i + (lane >> 5); scr[kk * 33 + (lane & 31)] = W[(size_t)(k0 + kk) * N + n0 + (lane & 31)]; }
    asm volatile("s_waitcnt lgkmcnt(0)" ::: "memory");
    const int c = lane & 7;
#pragma unroll
    for (int j = 0; j < 4; ++j) { const int n = (lane >> 3) + 8 * j; const LAS float* s = scr + (8 * c) * 33 + n;
        v4u o; o.x = pk2(s[0 * 33], s[1 * 33]); o.y = pk2(s[2 * 33], s[3 * 33]); o.z = pk2(s[4 * 33], s[5 * 33]); o.w = pk2(s[6 * 33], s[7 * 33]);
        *(v4u*)(WT + (size_t)(row_off + n0 + n) * K + k0 + 8 * c) = o; }
    asm volatile("s_waitcnt lgkmcnt(0)" ::: "memory");
}

__device__ __forceinline__ f32x4 mod_sum4(Frame& F, int b, int col) {
    f32x4 s = *(const f32x4*)(F.b_ada + col);
#pragma unroll
    for (int ks = 0; ks < 8; ++ks) s += *(const f32x4*)(F.MODP + (size_t)(ks * 2 + b) * (6 * D) + col);
    return s;
}
__device__ __forceinline__ void load_mod(Frame& F, LAS float* dst, int which) {
#pragma unroll 2
    for (int i = F.tid; i < 2 * D / 4; i += NTHR) { const int b = i / (D / 4), d4 = i % (D / 4); *(LAS f32x4*)(dst + 4 * i) = mod_sum4(F, b, which * D + 4 * d4); }
}
__device__ __forceinline__ void load_mod1(Frame& F, LAS float* dst, int which, int b) {
    *(LAS f32x4*)(dst + 4 * F.tid) = mod_sum4(F, b, which * D + 4 * F.tid);
}

template <int SKIP = 0> __device__ __forceinline__ void p0_prologue(Frame& F) {
    LAS float* L = (LAS float*)F.lds;
    if (!(SKIP & 1))
    {
        typedef float f32x2 __attribute__((ext_vector_type(2)));
        LAS float* sc = L;
        LAS float* red = L + 512;
        for (int u = F.bid; u < 96 * 8; u += F.G) {
            const int chunk = u % 96, ks = u / 96;
            __syncthreads();
            { const int b = F.tid >> 8, i = F.tid & 255; const float cv = F.c[b * D + ks * 256 + i]; sc[b * 256 + i] = cv / (1.f + __expf(-cv)); }
            __syncthreads();
            f32x2 a0 = {0.f, 0.f}, a1 = {0.f, 0.f};
            const float* wp = F.w_ada + (size_t)(ks * 256 + F.wave * 32) * (6 * D) + chunk * 128 + F.lane * 2;
#pragma unroll 16
            for (int r = 0; r < 32; ++r) { const f32x2 w = *(const f32x2*)(wp + (size_t)r * (6 * D)); const float s0 = sc[F.wave * 32 + r], s1 = sc[256 + F.wave * 32 + r]; a0 += w * s0; a1 += w * s1; }
            *(LAS f32x2*)(red + (F.wave * 2 + 0) * 128 + F.lane * 2) = a0;
            *(LAS f32x2*)(red + (F.wave * 2 + 1) * 128 + F.lane * 2) = a1;
            __syncthreads();
            if (F.tid < 256) { const int b = F.tid >> 7, col = F.tid & 127; float s = 0.f;
#pragma unroll
              for (int w = 0; w < 8; ++w) s += red[(w * 2 + b) * 128 + col];
              F.MODP[(size_t)(ks * 2 + b) * (6 * D) + chunk * 128 + col] = s; }
        }
        __syncthreads();
    }
    const int gw = F.bid * NWAVES + F.wave, NGW = F.G * NWAVES;
    if (!(SKIP & 2)) {
        LAS float* scr = (LAS float*)(F.lds + F.wave * 16384);
        constexpr int I_IN = (D / 64) * (INW / 32), I_BG = (D / 64) * (2 * D / 32), I_HY = (HW / 64) * (D / 32), I_AT = (512 / 64) * (D / 32), I_OUT = (D / 64) * (D / 32);
        constexpr int NITEMS = I_IN + I_BG + I_HY + I_AT + I_OUT;
        for (int it = gw; it < NITEMS; it += NGW) {
            int r = it;
            if (r < I_IN) { p0_transpose_item(F.w_in, D, INW, F.W1T, 0, scr, r, F.lane); continue; } r -= I_IN;
            if (r < I_BG) { p0_transpose_item(F.w_bg, D, 2 * D, F.W1T, INW, scr, r, F.lane); continue; } r -= I_BG;
            if (r < I_HY) { p0_transpose_item(F.w_hy_o, HW, D, F.WHYOT, 0, scr, r, F.lane); continue; } r -= I_HY;
            if (r < I_AT) { p0_transpose_item(F.w_at_o, 512, D, F.WATOT, 0, scr, r, F.lane); continue; } r -= I_AT;
            p0_transpose_item(F.w_out, D, D, F.WOUTT, 0, scr, r, F.lane);
        }
    }
    if (!(SKIP & 4)) {
    for (int i = F.bid * NTHR + F.tid; i < 64 * 4096; i += F.G * NTHR) { const int n = i >> 6, j = i & 63; F.W3TB[i] = (bf16)f2bf(F.fw3[j * 4096 + n]); }
    for (int i = F.bid * NTHR + F.tid; i < 8 * D; i += F.G * NTHR) { const int n = i / D, d = i % D; F.WGT[i] = F.w_group[d * 8 + n]; }
    for (int i = F.bid * NTHR + F.tid; i < 64 * D; i += F.G * NTHR) { const int ge = i / D, d = i % D, g = ge >> 3, e = ge & 7; F.WET[i] = F.w_expert[((size_t)g * D + d) * 8 + e]; }
    }
    if (!(SKIP & 8))
    for (int t = gw; t < SEQ; t += NGW) {
        const int j = F.lane;
        const float tn = (float)t * (1.0f / (float)(SEQ - 1));
        const float w = 6.283185307179586f * (float)t / (float)SEQ;
        float feat = 0.f;
        if (j == 0) feat = tn;
        else if (j <= 16) { const float band = 1e-4f + (float)(j - 1) * ((15.0f - 1e-4f) / 15.0f); feat = cosf(band * w); }
        else if (j <= 32) { const float band = 1e-4f + (float)(j - 17) * ((15.0f - 1e-4f) / 15.0f); feat = -sinf(band * w); }
        float a = F.fb1[j];
        for (int i = 0; i < 33; ++i) a += __shfl(feat, i) * F.fw1[i * 64 + j];
        const float fr = F.ffreq[j];
        const float h1 = sinf(fr * a);
        float a2 = F.fb2[j];
        for (int i = 0; i < 64; ++i) a2 += __shfl(h1, i) * F.fw2[i * 64 + j];
        { const float hv = sinf(fr * a2); F.HID2[t * 64 + j] = hv; F.HID2B[t * 64 + j] = (bf16)f2bf(hv); }
    }
    if (!(SKIP & 16))
    for (int i = F.bid * NTHR + F.tid; i < T * 16; i += F.G * NTHR) {
        const int tok = i >> 4, k = i & 15;
        const float inv = powf(500000.0f, -(float)k * (1.0f / 16.0f));
        const float ang = (float)F.positions[tok] * inv;
        F.ROT[tok * 32 + k] = cosf(ang); F.ROT[tok * 32 + 16 + k] = sinf(ang);
    }
}

__device__ __forceinline__ void p1_rows_filters(Frame& F) {
    LAS float* L = (LAS float*)F.lds;
    LAS float* shiftv = L;
    LAS float* scalev = L + 2 * D;
    load_mod(F, shiftv, 0); load_mod(F, scalev, 1);
    __syncthreads();
    const int gw = F.bid * NWAVES + F.wave, NGW = F.G * NWAVES;
    for (int m0 = gw; m0 < T; m0 += 4 * NGW) {
        f32x4 v[4][8];
#pragma unroll
        for (int r = 0; r < 4; ++r) { const int m = m0 + r * NGW; if (m < T) { const f32x4* xr = (const f32x4*)(F.x + (size_t)m * D) + F.lane;
#pragma unroll
            for (int j = 0; j < 8; ++j) v[r][j] = xr[64 * j]; } }
#pragma unroll
        for (int r = 0; r < 4; ++r) { const int m = m0 + r * NGW; if (m < T) { const int b = m / SEQ; float s = 0.f;
#pragma unroll
            for (int j = 0; j < 8; ++j) s += (v[r][j].x * v[r][j].x + v[r][j].y * v[r][j].y) + (v[r][j].z * v[r][j].z + v[r][j].w * v[r][j].w);
            const float rstd = 1.0f / sqrtf(wave_sum(s) * (1.f / D) + RMS_EPS);
            v2u* o8 = (v2u*)(F.H + (size_t)m * D) + F.lane;
#pragma unroll
            for (int j = 0; j < 8; ++j) { const int d = 256 * j + 4 * F.lane;
                const f32x4 g = *(const f32x4*)(F.g_mix_pre + d); const f32x4 sc = *(LAS f32x4*)(scalev + b * D + d), sh = *(LAS f32x4*)(shiftv + b * D + d);
                f32x4 h; h = (v[r][j] * rstd) * g; h = h * (sc + 1.0f) + sh;
                v2u w; w.x = pk2(h.x, h.y); w.y = pk2(h.z, h.w); o8[64 * j] = w; } } }
    }
    {
        typedef short bf16x8 __attribute__((ext_vector_type(8)));
        typedef float f32x16 __attribute__((ext_vector_type(16)));
        const int r31 = F.lane & 31, hh = F.lane >> 5;
        const float mind = -3.0701134573253945f, maxd = -15.350567286626972f;
        for (int u = gw; u < 128 * 32; u += NGW) {
            const int tt = u & 127, ng = u >> 7, t = tt * 32 + r31;
            bf16x8 bq[4];
#pragma unroll
            for (int s = 0; s < 4; ++s) bq[s] = *(const bf16x8*)(F.HID2B + (size_t)t * 64 + 16 * s + 8 * hh);
            const float tn = (float)t * (1.0f / (float)(SEQ - 1));
#pragma unroll 1
            for (int q = 0; q < 4; ++q) {
                const int n0 = (ng * 4 + q) * 32;
                f32x16 c;
#pragma unroll
                for (int i = 0; i < 16; ++i) c[i] = 0.f;
#pragma unroll
                for (int s = 0; s < 4; ++s) { const bf16x8 a = *(const bf16x8*)(F.W3TB + (size_t)(n0 + r31) * 64 + 16 * s + 8 * hh); c = __builtin_amdgcn_mfma_f32_32x32x16_bf16(a, bq[s], c, 0, 0, 0); }
#pragma unroll
                for (int i = 0; i < 16; ++i) { const int n = n0 + (i & 3) + 8 * (i >> 2) + 4 * hh, ch = n & (HW - 1);
                    const float delta = fabsf(mind + (float)ch * ((maxd - mind) / (float)(HW - 1)));
                    F.KF[(size_t)n * SEQ + t] = (bf16)f2bf(c[i] * __expf(-tn * delta)); }
            }
        }
    }
}

template <int NB, class LA, class LB, class EP>
__device__ __forceinline__ void simt_tile(LAS float* L, int K, int tid, const LA& la, const LB& lb, const EP& ep) {
    LAS float* As = L;
    LAS float* Bs = L + 32 * 68;
    const int ty = tid >> 4, tx = tid & 15;
    float acc[NB][2][4];
#pragma unroll
    for (int q = 0; q < NB; ++q)
#pragma unroll
        for (int i = 0; i < 2; ++i)
#pragma unroll
            for (int j = 0; j < 4; ++j) acc[q][i][j] = 0.f;
    for (int k0 = 0; k0 < K; k0 += 32) {
        __syncthreads();
        for (int e = tid; e < 64 * 32; e += NTHR) { const int r = e >> 5, kk = e & 31; As[kk * 68 + r] = la(r, k0 + kk); }
#pragma unroll
        for (int q = 0; q < NB; ++q)
            for (int e = tid; e < 32 * 64; e += NTHR) { const int kk = e >> 6, cc = e & 63; Bs[(q * 32 + kk) * 68 + cc] = lb(q, k0 + kk, cc); }
        __syncthreads();
#pragma unroll 8
        for (int kk = 0; kk < 32; ++kk) {
            const float a0 = As[kk * 68 + 2 * ty], a1 = As[kk * 68 + 2 * ty + 1];
#pragma unroll
            for (int q = 0; q < NB; ++q) { const f32x4 b = *(LAS f32x4*)(Bs + (q * 32 + kk) * 68 + 4 * tx);
                acc[q][0][0] += a0 * b.x; acc[q][0][1] += a0 * b.y; acc[q][0][2] += a0 * b.z; acc[q][0][3] += a0 * b.w;
                acc[q][1][0] += a1 * b.x; acc[q][1][1] += a1 * b.y; acc[q][1][2] += a1 * b.z; acc[q][1][3] += a1 * b.w; }
        }
    }
#pragma unroll
    for (int i = 0; i < 2; ++i)
#pragma unroll
        for (int j = 0; j < 4; ++j) { float v[NB];
#pragma unroll
            for (int q = 0; q < NB; ++q) v[q] = acc[q][i][j];
            ep(2 * ty + i, 4 * tx + j, v); }
}

struct EpiProj {
    static constexpr bool PERM = true, AFTER_DRAIN = false;
    bf16* QKVp; bf16* Gp; const float* ROT; const float* bias;
    __device__ __forceinline__ void operator()(const pg8::f32x4 (&acc)[2][2][4][2], const pg8::Unit& u, int wr, int wc, int fr, int fq) const {
        using namespace pg8;
        const int row0 = u.pm * BM + wr * 64 + fr;
        const int colt = u.pn * BM;
        if (colt < QKVW) {
            const bool rot = (colt < 2 * NH * HD) && (wc == 0);
#pragma unroll
            for (int ai = 0; ai < 2; ++ai)
#pragma unroll
                for (int m = 0; m < 4; ++m) { const int row = row0 + ai * HALF + m * 16;
                    bf16* rowp = QKVp + (size_t)row * QKVW + colt + wc * 32 + 8 * fq;
                    f32x4 cs0, cs1, sn0, sn1;
                    if (rot) { const float* rp = ROT + (size_t)row * 32 + 8 * (fq & 1); cs0 = *(const f32x4*)rp; cs1 = *(const f32x4*)(rp + 4); sn0 = *(const f32x4*)(rp + 16); sn1 = *(const f32x4*)(rp + 20); }
#pragma unroll
                    for (int bj = 0; bj < 2; ++bj) { f32x4 v0 = acc[ai][bj][m][0], v1 = acc[ai][bj][m][1];
                        if (rot) {
                            f32x4 o0, o1;
#pragma unroll
                            for (int j = 0; j < 4; ++j) { o0[j] = __shfl_xor(v0[j], 32); o1[j] = __shfl_xor(v1[j], 32); }
                            if (fq < 2) { v0 = v0 * cs0 - o0 * sn0; v1 = v1 * cs1 - o1 * sn1; }
                            else        { v0 = v0 * cs0 + o0 * sn0; v1 = v1 * cs1 + o1 * sn1; }
                        }
                        u32x4 w; w.x = cvt_pk_bf16(v0[0], v0[1]); w.y = cvt_pk_bf16(v0[2], v0[3]); w.z = cvt_pk_bf16(v1[0], v1[1]); w.w = cvt_pk_bf16(v1[2], v1[3]);
                        *(u32x4*)(rowp + bj * HALF) = w; } }
        } else {
            const int gc = colt - QKVW + wc * 32 + 8 * fq;
            f32x4 bv[2][2];
#pragma unroll
            for (int bj = 0; bj < 2; ++bj)
#pragma unroll
                for (int n = 0; n < 2; ++n) bv[bj][n] = *(const f32x4*)(bias + gc + bj * HALF + 4 * n);
#pragma unroll
            for (int ai = 0; ai < 2; ++ai)
#pragma unroll
                for (int m = 0; m < 4; ++m) { bf16* rowp = Gp + (size_t)(row0 + ai * HALF + m * 16) * (2 * D) + gc;
#pragma unroll
                    for (int bj = 0; bj < 2; ++bj) { f32x4 v0 = acc[ai][bj][m][0] + bv[bj][0], v1 = acc[ai][bj][m][1] + bv[bj][1];
#pragma unroll
                        for (int j = 0; j < 4; ++j) { v0[j] = 1.0f / (1.0f + __expf(-v0[j])); v1[j] = 1.0f / (1.0f + __expf(-v1[j])); }
                        u32x4 w; w.x = cvt_pk_bf16(v0[0], v0[1]); w.y = cvt_pk_bf16(v0[2], v0[3]); w.z = cvt_pk_bf16(v1[0], v1[1]); w.w = cvt_pk_bf16(v1[2], v1[3]);
                        *(u32x4*)(rowp + bj * HALF) = w; } }
        }
    }
};
struct EpiPlainBf16 {
    static constexpr bool PERM = true, AFTER_DRAIN = false;
    bf16* O; int ldc;
    __device__ __forceinline__ void operator()(const pg8::f32x4 (&acc)[2][2][4][2], const pg8::Unit& u, int wr, int wc, int fr, int fq) const {
        using namespace pg8;
        const int row0 = u.pm * BM + wr * 64 + fr, col0 = u.pn * BM + wc * 32 + 8 * fq;
#pragma unroll
        for (int ai = 0; ai < 2; ++ai)
#pragma unroll
            for (int m = 0; m < 4; ++m) { bf16* rowp = O + (size_t)(row0 + ai * HALF + m * 16) * ldc + col0;
#pragma unroll
                for (int bj = 0; bj < 2; ++bj) { const f32x4 v0 = acc[ai][bj][m][0], v1 = acc[ai][bj][m][1];
                    u32x4 w; w.x = cvt_pk_bf16(v0[0], v0[1]); w.y = cvt_pk_bf16(v0[2], v0[3]); w.z = cvt_pk_bf16(v1[0], v1[1]); w.w = cvt_pk_bf16(v1[2], v1[3]);
                    *(u32x4*)(rowp + bj * HALF) = w; } }
    }
};
template <int STAGE> struct EpiGate {
    static constexpr bool PERM = true, AFTER_DRAIN = false;
    const bf16* Gp; int goff; float* TMPp; bf16* Mp;
    __device__ __forceinline__ void operator()(const pg8::f32x4 (&acc)[2][2][4][2], const pg8::Unit& u, int wr, int wc, int fr, int fq) const {
        using namespace pg8;
        const int row0 = u.pm * BM + wr * 64 + fr, col0 = u.pn * BM + wc * 32 + 8 * fq;
#pragma unroll
        for (int ai = 0; ai < 2; ++ai)
#pragma unroll
            for (int m = 0; m < 4; ++m) { const size_t row = (size_t)(row0 + ai * HALF + m * 16);
#pragma unroll
                for (int bj = 0; bj < 2; ++bj) { const int col = col0 + bj * HALF;
                    const u32x4 gw = *(const u32x4*)(Gp + row * (2 * D) + goff + col);
                    f32x4 g0 = {bflo(gw.x), bfhi(gw.x), bflo(gw.y), bfhi(gw.y)}, g1 = {bflo(gw.z), bfhi(gw.z), bflo(gw.w), bfhi(gw.w)};
                    f32x4 v0 = acc[ai][bj][m][0] * g0, v1 = acc[ai][bj][m][1] * g1;
                    bf16* tp = (bf16*)TMPp + row * D + col;
                    if (STAGE == 0) { u32x4 w; w.x = cvt_pk_bf16(v0[0], v0[1]); w.y = cvt_pk_bf16(v0[2], v0[3]); w.z = cvt_pk_bf16(v1[0], v1[1]); w.w = cvt_pk_bf16(v1[2], v1[3]); *(u32x4*)tp = w; }
                    else { const u32x4 tw = *(const u32x4*)tp; v0 += (f32x4){bflo(tw.x), bfhi(tw.x), bflo(tw.y), bfhi(tw.y)}; v1 += (f32x4){bflo(tw.z), bfhi(tw.z), bflo(tw.w), bfhi(tw.w)};
                        u32x4 w; w.x = cvt_pk_bf16(v0[0], v0[1]); w.y = cvt_pk_bf16(v0[2], v0[3]); w.z = cvt_pk_bf16(v1[0], v1[1]); w.w = cvt_pk_bf16(v1[2], v1[3]);
                        *(u32x4*)(Mp + row * D + col) = w; } } }
    }
};
struct EpiF32 {
    static constexpr bool PERM = false, AFTER_DRAIN = false;
    float* C; int ldc;
    __device__ __forceinline__ void operator()(const pg8::f32x4 (&acc)[2][2][4][2], const pg8::Unit& u, int wr, int wc, int fr, int fq) const {
        using namespace pg8;
        const int row0 = u.pm * BM + wr * 64 + fr, col0 = u.pn * BM + wc * 32 + 4 * fq;
#pragma unroll
        for (int ai = 0; ai < 2; ++ai)
#pragma unroll
            for (int m = 0; m < 4; ++m) { float* rowp = C + (size_t)(row0 + ai * HALF + m * 16) * ldc + col0;
#pragma unroll
                for (int bj = 0; bj < 2; ++bj)
#pragma unroll
                    for (int n = 0; n < 2; ++n) *(f32x4*)(rowp + bj * HALF + n * 16) = acc[ai][bj][m][n]; }
    }
};


struct DualOrder {
    pg8::StaticOrder s0, s1; int G, c; const bf16* A0; const bf16* B0; const bf16* A1; const bf16* B1;
    __device__ __forceinline__ bool next(int i, pg8::Unit& u) const {
        const int L = i * G + c;
        if (L < s1.nwg) { pg8::StaticOrder t = s1; t.G = 1; t.c = L; const bool ok = t.next(0, u); u.kind = 1; return ok; }
        pg8::StaticOrder t = s0; t.G = 1; t.c = L - s1.nwg; const bool ok = t.next(0, u); u.kind = 0; return ok;
    }
    __device__ __forceinline__ void a_ready(const pg8::Unit&) const {}
    __device__ __forceinline__ void done(const pg8::Unit&) const {}
    __device__ __forceinline__ const bf16* abase(const pg8::Gemm&, const pg8::Unit& u) const { return u.kind ? A1 : A0; }
    __device__ __forceinline__ const bf16* bbase(const pg8::Gemm&, const pg8::Unit& u) const { return u.kind ? B1 : B0; }
};
struct EpiDual {
    static constexpr bool PERM = true, AFTER_DRAIN = false;
    EpiPlainBf16 e0; EpiProj e1;
    __device__ __forceinline__ void operator()(const pg8::f32x4 (&acc)[2][2][4][2], const pg8::Unit& u, int wr, int wc, int fr, int fq) const {
        if (u.kind == 0) e0(acc, u, wr, wc, fr, fq); else e1(acc, u, wr, wc, fr, fq);
    }
};
template <class Epi>
__device__ __forceinline__ void run_gemm(Frame& F, const bf16* A, const bf16* Bt, int M, int N, int K, const Epi& E) {
    pg8::Gemm g{A, Bt, M, N, K}; pg8::StaticOrder S; S.init(M, N, F.G, F.bid);
    pg8::gemm_phase<Epi, pg8::StaticOrder, true, true>(F.lds, g, S, E);
}

__device__ __forceinline__ float sconv_at(const bf16* rowp, int t, float w0, float w1, float w2, float bias) {
    const float um = t > 0 ? bf2f(rowp[t - 1]) : 0.f, u0 = bf2f(rowp[t]), up = t < SEQ - 1 ? bf2f(rowp[t + 1]) : 0.f;
    return um * w0 + u0 * w1 + up * w2 + bias;
}
__device__ __forceinline__ void conv8(const LAS float* kk, const LAS float* z, int t0, float (&acc)[2][8]) {
#pragma unroll
    for (int b = 0; b < 2; ++b)
#pragma unroll
        for (int j = 0; j < 8; ++j) acc[b][j] = 0.f;
    for (int s8 = 0; s8 < SEQ; s8 += 8) {
        const int base = t0 - s8 + (SEQ - 1);
        float kw[15];
#pragma unroll
        for (int i = 0; i < 15; ++i) kw[i] = kk[base - 7 + i];
        float zz[2][8];
#pragma unroll
        for (int b = 0; b < 2; ++b) { const f32x4 q0 = *(const LAS f32x4*)(z + b * SEQ + s8), q1 = *(const LAS f32x4*)(z + b * SEQ + s8 + 4);
            zz[b][0] = q0.x; zz[b][1] = q0.y; zz[b][2] = q0.z; zz[b][3] = q0.w; zz[b][4] = q1.x; zz[b][5] = q1.y; zz[b][6] = q1.z; zz[b][7] = q1.w; }
#pragma unroll
        for (int ds = 0; ds < 8; ++ds)
#pragma unroll
            for (int j = 0; j < 8; ++j) { const float k = kw[7 + j - ds]; acc[0][j] += k * zz[0][ds]; acc[1][j] += k * zz[1][ds]; }
    }
}
__device__ __forceinline__ void p3_hyena_naive(Frame& F) {
    LAS float* L = (LAS float*)F.lds;
    LAS float* zin = L;
    LAS float* kk = L + 2 * SEQ;
    LAS float* zmid = L + 4 * SEQ;
    for (int c = F.bid; c < HW; c += F.G) {
        __syncthreads();
        const float cw[3][3] = {{F.conv_w[c], F.conv_w[3 * HW + c], F.conv_w[6 * HW + c]},
                                {F.conv_w[HW + c], F.conv_w[3 * HW + HW + c], F.conv_w[6 * HW + HW + c]},
                                {F.conv_w[2 * HW + c], F.conv_w[3 * HW + 2 * HW + c], F.conv_w[6 * HW + 2 * HW + c]}};
        const float cb[3] = {F.conv_b[c], F.conv_b[HW + c], F.conv_b[2 * HW + c]};
        const bf16* pv = F.PHY + (size_t)c * T; const bf16* px1 = F.PHY + (size_t)(HW + c) * T; const bf16* px2 = F.PHY + (size_t)(2 * HW + c) * T;
        for (int i = F.tid; i < T; i += NTHR) { const int b = i / SEQ, t = i % SEQ; zin[i] = sconv_at(pv + b * SEQ, t, cw[0][0], cw[0][1], cw[0][2], cb[0]); }
        for (int i = F.tid; i < 2 * SEQ; i += NTHR) { const int d = i - (SEQ - 1);
            kk[i] = (i == 2 * SEQ - 1) ? 0.f : bf2f(d >= 0 ? F.KF[(size_t)(0 * HW + c) * SEQ + d] : F.KF[(size_t)(1 * HW + c) * SEQ - d]); }
        __syncthreads();
        const int t0 = F.tid * 8; float acc[2][8];
        conv8(kk, zin, t0, acc);
        const float sk0 = F.hskip[c], sk1 = F.hskip[HW + c];
#pragma unroll
        for (int b = 0; b < 2; ++b)
#pragma unroll
            for (int j = 0; j < 8; ++j) { const float x1 = sconv_at(px1 + b * SEQ, t0 + j, cw[1][0], cw[1][1], cw[1][2], cb[1]);
                zmid[b * SEQ + t0 + j] = x1 * (acc[b][j] + sk0 * zin[b * SEQ + t0 + j]); }
        __syncthreads();
        for (int i = F.tid; i < 2 * SEQ; i += NTHR) { const int d = i - (SEQ - 1);
            kk[i] = (i == 2 * SEQ - 1) ? 0.f : bf2f(d >= 0 ? F.KF[(size_t)(2 * HW + c) * SEQ + d] : F.KF[(size_t)(3 * HW + c) * SEQ - d]); }
        __syncthreads();
        conv8(kk, zmid, t0, acc);
#pragma unroll
        for (int b = 0; b < 2; ++b)
#pragma unroll
            for (int j = 0; j < 8; ++j) { const float x2 = sconv_at(px2 + b * SEQ, t0 + j, cw[2][0], cw[2][1], cw[2][2], cb[2]);
                const float z2 = x2 * (acc[b][j] + sk1 * zmid[b * SEQ + t0 + j]);
                F.YHY[(size_t)(b * SEQ + t0 + j) * HW + c] = (bf16)f2bf(z2); }
    }
}

constexpr int HY_KCOPY = 16448;
constexpr int HY_K_OFF = 0;
constexpr int HY_ZIN_OFF = 4 * HY_KCOPY;
constexpr int HY_ZBYTES = 160 * 2 * 80;
constexpr int HY_ZMID_OFF = HY_ZIN_OFF + HY_ZBYTES;
constexpr int HY_X1_OFF = HY_ZMID_OFF + HY_ZBYTES;
constexpr int HY_X2_OFF = HY_X1_OFF + 2 * SEQ * 2;
static_assert(HY_X2_OFF + 2 * SEQ * 2 <= MOE_OFFS_OFF, "hyena LDS map");
__device__ __forceinline__ unsigned hy_zaddr(int b, int t) { return (unsigned)((((t >> 5) + 16) * 2 + b) * 80 + (t & 31) * 2); }
__device__ __forceinline__ void hy_build_k(Frame& F, const bf16* hf, const bf16* hb) {
    LAS unsigned char* lds = F.lds + HY_K_OFF;
    const int i = F.tid;
    const v4u ca = *(const v4u*)(hf + (SEQ - 8 - 8 * i)), cb = *(const v4u*)(hb + 8 * i);
    unsigned short ga[8], gb[8];
    ga[7] = (unsigned short)(ca.x & 0xffff); ga[6] = (unsigned short)(ca.x >> 16); ga[5] = (unsigned short)(ca.y & 0xffff); ga[4] = (unsigned short)(ca.y >> 16);
    ga[3] = (unsigned short)(ca.z & 0xffff); ga[2] = (unsigned short)(ca.z >> 16); ga[1] = (unsigned short)(ca.w & 0xffff); ga[0] = (unsigned short)(ca.w >> 16);
    gb[0] = (unsigned short)(cb.x & 0xffff); gb[1] = (unsigned short)(cb.x >> 16); gb[2] = (unsigned short)(cb.y & 0xffff); gb[3] = (unsigned short)(cb.y >> 16);
    gb[4] = (unsigned short)(cb.z & 0xffff); gb[5] = (unsigned short)(cb.z >> 16); gb[6] = (unsigned short)(cb.w & 0xffff); gb[7] = (unsigned short)(cb.w >> 16);
    const unsigned pa[4] = {(unsigned)ga[0] | ((unsigned)ga[1] << 16), (unsigned)ga[2] | ((unsigned)ga[3] << 16), (unsigned)ga[4] | ((unsigned)ga[5] << 16), (unsigned)ga[6] | ((unsigned)ga[7] << 16)};
    const unsigned pb[4] = {(unsigned)gb[0] | ((unsigned)gb[1] << 16), (unsigned)gb[2] | ((unsigned)gb[3] << 16), (unsigned)gb[4] | ((unsigned)gb[5] << 16), (unsigned)gb[6] | ((unsigned)gb[7] << 16)};
    *(LAS v4u*)(lds + 1 * HY_KCOPY + 2 * (8 * i)) = (v4u){pa[0], pa[1], pa[2], pa[3]};
    if (i > 0) *(LAS unsigned*)(lds + 3 * HY_KCOPY + 2 * (8 * i - 2)) = pa[0];
#pragma unroll
    for (int p = 1; p < 4; ++p) *(LAS unsigned*)(lds + 3 * HY_KCOPY + 2 * (8 * i - 2 + 2 * p)) = pa[p];
#pragma unroll
    for (int j = 0; j < 8; ++j) { *(LAS unsigned short*)(lds + 0 * HY_KCOPY + 2 * (8 * i + 1 + j)) = ga[j]; if (8 * i + j - 1 >= 0) *(LAS unsigned short*)(lds + 2 * HY_KCOPY + 2 * (8 * i + j - 1)) = ga[j]; }
    if (i > 0) { *(LAS v4u*)(lds + 0 * HY_KCOPY + 2 * (SEQ + 8 * i)) = (v4u){pb[0], pb[1], pb[2], pb[3]};
#pragma unroll
        for (int p = 0; p < 4; ++p) *(LAS unsigned*)(lds + 2 * HY_KCOPY + 2 * (SEQ + 8 * i - 2 + 2 * p)) = pb[p]; }
    else {
#pragma unroll
        for (int j = 1; j < 8; ++j) { *(LAS unsigned short*)(lds + 0 * HY_KCOPY + 2 * (SEQ + j)) = gb[j]; *(LAS unsigned short*)(lds + 2 * HY_KCOPY + 2 * (SEQ + j - 2)) = gb[j]; } }
#pragma unroll
    for (int j = 0; j < 8; ++j) { if (i > 0 || j > 0) { *(LAS unsigned short*)(lds + 1 * HY_KCOPY + 2 * (SEQ + 8 * i + j - 1)) = gb[j]; *(LAS unsigned short*)(lds + 3 * HY_KCOPY + 2 * (SEQ + 8 * i + j - 3)) = gb[j]; } }
}
__device__ __forceinline__ void hy_stage_inputs(Frame& F, int c, const float (&cw)[3][3], const float (&cb)[3]) {
    LAS unsigned char* lds = F.lds;
    v4u ch[6]; unsigned short lo[6], hi[6];
#pragma unroll
    for (int k = 0; k < 6; ++k) { const int wh = k >> 1, chunk = F.tid + 512 * (k & 1), b = chunk >> 9, t0 = (chunk & 511) * 8;
        const bf16* rowp = F.PHY + (size_t)(wh * HW + c) * T + b * SEQ;
        ch[k] = *(const v4u*)(rowp + t0); lo[k] = t0 > 0 ? rowp[t0 - 1] : (unsigned short)0; hi[k] = t0 + 8 < SEQ ? rowp[t0 + 8] : (unsigned short)0; }
#pragma unroll
    for (int k = 0; k < 6; ++k) { const int wh = k >> 1, chunk = F.tid + 512 * (k & 1), b = chunk >> 9, t0 = (chunk & 511) * 8;
        float u[10]; u[0] = bf2f(lo[k]); u[9] = bf2f(hi[k]);
        u[1] = bflo(ch[k].x); u[2] = bfhi(ch[k].x); u[3] = bflo(ch[k].y); u[4] = bfhi(ch[k].y); u[5] = bflo(ch[k].z); u[6] = bfhi(ch[k].z); u[7] = bflo(ch[k].w); u[8] = bfhi(ch[k].w);
        float o[8];
#pragma unroll
        for (int j = 0; j < 8; ++j) o[j] = u[j] * cw[wh][0] + u[j + 1] * cw[wh][1] + u[j + 2] * cw[wh][2] + cb[wh];
        v4u pk; pk.x = pk2(o[0], o[1]); pk.y = pk2(o[2], o[3]); pk.z = pk2(o[4], o[5]); pk.w = pk2(o[6], o[7]);
        const unsigned off = (wh == 0) ? (unsigned)HY_ZIN_OFF + hy_zaddr(b, t0) : (unsigned)((wh == 1 ? HY_X1_OFF : HY_X2_OFF) + 2 * (b * SEQ + t0));
        *(LAS v4u*)(lds + off) = pk; }
}
__device__ __forceinline__ void hy_conv(Frame& F, unsigned zoff, pg8::f32x4 (&acc)[4]) {
    typedef short bf16x8 __attribute__((ext_vector_type(8)));
    typedef float f32x16 __attribute__((ext_vector_type(16)));
    const int lane = F.lane, q = F.wave, r = lane & 31, hh = lane >> 5, sg = (4 - (r & 3)) & 3, nn = r >> 1, b = r & 1;
    const int d0 = 16 * q - 127;
    unsigned aaddr = (unsigned)(HY_K_OFF + sg * HY_KCOPY + 2 * (SEQ - 32 * d0 - r + 8 * hh - sg));
    unsigned baddr = zoff + (unsigned)(((16 * q + nn - d0 + 16) * 2 + b) * 80 + 16 * hh);
    f32x16 c;
#pragma unroll
    for (int i = 0; i < 16; ++i) c[i] = 0.f;
    struct FragSet { v2u a[2][2][2]; bf16x8 b[2][2]; };
#define HY_LOAD(S, ADDR_A, ADDR_B) do { _Pragma("unroll") for (int _o = 0; _o < 2; ++_o) { const unsigned _ao = (ADDR_A) + (_o ? 0u : 64u), _bo = (ADDR_B) + (_o ? 0u : 160u); \
        _Pragma("unroll") for (int _h = 0; _h < 2; ++_h) { S.a[_o][_h][0] = *(volatile LAS v2u*)(F.lds + _ao + 32 * _h); S.a[_o][_h][1] = *(volatile LAS v2u*)(F.lds + _ao + 32 * _h + 8); \
            S.b[_o][_h] = *(const LAS bf16x8*)(F.lds + _bo + 32 * _h); } } } while (0)
#define HY_MMA(S) do { _Pragma("unroll") for (int _o = 0; _o < 2; ++_o) _Pragma("unroll") for (int _h = 0; _h < 2; ++_h) { union { bf16x8 v; v2u h[2]; } _a; _a.h[0] = S.a[_o][_h][0]; _a.h[1] = S.a[_o][_h][1]; \
        c = __builtin_amdgcn_mfma_f32_32x32x16_bf16(_a.v, S.b[_o][_h], c, 0, 0, 0); } } while (0)
    {
        union { bf16x8 v; v2u h[2]; } a0, a1;
        a0.h[0] = *(volatile LAS v2u*)(F.lds + aaddr);      a0.h[1] = *(volatile LAS v2u*)(F.lds + aaddr + 8);
        a1.h[0] = *(volatile LAS v2u*)(F.lds + aaddr + 32); a1.h[1] = *(volatile LAS v2u*)(F.lds + aaddr + 40);
        const bf16x8 b0 = *(const LAS bf16x8*)(F.lds + baddr), b1 = *(const LAS bf16x8*)(F.lds + baddr + 32);
        c = __builtin_amdgcn_mfma_f32_32x32x16_bf16(a0.v, b0, c, 0, 0, 0);
        c = __builtin_amdgcn_mfma_f32_32x32x16_bf16(a1.v, b1, c, 0, 0, 0);
    }
    FragSet sA, sB;
    aaddr -= 128; baddr -= 320;
    HY_LOAD(sA, aaddr, baddr);
#pragma clang loop unroll(disable)
    for (int it = 0; it < 35; ++it) {
        aaddr -= 128; baddr -= 320;
        asm volatile("" : "+v"(aaddr), "+v"(baddr));
        HY_LOAD(sB, aaddr, baddr);
        HY_MMA(sA);
        aaddr -= 128; baddr -= 320;
        asm volatile("" : "+v"(aaddr), "+v"(baddr));
        HY_LOAD(sA, aaddr, baddr);
        HY_MMA(sB);
    }
    HY_MMA(sA);
#undef HY_LOAD
#undef HY_MMA
#pragma unroll
    for (int g = 0; g < 4; ++g) acc[g] = (pg8::f32x4){c[4 * g], c[4 * g + 1], c[4 * g + 2], c[4 * g + 3]};
}
__device__ __forceinline__ void p3_hyena_mfma(Frame& F) {
    LAS unsigned char* lds = F.lds;
    for (int i = F.tid; i < 2 * HY_ZBYTES / 4; i += NTHR) *(LAS unsigned*)(lds + HY_ZIN_OFF + 4 * i) = 0u;
    const int lane = F.lane, q = F.wave, r = lane & 31, hh = lane >> 5, nn = r >> 1, b = r & 1;
    for (int c = F.bid; c < HW; c += F.G) {
        __syncthreads();
        const float cw[3][3] = {{F.conv_w[c], F.conv_w[3 * HW + c], F.conv_w[6 * HW + c]},
                                {F.conv_w[HW + c], F.conv_w[3 * HW + HW + c], F.conv_w[6 * HW + HW + c]},
                                {F.conv_w[2 * HW + c], F.conv_w[3 * HW + 2 * HW + c], F.conv_w[6 * HW + 2 * HW + c]}};
        const float cb[3] = {F.conv_b[c], F.conv_b[HW + c], F.conv_b[2 * HW + c]};
        const bf16* pv = F.PHY + (size_t)c * T; const bf16* px1 = F.PHY + (size_t)(HW + c) * T; const bf16* px2 = F.PHY + (size_t)(2 * HW + c) * T;
        hy_stage_inputs(F, c, cw, cb);
        hy_build_k(F, F.KF + (size_t)(0 * HW + c) * SEQ, F.KF + (size_t)(1 * HW + c) * SEQ);
        __syncthreads();
        pg8::f32x4 acc[4];
#if HY_REP & 1
        { pg8::f32x4 acc2[4]; hy_conv(F, HY_ZIN_OFF, acc2); asm volatile("" :: "v"(acc2[0][0]), "v"(acc2[1][1]), "v"(acc2[2][2]), "v"(acc2[3][3])); }
#endif
#if HY_REP & 2
        __syncthreads(); hy_build_k(F, F.KF + (size_t)(0 * HW + c) * SEQ, F.KF + (size_t)(1 * HW + c) * SEQ); __syncthreads();
#endif
#if HY_REP & 4
        __syncthreads(); hy_stage_inputs(F, c, cw, cb); __syncthreads();
#endif
        hy_conv(F, HY_ZIN_OFF, acc);
        const float sk0 = F.hskip[c], sk1 = F.hskip[HW + c];
        {
            unsigned zb = (unsigned)(((16 * q + nn + 16) * 2 + b) * 80 + 8 * hh), xb = (unsigned)(2 * (b * SEQ + 32 * (16 * q + nn) + 4 * hh));
            asm volatile("" : "+v"(zb), "+v"(xb));
#pragma unroll
            for (int g = 0; g < 4; ++g)
#pragma unroll
                for (int e = 0; e < 4; ++e) { const unsigned o = (unsigned)(16 * g + 2 * e);
                    const float vz = bf2f(*(LAS unsigned short*)(lds + HY_ZIN_OFF + zb + o)), x1 = bf2f(*(LAS unsigned short*)(lds + HY_X1_OFF + xb + o));
                    *(LAS unsigned short*)(lds + HY_ZMID_OFF + zb + o) = (unsigned short)f2bf(x1 * (acc[g][e] + sk0 * vz)); }
        }
        __syncthreads();
        hy_build_k(F, F.KF + (size_t)(2 * HW + c) * SEQ, F.KF + (size_t)(3 * HW + c) * SEQ);
        __syncthreads();
        hy_conv(F, HY_ZMID_OFF, acc);
        {
            unsigned zb = (unsigned)(((16 * q + nn + 16) * 2 + b) * 80 + 8 * hh), xb = (unsigned)(2 * (b * SEQ + 32 * (16 * q + nn) + 4 * hh));
            asm volatile("" : "+v"(zb), "+v"(xb));
            bf16* yp = F.YHY + (size_t)(b * SEQ + 32 * (16 * q + nn) + 4 * hh) * HW + c;
#pragma unroll
            for (int g = 0; g < 4; ++g)
#pragma unroll
                for (int e = 0; e < 4; ++e) { const unsigned o = (unsigned)(16 * g + 2 * e);
                    const float z1 = bf2f(*(LAS unsigned short*)(lds + HY_ZMID_OFF + zb + o)), x2 = bf2f(*(LAS unsigned short*)(lds + HY_X2_OFF + xb + o));
                    yp[(size_t)(8 * g + e) * HW] = (bf16)f2bf(x2 * (acc[g][e] + sk1 * z1)); }
        }
    }
}
__device__ __forceinline__ void p3_attn_naive(Frame& F) {
    LAS float* qs = (LAS float*)F.lds + F.wave * 128;
    const int gw = F.bid * NWAVES + F.wave, NGW = F.G * NWAVES;
    const float scale = 0.08838834764831845f;
    for (int u = gw; u < T * 4; u += NGW) {
        const int m = u >> 2, hh = u & 3, b = m / SEQ, s = m % SEQ;
        float Mrun = -3.0e38f, Lrun = 0.f, o0 = 0.f, o1 = 0.f;
#pragma unroll 1
        for (int g = 0; g < 3; ++g) {
            const int head = g * 4 + hh, dil = (g == 0) ? 1 : (g == 1 ? 4 : 16);
            const bf16* qp = F.QKV + (size_t)m * QKVW + head * HD;
            { const unsigned qq = *(const unsigned*)(qp + 2 * F.lane); qs[2 * F.lane] = bflo(qq); qs[2 * F.lane + 1] = bfhi(qq); }
            asm volatile("s_waitcnt lgkmcnt(0)" ::: "memory");
            float sc[3];
#pragma unroll
            for (int p = 0; p < 3; ++p) {
                const int j = (p == 0) ? F.lane - 64 : (p == 1 ? F.lane : 64);
                const int ks = s + j * dil; const bool valid = (ks >= 0) && (ks < SEQ) && (p < 2 || F.lane == 0);
                float dot = 0.f;
                if (valid) { const v4u* kp = (const v4u*)(F.QKV + (size_t)(b * SEQ + ks) * QKVW + NH * HD + head * HD);
#pragma unroll 4
                    for (int c8 = 0; c8 < 16; ++c8) { const v4u kv = kp[c8]; const LAS float* q8 = qs + 8 * c8;
                        dot += bflo(kv.x) * q8[0] + bfhi(kv.x) * q8[1] + bflo(kv.y) * q8[2] + bfhi(kv.y) * q8[3] + bflo(kv.z) * q8[4] + bfhi(kv.z) * q8[5] + bflo(kv.w) * q8[6] + bfhi(kv.w) * q8[7]; } }
                sc[p] = valid ? dot * scale : -1.0e30f;
            }
            const float mg = wave_max(fmaxf(fmaxf(sc[0], sc[1]), sc[2]));
            const float mnew = fmaxf(Mrun, mg), resc = __expf(Mrun - mnew);
            float pr[3];
#pragma unroll
            for (int p = 0; p < 3; ++p) pr[p] = (sc[p] > -1.0e29f) ? __expf(sc[p] - mnew) : 0.f;
            Lrun = Lrun * resc + wave_sum(pr[0] + pr[1] + pr[2]); o0 *= resc; o1 *= resc; Mrun = mnew;
            const bf16* vbase = F.QKV + 2 * NH * HD + head * HD + 2 * F.lane;
            for (int jj = 0; jj < 129; ++jj) {
                const int j = jj - 64, ks = s + j * dil;
                if (ks < 0 || ks >= SEQ) continue;
                const float pk = (jj < 64) ? __shfl(pr[0], jj) : (jj < 128 ? __shfl(pr[1], jj - 64) : __shfl(pr[2], 0));
                const unsigned vv = *(const unsigned*)(vbase + (size_t)(b * SEQ + ks) * QKVW);
                o0 += pk * bflo(vv); o1 += pk * bfhi(vv);
            }
        }
        const float inv = 1.0f / Lrun;
        *(unsigned*)(F.YAT + (size_t)m * 512 + hh * HD + 2 * F.lane) = pk2(o0 * inv, o1 * inv);
    }
}


constexpr int AT_VPITCH = 320, AT_VBYTES = 32 * AT_VPITCH;
typedef short s16x4 __attribute__((ext_vector_type(4)));
#define AT_TR8(S, VB, R) asm volatile( \
    "ds_read_b64_tr_b16 %0, %8 offset:%9\n\tds_read_b64_tr_b16 %1, %8 offset:%10\n\tds_read_b64_tr_b16 %2, %8 offset:%11\n\tds_read_b64_tr_b16 %3, %8 offset:%12\n\t" \
    "ds_read_b64_tr_b16 %4, %8 offset:%13\n\tds_read_b64_tr_b16 %5, %8 offset:%14\n\tds_read_b64_tr_b16 %6, %8 offset:%15\n\tds_read_b64_tr_b16 %7, %8 offset:%16\n\ts_waitcnt lgkmcnt(0)" \
    : "=&v"(R[0]), "=&v"(R[1]), "=&v"(R[2]), "=&v"(R[3]), "=&v"(R[4]), "=&v"(R[5]), "=&v"(R[6]), "=&v"(R[7]) \
    : "v"(VB), "i"((16 * (S)) * AT_VPITCH), "i"((16 * (S) + 8) * AT_VPITCH), "i"((16 * (S)) * AT_VPITCH + 64), "i"((16 * (S) + 8) * AT_VPITCH + 64), \
      "i"((16 * (S)) * AT_VPITCH + 128), "i"((16 * (S) + 8) * AT_VPITCH + 128), "i"((16 * (S)) * AT_VPITCH + 192), "i"((16 * (S) + 8) * AT_VPITCH + 192) : "memory")
__device__ __forceinline__ void p4_attn_mfma(Frame& F) {
    typedef short bf16x8 __attribute__((ext_vector_type(8)));
    typedef float f32x16 __attribute__((ext_vector_type(16)));
    typedef float f32x2 __attribute__((ext_vector_type(2)));
    typedef __bf16 bf16x2v __attribute__((ext_vector_type(2)));
    const int lane = F.lane, w = F.wave, r31 = lane & 31, hh = lane >> 5;
    LAS unsigned char* vimg = F.lds + w * AT_VBYTES;
    const unsigned vb = (unsigned)(size_t)vimg + (unsigned)((4 * hh + ((lane & 15) >> 2)) * AT_VPITCH + 32 * ((lane >> 4) & 1) + 8 * (lane & 3));
    const int gw = F.bid * NWAVES + w, NGW = F.G * NWAVES;
    const float scale = 0.08838834764831845f;
    bf16* AO = (bf16*)F.YB; float* LSE = (float*)((unsigned char*)F.YB + 32 * MiB);
    const int nunit = 2 * NH * 128, per_wg = (nunit + F.G - 1) / F.G;
    for (int k = w; k < per_wg; k += NWAVES) {
        const int u = F.bid * per_wg + k; if (u >= nunit) break;
        const int b = u / (NH * 128), rem = u % (NH * 128), head = rem >> 7, blk = rem & 127, g = head >> 2, hs = head & 3;
        const int dl = (g == 0) ? 0 : (g == 1 ? 2 : 4), dil = 1 << dl, res = blk & (dil - 1), q0 = (blk >> dl) * 32, n = SEQ >> dl;
        const size_t tokq = (size_t)(b * SEQ + res + dil * (q0 + r31));
        bf16x8 qf[8];
        { const bf16* qrow = F.QKV + tokq * QKVW + head * HD + 8 * hh;
#pragma unroll
          for (int s = 0; s < 8; ++s) qf[s] = *(const bf16x8*)(qrow + 16 * s); }
        f32x16 o[4];
#pragma unroll
        for (int dt = 0; dt < 4; ++dt)
#pragma unroll
            for (int i = 0; i < 16; ++i) o[dt][i] = 0.f;
        float mrun = -3.0e38f, lrun = 0.f;
        const int kt_lo = (q0 >= 64) ? 0 : (64 - q0) >> 5, kt_hi = ((n + 32 - q0) >> 5) < 4 ? ((n + 32 - q0) >> 5) : 4;
        bf16x8 kfN[8], vvN[8];
#define AT_FETCH(KT) do { const int _k0 = q0 - 64 + 32 * (KT); \
            const bf16* _krow = F.QKV + (size_t)(b * SEQ + res + dil * (_k0 + r31)) * QKVW + NH * HD + head * HD + 8 * hh; \
            const bf16* _vsrc = F.QKV + (size_t)(b * SEQ + res + dil * (_k0 + (lane >> 4))) * QKVW + 2 * NH * HD + head * HD + (lane & 15) * 8; \
            _Pragma("unroll") for (int _s = 0; _s < 8; ++_s) kfN[_s] = *(const bf16x8*)(_krow + 16 * _s); \
            _Pragma("unroll") for (int _i = 0; _i < 8; ++_i) vvN[_i] = *(const bf16x8*)(_vsrc + (size_t)(4 * _i * dil) * QKVW); } while (0)
        AT_FETCH(kt_lo);
#pragma unroll 1
        for (int kt = kt_lo; kt <= kt_hi; ++kt) {
            const int kt0 = q0 - 64 + 32 * kt;
            bf16x8 kf[8];
#pragma unroll
            for (int s = 0; s < 8; ++s) kf[s] = kfN[s];
#pragma unroll
            for (int i = 0; i < 8; ++i) *(LAS bf16x8*)(vimg + (4 * i + (lane >> 4)) * AT_VPITCH + (lane & 15) * 16) = vvN[i];
            if (kt < kt_hi) AT_FETCH(kt + 1);
            f32x16 sacc;
#pragma unroll
            for (int i = 0; i < 16; ++i) sacc[i] = 0.f;
#pragma unroll
            for (int s = 0; s < 8; ++s) sacc = __builtin_amdgcn_mfma_f32_32x32x16_bf16(kf[s], qf[s], sacc, 0, 0, 0);
            float p[16]; float mx = -3.0e38f;
            const bool edge = (kt == 0) || (kt == 4);
#pragma unroll
            for (int i = 0; i < 16; ++i) { float sv = sacc[i] * scale;
                if (edge) { const int diff = (q0 + r31) - (kt0 + (i & 3) + 8 * (i >> 2) + 4 * hh); if (diff > 64 || diff < -64) sv = -1.0e30f; }
                p[i] = sv; mx = fmaxf(mx, sv); }
            mx = fmaxf(mx, __shfl_xor(mx, 32));
            const float mnew = fmaxf(mrun, mx), resc = __expf(mrun - mnew);
            float ps = 0.f;
#pragma unroll
            for (int i = 0; i < 16; ++i) { p[i] = (p[i] > -1.0e29f) ? __expf(p[i] - mnew) : 0.f; ps += p[i]; }
            ps += __shfl_xor(ps, 32);
            lrun = lrun * resc + ps; mrun = mnew;
#pragma unroll
            for (int dt = 0; dt < 4; ++dt)
#pragma unroll
                for (int i = 0; i < 16; ++i) o[dt][i] *= resc;
            bf16x8 pf[2];
#pragma unroll
            for (int s = 0; s < 2; ++s) { union { bf16x8 v; bf16x2v h[4]; } cv;
#pragma unroll
                for (int j = 0; j < 4; ++j) cv.h[j] = __builtin_convertvector((f32x2){p[8 * s + 2 * j], p[8 * s + 2 * j + 1]}, bf16x2v);
                pf[s] = cv.v; }
            asm volatile("s_waitcnt lgkmcnt(0)" ::: "memory");
            { s16x4 tr[8]; AT_TR8(0, vb, tr);
#pragma unroll
              for (int dt = 0; dt < 4; ++dt) { const bf16x8 va = __builtin_shufflevector(tr[2 * dt], tr[2 * dt + 1], 0, 1, 2, 3, 4, 5, 6, 7); o[dt] = __builtin_amdgcn_mfma_f32_32x32x16_bf16(va, pf[0], o[dt], 0, 0, 0); } }
            { s16x4 tr[8]; AT_TR8(1, vb, tr);
#pragma unroll
              for (int dt = 0; dt < 4; ++dt) { const bf16x8 va = __builtin_shufflevector(tr[2 * dt], tr[2 * dt + 1], 0, 1, 2, 3, 4, 5, 6, 7); o[dt] = __builtin_amdgcn_mfma_f32_32x32x16_bf16(va, pf[1], o[dt], 0, 0, 0); } }
        }
#undef AT_FETCH
        const float inv = 1.0f / lrun;
        bf16* op = AO + ((size_t)g * T + tokq) * 512 + hs * HD + 4 * hh;
#pragma unroll
        for (int dt = 0; dt < 4; ++dt)
#pragma unroll
            for (int a = 0; a < 4; ++a) { v2u ov; ov.x = pk2(o[dt][4 * a] * inv, o[dt][4 * a + 1] * inv); ov.y = pk2(o[dt][4 * a + 2] * inv, o[dt][4 * a + 3] * inv);
                *(v2u*)(op + 32 * dt + 8 * a) = ov; }
        if (hh == 0) LSE[((size_t)g * T + tokq) * 4 + hs] = mrun + logf(lrun);
    }
}
__device__ __forceinline__ void p4b_combine(Frame& F) {
    const bf16* AO = (const bf16*)F.YB; const float* LSE = (const float*)((const unsigned char*)F.YB + 32 * MiB);
    const int gw = F.bid * NWAVES + F.wave, NGW = F.G * NWAVES, lane = F.lane, hs = lane >> 4;
    for (int m = gw; m < T; m += NGW) {
        float l[3];
#pragma unroll
        for (int g = 0; g < 3; ++g) l[g] = LSE[((size_t)g * T + m) * 4 + hs];
        const float mx = fmaxf(fmaxf(l[0], l[1]), l[2]);
        float wg[3], den = 0.f;
#pragma unroll
        for (int g = 0; g < 3; ++g) { wg[g] = __expf(l[g] - mx); den += wg[g]; }
        const float inv = 1.0f / den;
        float acc[8];
#pragma unroll
        for (int j = 0; j < 8; ++j) acc[j] = 0.f;
#pragma unroll
        for (int g = 0; g < 3; ++g) { const v4u q = *(const v4u*)(AO + ((size_t)g * T + m) * 512 + 8 * lane); const float ww = wg[g] * inv;
            acc[0] += ww * bflo(q.x); acc[1] += ww * bfhi(q.x); acc[2] += ww * bflo(q.y); acc[3] += ww * bfhi(q.y); acc[4] += ww * bflo(q.z); acc[5] += ww * bfhi(q.z); acc[6] += ww * bflo(q.w); acc[7] += ww * bfhi(q.w); }
        v4u ov; ov.x = pk2(acc[0], acc[1]); ov.y = pk2(acc[2], acc[3]); ov.z = pk2(acc[4], acc[5]); ov.w = pk2(acc[6], acc[7]);
        *(v4u*)(F.YAT + (size_t)m * 512 + 8 * lane) = ov;
    }
}
constexpr int RT_MOD_OFF = 0;
constexpr int RT_W_OFF = 3 * D * 4;
constexpr int RT_INFO_OFF = RT_W_OFF + 8 * D * 4;
__device__ __forceinline__ void rt_dot8(const f32x4 (&v)[8], const LAS float* W, int lane, float (&out)[8]) {
#pragma unroll
    for (int n = 0; n < 8; ++n) { float a = 0.f;
#pragma unroll
        for (int j = 0; j < 8; ++j) { const f32x4 w = *(const LAS f32x4*)(W + n * D + 256 * j + 4 * lane); a += (v[j].x * w.x + v[j].y * w.y) + (v[j].z * w.z + v[j].w * w.w); }
        out[n] = wave_sum(a); }
}
template <bool DRY> __device__ __forceinline__ void p6_rows_router(Frame& F) {
    LAS float* L = (LAS float*)F.lds;
    LAS float* gatem = L, *shiftf = L + D, *scalef = L + 2 * D;
    LAS float* Wl = (LAS float*)(F.lds + RT_W_OFF);
    LAS float* info = (LAS float*)(F.lds + RT_INFO_OFF);
    const int lane = F.lane;
    for (int blk = F.bid; blk < T / 32; blk += F.G) {
        const int m0 = blk * 32, b = m0 / SEQ;
        __syncthreads();
        load_mod1(F, gatem, 2, b); load_mod1(F, shiftf, 3, b); load_mod1(F, scalef, 4, b);
        for (int i = F.tid; i < 8 * D / 4; i += NTHR) *(LAS f32x4*)(Wl + 4 * i) = *(const f32x4*)(F.WGT + 4 * i);
        __syncthreads();
#pragma unroll 1
        for (int ip = 0; ip < 4; ip += 2) {
            v2u yv[2][8]; f32x4 xv[2][8];
#pragma unroll
            for (int r = 0; r < 2; ++r) { const int m = m0 + 4 * F.wave + ip + r;
                const v2u* yr = (const v2u*)((const bf16*)F.Y + (size_t)m * D) + lane; const f32x4* xr = (const f32x4*)(F.x + (size_t)m * D) + lane;
#pragma unroll
                for (int j = 0; j < 8; ++j) { yv[r][j] = yr[64 * j]; xv[r][j] = xr[64 * j]; } }
#pragma unroll
            for (int r = 0; r < 2; ++r) {
                const int rl = 4 * F.wave + ip + r, m = m0 + rl;
                f32x4 v[8]; float s = 0.f;
#pragma unroll
                for (int j = 0; j < 8; ++j) { const v2u yw = yv[r][j]; v[j] = (f32x4){bflo(yw.x), bfhi(yw.x), bflo(yw.y), bfhi(yw.y)}; s += (v[j].x * v[j].x + v[j].y * v[j].y) + (v[j].z * v[j].z + v[j].w * v[j].w); }
                const float rstd = 1.0f / sqrtf(wave_sum(s) * (1.f / D) + RMS_EPS);
                float s1 = 0.f;
                f32x4* x1r = (f32x4*)(F.X1 + (size_t)m * D) + lane;
#pragma unroll
                for (int j = 0; j < 8; ++j) { const int d = 256 * j + 4 * lane;
                    const f32x4 g = *(const f32x4*)(F.g_mix_post + d), gm = *(LAS f32x4*)(gatem + d);
                    const f32x4 x1 = xv[r][j] + gm * ((v[j] * rstd) * g);
                    x1r[64 * j] = x1; v[j] = x1; s1 += (x1.x * x1.x + x1.y * x1.y) + (x1.z * x1.z + x1.w * x1.w); }
                const float rstd1 = 1.0f / sqrtf(wave_sum(s1) * (1.f / D) + RMS_EPS);
                v2u* o8 = (v2u*)(F.H2 + (size_t)m * D) + lane;
#pragma unroll
                for (int j = 0; j < 8; ++j) { const int d = 256 * j + 4 * lane;
                    const f32x4 g = *(const f32x4*)(F.g_ffn_pre + d), sc = *(LAS f32x4*)(scalef + d), sh = *(LAS f32x4*)(shiftf + d);
                    f32x4 h = (v[j] * rstd1) * g; h = h * (sc + 1.0f) + sh; v[j] = h;
                    v2u w; w.x = pk2(h.x, h.y); w.y = pk2(h.z, h.w); o8[64 * j] = w; }
                float gl[8]; rt_dot8(v, Wl, lane, gl);
                float gmax = -3.0e38f; int gi = 0;
#pragma unroll
                for (int g = 0; g < 8; ++g) { gl[g] += F.b_group[g]; if (gl[g] > gmax) { gmax = gl[g]; gi = g; } }
                float gden = 0.f;
#pragma unroll
                for (int g = 0; g < 8; ++g) gden += expf(gl[g] - gmax);
                if (lane == 0) { info[rl] = rstd1; info[32 + rl] = 1.0f / gden; ((LAS int*)info)[64 + rl] = gi; }
            }
        }
        __syncthreads();
#pragma unroll 1
        for (int g = 0; g < 8; ++g) {
            int cnt = 0;
#pragma unroll 1
            for (int rl = 0; rl < 32; ++rl) cnt += (((LAS int*)info)[64 + rl] == g) ? 1 : 0;
            if (cnt == 0) continue;
            for (int i = F.tid; i < 8 * D / 4; i += NTHR) *(LAS f32x4*)(Wl + 4 * i) = *(const f32x4*)(F.WET + (size_t)g * 8 * D + 4 * i);
            __syncthreads();
            int k = 0;
#pragma unroll 1
            for (int rl = 0; rl < 32; ++rl) {
                if (((LAS int*)info)[64 + rl] != g) continue;
                const bool mine = ((k & 7) == F.wave); ++k;
                if (!mine) continue;
                const int m = m0 + rl; const float rstd1 = info[rl], gval = info[32 + rl];
                const f32x4* x1r = (const f32x4*)(F.X1 + (size_t)m * D) + lane;
                f32x4 v[8];
#pragma unroll
                for (int j = 0; j < 8; ++j) { const int d = 256 * j + 4 * lane;
                    const f32x4 gg = *(const f32x4*)(F.g_ffn_pre + d), sc = *(LAS f32x4*)(scalef + d), sh = *(LAS f32x4*)(shiftf + d);
                    f32x4 h = (x1r[64 * j] * rstd1) * gg; v[j] = h * (sc + 1.0f) + sh; }
                float el[8]; rt_dot8(v, Wl, lane, el);
                float e0v = -3.0e38f, e1v = -3.0e38f; int e0i = 0, e1i = 0;
#pragma unroll
                for (int q = 0; q < 8; ++q) { el[q] += F.b_expert[g * 8 + q];
                    if (el[q] > e0v) { e1v = e0v; e1i = e0i; e0v = el[q]; e0i = q; } else if (el[q] > e1v) { e1v = el[q]; e1i = q; } }
                const float p1 = expf(e1v - e0v), den = 1.0f + p1;
                const float gate0 = gval / den, gate1 = gval * p1 / den;
                if (DRY) { if (gate0 + gate1 == 12345.f) F.LISTG[0] = gate0; }
                if (lane == 0 && !DRY) {
                    const int ex0 = g * 8 + e0i, ex1 = g * 8 + e1i;
                    const unsigned pos0 = atomicAdd(F.ctl + CW_CNT + ex0, 1u), pos1 = atomicAdd(F.ctl + CW_CNT + ex1, 1u);
                    F.LISTT[ex0 * T + pos0] = m; F.LISTG[ex0 * T + pos0] = gate0;
                    F.LISTT[ex1 * T + pos1] = m; F.LISTG[ex1 * T + pos1] = gate1;
                    F.ROUTE[m * 4 + 0] = (unsigned)(ex0 * T) + pos0; F.ROUTE[m * 4 + 1] = (unsigned)(ex1 * T) + pos1;
                }
            }
            __syncthreads();
        }
    }
}

__device__ __forceinline__ void moe_offsets(Frame& F, LAS int* offs  , LAS int* toff  ) {
    if (F.tid < 64) { const int c = (int)__hip_atomic_load(F.ctl + CW_CNT + F.tid, __ATOMIC_RELAXED, __HIP_MEMORY_SCOPE_AGENT); const int tc = (c + 63) / 64; int incl = c, tincl = tc;
#pragma unroll
        for (int o = 1; o < 64; o <<= 1) { const int v = __shfl_up(incl, o), tv = __shfl_up(tincl, o); if (F.tid >= o) { incl += v; tincl += tv; } }
        offs[F.tid] = incl - c; toff[F.tid] = tincl - tc; if (F.tid == 63) { offs[NE] = incl; toff[NE] = tincl; } }
    __syncthreads();
}
__device__ __forceinline__ void p7_moe1(Frame& F) {
    LAS float* L = (LAS float*)F.lds;
    LAS int* offs = (LAS int*)(L + 8192 * 3); LAS int* toff = offs + 80;
    moe_offsets(F, offs, toff);
    const int ntiles = toff[NE];
    for (int u = F.bid; u < ntiles * 8; u += F.G) {
        const int rt = u >> 3, ct = u & 7;
        int e = 0; while (toff[e + 1] <= rt) ++e;
        const int r0 = (rt - toff[e]) * 64, ne = offs[e + 1] - offs[e];
        const int* lt = F.LISTT + e * T + r0;
        const float* W1 = F.w1e + (size_t)e * D * FF + ct * 64; const float* W3 = F.w3e + (size_t)e * D * FF + ct * 64;
        const bf16* H2 = F.H2;
        auto la = [&](int r, int k) -> float { return (r0 + r < ne) ? bf2f(H2[(size_t)lt[r] * D + k]) : 0.f; };
        auto lb = [&](int q, int k, int c) -> float { return (q == 0 ? W1 : W3)[(size_t)k * FF + c]; };
        float* ACT = F.ACT + (size_t)(offs[e] + r0) * FF + ct * 64;
        auto ep = [&](int r, int c, const float (&v)[2]) { if (r0 + r < ne) { const float a = v[0], bb = v[1]; ACT[(size_t)r * FF + c] = (a / (1.0f + __expf(-a))) * bb; } };
        simt_tile<2>(L, D, F.tid, la, lb, ep);
    }
}
__device__ __forceinline__ void p8_moe2(Frame& F) {
    LAS float* L = (LAS float*)F.lds;
    LAS int* offs = (LAS int*)(L + 8192 * 3); LAS int* toff = offs + 80;
    moe_offsets(F, offs, toff);
    const int ntiles = toff[NE];
    for (int u = F.bid; u < ntiles * 32; u += F.G) {
        const int rt = u >> 5, ct = u & 31;
        int e = 0; while (toff[e + 1] <= rt) ++e;
        const int r0 = (rt - toff[e]) * 64, ne = offs[e + 1] - offs[e];
        const float* A = F.ACT + (size_t)(offs[e] + r0) * FF;
        const float* W2 = F.w2e + (size_t)e * FF * D + ct * 64;
        const float* lg = F.LISTG + e * T + r0;
        auto la = [&](int r, int k) -> float { return (r0 + r < ne) ? A[(size_t)r * FF + k] : 0.f; };
        auto lb = [&](int q, int k, int c) -> float { return W2[(size_t)k * D + c]; };
        float* YB = F.YB + (size_t)(offs[e] + r0) * D + ct * 64;
        auto ep = [&](int r, int c, const float (&v)[1]) { if (r0 + r < ne) YB[(size_t)r * D + c] = v[0] * lg[r]; };
        simt_tile<1>(L, FF, F.tid, la, lb, ep);
    }
}

template <int MODE, int VAR = 0>
__device__ __forceinline__ void moe_mfma(Frame& F) {
    constexpr int K = MODE == 0 ? D : FF, LDW = MODE == 0 ? FF : D, NSL = MODE == 0 ? 8 : 16, NK = K / 32;
    constexpr int RPP = 368, NT = 23, S = MOE_S, WST = 16384, XST = NT * 1024, STB = WST + XST;
    static_assert(S * STB <= MOE_OFFS_OFF, "MoE stage ring vs LDS map");
    typedef short bf16x8 __attribute__((ext_vector_type(8)));
    LAS unsigned char* lds = F.lds;
    LAS int* offs = (LAS int*)(lds + MOE_OFFS_OFF);
    __syncthreads();
    if (F.tid < 64) { const int c = (int)__hip_atomic_load(F.ctl + CW_CNT + F.tid, __ATOMIC_RELAXED, __HIP_MEMORY_SCOPE_AGENT); int incl = c;
#pragma unroll
        for (int o = 1; o < 64; o <<= 1) { const int v = __shfl_up(incl, o); if (F.tid >= o) incl += v; }
        offs[F.tid] = incl - c; if (F.tid == 63) offs[NE] = incl; }
    __syncthreads();
    const int lane = F.lane, w = F.wave, cq = w & 3, rh = w >> 2;
    const int vcu = (F.G % 8 == 0) ? (F.bid % 8) * (F.G / 8) + F.bid / 8 : F.bid;
    for (int u = vcu; u < NE * NSL; u += F.G) {
        const int e = u / NSL, sl = u % NSL;
        const int oe = offs[e], ne = offs[e + 1] - oe;
        if (ne == 0) continue;
        const float* Wm0; const float* Wm1;
        if (MODE == 0) { Wm0 = F.w1e + (size_t)e * D * FF + sl * 64; Wm1 = F.w3e + (size_t)e * D * FF + sl * 64; }
        else { Wm0 = F.w2e + (size_t)e * FF * D + sl * 128; Wm1 = Wm0 + 64; }
        for (int r0 = 0; r0 < ne; r0 += RPP) {
            const int nr = (ne - r0) < RPP ? (ne - r0) : RPP, ntile = (nr + 15) >> 4;
            const char* xsrc[3]; unsigned xdst[3];
#pragma unroll
            for (int i = 0; i < 3; ++i) { int tile = 3 * w + i; if (tile > NT - 1) tile = NT - 1;
                int row = r0 + 16 * tile + (lane >> 2); if (row > ne - 1) row = ne - 1;
                const size_t srow = (MODE == 0) ? (size_t)F.LISTT[e * T + row] : (size_t)(oe + row);
                xsrc[i] = (const char*)(MODE == 0 ? (const void*)F.H2 : (const void*)F.ACTB) + srow * (size_t)(K * 2) + (lane & 3) * 16;
                xdst[i] = (unsigned)(WST + tile * 1024); }
            const char* wsrc[2]; unsigned wdst[2];
#pragma unroll
            for (int i = 0; i < 2; ++i) { const int kr = 8 * (w & 3) + 4 * i;
                wsrc[i] = (const char*)((w >> 2) ? Wm1 : Wm0) + ((size_t)(kr + (lane >> 4)) * LDW) * 4 + (lane & 15) * 16;
                if (VAR == 10) wsrc[i] = (const char*)F.w1e + (size_t)(u & 255) * (K * 128 * 4) + (size_t)(2 * w + i) * 1024 + lane * 16;
                wdst[i] = (unsigned)((w >> 2) * 8192 + kr * 256); }
            asm volatile("s_waitcnt vmcnt(0)" ::: "memory");
#define MOE_ISSUE(stage, ks) do { const unsigned _sb = (unsigned)(stage) * STB; const size_t _kx = (size_t)(ks) * 64, _kw = (VAR == 10) ? (size_t)(ks) * 16384 : (size_t)(ks) * 32 * LDW * 4; \
            if (VAR < 8) { _Pragma("unroll") for (int _i = 0; _i < 3; ++_i) __builtin_amdgcn_global_load_lds((const unsigned*)(xsrc[_i] + _kx), (LAS unsigned*)(lds + _sb + xdst[_i]), 16, 0, 0); } \
                        { _Pragma("unroll") for (int _i = 0; _i < 2; ++_i) __builtin_amdgcn_global_load_lds((const unsigned*)(wsrc[_i] + _kw), (LAS unsigned*)(lds + _sb + wdst[_i]), 16, 0, 2  ); } } while (0)
            if (VAR >= 11) {
                v4u r[4][2];
#pragma unroll
                for (int q = 0; q < 4; ++q) { r[q][0] = (v4u){0u, 0u, 0u, 0u}; r[q][1] = (v4u){0u, 0u, 0u, 0u}; }
#define RS_LOAD(slot, ks) do { const size_t _kw = (size_t)(ks) * 32 * LDW * 4; _Pragma("unroll") for (int _i = 0; _i < 2; ++_i) { \
                    if (VAR == 11) asm volatile("global_load_dwordx4 %0, %1, off nt" : "+v"(r[slot][_i]) : "v"(wsrc[_i] + _kw) : "memory"); \
                    else asm volatile("global_load_dwordx4 %0, %1, off" : "+v"(r[slot][_i]) : "v"(wsrc[_i] + _kw) : "memory"); } } while (0)
                RS_LOAD(0, 0); RS_LOAD(1, 1); RS_LOAD(2, 2);
#pragma unroll 1
                for (int t = 0; t < NK; t += 4) {
#pragma unroll
                    for (int q = 0; q < 4; ++q) { asm volatile("s_waitcnt vmcnt(4)" ::: "memory"); __builtin_amdgcn_s_barrier(); const int tn = t + q + 3; RS_LOAD((q + 3) & 3, tn < NK ? tn : 0); }
                }
                asm volatile("s_waitcnt vmcnt(0)" : "+v"(r[0][0]), "+v"(r[0][1]), "+v"(r[1][0]), "+v"(r[1][1]), "+v"(r[2][0]), "+v"(r[2][1]), "+v"(r[3][0]), "+v"(r[3][1]) :: "memory");
                unsigned sk = 0u;
#pragma unroll
                for (int q = 0; q < 4; ++q) sk ^= r[q][0].x ^ r[q][1].y;
                if (sk == 0x9e3779b9u) F.ctl[200] = sk;
                __builtin_amdgcn_s_barrier();
#undef RS_LOAD
                continue;
            }
            f32x4 acc[2][12]; unsigned sink = 0u;
#pragma unroll
            for (int m = 0; m < 2; ++m)
#pragma unroll
                for (int j = 0; j < 12; ++j) acc[m][j] = (f32x4){0.f, 0.f, 0.f, 0.f};
#pragma unroll
            for (int s = 0; s < S - 1; ++s) MOE_ISSUE(s, s);
            const unsigned wrd = (unsigned)((8 * (lane >> 4)) * 256 + (16 * cq + (lane & 15)) * 4);
            const unsigned xrd = (unsigned)(WST + (lane & 15) * 64 + (lane >> 4) * 16);
#pragma unroll 1
            for (int t = 0; t < NK; ++t) {
                if (VAR >= 8) asm volatile("s_waitcnt vmcnt(4)" ::: "memory"); else
                if (S == 3) asm volatile("s_waitcnt vmcnt(5)" ::: "memory"); else asm volatile("s_waitcnt vmcnt(10)" ::: "memory");
                __builtin_amdgcn_s_barrier();
                asm volatile("" ::: "memory");
                { const int tn = t + S - 1; MOE_ISSUE((S == 4 ? (tn & 3) : (tn % S)), tn < NK ? tn : 0); }
                if (VAR >= 8) continue;
                const unsigned sb = (unsigned)(S == 4 ? (t & 3) : (t % S)) * STB;
                bf16x8 af[2];
#pragma unroll
                for (int m = 0; m < 2; ++m) { float f[8];
#pragma unroll
                    for (int j = 0; j < 8; ++j) f[j] = *(const LAS float*)(lds + sb + m * 8192 + wrd + j * 256);
                    union { bf16x8 v; unsigned u[4]; } cv;
#pragma unroll
                    for (int p = 0; p < 4; ++p) cv.u[p] = pg8::cvt_pk_bf16(f[2 * p], f[2 * p + 1]);
                    af[m] = cv.v; }
#pragma unroll
                for (int jb = 0; jb < 12; jb += 6) { bf16x8 xb[6];
#pragma unroll
                    for (int q = 0; q < 6; ++q) { int tile = 2 * (jb + q) + rh; if (tile > NT - 1) tile = NT - 1; xb[q] = *(const LAS bf16x8*)(lds + sb + xrd + tile * 1024); }
#pragma unroll
                    for (int q = 0; q < 6; ++q) { const int j = jb + q;
                        if (2 * j + rh < ntile) {
                            acc[0][j] = __builtin_amdgcn_mfma_f32_16x16x32_bf16(af[0], xb[q], acc[0][j], 0, 0, 0);
                            acc[1][j] = __builtin_amdgcn_mfma_f32_16x16x32_bf16(af[1], xb[q], acc[1][j], 0, 0, 0); } } }
            }
            asm volatile("s_waitcnt vmcnt(0)" ::: "memory");
            __builtin_amdgcn_s_barrier();
            asm volatile("" ::: "memory");
            if (VAR >= 11 && sink == 0x9e3779b9u) F.ctl[200] = sink;
#undef MOE_ISSUE
#pragma unroll
            for (int j = 0; j < 12; ++j) { const int tile = 2 * j + rh, row = r0 + 16 * tile + (lane & 15);
                if (tile < ntile && row < ne) {
                    if (MODE == 0) { const f32x4 a = acc[0][j], b = acc[1][j]; f32x4 v;
#pragma unroll
                        for (int i = 0; i < 4; ++i) v[i] = (a[i] / (1.0f + __expf(-a[i]))) * b[i];
                        v2u o; o.x = pk2(v[0], v[1]); o.y = pk2(v[2], v[3]);
                        *(v2u*)((VAR ? F.YBB : F.ACTB) + (size_t)(oe + row) * FF + sl * 64 + 16 * cq + 4 * (lane >> 4)) = o; }
                    else { const float g = F.LISTG[e * T + row]; const f32x4 a = acc[0][j] * g, b = acc[1][j] * g;
                        bf16* yp = F.YBB + (size_t)(oe + row) * D + sl * 128 + 16 * cq + 4 * (lane >> 4);
                        v2u o0; o0.x = pk2(a[0], a[1]); o0.y = pk2(a[2], a[3]); *(v2u*)yp = o0;
                        v2u o1; o1.x = pk2(b[0], b[1]); o1.y = pk2(b[2], b[3]); *(v2u*)(yp + 64) = o1; }
                } }
        }
    }
}
__device__ __forceinline__ void p9_final(Frame& F) {
    LAS float* L = (LAS float*)F.lds;
    LAS float* gatef = L;
    LAS int* offs = (LAS int*)(L + 8192 * 3); LAS int* toff = offs + 80;
    load_mod(F, gatef, 5);
    moe_offsets(F, offs, toff);
    const int gw = F.bid * NWAVES + F.wave, NGW = F.G * NWAVES;
#if MOE_SIMT
    for (int m = gw; m < T; m += NGW) {
        const int b = m / SEQ;
        const unsigned s0 = F.ROUTE[m * 4 + 0], s1 = F.ROUTE[m * 4 + 1];
        const size_t r0 = (size_t)offs[s0 / T] + (s0 % T), r1 = (size_t)offs[s1 / T] + (s1 % T);
        f32x4 v[8]; float s = 0.f;
        const f32x4* y0 = (const f32x4*)(F.YB + r0 * D) + F.lane; const f32x4* y1 = (const f32x4*)(F.YB + r1 * D) + F.lane;
#pragma unroll
        for (int j = 0; j < 8; ++j) { v[j] = y0[64 * j] + y1[64 * j]; s += (v[j].x * v[j].x + v[j].y * v[j].y) + (v[j].z * v[j].z + v[j].w * v[j].w); }
        const float rstd = 1.0f / sqrtf(wave_sum(s) * (1.f / D) + RMS_EPS);
        const f32x4* x1r = (const f32x4*)(F.X1 + (size_t)m * D) + F.lane; f32x4* outr = (f32x4*)(F.out + (size_t)m * D) + F.lane;
#pragma unroll
        for (int j = 0; j < 8; ++j) { const int d = 256 * j + 4 * F.lane;
            const f32x4 g = *(const f32x4*)(F.g_ffn_post + d), gf = *(LAS f32x4*)(gatef + b * D + d);
            outr[64 * j] = x1r[64 * j] + gf * ((v[j] * rstd) * g); }
    }
#else
    for (int m0 = gw; m0 < T; m0 += 2 * NGW) {
        unsigned sl[2][2];
#pragma unroll
        for (int r = 0; r < 2; ++r) { const int m = m0 + r * NGW; if (m < T) { sl[r][0] = F.ROUTE[m * 4 + 0]; sl[r][1] = F.ROUTE[m * 4 + 1]; } else { sl[r][0] = 0; sl[r][1] = 0; } }
        v2u ya[2][8], yb[2][8]; f32x4 xv[2][8];
#pragma unroll
        for (int r = 0; r < 2; ++r) { const int m = m0 + r * NGW; if (m < T) {
            const size_t r0 = (size_t)offs[sl[r][0] / T] + (sl[r][0] % T), r1 = (size_t)offs[sl[r][1] / T] + (sl[r][1] % T);
            const v2u* y0 = (const v2u*)(F.YBB + r0 * D) + F.lane; const v2u* y1 = (const v2u*)(F.YBB + r1 * D) + F.lane; const f32x4* x1r = (const f32x4*)(F.X1 + (size_t)m * D) + F.lane;
#pragma unroll
            for (int j = 0; j < 8; ++j) { ya[r][j] = y0[64 * j]; yb[r][j] = y1[64 * j]; xv[r][j] = x1r[64 * j]; } } }
#pragma unroll
        for (int r = 0; r < 2; ++r) { const int m = m0 + r * NGW; if (m < T) { const int b = m / SEQ; f32x4 v[8]; float s = 0.f;
#pragma unroll
            for (int j = 0; j < 8; ++j) { const v2u a = ya[r][j], b2 = yb[r][j];
                v[j] = (f32x4){bflo(a.x) + bflo(b2.x), bfhi(a.x) + bfhi(b2.x), bflo(a.y) + bflo(b2.y), bfhi(a.y) + bfhi(b2.y)};
                s += (v[j].x * v[j].x + v[j].y * v[j].y) + (v[j].z * v[j].z + v[j].w * v[j].w); }
            const float rstd = 1.0f / sqrtf(wave_sum(s) * (1.f / D) + RMS_EPS);
            f32x4* outr = (f32x4*)(F.out + (size_t)m * D) + F.lane;
#pragma unroll
            for (int j = 0; j < 8; ++j) { const int d = 256 * j + 4 * F.lane;
                const f32x4 g = *(const f32x4*)(F.g_ffn_post + d), gf = *(LAS f32x4*)(gatef + b * D + d);
                outr[64 * j] = xv[r][j] + gf * ((v[j] * rstd) * g); } } }
    }
#endif
}

#if SIMPLE_GEMM
template <class EP>
__device__ __forceinline__ void simple_gemm(Frame& F, const bf16* A, const bf16* Bt, int M, int N, int K, const EP& ep) {
    LAS float* L = (LAS float*)F.lds;
    const int tn = N / 64, nt = (M / 64) * tn;
    for (int u = F.bid; u < nt; u += F.G) {
        const int r0 = (u / tn) * 64, c0 = (u % tn) * 64;
        auto la = [&](int r, int k) -> float { return bf2f(A[(size_t)(r0 + r) * K + k]); };
        auto lb = [&](int q, int k, int c) -> float { return bf2f(Bt[(size_t)(c0 + c) * K + k]); };
        auto e2 = [&](int r, int c, const float (&v)[1]) { ep(r0 + r, c0 + c, v[0]); };
        simt_tile<1>(L, K, F.tid, la, lb, e2);
    }
}
#endif

#ifndef REPEAT_MASK
#define REPEAT_MASK 0
#endif
__device__ __forceinline__ void phase_gemm2(Frame& F) {
#if SIMPLE_GEMM
        { bf16* PHY = F.PHY; simple_gemm(F, F.W1T, F.H, 3 * HW, T, D, [&](int r, int c, float v) { PHY[(size_t)r * T + c] = (bf16)f2bf(v); }); }
        __syncthreads();
        { bf16* QKVp = F.QKV; bf16* Gp = F.GT; const float* bias = F.b_bg;
          simple_gemm(F, F.H, F.W1T + (size_t)(3 * HW) * D, T, QKVW + 2 * D, D, [&](int r, int c, float v) {
              if (c < QKVW) QKVp[(size_t)r * QKVW + c] = (bf16)f2bf(v); else Gp[(size_t)r * (2 * D) + (c - QKVW)] = (bf16)f2bf(1.0f / (1.0f + __expf(-(v + bias[c - QKVW])))); }); }
#else
        { DualOrder S; S.s0.init(3 * HW, T, 1, 0); S.s1.init(T, QKVW + 2 * D, 1, 0); S.G = F.G; S.c = F.bid;
          S.A0 = F.W1T; S.B0 = F.H; S.A1 = F.H; S.B1 = F.W1T + (size_t)(3 * HW) * D;
          EpiDual E{EpiPlainBf16{F.PHY, T}, EpiProj{F.QKV, F.GT, F.ROT, F.b_bg}};
          pg8::Gemm g{F.H, F.H, T, T, D};
          pg8::gemm_phase<EpiDual, DualOrder, true, true>(F.lds, g, S, E); }
#endif
}
__device__ __forceinline__ void phase_gemm6(Frame& F) {
#if SIMPLE_GEMM
        { float* TMP = F.TMP; const bf16* G = F.GT; simple_gemm(F, F.YHY, F.WHYOT, T, D, HW, [&](int r, int c, float v) { TMP[(size_t)r * D + c] = v * bf2f(G[(size_t)r * (2 * D) + c]); }); }
        __syncthreads();
        { float* TMP = F.TMP; const bf16* G = F.GT; bf16* Mp = F.MERGED; simple_gemm(F, F.YAT, F.WATOT, T, D, 512, [&](int r, int c, float v) { Mp[(size_t)r * D + c] = (bf16)f2bf(TMP[(size_t)r * D + c] + v * bf2f(G[(size_t)r * (2 * D) + D + c])); }); }
#else
        { EpiGate<0> E{F.GT, 0, F.TMP, F.MERGED}; run_gemm(F, F.YHY, F.WHYOT, T, D, HW, E); }
        { EpiGate<1> E{F.GT, D, F.TMP, F.MERGED}; run_gemm(F, F.YAT, F.WATOT, T, D, 512, E); }
#endif
}
__device__ __forceinline__ void phase_gemm7(Frame& F) {
#if SIMPLE_GEMM
        { float* Y = F.Y; simple_gemm(F, F.MERGED, F.WOUTT, T, D, D, [&](int r, int c, float v) { Y[(size_t)r * D + c] = v; }); }
#else
        { EpiPlainBf16 E{(bf16*)F.Y, D}; run_gemm(F, F.MERGED, F.WOUTT, T, D, D, E); }
#endif
}
__global__ void __launch_bounds__(NTHR, 2) fwd_kernel(Args args) {
    extern __shared__ __attribute__((aligned(16))) unsigned char lds_raw[];
    Frame F;
    F.lds = (LAS unsigned char*)lds_raw;
    F.tid = threadIdx.x; F.lane = F.tid & 63; F.wave = __builtin_amdgcn_readfirstlane(F.tid >> 6); F.G = gridDim.x; F.bid = blockIdx.x;
    F.x = (const float*)args.in[0]; F.c = (const float*)args.in[1]; F.positions = (const int*)args.in[2]; F.w_ada = (const float*)args.in[3]; F.b_ada = (const float*)args.in[4];
    F.g_mix_pre = (const float*)args.in[5]; F.g_mix_post = (const float*)args.in[6]; F.g_ffn_pre = (const float*)args.in[7]; F.g_ffn_post = (const float*)args.in[8];
    F.w_in = (const float*)args.in[9]; F.conv_w = (const float*)args.in[10]; F.conv_b = (const float*)args.in[11]; F.fw1 = (const float*)args.in[12]; F.fb1 = (const float*)args.in[13];
    F.fw2 = (const float*)args.in[14]; F.fb2 = (const float*)args.in[15]; F.fw3 = (const float*)args.in[16]; F.ffreq = (const float*)args.in[17]; F.hskip = (const float*)args.in[18];
    F.w_bg = (const float*)args.in[19]; F.b_bg = (const float*)args.in[20]; F.w_hy_o = (const float*)args.in[21]; F.w_at_o = (const float*)args.in[22]; F.w_out = (const float*)args.in[23];
    F.w_group = (const float*)args.in[24]; F.b_group = (const float*)args.in[25]; F.w_expert = (const float*)args.in[26]; F.b_expert = (const float*)args.in[27];
    F.w1e = (const float*)args.in[28]; F.w3e = (const float*)args.in[29]; F.w2e = (const float*)args.in[30];
    F.out = args.out;
    unsigned char* ws = args.ws;
    F.ctl = (unsigned*)(ws + WS_CTL); F.MODP = (float*)(ws + WS_MODP); F.HID2 = (float*)(ws + WS_HID2); F.ROT = (float*)(ws + WS_ROT); F.W3T = (float*)(ws + WS_W3T);
    F.WGT = (float*)(ws + WS_WGT); F.WET = (float*)(ws + WS_WET); F.HID2B = (bf16*)(ws + WS_HID2B); F.W3TB = (bf16*)(ws + WS_W3TB);
    F.ROUTE = (unsigned*)(ws + WS_ROUTE); F.LISTT = (int*)(ws + WS_LISTT); F.LISTG = (float*)(ws + WS_LISTG);
    F.W1T = (bf16*)(ws + WS_W1T); F.WHYOT = (bf16*)(ws + WS_WHYOT); F.WATOT = (bf16*)(ws + WS_WATOT); F.WOUTT = (bf16*)(ws + WS_WOUTT);
    F.KF = (bf16*)(ws + WS_KF); F.H = (bf16*)(ws + WS_H); F.PHY = (bf16*)(ws + WS_PHY); F.QKV = (bf16*)(ws + WS_QKV); F.GT = (bf16*)(ws + WS_G);
    F.YHY = (bf16*)(ws + WS_YHY); F.YAT = (bf16*)(ws + WS_YAT); F.TMP = (float*)(ws + WS_TMP); F.MERGED = (bf16*)(ws + WS_MERGED); F.Y = (float*)(ws + WS_Y);
    F.X1 = (float*)(ws + WS_X1); F.H2 = (bf16*)(ws + WS_H2); F.ACT = (float*)(ws + WS_ACT); F.YB = (float*)(ws + WS_YB); F.ACTB = (bf16*)(ws + WS_ACT); F.YBB = (bf16*)(ws + WS_YB);

    volatile LAS unsigned* MISC = (volatile LAS unsigned*)(F.lds + MISC_OFF);
    if (F.tid < 32) MISC[F.tid] = 0u;
    __syncthreads();
    const int lo = args.ph_lo, hi = args.ph_hi;
    const bool multi = (hi - lo) > 1;
#if TLB_TOUCH
    {
        unsigned acc = 0u; const int sub = F.bid >> 3;
        const size_t nws = WS_END >> 21;
        for (size_t p = (size_t)sub * 16 + (F.tid >> 5); p < nws; p += 512) if ((F.tid & 31) == 0) acc += *(const volatile unsigned*)(ws + (p << 21));
        const void* big[8] = {args.in[0], args.in[3], args.in[9], args.in[19], args.in[23], args.in[28], args.in[29], args.in[30]};
        const size_t bsz[8] = {(size_t)T * D * 4, (size_t)D * 6 * D * 4, (size_t)D * INW * 4, (size_t)D * 2 * D * 4, (size_t)D * D * 4, (size_t)NE * D * FF * 4, (size_t)NE * D * FF * 4, (size_t)NE * D * FF * 4};
#pragma unroll
        for (int q = 0; q < 8; ++q) { const size_t np = bsz[q] >> 21;
            for (size_t p = (size_t)sub * 16 + (F.tid >> 5); p < np; p += 512) if ((F.tid & 31) == 0) acc += *(const volatile unsigned*)((const unsigned char*)big[q] + (p << 21)); }
        if (acc == 0x12345679u) F.ctl[100] = acc;
    }
#endif
    XcdBarrier bar; bar.bar = F.ctl + CW_BAR; bar.x = 0; bar.st = nullptr;
    if (multi) bar = xcd_barrier_post(F.ctl + CW_BAR, MISC + 8);
#ifndef PHASE_MASK
#define PHASE_MASK 0xFFFF
#endif
#define IN(k) ((((PHASE_MASK) >> (k)) & 1) && lo <= (k) && (k) < hi)
#ifndef REPEAT_MASK
#define REPEAT_MASK 0
#endif
#define REP(k) for (int _rep = 0; _rep < 1 + (((REPEAT_MASK) >> (k)) & 1); ++_rep)
#define SEAM(k) do { if (IN(k) && IN((k) + 1)) xcd_barrier(bar); } while (0)

#ifndef P0_SKIP
#define P0_SKIP 0
#endif
    if (IN(0)) { p0_prologue<0>(F); if ((REPEAT_MASK) & 1) { __syncthreads(); p0_prologue<P0_SKIP>(F); } } SEAM(0);
    if (IN(1)) REP(1) { __syncthreads(); p1_rows_filters(F); } SEAM(1);
    if (IN(2)) { phase_gemm2(F); if (((REPEAT_MASK) >> 2) & 1) { __syncthreads(); phase_gemm2(F); } } SEAM(2);
    if (IN(3)) {
#if SIMPLE_GEMM
        for (int i = F.bid * NTHR + F.tid; i < T * 24 * 16; i += F.G * NTHR) { const int k = i & 15, hd = (i >> 4) % 24, tok = (i >> 4) / 24;
            bf16* p = F.QKV + (size_t)tok * QKVW + hd * HD; const float a = bf2f(p[k]), b2 = bf2f(p[k + 16]), cs = F.ROT[tok * 32 + k], sn = F.ROT[tok * 32 + 16 + k];
            p[k] = (bf16)f2bf(a * cs - b2 * sn); p[k + 16] = (bf16)f2bf(b2 * cs + a * sn); }
#endif
    }
#if SIMPLE_GEMM
    SEAM(3);
#endif
#if HYENA_NAIVE
    if (IN(4)) { p3_hyena_naive(F); __syncthreads(); p3_attn_naive(F); } SEAM(4);
#elif ATTN_NAIVE
    if (IN(4)) { p3_hyena_mfma(F); __syncthreads(); p3_attn_naive(F); } SEAM(4);
#else
#ifndef P4_PARTS
#define P4_PARTS 3
#endif
    if (IN(4)) REP(4) { __syncthreads(); if (P4_PARTS & 1) p3_hyena_mfma(F); __syncthreads(); if (P4_PARTS & 2) p4_attn_mfma(F);
#if ATTN_REP
        __syncthreads(); p4_attn_mfma(F);
#endif
    } SEAM(4);
    if (IN(5)) REP(5) { p4b_combine(F); } SEAM(5);
#endif
    if (IN(6)) { phase_gemm6(F); if (((REPEAT_MASK) >> 6) & 1) { __syncthreads(); phase_gemm6(F); } } SEAM(6);
    if (IN(7)) { phase_gemm7(F); if (((REPEAT_MASK) >> 7) & 1) { __syncthreads(); phase_gemm7(F); } } SEAM(7);
#ifndef EXTRA_BARRIERS
#define EXTRA_BARRIERS 0
#endif
    if (IN(8)) { if (((REPEAT_MASK) >> 8) & 1) { p6_rows_router<true>(F); __syncthreads(); } for (int _e = 0; _e < EXTRA_BARRIERS; ++_e) xcd_barrier(bar); p6_rows_router<false>(F); } SEAM(8);
#if MOE_SIMT
    if (IN(9)) { p7_moe1(F); } SEAM(9);
    if (IN(10)) { p8_moe2(F); } SEAM(10);
#else
#ifndef MOE_SHADOW
#define MOE_SHADOW 0
#endif
    if (IN(9)) { if (MOE_SHADOW) { moe_mfma<0, (MOE_SHADOW ? MOE_SHADOW : 8)>(F); __syncthreads(); } } if (IN(9)) REP(9) { moe_mfma<0>(F); } SEAM(9);
    if (IN(10)) REP(10) { moe_mfma<1>(F); } SEAM(10);
#endif
    if (IN(11)) REP(11) { __syncthreads(); p9_final(F); }
#undef IN
#undef SEAM
}

extern "C" void kernel_launch(void* const* d_in, const int* in_sizes, int n_in, void* d_out, int out_size, void* d_ws, size_t ws_size, hipStream_t stream) {
    static int grid = 0;
    if (grid == 0) {
        if (n_in != 31 || out_size != T * D || ws_size < WS_END) { fprintf(stderr, "kernel_launch: unexpected shapes (n_in %d out %d ws %zu)\n", n_in, out_size, ws_size); grid = -1; return; }
        int dev = 0, cus = 0, per_cu = 0;
        if (hipGetDevice(&dev) != hipSuccess || hipDeviceGetAttribute(&cus, hipDeviceAttributeMultiprocessorCount, dev) != hipSuccess) { grid = -1; return; }
        if (hipFuncSetAttribute((const void*)fwd_kernel, hipFuncAttributeMaxDynamicSharedMemorySize, LDS_BYTES) != hipSuccess) { fprintf(stderr, "kernel_launch: hipFuncSetAttribute failed\n"); grid = -1; return; }
        if (hipOccupancyMaxActiveBlocksPerMultiprocessor(&per_cu, (const void*)fwd_kernel, NTHR, LDS_BYTES) != hipSuccess || per_cu < 1) fprintf(stderr, "kernel_launch: occupancy query says %d\n", per_cu);
        (void)hipGetLastError();
        grid = cus;
    }
    if (grid < 0) return;
    if (hipMemsetAsync((char*)d_ws + WS_CTL, 0, CTL_ZERO_BYTES, stream) != hipSuccess) return;
    Args a{};
    for (int i = 0; i < 31; ++i) a.in[i] = d_in[i];
    a.out = (float*)d_out; a.ws = (unsigned char*)d_ws;
#if N_LAUNCH_MODE == 1
    a.ph_lo = 0; a.ph_hi = NPHASE;
    hipLaunchKernelGGL(fwd_kernel, dim3(grid), dim3(NTHR), LDS_BYTES, stream, a);
#else
    for (int p = 0; p < NPHASE; ++p) { if (p == 3 && !SIMPLE_GEMM) continue; if (p == 5 && (HYENA_NAIVE || ATTN_NAIVE)) continue; a.ph_lo = p; a.ph_hi = p + 1; hipLaunchKernelGGL(fwd_kernel, dim3(grid), dim3(NTHR), LDS_BYTES, stream, a); }
#endif
}
```

```cpp
#include <hip/hip_runtime.h>
#include <cstdio>
#include <cstdint>
namespace pg8 {
#define PG8_LAS __attribute__((address_space(3)))
typedef unsigned short bf16_t;
typedef short bf16x8 __attribute__((ext_vector_type(8)));
typedef float f32x4 __attribute__((ext_vector_type(4)));
typedef unsigned u32x4 __attribute__((ext_vector_type(4)));
constexpr int BM = 256, BK = 64, HALF = 128, HTB = HALF * BK * 2  , STAGE_BYTES = 8 * HTB, NXCD = 8, WGM = 8;

__host__ __device__ __forceinline__ int lds_byte(int r, int c) { const int st = (r >> 4) * 2 + (c >> 5), rr = r & 15, cc = c & 31, ob = rr * 64 + cc * 2; return st * 1024 + (ob ^ (((ob >> 9) & 1) << 5)); }
__host__ __device__ __forceinline__ void stage_rc(int b, int& R, int& C) { const int st = b / 1024, sb = b % 1024, swz = sb ^ (((sb >> 9) & 1) << 5); R = (st >> 1) * 16 + swz / 64; C = (st & 1) * 32 + (swz % 64) / 2; }
__host__ __device__ __forceinline__ int perm32(int rho) { const int n = rho >> 4, i = rho & 15; return 8 * (i >> 2) + 4 * n + (i & 3); }

struct Unit { int pm, pn, kind; };
struct Gemm { const bf16_t* A; const bf16_t* Bt; int M, N, K; };

struct StaticOrder {
    int nM, nN, nwg, G, c;
    __host__ __device__ void init(int M, int N, int G_, int c_) { nM = M / BM; nN = N / BM; nwg = nM * nN; G = G_; c = c_; }
    __host__ __device__ bool next(int i, Unit& u) const {
        const long L = (long)i * G + c; if (L >= nwg) return false;
        int wgid = (int)L; { const int q = nwg / NXCD, r = nwg % NXCD, xcd = wgid % NXCD, off = wgid / NXCD; wgid = (xcd < r ? xcd * (q + 1) : r * (q + 1) + (xcd - r) * q) + off; }
        const int nig = WGM * nN, gid = wgid / nig, fm = gid * WGM, gsz = (nM - fm) < WGM ? (nM - fm) : WGM;
        u.pm = fm + ((wgid % nig) % gsz); u.pn = (wgid % nig) / gsz; u.kind = 0; return true;
    }
    __device__ __forceinline__ void a_ready(const Unit&) const {}
    __device__ __forceinline__ void done(const Unit&) const {}
    __device__ __forceinline__ const bf16_t* abase(const Gemm& g, const Unit&) const { return g.A; }
    __device__ __forceinline__ const bf16_t* bbase(const Gemm& g, const Unit&) const { return g.Bt; }
};

__device__ __forceinline__ unsigned cvt_pk_bf16(float lo, float hi) { unsigned r; asm volatile("v_cvt_pk_bf16_f32 %0, %1, %2" : "=v"(r) : "v"(lo), "v"(hi)); return r; }
typedef float f32x2 __attribute__((ext_vector_type(2)));
template <class Epi, class Sched, bool ALIGN_EPI = false, bool SP2 = false>
__device__ __forceinline__ void gemm_phase(PG8_LAS unsigned char* lds, const Gemm g, const Sched& S, const Epi& E) {
    const int tid = threadIdx.x, wid = __builtin_amdgcn_readfirstlane(tid >> 6), lane = tid & 63, wr = wid >> 2, wc = wid & 3, fr = lane & 15, fq = lane >> 4;
    const int K = g.K, nt = K / BK;
    unsigned voffA[2], voffB[2];
#pragma unroll
    for (int i = 0; i < 2; ++i) { int R, C; stage_rc(tid * 16 + i * 8192, R, C); const int Rb = Epi::PERM ? ((R & ~31) + perm32(R & 31)) : R;
        voffA[i] = (unsigned)(R * K + C) * 2u; voffB[i] = (unsigned)(Rb * K + C) * 2u; }
    const size_t kstep = (size_t)(BK * 2);
    const size_t hstep = (size_t)HALF * K * 2;
    const size_t tstep = 2 * hstep;
    const unsigned ldsw = (unsigned)wid * 1024u;
    const int aoff = lds_byte(wr * 64 + fr, fq * 8), boff = lds_byte(wc * 32 + fr, fq * 8);
#define PG8_SA(b, h) (((b) * 2 + (h)) * HTB)
#define PG8_SB(b, h) ((4 + (b) * 2 + (h)) * HTB)
#define PG8_STAGE(bufoff, gbase, voff) do { _Pragma("unroll") for (int _i = 0; _i < 2; ++_i) \
        __builtin_amdgcn_global_load_lds((const unsigned*)((const char*)(gbase) + (voff)[_i]), (PG8_LAS unsigned*)(lds + (bufoff) + ldsw + _i * 8192), 16, 0, 0); } while (0)
#define PG8_LDA(dst, b, h) do { _Pragma("unroll") for (int m = 0; m < 4; ++m) _Pragma("unroll") for (int k = 0; k < 2; ++k) dst[m][k] = *(const PG8_LAS bf16x8*)(lds + PG8_SA(b, h) + aoff + m * 2048 + k * 1024); } while (0)
#define PG8_LDB(dst, b, h) do { _Pragma("unroll") for (int n = 0; n < 2; ++n) _Pragma("unroll") for (int k = 0; k < 2; ++k) dst[n][k] = *(const PG8_LAS bf16x8*)(lds + PG8_SB(b, h) + boff + n * 2048 + k * 1024); } while (0)
#define PG8_MMA(ai, bj, At, Bt) do { __builtin_amdgcn_s_setprio(1); _Pragma("unroll") for (int m = 0; m < 4; ++m) _Pragma("unroll") for (int n = 0; n < 2; ++n) _Pragma("unroll") for (int k = 0; k < 2; ++k) \
        acc[ai][bj][m][n] = __builtin_amdgcn_mfma_f32_16x16x32_bf16(Bt[n][k], At[m][k], acc[ai][bj][m][n], 0, 0, 0); __builtin_amdgcn_s_setprio(0); } while (0)
#define PG8_WAIT_V(n) asm volatile("s_waitcnt vmcnt(" #n ")" ::: "memory")
#define PG8_WAIT_L(n) asm volatile("s_waitcnt lgkmcnt(" #n ")" ::: "memory")
#define PG8_BAR __builtin_amdgcn_s_barrier()
#define PG8_SCHED __builtin_amdgcn_sched_barrier(0)
    Unit cur, nxt; int ui = 0;
    if (!S.next(0, cur)) return;
    f32x4 acc[2][2][4][2];
#pragma unroll
    for (int a = 0; a < 2; ++a)
#pragma unroll
        for (int b = 0; b < 2; ++b)
#pragma unroll
            for (int m = 0; m < 4; ++m)
#pragma unroll
                for (int n = 0; n < 2; ++n) acc[a][b][m][n] = (f32x4){0.f, 0.f, 0.f, 0.f};
    bf16x8 At[4][2], B0[2][2], B1[2][2];
    const char* cA = (const char*)S.abase(g, cur) + (size_t)cur.pm * tstep; const char* cB = (const char*)S.bbase(g, cur) + (size_t)cur.pn * tstep;
    S.a_ready(cur);
    if constexpr (SP2) {
        PG8_STAGE(PG8_SB(0, 0), cB, voffB); PG8_STAGE(PG8_SB(0, 1), cB + hstep, voffB); PG8_STAGE(PG8_SA(0, 0), cA, voffA); PG8_STAGE(PG8_SA(0, 1), cA + hstep, voffA);
        if (wr == 1) PG8_BAR;
        PG8_WAIT_V(2); PG8_BAR;
        PG8_STAGE(PG8_SB(1, 0), cB + kstep, voffB); PG8_STAGE(PG8_SA(1, 0), cA + kstep, voffA); PG8_STAGE(PG8_SB(1, 1), cB + hstep + kstep, voffB);
        PG8_WAIT_V(6); PG8_BAR;
    } else {
        PG8_STAGE(PG8_SB(0, 0), cB, voffB); PG8_STAGE(PG8_SA(0, 0), cA, voffA); PG8_STAGE(PG8_SB(0, 1), cB + hstep, voffB); PG8_STAGE(PG8_SA(0, 1), cA + hstep, voffA);
        if (wr == 1) PG8_BAR;
        PG8_WAIT_V(4); PG8_BAR;
        PG8_STAGE(PG8_SB(1, 0), cB + kstep, voffB); PG8_STAGE(PG8_SA(1, 0), cA + kstep, voffA); PG8_STAGE(PG8_SB(1, 1), cB + hstep + kstep, voffB);
        PG8_WAIT_V(6); PG8_BAR;
    }
    for (;;) {
        const bool has_next = S.next(ui + 1, nxt);
        const char* nA = has_next ? (const char*)S.abase(g, nxt) + (size_t)nxt.pm * tstep : cA; const char* nB = has_next ? (const char*)S.bbase(g, nxt) + (size_t)nxt.pn * tstep : cB;
        asm volatile(".p2align 8" ::: "memory");
        for (int t = 0; t < nt; t += 2) {
            const bool last = (t == nt - 2);
            const char* a1 = cA + (size_t)(t + 1) * kstep;
            const char* a2 = last ? nA : cA + (size_t)(t + 2) * kstep; const char* b2 = last ? nB : cB + (size_t)(t + 2) * kstep;
            const char* a3 = a2 + kstep; const char* b3 = b2 + kstep;
            if (last && has_next) S.a_ready(nxt);
            if constexpr (SP2) {
            PG8_LDB(B0, 0, 0); PG8_LDB(B1, 0, 1); PG8_SCHED; PG8_LDA(At, 0, 0); PG8_STAGE(PG8_SA(1, 1), a1 + hstep, voffA);
            PG8_WAIT_V(8); PG8_WAIT_L(0); PG8_BAR; PG8_MMA(0, 0, At, B0); PG8_MMA(0, 1, At, B1); PG8_BAR; PG8_SCHED;
            PG8_LDA(At, 0, 1); PG8_STAGE(PG8_SB(0, 0), b2, voffB); PG8_STAGE(PG8_SB(0, 1), b2 + hstep, voffB); PG8_STAGE(PG8_SA(0, 0), a2, voffA);
            PG8_WAIT_V(8); PG8_WAIT_L(0); PG8_BAR; PG8_MMA(1, 0, At, B0); PG8_MMA(1, 1, At, B1); PG8_BAR; PG8_SCHED;
            PG8_LDB(B0, 1, 0); PG8_LDB(B1, 1, 1); PG8_SCHED; PG8_LDA(At, 1, 0); PG8_STAGE(PG8_SA(0, 1), a2 + hstep, voffA);
            PG8_WAIT_V(8); PG8_WAIT_L(0); PG8_BAR; PG8_MMA(0, 0, At, B0); PG8_MMA(0, 1, At, B1); PG8_BAR; PG8_SCHED;
            PG8_LDA(At, 1, 1); PG8_STAGE(PG8_SB(1, 0), b3, voffB); PG8_STAGE(PG8_SB(1, 1), b3 + hstep, voffB); PG8_STAGE(PG8_SA(1, 0), a3, voffA);
            PG8_WAIT_V(8); PG8_WAIT_L(0); PG8_BAR; PG8_MMA(1, 0, At, B0); PG8_MMA(1, 1, At, B1); PG8_BAR; PG8_SCHED;
            } else {
            PG8_LDB(B0, 0, 0); PG8_SCHED; PG8_LDA(At, 0, 0); PG8_STAGE(PG8_SA(1, 1), a1 + hstep, voffA);
            PG8_WAIT_L(8); PG8_BAR; PG8_WAIT_L(0); PG8_MMA(0, 0, At, B0); PG8_BAR; PG8_SCHED;
            PG8_LDB(B1, 0, 1); PG8_STAGE(PG8_SB(0, 0), b2, voffB);
            PG8_BAR; PG8_WAIT_L(0); PG8_MMA(0, 1, At, B1); PG8_BAR;
            PG8_LDA(At, 0, 1); PG8_STAGE(PG8_SA(0, 0), a2, voffA);
            PG8_BAR; PG8_WAIT_L(0); PG8_MMA(1, 0, At, B0); PG8_BAR; PG8_SCHED;
            PG8_STAGE(PG8_SB(0, 1), b2 + hstep, voffB);
            PG8_WAIT_V(6); PG8_BAR; PG8_MMA(1, 1, At, B1); PG8_BAR;
            PG8_LDB(B0, 1, 0); PG8_SCHED; PG8_LDA(At, 1, 0); PG8_STAGE(PG8_SA(0, 1), a2 + hstep, voffA);
            PG8_WAIT_L(8); PG8_BAR; PG8_WAIT_L(0); PG8_MMA(0, 0, At, B0); PG8_BAR; PG8_SCHED;
            PG8_LDB(B1, 1, 1); PG8_STAGE(PG8_SB(1, 0), b3, voffB);
            PG8_BAR; PG8_WAIT_L(0); PG8_MMA(0, 1, At, B1); PG8_BAR;
            PG8_LDA(At, 1, 1); PG8_STAGE(PG8_SA(1, 0), a3, voffA);
            PG8_BAR; PG8_WAIT_L(0); PG8_MMA(1, 0, At, B0); PG8_BAR; PG8_SCHED;
            PG8_STAGE(PG8_SB(1, 1), b3 + hstep, voffB);
            PG8_WAIT_V(6); PG8_BAR; PG8_MMA(1, 1, At, B1); PG8_BAR;
            }
        }
        if constexpr (ALIGN_EPI) { if (wr == 0) PG8_BAR; }
        if constexpr (!Epi::AFTER_DRAIN) { E(acc, cur, wr, wc, fr, fq); S.done(cur); }
        if (!has_next) break;
#pragma unroll
        for (int a = 0; a < 2; ++a)
#pragma unroll
            for (int b = 0; b < 2; ++b)
#pragma unroll
                for (int m = 0; m < 4; ++m)
#pragma unroll
                    for (int n = 0; n < 2; ++n) acc[a][b][m][n] = (f32x4){0.f, 0.f, 0.f, 0.f};
        cur = nxt; cA = nA; cB = nB; ++ui;
        if constexpr (ALIGN_EPI) { if (wr == 1) PG8_BAR; }
    }
    PG8_WAIT_V(0);
    if constexpr (!ALIGN_EPI) { if (wr == 0) PG8_BAR; }
    PG8_BAR;
    if constexpr (Epi::AFTER_DRAIN) { E.fused(acc, cur, wr, wc, fr, fq, lds, wid, lane); S.done(cur); }
#undef PG8_SA
#undef PG8_SB
#undef PG8_STAGE
#undef PG8_LDA
#undef PG8_LDB
#undef PG8_MMA
#undef PG8_WAIT_V
#undef PG8_WAIT_L
#undef PG8_BAR
#undef PG8_SCHED
}
}


#ifndef N_LAUNCH_MODE
#define N_LAUNCH_MODE 1
#endif
#ifndef MOE_SIMT
#define MOE_SIMT 0
#endif
#ifndef HYENA_NAIVE
#define HYENA_NAIVE 0
#endif
#ifndef ATTN_NAIVE
#define ATTN_NAIVE 0
#endif
#ifndef TLB_TOUCH
#define TLB_TOUCH 0
#endif
#ifndef DUAL_BIG_FIRST
#define DUAL_BIG_FIRST 1
#endif
#ifndef MOE_S
#define MOE_S 4
#endif
#ifndef HY_REP
#define HY_REP 0
#endif
#ifndef ATTN_REP
#define ATTN_REP 0
#endif
#ifndef SIMPLE_GEMM
#define SIMPLE_GEMM 0
#endif

constexpr int D = 2048, BATCH = 2, SEQ = 4096, T = BATCH * SEQ;
constexpr int HW = 1024;
constexpr int NH = 12, HD = 128, QKVW = 3 * NH * HD;
constexpr int INW = 3 * HW + QKVW;
constexpr int N1 = INW + 2 * D;
constexpr int NE = 64, FF = 512;
constexpr float RMS_EPS = 1e-6f;
constexpr int NWAVES = 8, NTHR = 512;
constexpr int NPHASE = 12;

constexpr size_t MiB = 1u << 20;
constexpr size_t WS_CTL = 0, CTL_ZERO_BYTES = 128 * 1024;
constexpr size_t WS_MODP = 1 * MiB;
constexpr size_t WS_HID2 = 2 * MiB;
constexpr size_t WS_ROT = 3 * MiB;
constexpr size_t WS_W3T = 4 * MiB;
constexpr size_t WS_ROUTE = 5 * MiB;
constexpr size_t WS_LISTT = 6 * MiB;
constexpr size_t WS_LISTG = 8 * MiB;
constexpr size_t WS_WGT = 10 * MiB;
constexpr size_t WS_WET = 11 * MiB;
constexpr size_t WS_HID2B = 12 * MiB;
constexpr size_t WS_W3TB = 13 * MiB;
constexpr size_t WS_W1T = 16 * MiB;
constexpr size_t WS_WHYOT = 64 * MiB;
constexpr size_t WS_WATOT = 68 * MiB;
constexpr size_t WS_WOUTT = 70 * MiB;
constexpr size_t WS_KF = 80 * MiB;
constexpr size_t WS_H = 144 * MiB;
constexpr size_t WS_PHY = 176 * MiB;
constexpr size_t WS_QKV = 224 * MiB;
constexpr size_t WS_G = 296 * MiB;
constexpr size_t WS_YHY = 360 * MiB;
constexpr size_t WS_YAT = 376 * MiB;
constexpr size_t WS_TMP = 384 * MiB;
constexpr size_t WS_MERGED = 448 * MiB;
constexpr size_t WS_Y = 480 * MiB;
constexpr size_t WS_X1 = 544 * MiB;
constexpr size_t WS_H2 = 608 * MiB;
constexpr size_t WS_ACT = 640 * MiB;
constexpr size_t WS_YB = 672 * MiB;
constexpr size_t WS_END = 800 * MiB;
constexpr int CW_BAR = 4096;
constexpr int CW_CNT = 16384, CNT_STRIDE = 64;

constexpr int RING_BYTES = 131072;
constexpr int LDS_BYTES = 163840;
constexpr int MISC_OFF = LDS_BYTES - 256;
constexpr int MOE_OFFS_OFF = LDS_BYTES - 1024;

#define GAS __attribute__((address_space(1)))
#define LAS __attribute__((address_space(3)))
typedef unsigned short bf16;
typedef unsigned v4u __attribute__((ext_vector_type(4)));
typedef unsigned v2u __attribute__((ext_vector_type(2)));
typedef float f32x4 __attribute__((ext_vector_type(4)));
typedef LAS float lfloat;

__device__ __forceinline__ unsigned f2bf(float f) { unsigned u = __builtin_bit_cast(unsigned, f); return (u + 0x7fffu + ((u >> 16) & 1u)) >> 16; }
__device__ __forceinline__ unsigned pk2(float lo, float hi) { return f2bf(lo) | (f2bf(hi) << 16); }
__device__ __forceinline__ float bf2f(unsigned short b) { return __builtin_bit_cast(float, ((unsigned)b) << 16); }
__device__ __forceinline__ float bflo(unsigned w) { return __builtin_bit_cast(float, w << 16); }
__device__ __forceinline__ float bfhi(unsigned w) { return __builtin_bit_cast(float, w & 0xffff0000u); }

#define XB_TMO      128
#define XB_XCNT(j)  (256  + 64 * (j))
#define XB_XSUB(j)  (1280 + 64 * (j))
#define XB_XGEN(j)  (2304 + 64 * (j))
#define XB_TOP      3328
#define XB_TOPGEN   3392
#define XCD_BAR_WORDS 3456
#define XB_SPIN_CAP (1u << 18)
__device__ __forceinline__ unsigned xb_ld(unsigned* p)              { return __hip_atomic_load(p, __ATOMIC_RELAXED, __HIP_MEMORY_SCOPE_AGENT); }
__device__ __forceinline__ unsigned xb_add(unsigned* p, unsigned v) { return __hip_atomic_fetch_add(p, v, __ATOMIC_RELAXED, __HIP_MEMORY_SCOPE_AGENT); }
__device__ __forceinline__ unsigned xb_xcc_id() { return (unsigned)__builtin_amdgcn_s_getreg((3 << 11) | 20) & 0xFu; }
#define XB_SPIN(cond, bar) do { unsigned _sp = 0; while (cond) { __builtin_amdgcn_s_sleep(1); \
    if ((++_sp & 255u) == 0u) { if (xb_ld(&(bar)[XB_TMO])) break; if (_sp > XB_SPIN_CAP) { atomicAdd(&(bar)[XB_TMO], 1u); break; } } } } while (0)
struct XcdBarrier { unsigned* bar; unsigned x; volatile LAS unsigned* st; };
__device__ __forceinline__ XcdBarrier xcd_barrier_post(unsigned* bar, volatile LAS unsigned* st) {
    XcdBarrier b; b.bar = bar; b.x = xb_xcc_id(); b.st = st;
    if (threadIdx.x == 0) (void)xb_add(&bar[XB_XCNT(b.x)], 1u);
    return b;
}
__device__ __forceinline__ void xcd_barrier_complete(unsigned* bar, unsigned x, unsigned& nloc, unsigned& nx) {
    const unsigned G = gridDim.x * gridDim.y * gridDim.z;
    unsigned sum, cnt, mine, sp = 0u;
    for (;;) {
        sum = 0u; cnt = 0u; mine = 0u;
#pragma unroll
        for (unsigned j = 0; j < 16; ++j) { const unsigned c = xb_ld(&bar[XB_XCNT(j)]); sum += c; cnt += (c > 0u) ? 1u : 0u; mine = (j == x) ? c : mine; }
        if (sum == G) break;
        __builtin_amdgcn_s_sleep(1);
        if ((++sp & 255u) == 0u) { if (xb_ld(&bar[XB_TMO])) break; if (sp > XB_SPIN_CAP) { atomicAdd(&bar[XB_TMO], 1u); break; } }
    }
    nloc = mine > 0u ? mine : 1u; nx = cnt > 0u ? cnt : 1u;
}
__device__ __forceinline__ void xcd_barrier(const XcdBarrier& b) {
    asm volatile("s_waitcnt vmcnt(0)" ::: "memory");
    __syncthreads();
    if (threadIdx.x == 0) {
        unsigned* bar = b.bar;
        __builtin_amdgcn_s_waitcnt(0);
        unsigned nloc = b.st[0], nx = b.st[1];
        if (nloc == 0u) { xcd_barrier_complete(bar, b.x, nloc, nx); b.st[0] = nloc; b.st[1] = nx; }
        const unsigned old = xb_add(&bar[XB_XSUB(b.x)], 1u);
        const unsigned gen = old / nloc;
        if (old + 1u == (gen + 1u) * nloc) {
            __builtin_amdgcn_fence(__ATOMIC_RELEASE, "agent");
            asm volatile("s_waitcnt vmcnt(0)" ::: "memory");
            const unsigned og = xb_add(&bar[XB_TOP], 1u);
            const unsigned tg = og / nx;
            if (og + 1u == (tg + 1u) * nx) xb_add(&bar[XB_TOPGEN], 1u);
            else XB_SPIN(xb_ld(&bar[XB_TOPGEN]) == tg, bar);
            __builtin_amdgcn_fence(__ATOMIC_ACQUIRE, "agent");
            xb_add(&bar[XB_XGEN(b.x)], 1u);
            asm volatile("s_waitcnt vmcnt(0)" ::: "memory");
        } else {
            XB_SPIN(xb_ld(&bar[XB_XGEN(b.x)]) == gen, bar);
            __builtin_amdgcn_fence(__ATOMIC_ACQUIRE, "agent");
            asm volatile("s_waitcnt vmcnt(0)" ::: "memory");
        }
    }
    __syncthreads();
}

struct Args { const void* in[31]; float* out; unsigned char* ws; int ph_lo, ph_hi; };
struct Frame {
    LAS unsigned char* lds;
    int tid, lane, wave, G, bid;
    const float *x, *c, *w_ada, *b_ada, *g_mix_pre, *g_mix_post, *g_ffn_pre, *g_ffn_post, *w_in, *conv_w, *conv_b, *fw1, *fb1, *fw2, *fb2, *fw3, *ffreq, *hskip,
        *w_bg, *b_bg, *w_hy_o, *w_at_o, *w_out, *w_group, *b_group, *w_expert, *b_expert, *w1e, *w3e, *w2e;
    const int* positions;
    float* out;
    unsigned* ctl; float *MODP, *HID2, *ROT, *W3T, *TMP, *Y, *X1, *ACT, *YB, *LISTG, *WGT, *WET; bf16 *KF, *HID2B, *W3TB;
    unsigned* ROUTE; int* LISTT;
    bf16 *W1T, *WHYOT, *WATOT, *WOUTT, *H, *PHY, *QKV, *GT, *YHY, *YAT, *MERGED, *H2, *ACTB, *YBB;
};

__device__ __forceinline__ float wave_sum(float v) {
#pragma unroll
    for (int o = 1; o < 64; o <<= 1) v += __shfl_xor(v, o);
    return v;
}
__device__ __forceinline__ float wave_max(float v) {
#pragma unroll
    for (int o = 1; o < 64; o <<= 1) v = fmaxf(v, __shfl_xor(v, o));
    return v;
}

__device__ __forceinline__ void p0_transpose_item(const float* W, int K, int N, bf16* WT, int row_off, LAS float* scr, int item, int lane) {
    const int nblk = N / 32, kb = item / nblk, nb = item % nblk, k0 = 64 * kb, n0 = 32 * nb;
#pragma unroll 8
    for (int i = 0; i < 32; ++i) { const int kk = 2 * i + (lane >> 5); scr[kk * 33 + (lane & 31)] = W[(size_t)(k0 + kk) * N + n0 + (lane & 31)]; }
    asm volatile("s_waitcnt lgkmcnt(0)" ::: "memory");
    const int c = lane & 7;
#pragma unroll
    for (int j = 0; j < 4; ++j) { const int n = (lane >> 3) + 8 * j; const LAS float* s = scr + (8 * c) * 33 + n;
        v4u o; o.x = pk2(s[0 * 33], s[1 * 33]); o.y = pk2(s[2 * 33], s[3 * 33]); o.z = pk2(s[4 * 33], s[5 * 33]); o.w = pk2(s[6 * 33], s[7 * 33]);
        *(v4u*)(WT + (size_t)(row_off + n0 + n) * K + k0 + 8 * c) = o; }
    asm volatile("s_waitcnt lgkmcnt(0)" ::: "memory");
}

__device__ __forceinline__ f32x4 mod_sum4(Frame& F, int b, int col) {
    f32x4 s = *(const f32x4*)(F.b_ada + col);
#pragma unroll
    for (int ks = 0; ks < 8; ++ks) s += *(const f32x4*)(F.MODP + (size_t)(ks * 2 + b) * (6 * D) + col);
    return s;
}
__device__ __forceinline__ void load_mod(Frame& F, LAS float* dst, int which) {
#pragma unroll 2
    for (int i = F.tid; i < 2 * D / 4; i += NTHR) { const int b = i / (D / 4), d4 = i % (D / 4); *(LAS f32x4*)(dst + 4 * i) = mod_sum4(F, b, which * D + 4 * d4); }
}
__device__ __forceinline__ void load_mod1(Frame& F, LAS float* dst, int which, int b) {
    *(LAS f32x4*)(dst + 4 * F.tid) = mod_sum4(F, b, which * D + 4 * F.tid);
}

template <int SKIP = 0> __device__ __forceinline__ void p0_prologue(Frame& F) {
    LAS float* L = (LAS float*)F.lds;
    if (!(SKIP & 1))
    {
        typedef float f32x2 __attribute__((ext_vector_type(2)));
        LAS float* sc = L;
        LAS float* red = L + 512;
        for (int u = F.bid; u < 96 * 8; u += F.G) {
            const int chunk = u % 96, ks = u / 96;
            __syncthreads();
            { const int b = F.tid >> 8, i = F.tid & 255; const float cv = F.c[b * D + ks * 256 + i]; sc[b * 256 + i] = cv / (1.f + __expf(-cv)); }
            __syncthreads();
            f32x2 a0 = {0.f, 0.f}, a1 = {0.f, 0.f};
            const float* wp = F.w_ada + (size_t)(ks * 256 + F.wave * 32) * (6 * D) + chunk * 128 + F.lane * 2;
#pragma unroll 16
            for (int r = 0; r < 32; ++r) { const f32x2 w = *(const f32x2*)(wp + (size_t)r * (6 * D)); const float s0 = sc[F.wave * 32 + r], s1 = sc[256 + F.wave * 32 + r]; a0 += w * s0; a1 += w * s1; }
            *(LAS f32x2*)(red + (F.wave * 2 + 0) * 128 + F.lane * 2) = a0;
            *(LAS f32x2*)(red + (F.wave * 2 + 1) * 128 + F.lane * 2) = a1;
            __syncthreads();
            if (F.tid < 256) { const int b = F.tid >> 7, col = F.tid & 127; float s = 0.f;
#pragma unroll
              for (int w = 0; w < 8; ++w) s += red[(w * 2 + b) * 128 + col];
              F.MODP[(size_t)(ks * 2 + b) * (6 * D) + chunk * 128 + col] = s; }
        }
        __syncthreads();
    }
    const int gw = F.bid * NWAVES + F.wave, NGW = F.G * NWAVES;
    if (!(SKIP & 2)) {
        LAS float* scr = (LAS float*)(F.lds + F.wave * 16384);
        constexpr int I_IN = (D / 64) * (INW / 32), I_BG = (D / 64) * (2 * D / 32), I_HY = (HW / 64) * (D / 32), I_AT = (512 / 64) * (D / 32), I_OUT = (D / 64) * (D / 32);
        constexpr int NITEMS = I_IN + I_BG + I_HY + I_AT + I_OUT;
        for (int it = gw; it < NITEMS; it += NGW) {
            int r = it;
            if (r < I_IN) { p0_transpose_item(F.w_in, D, INW, F.W1T, 0, scr, r, F.lane); continue; } r -= I_IN;
            if (r < I_BG) { p0_transpose_item(F.w_bg, D, 2 * D, F.W1T, INW, scr, r, F.lane); continue; } r -= I_BG;
            if (r < I_HY) { p0_transpose_item(F.w_hy_o, HW, D, F.WHYOT, 0, scr, r, F.lane); continue; } r -= I_HY;
            if (r < I_AT) { p0_transpose_item(F.w_at_o, 512, D, F.WATOT, 0, scr, r, F.lane); continue; } r -= I_AT;
            p0_transpose_item(F.w_out, D, D, F.WOUTT, 0, scr, r, F.lane);
        }
    }
    if (!(SKIP & 4)) {
    for (int i = F.bid * NTHR + F.tid; i < 64 * 4096; i += F.G * NTHR) { const int n = i >> 6, j = i & 63; F.W3TB[i] = (bf16)f2bf(F.fw3[j * 4096 + n]); }
    for (int i = F.bid * NTHR + F.tid; i < 8 * D; i += F.G * NTHR) { const int n = i / D, d = i % D; F.WGT[i] = F.w_group[d * 8 + n]; }
    for (int i = F.bid * NTHR + F.tid; i < 64 * D; i += F.G * NTHR) { const int ge = i / D, d = i % D, g = ge >> 3, e = ge & 7; F.WET[i] = F.w_expert[((size_t)g * D + d) * 8 + e]; }
    }
    if (!(SKIP & 8))
    for (int t = gw; t < SEQ; t += NGW) {
        const int j = F.lane;
        const float tn = (float)t * (1.0f / (float)(SEQ - 1));
        const float w = 6.283185307179586f * (float)t / (float)SEQ;
        float feat = 0.f;
        if (j == 0) feat = tn;
        else if (j <= 16) { const float band = 1e-4f + (float)(j - 1) * ((15.0f - 1e-4f) / 15.0f); feat = cosf(band * w); }
        else if (j <= 32) { const float band = 1e-4f + (float)(j - 17) * ((15.0f - 1e-4f) / 15.0f); feat = -sinf(band * w); }
        float a = F.fb1[j];
        for (int i = 0; i < 33; ++i) a += __shfl(feat, i) * F.fw1[i * 64 + j];
        const float fr = F.ffreq[j];
        const float h1 = sinf(fr * a);
        float a2 = F.fb2[j];
        for (int i = 0; i < 64; ++i) a2 += __shfl(h1, i) * F.fw2[i * 64 + j];
        { const float hv = sinf(fr * a2); F.HID2[t * 64 + j] = hv; F.HID2B[t * 64 + j] = (bf16)f2bf(hv); }
    }
    if (!(SKIP & 16))
    for (int i = F.bid * NTHR + F.tid; i < T * 16; i += F.G * NTHR) {
        const int tok = i >> 4, k = i & 15;
        const float inv = powf(500000.0f, -(float)k * (1.0f / 16.0f));
        const float ang = (float)F.positions[tok] * inv;
        F.ROT[tok * 32 + k] = cosf(ang); F.ROT[tok * 32 + 16 + k] = sinf(ang);
    }
}

__device__ __forceinline__ void p1_rows_filters(Frame& F) {
    LAS float* L = (LAS float*)F.lds;
    LAS float* shiftv = L;
    LAS float* scalev = L + 2 * D;
    load_mod(F, shiftv, 0); load_mod(F, scalev, 1);
    __syncthreads();
    const int gw = F.bid * NWAVES + F.wave, NGW = F.G * NWAVES;
    for (int m0 = gw; m0 < T; m0 += 4 * NGW) {
        f32x4 v[4][8];
#pragma unroll
        for (int r = 0; r < 4; ++r) { const int m = m0 + r * NGW; if (m < T) { const f32x4* xr = (const f32x4*)(F.x + (size_t)m * D) + F.lane;
#pragma unroll
            for (int j = 0; j < 8; ++j) v[r][j] = xr[64 * j]; } }
#pragma unroll
        for (int r = 0; r < 4; ++r) { const int m = m0 + r * NGW; if (m < T) { const int b = m / SEQ; float s = 0.f;
#pragma unroll
            for (int j = 0; j < 8; ++j) s += (v[r][j].x * v[r][j].x + v[r][j].y * v[r][j].y) + (v[r][j].z * v[r][j].z + v[r][j].w * v[r][j].w);
            const float rstd = 1.0f / sqrtf(wave_sum(s) * (1.f / D) + RMS_EPS);
            v2u* o8 = (v2u*)(F.H + (size_t)m * D) + F.lane;
#pragma unroll
            for (int j = 0; j < 8; ++j) { const int d = 256 * j + 4 * F.lane;
                const f32x4 g = *(const f32x4*)(F.g_mix_pre + d); const f32x4 sc = *(LAS f32x4*)(scalev + b * D + d), sh = *(LAS f32x4*)(shiftv + b * D + d);
                f32x4 h; h = (v[r][j] * rstd) * g; h = h * (sc + 1.0f) + sh;
                v2u w; w.x = pk2(h.x, h.y); w.y = pk2(h.z, h.w); o8[64 * j] = w; } } }
    }
    {
        typedef short bf16x8 __attribute__((ext_vector_type(8)));
        typedef float f32x16 __attribute__((ext_vector_type(16)));
        const int r31 = F.lane & 31, hh = F.lane >> 5;
        const float mind = -3.0701134573253945f, maxd = -15.350567286626972f;
        for (int u = gw; u < 128 * 32; u += NGW) {
            const int tt = u & 127, ng = u >> 7, t = tt * 32 + r31;
            bf16x8 bq[4];
#pragma unroll
            for (int s = 0; s < 4; ++s) bq[s] = *(const bf16x8*)(F.HID2B + (size_t)t * 64 + 16 * s + 8 * hh);
            const float tn = (float)t * (1.0f / (float)(SEQ - 1));
#pragma unroll 1
            for (int q = 0; q < 4; ++q) {
                const int n0 = (ng * 4 + q) * 32;
                f32x16 c;
#pragma unroll
                for (int i = 0; i < 16; ++i) c[i] = 0.f;
#pragma unroll
                for (int s = 0; s < 4; ++s) { const bf16x8 a = *(const bf16x8*)(F.W3TB + (size_t)(n0 + r31) * 64 + 16 * s + 8 * hh); c = __builtin_amdgcn_mfma_f32_32x32x16_bf16(a, bq[s], c, 0, 0, 0); }
#pragma unroll
                for (int i = 0; i < 16; ++i) { const int n = n0 + (i & 3) + 8 * (i >> 2) + 4 * hh, ch = n & (HW - 1);
                    const float delta = fabsf(mind + (float)ch * ((maxd - mind) / (float)(HW - 1)));
                    F.KF[(size_t)n * SEQ + t] = (bf16)f2bf(c[i] * __expf(-tn * delta)); }
            }
        }
    }
}

template <int NB, class LA, class LB, class EP>
__device__ __forceinline__ void simt_tile(LAS float* L, int K, int tid, const LA& la, const LB& lb, const EP& ep) {
    LAS float* As = L;
    LAS float* Bs = L + 32 * 68;
    const int ty = tid >> 4, tx = tid & 15;
    float acc[NB][2][4];
#pragma unroll
    for (int q = 0; q < NB; ++q)
#pragma unroll
        for (int i = 0; i < 2; ++i)
#pragma unroll
            for (int j = 0; j < 4; ++j) acc[q][i][j] = 0.f;
    for (int k0 = 0; k0 < K; k0 += 32) {
        __syncthreads();
        for (int e = tid; e < 64 * 32; e += NTHR) { const int r = e >> 5, kk = e & 31; As[kk * 68 + r] = la(r, k0 + kk); }
#pragma unroll
        for (int q = 0; q < NB; ++q)
            for (int e = tid; e < 32 * 64; e += NTHR) { const int kk = e >> 6, cc = e & 63; Bs[(q * 32 + kk) * 68 + cc] = lb(q, k0 + kk, cc); }
        __syncthreads();
#pragma unroll 8
        for (int kk = 0; kk < 32; ++kk) {
            const float a0 = As[kk * 68 + 2 * ty], a1 = As[kk * 68 + 2 * ty + 1];
#pragma unroll
            for (int q = 0; q < NB; ++q) { const f32x4 b = *(LAS f32x4*)(Bs + (q * 32 + kk) * 68 + 4 * tx);
                acc[q][0][0] += a0 * b.x; acc[q][0][1] += a0 * b.y; acc[q][0][2] += a0 * b.z; acc[q][0][3] += a0 * b.w;
                acc[q][1][0] += a1 * b.x; acc[q][1][1] += a1 * b.y; acc[q][1][2] += a1 * b.z; acc[q][1][3] += a1 * b.w; }
        }
    }
#pragma unroll
    for (int i = 0; i < 2; ++i)
#pragma unroll
        for (int j = 0; j < 4; ++j) { float v[NB];
#pragma unroll
            for (int q = 0; q < NB; ++q) v[q] = acc[q][i][j];
            ep(2 * ty + i, 4 * tx + j, v); }
}

struct EpiProj {
    static constexpr bool PERM = true, AFTER_DRAIN = false;
    bf16* QKVp; bf16* Gp; const float* ROT; const float* bias;
    __device__ __forceinline__ void operator()(const pg8::f32x4 (&acc)[2][2][4][2], const pg8::Unit& u, int wr, int wc, int fr, int fq) const {
        using namespace pg8;
        const int row0 = u.pm * BM + wr * 64 + fr;
        const int colt = u.pn * BM;
        if (colt < QKVW) {
            const bool rot = (colt < 2 * NH * HD) && (wc == 0);
#pragma unroll
            for (int ai = 0; ai < 2; ++ai)
#pragma unroll
                for (int m = 0; m < 4; ++m) { const int row = row0 + ai * HALF + m * 16;
                    bf16* rowp = QKVp + (size_t)row * QKVW + colt + wc * 32 + 8 * fq;
                    f32x4 cs0, cs1, sn0, sn1;
                    if (rot) { const float* rp = ROT + (size_t)row * 32 + 8 * (fq & 1); cs0 = *(const f32x4*)rp; cs1 = *(const f32x4*)(rp + 4); sn0 = *(const f32x4*)(rp + 16); sn1 = *(const f32x4*)(rp + 20); }
#pragma unroll
                    for (int bj = 0; bj < 2; ++bj) { f32x4 v0 = acc[ai][bj][m][0], v1 = acc[ai][bj][m][1];
                        if (rot) {
                            f32x4 o0, o1;
#pragma unroll
                            for (int j = 0; j < 4; ++j) { o0[j] = __shfl_xor(v0[j], 32); o1[j] = __shfl_xor(v1[j], 32); }
                            if (fq < 2) { v0 = v0 * cs0 - o0 * sn0; v1 = v1 * cs1 - o1 * sn1; }
                            else        { v0 = v0 * cs0 + o0 * sn0; v1 = v1 * cs1 + o1 * sn1; }
                        }
                        u32x4 w; w.x = cvt_pk_bf16(v0[0], v0[1]); w.y = cvt_pk_bf16(v0[2], v0[3]); w.z = cvt_pk_bf16(v1[0], v1[1]); w.w = cvt_pk_bf16(v1[2], v1[3]);
                        *(u32x4*)(rowp + bj * HALF) = w; } }
        } else {
            const int gc = colt - QKVW + wc * 32 + 8 * fq;
            f32x4 bv[2][2];
#pragma unroll
            for (int bj = 0; bj < 2; ++bj)
#pragma unroll
                for (int n = 0; n < 2; ++n) bv[bj][n] = *(const f32x4*)(bias + gc + bj * HALF + 4 * n);
#pragma unroll
            for (int ai = 0; ai < 2; ++ai)
#pragma unroll
                for (int m = 0; m < 4; ++m) { bf16* rowp = Gp + (size_t)(row0 + ai * HALF + m * 16) * (2 * D) + gc;
#pragma unroll
                    for (int bj = 0; bj < 2; ++bj) { f32x4 v0 = acc[ai][bj][m][0] + bv[bj][0], v1 = acc[ai][bj][m][1] + bv[bj][1];
#pragma unroll
                        for (int j = 0; j < 4; ++j) { v0[j] = 1.0f / (1.0f + __expf(-v0[j])); v1[j] = 1.0f / (1.0f + __expf(-v1[j])); }
                        u32x4 w; w.x = cvt_pk_bf16(v0[0], v0[1]); w.y = cvt_pk_bf16(v0[2], v0[3]); w.z = cvt_pk_bf16(v1[0], v1[1]); w.w = cvt_pk_bf16(v1[2], v1[3]);
                        *(u32x4*)(rowp + bj * HALF) = w; } }
        }
    }
};
struct EpiPlainBf16 {
    static constexpr bool PERM = true, AFTER_DRAIN = false;
    bf16* O; int ldc;
    __device__ __forceinline__ void operator()(const pg8::f32x4 (&acc)[2][2][4][2], const pg8::Unit& u, int wr, int wc, int fr, int fq) const {
        using namespace pg8;
        const int row0 = u.pm * BM + wr * 64 + fr, col0 = u.pn * BM + wc * 32 + 8 * fq;
#pragma unroll
        for (int ai = 0; ai < 2; ++ai)
#pragma unroll
            for (int m = 0; m < 4; ++m) { bf16* rowp = O + (size_t)(row0 + ai * HALF + m * 16) * ldc + col0;
#pragma unroll
                for (int bj = 0; bj < 2; ++bj) { const f32x4 v0 = acc[ai][bj][m][0], v1 = acc[ai][bj][m][1];
                    u32x4 w; w.x = cvt_pk_bf16(v0[0], v0[1]); w.y = cvt_pk_bf16(v0[2], v0[3]); w.z = cvt_pk_bf16(v1[0], v1[1]); w.w = cvt_pk_bf16(v1[2], v1[3]);
                    *(u32x4*)(rowp + bj * HALF) = w; } }
    }
};
template <int STAGE> struct EpiGate {
    static constexpr bool PERM = true, AFTER_DRAIN = false;
    const bf16* Gp; int goff; float* TMPp; bf16* Mp;
    __device__ __forceinline__ void operator()(const pg8::f32x4 (&acc)[2][2][4][2], const pg8::Unit& u, int wr, int wc, int fr, int fq) const {
        using namespace pg8;
        const int row0 = u.pm * BM + wr * 64 + fr, col0 = u.pn * BM + wc * 32 + 8 * fq;
#pragma unroll
        for (int ai = 0; ai < 2; ++ai)
#pragma unroll
            for (int m = 0; m < 4; ++m) { const size_t row = (size_t)(row0 + ai * HALF + m * 16);
#pragma unroll
                for (int bj = 0; bj < 2; ++bj) { const int col = col0 + bj * HALF;
                    const u32x4 gw = *(const u32x4*)(Gp + row * (2 * D) + goff + col);
                    f32x4 g0 = {bflo(gw.x), bfhi(gw.x), bflo(gw.y), bfhi(gw.y)}, g1 = {bflo(gw.z), bfhi(gw.z), bflo(gw.w), bfhi(gw.w)};
                    f32x4 v0 = acc[ai][bj][m][0] * g0, v1 = acc[ai][bj][m][1] * g1;
                    bf16* tp = (bf16*)TMPp + row * D + col;
                    if (STAGE == 0) { u32x4 w; w.x = cvt_pk_bf16(v0[0], v0[1]); w.y = cvt_pk_bf16(v0[2], v0[3]); w.z = cvt_pk_bf16(v1[0], v1[1]); w.w = cvt_pk_bf16(v1[2], v1[3]); *(u32x4*)tp = w; }
                    else { const u32x4 tw = *(const u32x4*)tp; v0 += (f32x4){bflo(tw.x), bfhi(tw.x), bflo(tw.y), bfhi(tw.y)}; v1 += (f32x4){bflo(tw.z), bfhi(tw.z), bflo(tw.w), bfhi(tw.w)};
                        u32x4 w; w.x = cvt_pk_bf16(v0[0], v0[1]); w.y = cvt_pk_bf16(v0[2], v0[3]); w.z = cvt_pk_bf16(v1[0], v1[1]); w.w = cvt_pk_bf16(v1[2], v1[3]);
                        *(u32x4*)(Mp + row * D + col) = w; } } }
    }
};
struct EpiF32 {
    static constexpr bool PERM = false, AFTER_DRAIN = false;
    float* C; int ldc;
    __device__ __forceinline__ void operator()(const pg8::f32x4 (&acc)[2][2][4][2], const pg8::Unit& u, int wr, int wc, int fr, int fq) const {
        using namespace pg8;
        const int row0 = u.pm * BM + wr * 64 + fr, col0 = u.pn * BM + wc * 32 + 4 * fq;
#pragma unroll
        for (int ai = 0; ai < 2; ++ai)
#pragma unroll
            for (int m = 0; m < 4; ++m) { float* rowp = C + (size_t)(row0 + ai * HALF + m * 16) * ldc + col0;
#pragma unroll
                for (int bj = 0; bj < 2; ++bj)
#pragma unroll
                    for (int n = 0; n < 2; ++n) *(f32x4*)(rowp + bj * HALF + n * 16) = acc[ai][bj][m][n]; }
    }
};


struct DualOrder {
    pg8::StaticOrder s0, s1; int G, c; const bf16* A0; const bf16* B0; const bf16* A1; const bf16* B1;
    __device__ __forceinline__ bool next(int i, pg8::Unit& u) const {
        const int L = i * G + c;
        if (L < s1.nwg) { pg8::StaticOrder t = s1; t.G = 1; t.c = L; const bool ok = t.next(0, u); u.kind = 1; return ok; }
        pg8::StaticOrder t = s0; t.G = 1; t.c = L - s1.nwg; const bool ok = t.next(0, u); u.kind = 0; return ok;
    }
    __device__ __forceinline__ void a_ready(const pg8::Unit&) const {}
    __device__ __forceinline__ void done(const pg8::Unit&) const {}
    __device__ __forceinline__ const bf16* abase(const pg8::Gemm&, const pg8::Unit& u) const { return u.kind ? A1 : A0; }
    __device__ __forceinline__ const bf16* bbase(const pg8::Gemm&, const pg8::Unit& u) const { return u.kind ? B1 : B0; }
};
struct EpiDual {
    static constexpr bool PERM = true, AFTER_DRAIN = false;
    EpiPlainBf16 e0; EpiProj e1;
    __device__ __forceinline__ void operator()(const pg8::f32x4 (&acc)[2][2][4][2], const pg8::Unit& u, int wr, int wc, int fr, int fq) const {
        if (u.kind == 0) e0(acc, u, wr, wc, fr, fq); else e1(acc, u, wr, wc, fr, fq);
    }
};
template <class Epi>
__device__ __forceinline__ void run_gemm(Frame& F, const bf16* A, const bf16* Bt, int M, int N, int K, const Epi& E) {
    pg8::Gemm g{A, Bt, M, N, K}; pg8::StaticOrder S; S.init(M, N, F.G, F.bid);
    pg8::gemm_phase<Epi, pg8::StaticOrder, true, true>(F.lds, g, S, E);
}

__device__ __forceinline__ float sconv_at(const bf16* rowp, int t, float w0, float w1, float w2, float bias) {
    const float um = t > 0 ? bf2f(rowp[t - 1]) : 0.f, u0 = bf2f(rowp[t]), up = t < SEQ - 1 ? bf2f(rowp[t + 1]) : 0.f;
    return um * w0 + u0 * w1 + up * w2 + bias;
}
__device__ __forceinline__ void conv8(const LAS float* kk, const LAS float* z, int t0, float (&acc)[2][8]) {
#pragma unroll
    for (int b = 0; b < 2; ++b)
#pragma unroll
        for (int j = 0; j < 8; ++j) acc[b][j] = 0.f;
    for (int s8 = 0; s8 < SEQ; s8 += 8) {
        const int base = t0 - s8 + (SEQ - 1);
        float kw[15];
#pragma unroll
        for (int i = 0; i < 15; ++i) kw[i] = kk[base - 7 + i];
        float zz[2][8];
#pragma unroll
        for (int b = 0; b < 2; ++b) { const f32x4 q0 = *(const LAS f32x4*)(z + b * SEQ + s8), q1 = *(const LAS f32x4*)(z + b * SEQ + s8 + 4);
            zz[b][0] = q0.x; zz[b][1] = q0.y; zz[b][2] = q0.z; zz[b][3] = q0.w; zz[b][4] = q1.x; zz[b][5] = q1.y; zz[b][6] = q1.z; zz[b][7] = q1.w; }
#pragma unroll
        for (int ds = 0; ds < 8; ++ds)
#pragma unroll
            for (int j = 0; j < 8; ++j) { const float k = kw[7 + j - ds]; acc[0][j] += k * zz[0][ds]; acc[1][j] += k * zz[1][ds]; }
    }
}
__device__ __forceinline__ void p3_hyena_naive(Frame& F) {
    LAS float* L = (LAS float*)F.lds;
    LAS float* zin = L;
    LAS float* kk = L + 2 * SEQ;
    LAS float* zmid = L + 4 * SEQ;
    for (int c = F.bid; c < HW; c += F.G) {
        __syncthreads();
        const float cw[3][3] = {{F.conv_w[c], F.conv_w[3 * HW + c], F.conv_w[6 * HW + c]},
                                {F.conv_w[HW + c], F.conv_w[3 * HW + HW + c], F.conv_w[6 * HW + HW + c]},
                                {F.conv_w[2 * HW + c], F.conv_w[3 * HW + 2 * HW + c], F.conv_w[6 * HW + 2 * HW + c]}};
        const float cb[3] = {F.conv_b[c], F.conv_b[HW + c], F.conv_b[2 * HW + c]};
        const bf16* pv = F.PHY + (size_t)c * T; const bf16* px1 = F.PHY + (size_t)(HW + c) * T; const bf16* px2 = F.PHY + (size_t)(2 * HW + c) * T;
        for (int i = F.tid; i < T; i += NTHR) { const int b = i / SEQ, t = i % SEQ; zin[i] = sconv_at(pv + b * SEQ, t, cw[0][0], cw[0][1], cw[0][2], cb[0]); }
        for (int i = F.tid; i < 2 * SEQ; i += NTHR) { const int d = i - (SEQ - 1);
            kk[i] = (i == 2 * SEQ - 1) ? 0.f : bf2f(d >= 0 ? F.KF[(size_t)(0 * HW + c) * SEQ + d] : F.KF[(size_t)(1 * HW + c) * SEQ - d]); }
        __syncthreads();
        const int t0 = F.tid * 8; float acc[2][8];
        conv8(kk, zin, t0, acc);
        const float sk0 = F.hskip[c], sk1 = F.hskip[HW + c];
#pragma unroll
        for (int b = 0; b < 2; ++b)
#pragma unroll
            for (int j = 0; j < 8; ++j) { const float x1 = sconv_at(px1 + b * SEQ, t0 + j, cw[1][0], cw[1][1], cw[1][2], cb[1]);
                zmid[b * SEQ + t0 + j] = x1 * (acc[b][j] + sk0 * zin[b * SEQ + t0 + j]); }
        __syncthreads();
        for (int i = F.tid; i < 2 * SEQ; i += NTHR) { const int d = i - (SEQ - 1);
            kk[i] = (i == 2 * SEQ - 1) ? 0.f : bf2f(d >= 0 ? F.KF[(size_t)(2 * HW + c) * SEQ + d] : F.KF[(size_t)(3 * HW + c) * SEQ - d]); }
        __syncthreads();
        conv8(kk, zmid, t0, acc);
#pragma unroll
        for (int b = 0; b < 2; ++b)
#pragma unroll
            for (int j = 0; j < 8; ++j) { const float x2 = sconv_at(px2 + b * SEQ, t0 + j, cw[2][0], cw[2][1], cw[2][2], cb[2]);
                const float z2 = x2 * (acc[b][j] + sk1 * zmid[b * SEQ + t0 + j]);
                F.YHY[(size_t)(b * SEQ + t0 + j) * HW + c] = (bf16)f2bf(z2); }
    }
}

constexpr int HY_KCOPY = 16448;
constexpr int HY_K_OFF = 0;
constexpr int HY_ZIN_OFF = 4 * HY_KCOPY;
constexpr int HY_ZBYTES = 160 * 2 * 80;
constexpr int HY_ZMID_OFF = HY_ZIN_OFF + HY_ZBYTES;
constexpr int HY_X1_OFF = HY_ZMID_OFF + HY_ZBYTES;
constexpr int HY_X2_OFF = HY_X1_OFF + 2 * SEQ * 2;
static_assert(HY_X2_OFF + 2 * SEQ * 2 <= MOE_OFFS_OFF, "hyena LDS map");
__device__ __forceinline__ unsigned hy_zaddr(int b, int t) { return (unsigned)((((t >> 5) + 16) * 2 + b) * 80 + (t & 31) * 2); }
__device__ __forceinline__ void hy_build_k(Frame& F, const bf16* hf, const bf16* hb) {
    LAS unsigned char* lds = F.lds + HY_K_OFF;
    const int i = F.tid;
    const v4u ca = *(const v4u*)(hf + (SEQ - 8 - 8 * i)), cb = *(const v4u*)(hb + 8 * i);
    unsigned short ga[8], gb[8];
    ga[7] = (unsigned short)(ca.x & 0xffff); ga[6] = (unsigned short)(ca.x >> 16); ga[5] = (unsigned short)(ca.y & 0xffff); ga[4] = (unsigned short)(ca.y >> 16);
    ga[3] = (unsigned short)(ca.z & 0xffff); ga[2] = (unsigned short)(ca.z >> 16); ga[1] = (unsigned short)(ca.w & 0xffff); ga[0] = (unsigned short)(ca.w >> 16);
    gb[0] = (unsigned short)(cb.x & 0xffff); gb[1] = (unsigned short)(cb.x >> 16); gb[2] = (unsigned short)(cb.y & 0xffff); gb[3] = (unsigned short)(cb.y >> 16);
    gb[4] = (unsigned short)(cb.z & 0xffff); gb[5] = (unsigned short)(cb.z >> 16); gb[6] = (unsigned short)(cb.w & 0xffff); gb[7] = (unsigned short)(cb.w >> 16);
#pragma unroll
    for (int s = 0; s < 4; ++s) {
        LAS unsigned char* cp = lds + s * HY_KCOPY;
#pragma unroll
        for (int j = 0; j < 8; ++j) { const int xa = 8 * i + 1 + j, xb = SEQ + 8 * i + j;
            if (xa - s >= 0) *(LAS unsigned short*)(cp + 2 * (xa - s)) = ga[j];
            if (xb > SEQ) *(LAS unsigned short*)(cp + 2 * (xb - s)) = gb[j]; }
    }
}
__device__ __forceinline__ void hy_stage_inputs(Frame& F, int c, const float (&cw)[3][3], const float (&cb)[3]) {
    LAS unsigned char* lds = F.lds;
    v4u ch[6]; unsigned short lo[6], hi[6];
#pragma unroll
    for (int k = 0; k < 6; ++k) { const int wh = k >> 1, chunk = F.tid + 512 * (k & 1), b = chunk >> 9, t0 = (chunk & 511) * 8;
        const bf16* rowp = F.PHY + (size_t)(wh * HW + c) * T + b * SEQ;
        ch[k] = *(const v4u*)(rowp + t0); lo[k] = t0 > 0 ? rowp[t0 - 1] : (unsigned short)0; hi[k] = t0 + 8 < SEQ ? rowp[t0 + 8] : (unsigned short)0; }
#pragma unroll
    for (int k = 0; k < 6; ++k) { const int wh = k >> 1, chunk = F.tid + 512 * (k & 1), b = chunk >> 9, t0 = (chunk & 511) * 8;
        float u[10]; u[0] = bf2f(lo[k]); u[9] = bf2f(hi[k]);
        u[1] = bflo(ch[k].x); u[2] = bfhi(ch[k].x); u[3] = bflo(ch[k].y); u[4] = bfhi(ch[k].y); u[5] = bflo(ch[k].z); u[6] = bfhi(ch[k].z); u[7] = bflo(ch[k].w); u[8] = bfhi(ch[k].w);
        float o[8];
#pragma unroll
        for (int j = 0; j < 8; ++j) o[j] = u[j] * cw[wh][0] + u[j + 1] * cw[wh][1] + u[j + 2] * cw[wh][2] + cb[wh];
        v4u pk; pk.x = pk2(o[0], o[1]); pk.y = pk2(o[2], o[3]); pk.z = pk2(o[4], o[5]); pk.w = pk2(o[6], o[7]);
        const unsigned off = (wh == 0) ? (unsigned)HY_ZIN_OFF + hy_zaddr(b, t0) : (unsigned)((wh == 1 ? HY_X1_OFF : HY_X2_OFF) + 2 * (b * SEQ + t0));
        *(LAS v4u*)(lds + off) = pk; }
}
__device__ __forceinline__ void hy_conv(Frame& F, unsigned zoff, pg8::f32x4 (&acc)[4]) {
    typedef short bf16x8 __attribute__((ext_vector_type(8)));
    typedef float f32x16 __attribute__((ext_vector_type(16)));
    const int lane = F.lane, q = F.wave, r = lane & 31, hh = lane >> 5, sg = (4 - (r & 3)) & 3, nn = r >> 1, b = r & 1;
    const int d0 = 16 * q - 127;
    unsigned aaddr = (unsigned)(HY_K_OFF + sg * HY_KCOPY + 2 * (SEQ - 32 * d0 - r + 8 * hh - sg));
    unsigned baddr = zoff + (unsigned)(((16 * q + nn - d0 + 16) * 2 + b) * 80 + 16 * hh);
    f32x16 c;
#pragma unroll
    for (int i = 0; i < 16; ++i) c[i] = 0.f;
    struct FragSet { v2u a[2][2][2]; bf16x8 b[2][2]; };
#define HY_LOAD(S, ADDR_A, ADDR_B) do { _Pragma("unroll") for (int _o = 0; _o < 2; ++_o) { const unsigned _ao = (ADDR_A) + (_o ? 0u : 64u), _bo = (ADDR_B) + (_o ? 0u : 160u); \
        _Pragma("unroll") for (int _h = 0; _h < 2; ++_h) { S.a[_o][_h][0] = *(volatile LAS v2u*)(F.lds + _ao + 32 * _h); S.a[_o][_h][1] = *(volatile LAS v2u*)(F.lds + _ao + 32 * _h + 8); \
            S.b[_o][_h] = *(const LAS bf16x8*)(F.lds + _bo + 32 * _h); } } } while (0)
#define HY_MMA(S) do { _Pragma("unroll") for (int _o = 0; _o < 2; ++_o) _Pragma("unroll") for (int _h = 0; _h < 2; ++_h) { union { bf16x8 v; v2u h[2]; } _a; _a.h[0] = S.a[_o][_h][0]; _a.h[1] = S.a[_o][_h][1]; \
        c = __builtin_amdgcn_mfma_f32_32x32x16_bf16(_a.v, S.b[_o][_h], c, 0, 0, 0); } } while (0)
    {
        union { bf16x8 v; v2u h[2]; } a0, a1;
        a0.h[0] = *(volatile LAS v2u*)(F.lds + aaddr);      a0.h[1] = *(volatile LAS v2u*)(F.lds + aaddr + 8);
        a1.h[0] = *(volatile LAS v2u*)(F.lds + aaddr + 32); a1.h[1] = *(volatile LAS v2u*)(F.lds + aaddr + 40);
        const bf16x8 b0 = *(const LAS bf16x8*)(F.lds + baddr), b1 = *(const LAS bf16x8*)(F.lds + baddr + 32);
        c = __builtin_amdgcn_mfma_f32_32x32x16_bf16(a0.v, b0, c, 0, 0, 0);
        c = __builtin_amdgcn_mfma_f32_32x32x16_bf16(a1.v, b1, c, 0, 0, 0);
    }
    FragSet sA, sB;
    aaddr -= 128; baddr -= 320;
    HY_LOAD(sA, aaddr, baddr);
#pragma clang loop unroll(disable)
    for (int it = 0; it < 35; ++it) {
        aaddr -= 128; baddr -= 320;
        asm volatile("" : "+v"(aaddr), "+v"(baddr));
        HY_LOAD(sB, aaddr, baddr);
        HY_MMA(sA);
        aaddr -= 128; baddr -= 320;
        asm volatile("" : "+v"(aaddr), "+v"(baddr));
        HY_LOAD(sA, aaddr, baddr);
        HY_MMA(sB);
    }
    HY_MMA(sA);
#undef HY_LOAD
#undef HY_MMA
#pragma unroll
    for (int g = 0; g < 4; ++g) acc[g] = (pg8::f32x4){c[4 * g], c[4 * g + 1], c[4 * g + 2], c[4 * g + 3]};
}
__device__ __forceinline__ void p3_hyena_mfma(Frame& F) {
    LAS unsigned char* lds = F.lds;
    for (int i = F.tid; i < 2 * HY_ZBYTES / 4; i += NTHR) *(LAS unsigned*)(lds + HY_ZIN_OFF + 4 * i) = 0u;
    const int lane = F.lane, q = F.wave, r = lane & 31, hh = lane >> 5, nn = r >> 1, b = r & 1;
    for (int c = F.bid; c < HW; c += F.G) {
        __syncthreads();
        const float cw[3][3] = {{F.conv_w[c], F.conv_w[3 * HW + c], F.conv_w[6 * HW + c]},
                                {F.conv_w[HW + c], F.conv_w[3 * HW + HW + c], F.conv_w[6 * HW + HW + c]},
                                {F.conv_w[2 * HW + c], F.conv_w[3 * HW + 2 * HW + c], F.conv_w[6 * HW + 2 * HW + c]}};
        const float cb[3] = {F.conv_b[c], F.conv_b[HW + c], F.conv_b[2 * HW + c]};
        const bf16* pv = F.PHY + (size_t)c * T; const bf16* px1 = F.PHY + (size_t)(HW + c) * T; const bf16* px2 = F.PHY + (size_t)(2 * HW + c) * T;
        hy_stage_inputs(F, c, cw, cb);
        hy_build_k(F, F.KF + (size_t)(0 * HW + c) * SEQ, F.KF + (size_t)(1 * HW + c) * SEQ);
        __syncthreads();
        pg8::f32x4 acc[4];
#if HY_REP & 1
        { pg8::f32x4 acc2[4]; hy_conv(F, HY_ZIN_OFF, acc2); asm volatile("" :: "v"(acc2[0][0]), "v"(acc2[1][1]), "v"(acc2[2][2]), "v"(acc2[3][3])); }
#endif
#if HY_REP & 2
        __syncthreads(); hy_build_k(F, F.KF + (size_t)(0 * HW + c) * SEQ, F.KF + (size_t)(1 * HW + c) * SEQ); __syncthreads();
#endif
#if HY_REP & 4
        __syncthreads(); hy_stage_inputs(F, c, cw, cb); __syncthreads();
#endif
        hy_conv(F, HY_ZIN_OFF, acc);
        const float sk0 = F.hskip[c], sk1 = F.hskip[HW + c];
        {
            unsigned zb = (unsigned)(((16 * q + nn + 16) * 2 + b) * 80 + 8 * hh), xb = (unsigned)(2 * (b * SEQ + 32 * (16 * q + nn) + 4 * hh));
            asm volatile("" : "+v"(zb), "+v"(xb));
#pragma unroll
            for (int g = 0; g < 4; ++g)
#pragma unroll
                for (int e = 0; e < 4; ++e) { const unsigned o = (unsigned)(16 * g + 2 * e);
                    const float vz = bf2f(*(LAS unsigned short*)(lds + HY_ZIN_OFF + zb + o)), x1 = bf2f(*(LAS unsigned short*)(lds + HY_X1_OFF + xb + o));
                    *(LAS unsigned short*)(lds + HY_ZMID_OFF + zb + o) = (unsigned short)f2bf(x1 * (acc[g][e] + sk0 * vz)); }
        }
        __syncthreads();
        hy_build_k(F, F.KF + (size_t)(2 * HW + c) * SEQ, F.KF + (size_t)(3 * HW + c) * SEQ);
        __syncthreads();
        hy_conv(F, HY_ZMID_OFF, acc);
        {
            unsigned zb = (unsigned)(((16 * q + nn + 16) * 2 + b) * 80 + 8 * hh), xb = (unsigned)(2 * (b * SEQ + 32 * (16 * q + nn) + 4 * hh));
            asm volatile("" : "+v"(zb), "+v"(xb));
            bf16* yp = F.YHY + (size_t)(b * SEQ + 32 * (16 * q + nn) + 4 * hh) * HW + c;
#pragma unroll
            for (int g = 0; g < 4; ++g)
#pragma unroll
                for (int e = 0; e < 4; ++e) { const unsigned o = (unsigned)(16 * g + 2 * e);
                    const float z1 = bf2f(*(LAS unsigned short*)(lds + HY_ZMID_OFF + zb + o)), x2 = bf2f(*(LAS unsigned short*)(lds + HY_X2_OFF + xb + o));
                    yp[(size_t)(8 * g + e) * HW] = (bf16)f2bf(x2 * (acc[g][e] + sk1 * z1)); }
        }
    }
}
__device__ __forceinline__ void p3_attn_naive(Frame& F) {
    LAS float* qs = (LAS float*)F.lds + F.wave * 128;
    const int gw = F.bid * NWAVES + F.wave, NGW = F.G * NWAVES;
    const float scale = 0.08838834764831845f;
    for (int u = gw; u < T * 4; u += NGW) {
        const int m = u >> 2, hh = u & 3, b = m / SEQ, s = m % SEQ;
        float Mrun = -3.0e38f, Lrun = 0.f, o0 = 0.f, o1 = 0.f;
#pragma unroll 1
        for (int g = 0; g < 3; ++g) {
            const int head = g * 4 + hh, dil = (g == 0) ? 1 : (g == 1 ? 4 : 16);
            const bf16* qp = F.QKV + (size_t)m * QKVW + head * HD;
            { const unsigned qq = *(const unsigned*)(qp + 2 * F.lane); qs[2 * F.lane] = bflo(qq); qs[2 * F.lane + 1] = bfhi(qq); }
            asm volatile("s_waitcnt lgkmcnt(0)" ::: "memory");
            float sc[3];
#pragma unroll
            for (int p = 0; p < 3; ++p) {
                const int j = (p == 0) ? F.lane - 64 : (p == 1 ? F.lane : 64);
                const int ks = s + j * dil; const bool valid = (ks >= 0) && (ks < SEQ) && (p < 2 || F.lane == 0);
                float dot = 0.f;
                if (valid) { const v4u* kp = (const v4u*)(F.QKV + (size_t)(b * SEQ + ks) * QKVW + NH * HD + head * HD);
#pragma unroll 4
                    for (int c8 = 0; c8 < 16; ++c8) { const v4u kv = kp[c8]; const LAS float* q8 = qs + 8 * c8;
                        dot += bflo(kv.x) * q8[0] + bfhi(kv.x) * q8[1] + bflo(kv.y) * q8[2] + bfhi(kv.y) * q8[3] + bflo(kv.z) * q8[4] + bfhi(kv.z) * q8[5] + bflo(kv.w) * q8[6] + bfhi(kv.w) * q8[7]; } }
                sc[p] = valid ? dot * scale : -1.0e30f;
            }
            const float mg = wave_max(fmaxf(fmaxf(sc[0], sc[1]), sc[2]));
            const float mnew = fmaxf(Mrun, mg), resc = __expf(Mrun - mnew);
            float pr[3];
#pragma unroll
            for (int p = 0; p < 3; ++p) pr[p] = (sc[p] > -1.0e29f) ? __expf(sc[p] - mnew) : 0.f;
            Lrun = Lrun * resc + wave_sum(pr[0] + pr[1] + pr[2]); o0 *= resc; o1 *= resc; Mrun = mnew;
            const bf16* vbase = F.QKV + 2 * NH * HD + head * HD + 2 * F.lane;
            for (int jj = 0; jj < 129; ++jj) {
                const int j = jj - 64, ks = s + j * dil;
                if (ks < 0 || ks >= SEQ) continue;
                const float pk = (jj < 64) ? __shfl(pr[0], jj) : (jj < 128 ? __shfl(pr[1], jj - 64) : __shfl(pr[2], 0));
                const unsigned vv = *(const unsigned*)(vbase + (size_t)(b * SEQ + ks) * QKVW);
                o0 += pk * bflo(vv); o1 += pk * bfhi(vv);
            }
        }
        const float inv = 1.0f / Lrun;
        *(unsigned*)(F.YAT + (size_t)m * 512 + hh * HD + 2 * F.lane) = pk2(o0 * inv, o1 * inv);
    }
}


constexpr int AT_VPITCH = 320, AT_VBYTES = 32 * AT_VPITCH;
typedef short s16x4 __attribute__((ext_vector_type(4)));
#define AT_TR8(S, VB, R) asm volatile( \
    "ds_read_b64_tr_b16 %0, %8 offset:%9\n\tds_read_b64_tr_b16 %1, %8 offset:%10\n\tds_read_b64_tr_b16 %2, %8 offset:%11\n\tds_read_b64_tr_b16 %3, %8 offset:%12\n\t" \
    "ds_read_b64_tr_b16 %4, %8 offset:%13\n\tds_read_b64_tr_b16 %5, %8 offset:%14\n\tds_read_b64_tr_b16 %6, %8 offset:%15\n\tds_read_b64_tr_b16 %7, %8 offset:%16\n\ts_waitcnt lgkmcnt(0)" \
    : "=&v"(R[0]), "=&v"(R[1]), "=&v"(R[2]), "=&v"(R[3]), "=&v"(R[4]), "=&v"(R[5]), "=&v"(R[6]), "=&v"(R[7]) \
    : "v"(VB), "i"((16 * (S)) * AT_VPITCH), "i"((16 * (S) + 8) * AT_VPITCH), "i"((16 * (S)) * AT_VPITCH + 64), "i"((16 * (S) + 8) * AT_VPITCH + 64), \
      "i"((16 * (S)) * AT_VPITCH + 128), "i"((16 * (S) + 8) * AT_VPITCH + 128), "i"((16 * (S)) * AT_VPITCH + 192), "i"((16 * (S) + 8) * AT_VPITCH + 192) : "memory")
__device__ __forceinline__ void p4_attn_mfma(Frame& F) {
    typedef short bf16x8 __attribute__((ext_vector_type(8)));
    typedef float f32x16 __attribute__((ext_vector_type(16)));
    typedef float f32x2 __attribute__((ext_vector_type(2)));
    typedef __bf16 bf16x2v __attribute__((ext_vector_type(2)));
    const int lane = F.lane, w = F.wave, r31 = lane & 31, hh = lane >> 5;
    LAS unsigned char* vimg = F.lds + w * AT_VBYTES;
    const unsigned vb = (unsigned)(size_t)vimg + (unsigned)((4 * hh + ((lane & 15) >> 2)) * AT_VPITCH + 32 * ((lane >> 4) & 1) + 8 * (lane & 3));
    const int gw = F.bid * NWAVES + w, NGW = F.G * NWAVES;
    const float scale = 0.08838834764831845f;
    bf16* AO = (bf16*)F.YB; float* LSE = (float*)((unsigned char*)F.YB + 32 * MiB);
    const int nunit = 2 * NH * 128, per_wg = (nunit + F.G - 1) / F.G;
    for (int k = w; k < per_wg; k += NWAVES) {
        const int u = F.bid * per_wg + k; if (u >= nunit) break;
        const int b = u / (NH * 128), rem = u % (NH * 128), head = rem >> 7, blk = rem & 127, g = head >> 2, hs = head & 3;
        const int dl = (g == 0) ? 0 : (g == 1 ? 2 : 4), dil = 1 << dl, res = blk & (dil - 1), q0 = (blk >> dl) * 32, n = SEQ >> dl;
        const size_t tokq = (size_t)(b * SEQ + res + dil * (q0 + r31));
        bf16x8 qf[8];
        { const bf16* qrow = F.QKV + tokq * QKVW + head * HD + 8 * hh;
#pragma unroll
          for (int s = 0; s < 8; ++s) qf[s] = *(const bf16x8*)(qrow + 16 * s); }
        f32x16 o[4];
#pragma unroll
        for (int dt = 0; dt < 4; ++dt)
#pragma unroll
            for (int i = 0; i < 16; ++i) o[dt][i] = 0.f;
        float mrun = -3.0e38f, lrun = 0.f;
        const int kt_lo = (q0 >= 64) ? 0 : (64 - q0) >> 5, kt_hi = ((n + 32 - q0) >> 5) < 4 ? ((n + 32 - q0) >> 5) : 4;
        bf16x8 kfN[8], vvN[8];
#define AT_FETCH(KT) do { const int _k0 = q0 - 64 + 32 * (KT); \
            const bf16* _krow = F.QKV + (size_t)(b * SEQ + res + dil * (_k0 + r31)) * QKVW + NH * HD + head * HD + 8 * hh; \
            const bf16* _vsrc = F.QKV + (size_t)(b * SEQ + res + dil * (_k0 + (lane >> 4))) * QKVW + 2 * NH * HD + head * HD + (lane & 15) * 8; \
            _Pragma("unroll") for (int _s = 0; _s < 8; ++_s) kfN[_s] = *(const bf16x8*)(_krow + 16 * _s); \
            _Pragma("unroll") for (int _i = 0; _i < 8; ++_i) vvN[_i] = *(const bf16x8*)(_vsrc + (size_t)(4 * _i * dil) * QKVW); } while (0)
        AT_FETCH(kt_lo);
#pragma unroll 1
        for (int kt = kt_lo; kt <= kt_hi; ++kt) {
            const int kt0 = q0 - 64 + 32 * kt;
            bf16x8 kf[8];
#pragma unroll
            for (int s = 0; s < 8; ++s) kf[s] = kfN[s];
#pragma unroll
            for (int i = 0; i < 8; ++i) *(LAS bf16x8*)(vimg + (4 * i + (lane >> 4)) * AT_VPITCH + (lane & 15) * 16) = vvN[i];
            if (kt < kt_hi) AT_FETCH(kt + 1);
            f32x16 sacc;
#pragma unroll
            for (int i = 0; i < 16; ++i) sacc[i] = 0.f;
#pragma unroll
            for (int s = 0; s < 8; ++s) sacc = __builtin_amdgcn_mfma_f32_32x32x16_bf16(kf[s], qf[s], sacc, 0, 0, 0);
            float p[16]; float mx = -3.0e38f;
            const bool edge = (kt == 0) || (kt == 4);
#pragma unroll
            for (int i = 0; i < 16; ++i) { float sv = sacc[i] * scale;
                if (edge) { const int diff = (q0 + r31) - (kt0 + (i & 3) + 8 * (i >> 2) + 4 * hh); if (diff > 64 || diff < -64) sv = -1.0e30f; }
                p[i] = sv; mx = fmaxf(mx, sv); }
            mx = fmaxf(mx, __shfl_xor(mx, 32));
            const float mnew = fmaxf(mrun, mx), resc = __expf(mrun - mnew);
            float ps = 0.f;
#pragma unroll
            for (int i = 0; i < 16; ++i) { p[i] = (p[i] > -1.0e29f) ? __expf(p[i] - mnew) : 0.f; ps += p[i]; }
            ps += __shfl_xor(ps, 32);
            lrun = lrun * resc + ps; mrun = mnew;
#pragma unroll
            for (int dt = 0; dt < 4; ++dt)
#pragma unroll
                for (int i = 0; i < 16; ++i) o[dt][i] *= resc;
            bf16x8 pf[2];
#pragma unroll
            for (int s = 0; s < 2; ++s) { union { bf16x8 v; bf16x2v h[4]; } cv;
#pragma unroll
                for (int j = 0; j < 4; ++j) cv.h[j] = __builtin_convertvector((f32x2){p[8 * s + 2 * j], p[8 * s + 2 * j + 1]}, bf16x2v);
                pf[s] = cv.v; }
            asm volatile("s_waitcnt lgkmcnt(0)" ::: "memory");
            { s16x4 tr[8]; AT_TR8(0, vb, tr);
#pragma unroll
              for (int dt = 0; dt < 4; ++dt) { const bf16x8 va = __builtin_shufflevector(tr[2 * dt], tr[2 * dt + 1], 0, 1, 2, 3, 4, 5, 6, 7); o[dt] = __builtin_amdgcn_mfma_f32_32x32x16_bf16(va, pf[0], o[dt], 0, 0, 0); } }
            { s16x4 tr[8]; AT_TR8(1, vb, tr);
#pragma unroll
              for (int dt = 0; dt < 4; ++dt) { const bf16x8 va = __builtin_shufflevector(tr[2 * dt], tr[2 * dt + 1], 0, 1, 2, 3, 4, 5, 6, 7); o[dt] = __builtin_amdgcn_mfma_f32_32x32x16_bf16(va, pf[1], o[dt], 0, 0, 0); } }
        }
#undef AT_FETCH
        const float inv = 1.0f / lrun;
        bf16* op = AO + ((size_t)g * T + tokq) * 512 + hs * HD + 4 * hh;
#pragma unroll
        for (int dt = 0; dt < 4; ++dt)
#pragma unroll
            for (int a = 0; a < 4; ++a) { v2u ov; ov.x = pk2(o[dt][4 * a] * inv, o[dt][4 * a + 1] * inv); ov.y = pk2(o[dt][4 * a + 2] * inv, o[dt][4 * a + 3] * inv);
                *(v2u*)(op + 32 * dt + 8 * a) = ov; }
        if (hh == 0) LSE[((size_t)g * T + tokq) * 4 + hs] = mrun + logf(lrun);
    }
}
__device__ __forceinline__ void p4b_combine(Frame& F) {
    const bf16* AO = (const bf16*)F.YB; const float* LSE = (const float*)((const unsigned char*)F.YB + 32 * MiB);
    const int gw = F.bid * NWAVES + F.wave, NGW = F.G * NWAVES, lane = F.lane, hs = lane >> 4;
    for (int m = gw; m < T; m += NGW) {
        float l[3];
#pragma unroll
        for (int g = 0; g < 3; ++g) l[g] = LSE[((size_t)g * T + m) * 4 + hs];
        const float mx = fmaxf(fmaxf(l[0], l[1]), l[2]);
        float wg[3], den = 0.f;
#pragma unroll
        for (int g = 0; g < 3; ++g) { wg[g] = __expf(l[g] - mx); den += wg[g]; }
        const float inv = 1.0f / den;
        float acc[8];
#pragma unroll
        for (int j = 0; j < 8; ++j) acc[j] = 0.f;
#pragma unroll
        for (int g = 0; g < 3; ++g) { const v4u q = *(const v4u*)(AO + ((size_t)g * T + m) * 512 + 8 * lane); const float ww = wg[g] * inv;
            acc[0] += ww * bflo(q.x); acc[1] += ww * bfhi(q.x); acc[2] += ww * bflo(q.y); acc[3] += ww * bfhi(q.y); acc[4] += ww * bflo(q.z); acc[5] += ww * bfhi(q.z); acc[6] += ww * bflo(q.w); acc[7] += ww * bfhi(q.w); }
        v4u ov; ov.x = pk2(acc[0], acc[1]); ov.y = pk2(acc[2], acc[3]); ov.z = pk2(acc[4], acc[5]); ov.w = pk2(acc[6], acc[7]);
        *(v4u*)(F.YAT + (size_t)m * 512 + 8 * lane) = ov;
    }
}
constexpr int RT_MOD_OFF = 0;
constexpr int RT_W_OFF = 3 * D * 4;
constexpr int RT_INFO_OFF = RT_W_OFF + 8 * D * 4;
__device__ __forceinline__ void rt_dot8(const f32x4 (&v)[8], const LAS float* W, int lane, float (&out)[8]) {
#pragma unroll
    for (int n = 0; n < 8; ++n) { float a = 0.f;
#pragma unroll
        for (int j = 0; j < 8; ++j) { const f32x4 w = *(const LAS f32x4*)(W + n * D + 256 * j + 4 * lane); a += (v[j].x * w.x + v[j].y * w.y) + (v[j].z * w.z + v[j].w * w.w); }
        out[n] = wave_sum(a); }
}
template <bool DRY> __device__ __forceinline__ void p6_rows_router(Frame& F) {
    LAS float* L = (LAS float*)F.lds;
    LAS float* gatem = L, *shiftf = L + D, *scalef = L + 2 * D;
    LAS float* Wl = (LAS float*)(F.lds + RT_W_OFF);
    LAS float* info = (LAS float*)(F.lds + RT_INFO_OFF);
    const int lane = F.lane;
    for (int blk = F.bid; blk < T / 32; blk += F.G) {
        const int m0 = blk * 32, b = m0 / SEQ;
        __syncthreads();
        load_mod1(F, gatem, 2, b); load_mod1(F, shiftf, 3, b); load_mod1(F, scalef, 4, b);
        for (int i = F.tid; i < 8 * D / 4; i += NTHR) *(LAS f32x4*)(Wl + 4 * i) = *(const f32x4*)(F.WGT + 4 * i);
        __syncthreads();
#pragma unroll 1
        for (int ip = 0; ip < 4; ip += 2) {
            v2u yv[2][8]; f32x4 xv[2][8];
#pragma unroll
            for (int r = 0; r < 2; ++r) { const int m = m0 + 4 * F.wave + ip + r;
                const v2u* yr = (const v2u*)((const bf16*)F.Y + (size_t)m * D) + lane; const f32x4* xr = (const f32x4*)(F.x + (size_t)m * D) + lane;
#pragma unroll
                for (int j = 0; j < 8; ++j) { yv[r][j] = yr[64 * j]; xv[r][j] = xr[64 * j]; } }
#pragma unroll
            for (int r = 0; r < 2; ++r) {
                const int rl = 4 * F.wave + ip + r, m = m0 + rl;
                f32x4 v[8]; float s = 0.f;
#pragma unroll
                for (int j = 0; j < 8; ++j) { const v2u yw = yv[r][j]; v[j] = (f32x4){bflo(yw.x), bfhi(yw.x), bflo(yw.y), bfhi(yw.y)}; s += (v[j].x * v[j].x + v[j].y * v[j].y) + (v[j].z * v[j].z + v[j].w * v[j].w); }
                const float rstd = 1.0f / sqrtf(wave_sum(s) * (1.f / D) + RMS_EPS);
                float s1 = 0.f;
                f32x4* x1r = (f32x4*)(F.X1 + (size_t)m * D) + lane;
#pragma unroll
                for (int j = 0; j < 8; ++j) { const int d = 256 * j + 4 * lane;
                    const f32x4 g = *(const f32x4*)(F.g_mix_post + d), gm = *(LAS f32x4*)(gatem + d);
                    const f32x4 x1 = xv[r][j] + gm * ((v[j] * rstd) * g);
                    x1r[64 * j] = x1; v[j] = x1; s1 += (x1.x * x1.x + x1.y * x1.y) + (x1.z * x1.z + x1.w * x1.w); }
                const float rstd1 = 1.0f / sqrtf(wave_sum(s1) * (1.f / D) + RMS_EPS);
                v2u* o8 = (v2u*)(F.H2 + (size_t)m * D) + lane;
#pragma unroll
                for (int j = 0; j < 8; ++j) { const int d = 256 * j + 4 * lane;
                    const f32x4 g = *(const f32x4*)(F.g_ffn_pre + d), sc = *(LAS f32x4*)(scalef + d), sh = *(LAS f32x4*)(shiftf + d);
                    f32x4 h = (v[j] * rstd1) * g; h = h * (sc + 1.0f) + sh; v[j] = h;
                    v2u w; w.x = pk2(h.x, h.y); w.y = pk2(h.z, h.w); o8[64 * j] = w; }
                float gl[8]; rt_dot8(v, Wl, lane, gl);
                float gmax = -3.0e38f; int gi = 0;
#pragma unroll
                for (int g = 0; g < 8; ++g) { gl[g] += F.b_group[g]; if (gl[g] > gmax) { gmax = gl[g]; gi = g; } }
                float gden = 0.f;
#pragma unroll
                for (int g = 0; g < 8; ++g) gden += expf(gl[g] - gmax);
                if (lane == 0) { info[rl] = rstd1; info[32 + rl] = 1.0f / gden; ((LAS int*)info)[64 + rl] = gi; }
            }
        }
        __syncthreads();
#pragma unroll 1
        for (int g = 0; g < 8; ++g) {
            int cnt = 0;
#pragma unroll 1
            for (int rl = 0; rl < 32; ++rl) cnt += (((LAS int*)info)[64 + rl] == g) ? 1 : 0;
            if (cnt == 0) continue;
            for (int i = F.tid; i < 8 * D / 4; i += NTHR) *(LAS f32x4*)(Wl + 4 * i) = *(const f32x4*)(F.WET + (size_t)g * 8 * D + 4 * i);
            __syncthreads();
            int k = 0;
#pragma unroll 1
            for (int rl = 0; rl < 32; ++rl) {
                if (((LAS int*)info)[64 + rl] != g) continue;
                const bool mine = ((k & 7) == F.wave); ++k;
                if (!mine) continue;
                const int m = m0 + rl; const float rstd1 = info[rl], gval = info[32 + rl];
                const f32x4* x1r = (const f32x4*)(F.X1 + (size_t)m * D) + lane;
                f32x4 v[8];
#pragma unroll
                for (int j = 0; j < 8; ++j) { const int d = 256 * j + 4 * lane;
                    const f32x4 gg = *(const f32x4*)(F.g_ffn_pre + d), sc = *(LAS f32x4*)(scalef + d), sh = *(LAS f32x4*)(shiftf + d);
                    f32x4 h = (x1r[64 * j] * rstd1) * gg; v[j] = h * (sc + 1.0f) + sh; }
                float el[8]; rt_dot8(v, Wl, lane, el);
                float e0v = -3.0e38f, e1v = -3.0e38f; int e0i = 0, e1i = 0;
#pragma unroll
                for (int q = 0; q < 8; ++q) { el[q] += F.b_expert[g * 8 + q];
                    if (el[q] > e0v) { e1v = e0v; e1i = e0i; e0v = el[q]; e0i = q; } else if (el[q] > e1v) { e1v = el[q]; e1i = q; } }
                const float p1 = expf(e1v - e0v), den = 1.0f + p1;
                const float gate0 = gval / den, gate1 = gval * p1 / den;
                if (DRY) { if (gate0 + gate1 == 12345.f) F.LISTG[0] = gate0; }
                if (lane == 0 && !DRY) {
                    ((LAS int*)info)[96 + rl] = (g * 8 + e0i) | ((g * 8 + e1i) << 8); info[128 + rl] = gate0; info[160 + rl] = gate1; }
            }
            __syncthreads();
        }
        if (!DRY && F.tid < 32) {
            const int rl = F.tid, m = m0 + rl; const int ee = ((LAS int*)info)[96 + rl], ex0 = ee & 255, ex1 = ee >> 8; const float gate0 = info[128 + rl], gate1 = info[160 + rl];
            const unsigned pos0 = atomicAdd(F.ctl + CW_CNT + CNT_STRIDE * ex0, 1u), pos1 = atomicAdd(F.ctl + CW_CNT + CNT_STRIDE * ex1, 1u);
            F.LISTT[ex0 * T + pos0] = m; F.LISTG[ex0 * T + pos0] = gate0;
            F.LISTT[ex1 * T + pos1] = m; F.LISTG[ex1 * T + pos1] = gate1;
            F.ROUTE[m * 4 + 0] = (unsigned)(ex0 * T) + pos0; F.ROUTE[m * 4 + 1] = (unsigned)(ex1 * T) + pos1;
        }
    }
}

__device__ __forceinline__ void moe_offsets(Frame& F, LAS int* offs  , LAS int* toff  ) {
    if (F.tid < 64) { const int c = (int)__hip_atomic_load(F.ctl + CW_CNT + CNT_STRIDE * F.tid, __ATOMIC_RELAXED, __HIP_MEMORY_SCOPE_AGENT); const int tc = (c + 63) / 64; int incl = c, tincl = tc;
#pragma unroll
        for (int o = 1; o < 64; o <<= 1) { const int v = __shfl_up(incl, o), tv = __shfl_up(tincl, o); if (F.tid >= o) { incl += v; tincl += tv; } }
        offs[F.tid] = incl - c; toff[F.tid] = tincl - tc; if (F.tid == 63) { offs[NE] = incl; toff[NE] = tincl; } }
    __syncthreads();
}
__device__ __forceinline__ void p7_moe1(Frame& F) {
    LAS float* L = (LAS float*)F.lds;
    LAS int* offs = (LAS int*)(L + 8192 * 3); LAS int* toff = offs + 80;
    moe_offsets(F, offs, toff);
    const int ntiles = toff[NE];
    for (int u = F.bid; u < ntiles * 8; u += F.G) {
        const int rt = u >> 3, ct = u & 7;
        int e = 0; while (toff[e + 1] <= rt) ++e;
        const int r0 = (rt - toff[e]) * 64, ne = offs[e + 1] - offs[e];
        const int* lt = F.LISTT + e * T + r0;
        const float* W1 = F.w1e + (size_t)e * D * FF + ct * 64; const float* W3 = F.w3e + (size_t)e * D * FF + ct * 64;
        const bf16* H2 = F.H2;
        auto la = [&](int r, int k) -> float { return (r0 + r < ne) ? bf2f(H2[(size_t)lt[r] * D + k]) : 0.f; };
        auto lb = [&](int q, int k, int c) -> float { return (q == 0 ? W1 : W3)[(size_t)k * FF + c]; };
        float* ACT = F.ACT + (size_t)(offs[e] + r0) * FF + ct * 64;
        auto ep = [&](int r, int c, const float (&v)[2]) { if (r0 + r < ne) { const float a = v[0], bb = v[1]; ACT[(size_t)r * FF + c] = (a / (1.0f + __expf(-a))) * bb; } };
        simt_tile<2>(L, D, F.tid, la, lb, ep);
    }
}
__device__ __forceinline__ void p8_moe2(Frame& F) {
    LAS float* L = (LAS float*)F.lds;
    LAS int* offs = (LAS int*)(L + 8192 * 3); LAS int* toff = offs + 80;
    moe_offsets(F, offs, toff);
    const int ntiles = toff[NE];
    for (int u = F.bid; u < ntiles * 32; u += F.G) {
        const int rt = u >> 5, ct = u & 31;
        int e = 0; while (toff[e + 1] <= rt) ++e;
        const int r0 = (rt - toff[e]) * 64, ne = offs[e + 1] - offs[e];
        const float* A = F.ACT + (size_t)(offs[e] + r0) * FF;
        const float* W2 = F.w2e + (size_t)e * FF * D + ct * 64;
        const float* lg = F.LISTG + e * T + r0;
        auto la = [&](int r, int k) -> float { return (r0 + r < ne) ? A[(size_t)r * FF + k] : 0.f; };
        auto lb = [&](int q, int k, int c) -> float { return W2[(size_t)k * D + c]; };
        float* YB = F.YB + (size_t)(offs[e] + r0) * D + ct * 64;
        auto ep = [&](int r, int c, const float (&v)[1]) { if (r0 + r < ne) YB[(size_t)r * D + c] = v[0] * lg[r]; };
        simt_tile<1>(L, FF, F.tid, la, lb, ep);
    }
}

template <int MODE, int VAR = 0>
__device__ __forceinline__ void moe_mfma(Frame& F) {
    constexpr int K = MODE == 0 ? D : FF, LDW = MODE == 0 ? FF : D, NSL = MODE == 0 ? 8 : 16, NK = K / 32;
    constexpr int RPP = 368, NT = 23, S = MOE_S, WST = 16384, XST = NT * 1024, STB = WST + XST;
    static_assert(S * STB <= MOE_OFFS_OFF, "MoE stage ring vs LDS map");
    typedef short bf16x8 __attribute__((ext_vector_type(8)));
    LAS unsigned char* lds = F.lds;
    LAS int* offs = (LAS int*)(lds + MOE_OFFS_OFF);
    __syncthreads();
    if (F.tid < 64) { const int c = (int)__hip_atomic_load(F.ctl + CW_CNT + CNT_STRIDE * F.tid, __ATOMIC_RELAXED, __HIP_MEMORY_SCOPE_AGENT); int incl = c;
#pragma unroll
        for (int o = 1; o < 64; o <<= 1) { const int v = __shfl_up(incl, o); if (F.tid >= o) incl += v; }
        offs[F.tid] = incl - c; if (F.tid == 63) offs[NE] = incl; }
    __syncthreads();
    const int lane = F.lane, w = F.wave, cq = w & 3, rh = w >> 2;
    const int vcu = (F.G % 8 == 0) ? (F.bid % 8) * (F.G / 8) + F.bid / 8 : F.bid;
    for (int u = vcu; u < NE * NSL; u += F.G) {
        const int e = u / NSL, sl = u % NSL;
        const int oe = offs[e], ne = offs[e + 1] - oe;
        if (ne == 0) continue;
        const float* Wm0; const float* Wm1;
        if (MODE == 0) { Wm0 = F.w1e + (size_t)e * D * FF + sl * 64; Wm1 = F.w3e + (size_t)e * D * FF + sl * 64; }
        else { Wm0 = F.w2e + (size_t)e * FF * D + sl * 128; Wm1 = Wm0 + 64; }
        for (int r0 = 0; r0 < ne; r0 += RPP) {
            const int nr = (ne - r0) < RPP ? (ne - r0) : RPP, ntile = (nr + 15) >> 4;
            const char* xsrc[3]; unsigned xdst[3];
#pragma unroll
            for (int i = 0; i < 3; ++i) { int tile = 3 * w + i; if (tile > NT - 1) tile = NT - 1;
                int row = r0 + 16 * tile + (lane >> 2); if (row > ne - 1) row = ne - 1;
                const size_t srow = (MODE == 0) ? (size_t)F.LISTT[e * T + row] : (size_t)(oe + row);
                xsrc[i] = (const char*)(MODE == 0 ? (const void*)F.H2 : (const void*)F.ACTB) + srow * (size_t)(K * 2) + (lane & 3) * 16;
                xdst[i] = (unsigned)(WST + tile * 1024); }
            const char* wsrc[2]; unsigned wdst[2];
#pragma unroll
            for (int i = 0; i < 2; ++i) { const int kr = 8 * (w & 3) + 4 * i;
                wsrc[i] = (const char*)((w >> 2) ? Wm1 : Wm0) + ((size_t)(kr + (lane >> 4)) * LDW) * 4 + (lane & 15) * 16;
                if (VAR == 10) wsrc[i] = (const char*)F.w1e + (size_t)(u & 255) * (K * 128 * 4) + (size_t)(2 * w + i) * 1024 + lane * 16;
                wdst[i] = (unsigned)((w >> 2) * 8192 + kr * 256); }
            asm volatile("s_waitcnt vmcnt(0)" ::: "memory");
#define MOE_ISSUE(stage, ks) do { const unsigned _sb = (unsigned)(stage) * STB; const size_t _kx = (size_t)(ks) * 64, _kw = (VAR == 10) ? (size_t)(ks) * 16384 : (size_t)(ks) * 32 * LDW * 4; \
            if (VAR < 8) { _Pragma("unroll") for (int _i = 0; _i < 3; ++_i) __builtin_amdgcn_global_load_lds((const unsigned*)(xsrc[_i] + _kx), (LAS unsigned*)(lds + _sb + xdst[_i]), 16, 0, 0); } \
                        { _Pragma("unroll") for (int _i = 0; _i < 2; ++_i) __builtin_amdgcn_global_load_lds((const unsigned*)(wsrc[_i] + _kw), (LAS unsigned*)(lds + _sb + wdst[_i]), 16, 0, 2  ); } } while (0)
            if (VAR >= 11) {
                v4u r[4][2];
#pragma unroll
                for (int q = 0; q < 4; ++q) { r[q][0] = (v4u){0u, 0u, 0u, 0u}; r[q][1] = (v4u){0u, 0u, 0u, 0u}; }
#define RS_LOAD(slot, ks) do { const size_t _kw = (size_t)(ks) * 32 * LDW * 4; _Pragma("unroll") for (int _i = 0; _i < 2; ++_i) { \
                    if (VAR == 11) asm volatile("global_load_dwordx4 %0, %1, off nt" : "+v"(r[slot][_i]) : "v"(wsrc[_i] + _kw) : "memory"); \
                    else asm volatile("global_load_dwordx4 %0, %1, off" : "+v"(r[slot][_i]) : "v"(wsrc[_i] + _kw) : "memory"); } } while (0)
                RS_LOAD(0, 0); RS_LOAD(1, 1); RS_LOAD(2, 2);
#pragma unroll 1
                for (int t = 0; t < NK; t += 4) {
#pragma unroll
                    for (int q = 0; q < 4; ++q) { asm volatile("s_waitcnt vmcnt(4)" ::: "memory"); __builtin_amdgcn_s_barrier(); const int tn = t + q + 3; RS_LOAD((q + 3) & 3, tn < NK ? tn : 0); }
                }
                asm volatile("s_waitcnt vmcnt(0)" : "+v"(r[0][0]), "+v"(r[0][1]), "+v"(r[1][0]), "+v"(r[1][1]), "+v"(r[2][0]), "+v"(r[2][1]), "+v"(r[3][0]), "+v"(r[3][1]) :: "memory");
                unsigned sk = 0u;
#pragma unroll
                for (int q = 0; q < 4; ++q) sk ^= r[q][0].x ^ r[q][1].y;
                if (sk == 0x9e3779b9u) F.ctl[200] = sk;
                __builtin_amdgcn_s_barrier();
#undef RS_LOAD
                continue;
            }
            f32x4 acc[2][12]; unsigned sink = 0u;
#pragma unroll
            for (int m = 0; m < 2; ++m)
#pragma unroll
                for (int j = 0; j < 12; ++j) acc[m][j] = (f32x4){0.f, 0.f, 0.f, 0.f};
#pragma unroll
            for (int s = 0; s < S - 1; ++s) MOE_ISSUE(s, s);
            const unsigned wrd = (unsigned)((8 * (lane >> 4)) * 256 + (16 * cq + (lane & 15)) * 4);
            const unsigned xrd = (unsigned)(WST + (lane & 15) * 64 + (lane >> 4) * 16);
#pragma unroll 1
            for (int t = 0; t < NK; ++t) {
                if (VAR >= 8) asm volatile("s_waitcnt vmcnt(4)" ::: "memory"); else
                if (S == 3) asm volatile("s_waitcnt vmcnt(5)" ::: "memory"); else asm volatile("s_waitcnt vmcnt(10)" ::: "memory");
                __builtin_amdgcn_s_barrier();
                asm volatile("" ::: "memory");
                { const int tn = t + S - 1; MOE_ISSUE((S == 4 ? (tn & 3) : (tn % S)), tn < NK ? tn : 0); }
                if (VAR >= 8) continue;
                const unsigned sb = (unsigned)(S == 4 ? (t & 3) : (t % S)) * STB;
                bf16x8 af[2];
#pragma unroll
                for (int m = 0; m < 2; ++m) { float f[8];
#pragma unroll
                    for (int j = 0; j < 8; ++j) f[j] = *(const LAS float*)(lds + sb + m * 8192 + wrd + j * 256);
                    union { bf16x8 v; unsigned u[4]; } cv;
#pragma unroll
                    for (int p = 0; p < 4; ++p) cv.u[p] = pg8::cvt_pk_bf16(f[2 * p], f[2 * p + 1]);
                    af[m] = cv.v; }
#pragma unroll
                for (int jb = 0; jb < 12; jb += 6) { bf16x8 xb[6];
#pragma unroll
                    for (int q = 0; q < 6; ++q) { int tile = 2 * (jb + q) + rh; if (tile > NT - 1) tile = NT - 1; xb[q] = *(const LAS bf16x8*)(lds + sb + xrd + tile * 1024); }
#pragma unroll
                    for (int q = 0; q < 6; ++q) { const int j = jb + q;
                        if (2 * j + rh < ntile) {
                            acc[0][j] = __builtin_amdgcn_mfma_f32_16x16x32_bf16(af[0], xb[q], acc[0][j], 0, 0, 0);
                            acc[1][j] = __builtin_amdgcn_mfma_f32_16x16x32_bf16(af[1], xb[q], acc[1][j], 0, 0, 0); } } }
            }
            asm volatile("s_waitcnt vmcnt(0)" ::: "memory");
            __builtin_amdgcn_s_barrier();
            asm volatile("" ::: "memory");
            if (VAR >= 11 && sink == 0x9e3779b9u) F.ctl[200] = sink;
#undef MOE_ISSUE
#pragma unroll
            for (int j = 0; j < 12; ++j) { const int tile = 2 * j + rh, row = r0 + 16 * tile + (lane & 15);
                if (tile < ntile && row < ne) {
                    if (MODE == 0) { const f32x4 a = acc[0][j], b = acc[1][j]; f32x4 v;
#pragma unroll
                        for (int i = 0; i < 4; ++i) v[i] = (a[i] / (1.0f + __expf(-a[i]))) * b[i];
                        v2u o; o.x = pk2(v[0], v[1]); o.y = pk2(v[2], v[3]);
                        *(v2u*)((VAR ? F.YBB : F.ACTB) + (size_t)(oe + row) * FF + sl * 64 + 16 * cq + 4 * (lane >> 4)) = o; }
                    else { const float g = F.LISTG[e * T + row]; const f32x4 a = acc[0][j] * g, b = acc[1][j] * g;
                        bf16* yp = F.YBB + (size_t)(oe + row) * D + sl * 128 + 16 * cq + 4 * (lane >> 4);
                        v2u o0; o0.x = pk2(a[0], a[1]); o0.y = pk2(a[2], a[3]); *(v2u*)yp = o0;
                        v2u o1; o1.x = pk2(b[0], b[1]); o1.y = pk2(b[2], b[3]); *(v2u*)(yp + 64) = o1; }
                } }
        }
    }
}
__device__ __forceinline__ void p9_final(Frame& F) {
    LAS float* L = (LAS float*)F.lds;
    LAS float* gatef = L;
    LAS int* offs = (LAS int*)(L + 8192 * 3); LAS int* toff = offs + 80;
    load_mod(F, gatef, 5);
    moe_offsets(F, offs, toff);
    const int gw = F.bid * NWAVES + F.wave, NGW = F.G * NWAVES;
#if MOE_SIMT
    for (int m = gw; m < T; m += NGW) {
        const int b = m / SEQ;
        const unsigned s0 = F.ROUTE[m * 4 + 0], s1 = F.ROUTE[m * 4 + 1];
        const size_t r0 = (size_t)offs[s0 / T] + (s0 % T), r1 = (size_t)offs[s1 / T] + (s1 % T);
        f32x4 v[8]; float s = 0.f;
        const f32x4* y0 = (const f32x4*)(F.YB + r0 * D) + F.lane; const f32x4* y1 = (const f32x4*)(F.YB + r1 * D) + F.lane;
#pragma unroll
        for (int j = 0; j < 8; ++j) { v[j] = y0[64 * j] + y1[64 * j]; s += (v[j].x * v[j].x + v[j].y * v[j].y) + (v[j].z * v[j].z + v[j].w * v[j].w); }
        const float rstd = 1.0f / sqrtf(wave_sum(s) * (1.f / D) + RMS_EPS);
        const f32x4* x1r = (const f32x4*)(F.X1 + (size_t)m * D) + F.lane; f32x4* outr = (f32x4*)(F.out + (size_t)m * D) + F.lane;
#pragma unroll
        for (int j = 0; j < 8; ++j) { const int d = 256 * j + 4 * F.lane;
            const f32x4 g = *(const f32x4*)(F.g_ffn_post + d), gf = *(LAS f32x4*)(gatef + b * D + d);
            outr[64 * j] = x1r[64 * j] + gf * ((v[j] * rstd) * g); }
    }
#else
    for (int m0 = gw; m0 < T; m0 += 2 * NGW) {
        unsigned sl[2][2];
#pragma unroll
        for (int r = 0; r < 2; ++r) { const int m = m0 + r * NGW; if (m < T) { sl[r][0] = F.ROUTE[m * 4 + 0]; sl[r][1] = F.ROUTE[m * 4 + 1]; } else { sl[r][0] = 0; sl[r][1] = 0; } }
        v2u ya[2][8], yb[2][8]; f32x4 xv[2][8];
#pragma unroll
        for (int r = 0; r < 2; ++r) { const int m = m0 + r * NGW; if (m < T) {
            const size_t r0 = (size_t)offs[sl[r][0] / T] + (sl[r][0] % T), r1 = (size_t)offs[sl[r][1] / T] + (sl[r][1] % T);
            const v2u* y0 = (const v2u*)(F.YBB + r0 * D) + F.lane; const v2u* y1 = (const v2u*)(F.YBB + r1 * D) + F.lane; const f32x4* x1r = (const f32x4*)(F.X1 + (size_t)m * D) + F.lane;
#pragma unroll
            for (int j = 0; j < 8; ++j) { ya[r][j] = y0[64 * j]; yb[r][j] = y1[64 * j]; xv[r][j] = x1r[64 * j]; } } }
#pragma unroll
        for (int r = 0; r < 2; ++r) { const int m = m0 + r * NGW; if (m < T) { const int b = m / SEQ; f32x4 v[8]; float s = 0.f;
#pragma unroll
            for (int j = 0; j < 8; ++j) { const v2u a = ya[r][j], b2 = yb[r][j];
                v[j] = (f32x4){bflo(a.x) + bflo(b2.x), bfhi(a.x) + bfhi(b2.x), bflo(a.y) + bflo(b2.y), bfhi(a.y) + bfhi(b2.y)};
                s += (v[j].x * v[j].x + v[j].y * v[j].y) + (v[j].z * v[j].z + v[j].w * v[j].w); }
            const float rstd = 1.0f / sqrtf(wave_sum(s) * (1.f / D) + RMS_EPS);
            f32x4* outr = (f32x4*)(F.out + (size_t)m * D) + F.lane;
#pragma unroll
            for (int j = 0; j < 8; ++j) { const int d = 256 * j + 4 * F.lane;
                const f32x4 g = *(const f32x4*)(F.g_ffn_post + d), gf = *(LAS f32x4*)(gatef + b * D + d);
                outr[64 * j] = xv[r][j] + gf * ((v[j] * rstd) * g); } } }
    }
#endif
}

#if SIMPLE_GEMM
template <class EP>
__device__ __forceinline__ void simple_gemm(Frame& F, const bf16* A, const bf16* Bt, int M, int N, int K, const EP& ep) {
    LAS float* L = (LAS float*)F.lds;
    const int tn = N / 64, nt = (M / 64) * tn;
    for (int u = F.bid; u < nt; u += F.G) {
        const int r0 = (u / tn) * 64, c0 = (u % tn) * 64;
        auto la = [&](int r, int k) -> float { return bf2f(A[(size_t)(r0 + r) * K + k]); };
        auto lb = [&](int q, int k, int c) -> float { return bf2f(Bt[(size_t)(c0 + c) * K + k]); };
        auto e2 = [&](int r, int c, const float (&v)[1]) { ep(r0 + r, c0 + c, v[0]); };
        simt_tile<1>(L, K, F.tid, la, lb, e2);
    }
}
#endif

#ifndef REPEAT_MASK
#define REPEAT_MASK 0
#endif
__device__ __forceinline__ void phase_gemm2(Frame& F) {
#if SIMPLE_GEMM
        { bf16* PHY = F.PHY; simple_gemm(F, F.W1T, F.H, 3 * HW, T, D, [&](int r, int c, float v) { PHY[(size_t)r * T + c] = (bf16)f2bf(v); }); }
        __syncthreads();
        { bf16* QKVp = F.QKV; bf16* Gp = F.GT; const float* bias = F.b_bg;
          simple_gemm(F, F.H, F.W1T + (size_t)(3 * HW) * D, T, QKVW + 2 * D, D, [&](int r, int c, float v) {
              if (c < QKVW) QKVp[(size_t)r * QKVW + c] = (bf16)f2bf(v); else Gp[(size_t)r * (2 * D) + (c - QKVW)] = (bf16)f2bf(1.0f / (1.0f + __expf(-(v + bias[c - QKVW])))); }); }
#else
        { DualOrder S; S.s0.init(3 * HW, T, 1, 0); S.s1.init(T, QKVW + 2 * D, 1, 0); S.G = F.G; S.c = F.bid;
          S.A0 = F.W1T; S.B0 = F.H; S.A1 = F.H; S.B1 = F.W1T + (size_t)(3 * HW) * D;
          EpiDual E{EpiPlainBf16{F.PHY, T}, EpiProj{F.QKV, F.GT, F.ROT, F.b_bg}};
          pg8::Gemm g{F.H, F.H, T, T, D};
          pg8::gemm_phase<EpiDual, DualOrder, true, true>(F.lds, g, S, E); }
#endif
}
__device__ __forceinline__ void phase_gemm6(Frame& F) {
#if SIMPLE_GEMM
        { float* TMP = F.TMP; const bf16* G = F.GT; simple_gemm(F, F.YHY, F.WHYOT, T, D, HW, [&](int r, int c, float v) { TMP[(size_t)r * D + c] = v * bf2f(G[(size_t)r * (2 * D) + c]); }); }
        __syncthreads();
        { float* TMP = F.TMP; const bf16* G = F.GT; bf16* Mp = F.MERGED; simple_gemm(F, F.YAT, F.WATOT, T, D, 512, [&](int r, int c, float v) { Mp[(size_t)r * D + c] = (bf16)f2bf(TMP[(size_t)r * D + c] + v * bf2f(G[(size_t)r * (2 * D) + D + c])); }); }
#else
        { EpiGate<0> E{F.GT, 0, F.TMP, F.MERGED}; run_gemm(F, F.YHY, F.WHYOT, T, D, HW, E); }
        { EpiGate<1> E{F.GT, D, F.TMP, F.MERGED}; run_gemm(F, F.YAT, F.WATOT, T, D, 512, E); }
#endif
}
__device__ __forceinline__ void phase_gemm7(Frame& F) {
#if SIMPLE_GEMM
        { float* Y = F.Y; simple_gemm(F, F.MERGED, F.WOUTT, T, D, D, [&](int r, int c, float v) { Y[(size_t)r * D + c] = v; }); }
#else
        { EpiPlainBf16 E{(bf16*)F.Y, D}; run_gemm(F, F.MERGED, F.WOUTT, T, D, D, E); }
#endif
}
__global__ void __launch_bounds__(NTHR, 2) fwd_kernel(Args args) {
    extern __shared__ __attribute__((aligned(16))) unsigned char lds_raw[];
    Frame F;
    F.lds = (LAS unsigned char*)lds_raw;
    F.tid = threadIdx.x; F.lane = F.tid & 63; F.wave = __builtin_amdgcn_readfirstlane(F.tid >> 6); F.G = gridDim.x; F.bid = blockIdx.x;
    F.x = (const float*)args.in[0]; F.c = (const float*)args.in[1]; F.positions = (const int*)args.in[2]; F.w_ada = (const float*)args.in[3]; F.b_ada = (const float*)args.in[4];
    F.g_mix_pre = (const float*)args.in[5]; F.g_mix_post = (const float*)args.in[6]; F.g_ffn_pre = (const float*)args.in[7]; F.g_ffn_post = (const float*)args.in[8];
    F.w_in = (const float*)args.in[9]; F.conv_w = (const float*)args.in[10]; F.conv_b = (const float*)args.in[11]; F.fw1 = (const float*)args.in[12]; F.fb1 = (const float*)args.in[13];
    F.fw2 = (const float*)args.in[14]; F.fb2 = (const float*)args.in[15]; F.fw3 = (const float*)args.in[16]; F.ffreq = (const float*)args.in[17]; F.hskip = (const float*)args.in[18];
    F.w_bg = (const float*)args.in[19]; F.b_bg = (const float*)args.in[20]; F.w_hy_o = (const float*)args.in[21]; F.w_at_o = (const float*)args.in[22]; F.w_out = (const float*)args.in[23];
    F.w_group = (const float*)args.in[24]; F.b_group = (const float*)args.in[25]; F.w_expert = (const float*)args.in[26]; F.b_expert = (const float*)args.in[27];
    F.w1e = (const float*)args.in[28]; F.w3e = (const float*)args.in[29]; F.w2e = (const float*)args.in[30];
    F.out = args.out;
    unsigned char* ws = args.ws;
    F.ctl = (unsigned*)(ws + WS_CTL); F.MODP = (float*)(ws + WS_MODP); F.HID2 = (float*)(ws + WS_HID2); F.ROT = (float*)(ws + WS_ROT); F.W3T = (float*)(ws + WS_W3T);
    F.WGT = (float*)(ws + WS_WGT); F.WET = (float*)(ws + WS_WET); F.HID2B = (bf16*)(ws + WS_HID2B); F.W3TB = (bf16*)(ws + WS_W3TB);
    F.ROUTE = (unsigned*)(ws + WS_ROUTE); F.LISTT = (int*)(ws + WS_LISTT); F.LISTG = (float*)(ws + WS_LISTG);
    F.W1T = (bf16*)(ws + WS_W1T); F.WHYOT = (bf16*)(ws + WS_WHYOT); F.WATOT = (bf16*)(ws + WS_WATOT); F.WOUTT = (bf16*)(ws + WS_WOUTT);
    F.KF = (bf16*)(ws + WS_KF); F.H = (bf16*)(ws + WS_H); F.PHY = (bf16*)(ws + WS_PHY); F.QKV = (bf16*)(ws + WS_QKV); F.GT = (bf16*)(ws + WS_G);
    F.YHY = (bf16*)(ws + WS_YHY); F.YAT = (bf16*)(ws + WS_YAT); F.TMP = (float*)(ws + WS_TMP); F.MERGED = (bf16*)(ws + WS_MERGED); F.Y = (float*)(ws + WS_Y);
    F.X1 = (float*)(ws + WS_X1); F.H2 = (bf16*)(ws + WS_H2); F.ACT = (float*)(ws + WS_ACT); F.YB = (float*)(ws + WS_YB); F.ACTB = (bf16*)(ws + WS_ACT); F.YBB = (bf16*)(ws + WS_YB);

    volatile LAS unsigned* MISC = (volatile LAS unsigned*)(F.lds + MISC_OFF);
    if (F.tid < 32) MISC[F.tid] = 0u;
    __syncthreads();
    const int lo = args.ph_lo, hi = args.ph_hi;
    const bool multi = (hi - lo) > 1;
#if TLB_TOUCH
    {
        unsigned acc = 0u; const int sub = F.bid >> 3;
        const size_t nws = WS_END >> 21;
        for (size_t p = (size_t)sub * 16 + (F.tid >> 5); p < nws; p += 512) if ((F.tid & 31) == 0) acc += *(const volatile unsigned*)(ws + (p << 21));
        const void* big[8] = {args.in[0], args.in[3], args.in[9], args.in[19], args.in[23], args.in[28], args.in[29], args.in[30]};
        const size_t bsz[8] = {(size_t)T * D * 4, (size_t)D * 6 * D * 4, (size_t)D * INW * 4, (size_t)D * 2 * D * 4, (size_t)D * D * 4, (size_t)NE * D * FF * 4, (size_t)NE * D * FF * 4, (size_t)NE * D * FF * 4};
#pragma unroll
        for (int q = 0; q < 8; ++q) { const size_t np = bsz[q] >> 21;
            for (size_t p = (size_t)sub * 16 + (F.tid >> 5); p < np; p += 512) if ((F.tid & 31) == 0) acc += *(const volatile unsigned*)((const unsigned char*)big[q] + (p << 21)); }
        if (acc == 0x12345679u) F.ctl[100] = acc;
    }
#endif
    XcdBarrier bar; bar.bar = F.ctl + CW_BAR; bar.x = 0; bar.st = nullptr;
    if (multi) bar = xcd_barrier_post(F.ctl + CW_BAR, MISC + 8);
#ifndef PHASE_MASK
#define PHASE_MASK 0xFFFF
#endif
#define IN(k) ((((PHASE_MASK) >> (k)) & 1) && lo <= (k) && (k) < hi)
#ifndef REPEAT_MASK
#define REPEAT_MASK 0
#endif
#define REP(k) for (int _rep = 0; _rep < 1 + (((REPEAT_MASK) >> (k)) & 1); ++_rep)
#ifndef PROBE_TS
#define PROBE_TS -1
#endif
#ifndef PROBE_TSB
#define PROBE_TSB (PROBE_TS + 1)
#endif
#define STAMP(i) do { if (PROBE_TS >= -1 && F.bid == 0 && F.tid == 0) ((unsigned long long*)(F.ctl + 65536))[i] = __builtin_amdgcn_s_memrealtime(); } while (0)
#define SEAM(k) do { if (IN(k) && IN((k) + 1)) xcd_barrier(bar); if (PROBE_TS >= 0) STAMP((k) + 1); } while (0)

#ifndef P0_SKIP
#define P0_SKIP 0
#endif
    if (IN(0)) { p0_prologue<0>(F); if ((REPEAT_MASK) & 1) { __syncthreads(); p0_prologue<P0_SKIP>(F); } } SEAM(0);
    if (IN(1)) REP(1) { __syncthreads(); p1_rows_filters(F); } SEAM(1);
    if (IN(2)) { phase_gemm2(F); if (((REPEAT_MASK) >> 2) & 1) { __syncthreads(); phase_gemm2(F); } } SEAM(2);
    if (IN(3)) {
#if SIMPLE_GEMM
        for (int i = F.bid * NTHR + F.tid; i < T * 24 * 16; i += F.G * NTHR) { const int k = i & 15, hd = (i >> 4) % 24, tok = (i >> 4) / 24;
            bf16* p = F.QKV + (size_t)tok * QKVW + hd * HD; const float a = bf2f(p[k]), b2 = bf2f(p[k + 16]), cs = F.ROT[tok * 32 + k], sn = F.ROT[tok * 32 + 16 + k];
            p[k] = (bf16)f2bf(a * cs - b2 * sn); p[k + 16] = (bf16)f2bf(b2 * cs + a * sn); }
#endif
    }
#if SIMPLE_GEMM
    SEAM(3);
#endif
#if HYENA_NAIVE
    if (IN(4)) { p3_hyena_naive(F); __syncthreads(); p3_attn_naive(F); } SEAM(4);
#elif ATTN_NAIVE
    if (IN(4)) { p3_hyena_mfma(F); __syncthreads(); p3_attn_naive(F); } SEAM(4);
#else
#ifndef P4_PARTS
#define P4_PARTS 3
#endif
    if (IN(4)) REP(4) { __syncthreads(); if (P4_PARTS & 1) p3_hyena_mfma(F); __syncthreads(); if (P4_PARTS & 2) p4_attn_mfma(F);
#if ATTN_REP
        __syncthreads(); p4_attn_mfma(F);
#endif
    } SEAM(4);
    if (IN(5)) REP(5) { p4b_combine(F); } SEAM(5);
#endif
    if (IN(6)) { phase_gemm6(F); if (((REPEAT_MASK) >> 6) & 1) { __syncthreads(); phase_gemm6(F); } } SEAM(6);
    if (IN(7)) { phase_gemm7(F); if (((REPEAT_MASK) >> 7) & 1) { __syncthreads(); phase_gemm7(F); } } SEAM(7);
#ifndef EXTRA_BARRIERS
#define EXTRA_BARRIERS 0
#endif
    if (IN(8)) { if (((REPEAT_MASK) >> 8) & 1) { p6_rows_router<true>(F); __syncthreads(); } for (int _e = 0; _e < EXTRA_BARRIERS; ++_e) xcd_barrier(bar); p6_rows_router<false>(F); } SEAM(8);
#if MOE_SIMT
    if (IN(9)) { p7_moe1(F); } SEAM(9);
    if (IN(10)) { p8_moe2(F); } SEAM(10);
#else
#ifndef MOE_SHADOW
#define MOE_SHADOW 0
#endif
    if (IN(9)) { if (MOE_SHADOW) { moe_mfma<0, (MOE_SHADOW ? MOE_SHADOW : 8)>(F); __syncthreads(); } } if (IN(9)) REP(9) { moe_mfma<0>(F); } SEAM(9);
    if (IN(10)) REP(10) { moe_mfma<1>(F); } SEAM(10);
#endif
    if (IN(11)) REP(11) { __syncthreads(); p9_final(F); }
#if PROBE_TS >= 0
    if (F.bid == 0 && F.tid == 0) { asm volatile("s_waitcnt vmcnt(0)" ::: "memory");
        const unsigned long long* ts = (const unsigned long long*)(F.ctl + 65536);
        const float us = (PROBE_TS == 99) ? 100.0f : (float)(ts[PROBE_TSB] - ts[PROBE_TS]) * 0.01f;
        F.out[0] += sqrtf(198.0f * us); }
#endif
#undef IN
#undef SEAM
}

extern "C" void kernel_launch(void* const* d_in, const int* in_sizes, int n_in, void* d_out, int out_size, void* d_ws, size_t ws_size, hipStream_t stream) {
    static int grid = 0;
    if (grid == 0) {
        if (n_in != 31 || out_size != T * D || ws_size < WS_END) { fprintf(stderr, "kernel_launch: unexpected shapes (n_in %d out %d ws %zu)\n", n_in, out_size, ws_size); grid = -1; return; }
        int dev = 0, cus = 0, per_cu = 0;
        if (hipGetDevice(&dev) != hipSuccess || hipDeviceGetAttribute(&cus, hipDeviceAttributeMultiprocessorCount, dev) != hipSuccess) { grid = -1; return; }
        if (hipFuncSetAttribute((const void*)fwd_kernel, hipFuncAttributeMaxDynamicSharedMemorySize, LDS_BYTES) != hipSuccess) { fprintf(stderr, "kernel_launch: hipFuncSetAttribute failed\n"); grid = -1; return; }
        if (hipOccupancyMaxActiveBlocksPerMultiprocessor(&per_cu, (const void*)fwd_kernel, NTHR, LDS_BYTES) != hipSuccess || per_cu < 1) fprintf(stderr, "kernel_launch: occupancy query says %d\n", per_cu);
        (void)hipGetLastError();
        grid = cus;
    }
    if (grid < 0) return;
    if (hipMemsetAsync((char*)d_ws + WS_CTL, 0, CTL_ZERO_BYTES, stream) != hipSuccess) return;
    Args a{};
    for (int i = 0; i < 31; ++i) a.in[i] = d_in[i];
    a.out = (float*)d_out; a.ws = (unsigned char*)d_ws;
#if N_LAUNCH_MODE == 1
    a.ph_lo = 0; a.ph_hi = NPHASE;
    hipLaunchKernelGGL(fwd_kernel, dim3(grid), dim3(NTHR), LDS_BYTES, stream, a);
#else
    for (int p = 0; p < NPHASE; ++p) { if (p == 3 && !SIMPLE_GEMM) continue; if (p == 5 && (HYENA_NAIVE || ATTN_NAIVE)) continue; a.ph_lo = p; a.ph_hi = p + 1; hipLaunchKernelGGL(fwd_kernel, dim3(grid), dim3(NTHR), LDS_BYTES, stream, a); }
#endif
}
```

```cpp
#include <hip/hip_runtime.h>
#include <cstdio>
#include <cstdint>
namespace pg8 {
#define PG8_LAS __attribute__((address_space(3)))
typedef unsigned short bf16_t;
typedef short bf16x8 __attribute__((ext_vector_type(8)));
typedef float f32x4 __attribute__((ext_vector_type(4)));
typedef unsigned u32x4 __attribute__((ext_vector_type(4)));
constexpr int BM = 256, BK = 64, HALF = 128, HTB = HALF * BK * 2  , STAGE_BYTES = 8 * HTB, NXCD = 8, WGM = 8;

__host__ __device__ __forceinline__ int lds_byte(int r, int c) { const int st = (r >> 4) * 2 + (c >> 5), rr = r & 15, cc = c & 31, ob = rr * 64 + cc * 2; return st * 1024 + (ob ^ (((ob >> 9) & 1) << 5)); }
__host__ __device__ __forceinline__ void stage_rc(int b, int& R, int& C) { const int st = b / 1024, sb = b % 1024, swz = sb ^ (((sb >> 9) & 1) << 5); R = (st >> 1) * 16 + swz / 64; C = (st & 1) * 32 + (swz % 64) / 2; }
__host__ __device__ __forceinline__ int perm32(int rho) { const int n = rho >> 4, i = rho & 15; return 8 * (i >> 2) + 4 * n + (i & 3); }

struct Unit { int pm, pn, kind; };
struct Gemm { const bf16_t* A; const bf16_t* Bt; int M, N, K; };

struct StaticOrder {
    int nM, nN, nwg, G, c;
    __host__ __device__ void init(int M, int N, int G_, int c_) { nM = M / BM; nN = N / BM; nwg = nM * nN; G = G_; c = c_; }
    __host__ __device__ bool next(int i, Unit& u) const {
        const long L = (long)i * G + c; if (L >= nwg) return false;
        int wgid = (int)L; { const int q = nwg / NXCD, r = nwg % NXCD, xcd = wgid % NXCD, off = wgid / NXCD; wgid = (xcd < r ? xcd * (q + 1) : r * (q + 1) + (xcd - r) * q) + off; }
        const int nig = WGM * nN, gid = wgid / nig, fm = gid * WGM, gsz = (nM - fm) < WGM ? (nM - fm) : WGM;
        u.pm = fm + ((wgid % nig) % gsz); u.pn = (wgid % nig) / gsz; u.kind = 0; return true;
    }
    __device__ __forceinline__ void a_ready(const Unit&) const {}
    __device__ __forceinline__ void done(const Unit&) const {}
    __device__ __forceinline__ const bf16_t* abase(const Gemm& g, const Unit&) const { return g.A; }
    __device__ __forceinline__ const bf16_t* bbase(const Gemm& g, const Unit&) const { return g.Bt; }
};

__device__ __forceinline__ unsigned cvt_pk_bf16(float lo, float hi) { unsigned r; asm volatile("v_cvt_pk_bf16_f32 %0, %1, %2" : "=v"(r) : "v"(lo), "v"(hi)); return r; }
typedef float f32x2 __attribute__((ext_vector_type(2)));
template <class Epi, class Sched, bool ALIGN_EPI = false, bool SP2 = false>
__device__ __forceinline__ void gemm_phase(PG8_LAS unsigned char* lds, const Gemm g, const Sched& S, const Epi& E) {
    const int tid = threadIdx.x, wid = __builtin_amdgcn_readfirstlane(tid >> 6), lane = tid & 63, wr = wid >> 2, wc = wid & 3, fr = lane & 15, fq = lane >> 4;
    const int K = g.K, nt = K / BK;
    unsigned voffA[2], voffB[2];
#pragma unroll
    for (int i = 0; i < 2; ++i) { int R, C; stage_rc(tid * 16 + i * 8192, R, C); const int Rb = Epi::PERM ? ((R & ~31) + perm32(R & 31)) : R;
        voffA[i] = (unsigned)(R * K + C) * 2u; voffB[i] = (unsigned)(Rb * K + C) * 2u; }
    const size_t kstep = (size_t)(BK * 2);
    const size_t hstep = (size_t)HALF * K * 2;
    const size_t tstep = 2 * hstep;
    const unsigned ldsw = (unsigned)wid * 1024u;
    const int aoff = lds_byte(wr * 64 + fr, fq * 8), boff = lds_byte(wc * 32 + fr, fq * 8);
#define PG8_SA(b, h) (((b) * 2 + (h)) * HTB)
#define PG8_SB(b, h) ((4 + (b) * 2 + (h)) * HTB)
#define PG8_STAGE(bufoff, gbase, voff) do { _Pragma("unroll") for (int _i = 0; _i < 2; ++_i) \
        __builtin_amdgcn_global_load_lds((const unsigned*)((const char*)(gbase) + (voff)[_i]), (PG8_LAS unsigned*)(lds + (bufoff) + ldsw + _i * 8192), 16, 0, 0); } while (0)
#define PG8_LDA(dst, b, h) do { _Pragma("unroll") for (int m = 0; m < 4; ++m) _Pragma("unroll") for (int k = 0; k < 2; ++k) dst[m][k] = *(const PG8_LAS bf16x8*)(lds + PG8_SA(b, h) + aoff + m * 2048 + k * 1024); } while (0)
#define PG8_LDB(dst, b, h) do { _Pragma("unroll") for (int n = 0; n < 2; ++n) _Pragma("unroll") for (int k = 0; k < 2; ++k) dst[n][k] = *(const PG8_LAS bf16x8*)(lds + PG8_SB(b, h) + boff + n * 2048 + k * 1024); } while (0)
#define PG8_MMA(ai, bj, At, Bt) do { __builtin_amdgcn_s_setprio(1); _Pragma("unroll") for (int m = 0; m < 4; ++m) _Pragma("unroll") for (int n = 0; n < 2; ++n) _Pragma("unroll") for (int k = 0; k < 2; ++k) \
        acc[ai][bj][m][n] = __builtin_amdgcn_mfma_f32_16x16x32_bf16(Bt[n][k], At[m][k], acc[ai][bj][m][n], 0, 0, 0); __builtin_amdgcn_s_setprio(0); } while (0)
#define PG8_WAIT_V(n) asm volatile("s_waitcnt vmcnt(" #n ")" ::: "memory")
#define PG8_WAIT_L(n) asm volatile("s_waitcnt lgkmcnt(" #n ")" ::: "memory")
#define PG8_BAR __builtin_amdgcn_s_barrier()
#define PG8_SCHED __builtin_amdgcn_sched_barrier(0)
    Unit cur, nxt; int ui = 0;
    if (!S.next(0, cur)) return;
    f32x4 acc[2][2][4][2];
#pragma unroll
    for (int a = 0; a < 2; ++a)
#pragma unroll
        for (int b = 0; b < 2; ++b)
#pragma unroll
            for (int m = 0; m < 4; ++m)
#pragma unroll
                for (int n = 0; n < 2; ++n) acc[a][b][m][n] = (f32x4){0.f, 0.f, 0.f, 0.f};
    bf16x8 At[4][2], B0[2][2], B1[2][2];
    const char* cA = (const char*)S.abase(g, cur) + (size_t)cur.pm * tstep; const char* cB = (const char*)S.bbase(g, cur) + (size_t)cur.pn * tstep;
    S.a_ready(cur);
    if constexpr (SP2) {
        PG8_STAGE(PG8_SB(0, 0), cB, voffB); PG8_STAGE(PG8_SB(0, 1), cB + hstep, voffB); PG8_STAGE(PG8_SA(0, 0), cA, voffA); PG8_STAGE(PG8_SA(0, 1), cA + hstep, voffA);
        if (wr == 1) PG8_BAR;
        PG8_WAIT_V(2); PG8_BAR;
        PG8_STAGE(PG8_SB(1, 0), cB + kstep, voffB); PG8_STAGE(PG8_SA(1, 0), cA + kstep, voffA); PG8_STAGE(PG8_SB(1, 1), cB + hstep + kstep, voffB);
        PG8_WAIT_V(6); PG8_BAR;
    } else {
        PG8_STAGE(PG8_SB(0, 0), cB, voffB); PG8_STAGE(PG8_SA(0, 0), cA, voffA); PG8_STAGE(PG8_SB(0, 1), cB + hstep, voffB); PG8_STAGE(PG8_SA(0, 1), cA + hstep, voffA);
        if (wr == 1) PG8_BAR;
        PG8_WAIT_V(4); PG8_BAR;
        PG8_STAGE(PG8_SB(1, 0), cB + kstep, voffB); PG8_STAGE(PG8_SA(1, 0), cA + kstep, voffA); PG8_STAGE(PG8_SB(1, 1), cB + hstep + kstep, voffB);
        PG8_WAIT_V(6); PG8_BAR;
    }
    for (;;) {
        const bool has_next = S.next(ui + 1, nxt);
        const char* nA = has_next ? (const char*)S.abase(g, nxt) + (size_t)nxt.pm * tstep : cA; const char* nB = has_next ? (const char*)S.bbase(g, nxt) + (size_t)nxt.pn * tstep : cB;
        asm volatile(".p2align 8" ::: "memory");
        for (int t = 0; t < nt; t += 2) {
            const bool last = (t == nt - 2);
            const char* a1 = cA + (size_t)(t + 1) * kstep;
            const char* a2 = last ? nA : cA + (size_t)(t + 2) * kstep; const char* b2 = last ? nB : cB + (size_t)(t + 2) * kstep;
            const char* a3 = a2 + kstep; const char* b3 = b2 + kstep;
            if (last && has_next) S.a_ready(nxt);
            if constexpr (SP2) {
            PG8_LDB(B0, 0, 0); PG8_LDB(B1, 0, 1); PG8_SCHED; PG8_LDA(At, 0, 0); PG8_STAGE(PG8_SA(1, 1), a1 + hstep, voffA);
            PG8_WAIT_V(8); PG8_WAIT_L(0); PG8_BAR; PG8_MMA(0, 0, At, B0); PG8_MMA(0, 1, At, B1); PG8_BAR; PG8_SCHED;
            PG8_LDA(At, 0, 1); PG8_STAGE(PG8_SB(0, 0), b2, voffB); PG8_STAGE(PG8_SB(0, 1), b2 + hstep, voffB); PG8_STAGE(PG8_SA(0, 0), a2, voffA);
            PG8_WAIT_V(8); PG8_WAIT_L(0); PG8_BAR; PG8_MMA(1, 0, At, B0); PG8_MMA(1, 1, At, B1); PG8_BAR; PG8_SCHED;
            PG8_LDB(B0, 1, 0); PG8_LDB(B1, 1, 1); PG8_SCHED; PG8_LDA(At, 1, 0); PG8_STAGE(PG8_SA(0, 1), a2 + hstep, voffA);
            PG8_WAIT_V(8); PG8_WAIT_L(0); PG8_BAR; PG8_MMA(0, 0, At, B0); PG8_MMA(0, 1, At, B1); PG8_BAR; PG8_SCHED;
            PG8_LDA(At, 1, 1); PG8_STAGE(PG8_SB(1, 0), b3, voffB); PG8_STAGE(PG8_SB(1, 1), b3 + hstep, voffB); PG8_STAGE(PG8_SA(1, 0), a3, voffA);
            PG8_WAIT_V(8); PG8_WAIT_L(0); PG8_BAR; PG8_MMA(1, 0, At, B0); PG8_MMA(1, 1, At, B1); PG8_BAR; PG8_SCHED;
            } else {
            PG8_LDB(B0, 0, 0); PG8_SCHED; PG8_LDA(At, 0, 0); PG8_STAGE(PG8_SA(1, 1), a1 + hstep, voffA);
            PG8_WAIT_L(8); PG8_BAR; PG8_WAIT_L(0); PG8_MMA(0, 0, At, B0); PG8_BAR; PG8_SCHED;
            PG8_LDB(B1, 0, 1); PG8_STAGE(PG8_SB(0, 0), b2, voffB);
            PG8_BAR; PG8_WAIT_L(0); PG8_MMA(0, 1, At, B1); PG8_BAR;
            PG8_LDA(At, 0, 1); PG8_STAGE(PG8_SA(0, 0), a2, voffA);
            PG8_BAR; PG8_WAIT_L(0); PG8_MMA(1, 0, At, B0); PG8_BAR; PG8_SCHED;
            PG8_STAGE(PG8_SB(0, 1), b2 + hstep, voffB);
            PG8_WAIT_V(6); PG8_BAR; PG8_MMA(1, 1, At, B1); PG8_BAR;
            PG8_LDB(B0, 1, 0); PG8_SCHED; PG8_LDA(At, 1, 0); PG8_STAGE(PG8_SA(0, 1), a2 + hstep, voffA);
            PG8_WAIT_L(8); PG8_BAR; PG8_WAIT_L(0); PG8_MMA(0, 0, At, B0); PG8_BAR; PG8_SCHED;
            PG8_LDB(B1, 1, 1); PG8_STAGE(PG8_SB(1, 0), b3, voffB);
            PG8_BAR; PG8_WAIT_L(0); PG8_MMA(0, 1, At, B1); PG8_BAR;
            PG8_LDA(At, 1, 1); PG8_STAGE(PG8_SA(1, 0), a3, voffA);
            PG8_BAR; PG8_WAIT_L(0); PG8_MMA(1, 0, At, B0); PG8_BAR; PG8_SCHED;
            PG8_STAGE(PG8_SB(1, 1), b3 + hstep, voffB);
            PG8_WAIT_V(6); PG8_BAR; PG8_MMA(1, 1, At, B1); PG8_BAR;
            }
        }
        if constexpr (ALIGN_EPI) { if (wr == 0) PG8_BAR; }
        if constexpr (!Epi::AFTER_DRAIN) { E(acc, cur, wr, wc, fr, fq); S.done(cur); }
        if (!has_next) break;
#pragma unroll
        for (int a = 0; a < 2; ++a)
#pragma unroll
            for (int b = 0; b < 2; ++b)
#pragma unroll
                for (int m = 0; m < 4; ++m)
#pragma unroll
                    for (int n = 0; n < 2; ++n) acc[a][b][m][n] = (f32x4){0.f, 0.f, 0.f, 0.f};
        cur = nxt; cA = nA; cB = nB; ++ui;
        if constexpr (ALIGN_EPI) { if (wr == 1) PG8_BAR; }
    }
    PG8_WAIT_V(0);
    if constexpr (!ALIGN_EPI) { if (wr == 0) PG8_BAR; }
    PG8_BAR;
    if constexpr (Epi::AFTER_DRAIN) { E.fused(acc, cur, wr, wc, fr, fq, lds, wid, lane); S.done(cur); }
#undef PG8_SA
#undef PG8_SB
#undef PG8_STAGE
#undef PG8_LDA
#undef PG8_LDB
#undef PG8_MMA
#undef PG8_WAIT_V
#undef PG8_WAIT_L
#undef PG8_BAR
#undef PG8_SCHED
}
}


#ifndef N_LAUNCH_MODE
#define N_LAUNCH_MODE 1
#endif
#ifndef MOE_SIMT
#define MOE_SIMT 0
#endif
#ifndef HYENA_NAIVE
#define HYENA_NAIVE 0
#endif
#ifndef ATTN_NAIVE
#define ATTN_NAIVE 0
#endif
#ifndef TLB_TOUCH
#define TLB_TOUCH 0
#endif
#ifndef DUAL_BIG_FIRST
#define DUAL_BIG_FIRST 1
#endif
#ifndef MOE_S
#define MOE_S 4
#endif
#ifndef HY_REP
#define HY_REP 0
#endif
#ifndef ATTN_REP
#define ATTN_REP 0
#endif
#ifndef SIMPLE_GEMM
#define SIMPLE_GEMM 0
#endif

constexpr int D = 2048, BATCH = 2, SEQ = 4096, T = BATCH * SEQ;
constexpr int HW = 1024;
constexpr int NH = 12, HD = 128, QKVW = 3 * NH * HD;
constexpr int INW = 3 * HW + QKVW;
constexpr int N1 = INW + 2 * D;
constexpr int NE = 64, FF = 512;
constexpr float RMS_EPS = 1e-6f;
constexpr int NWAVES = 8, NTHR = 512;
constexpr int NPHASE = 12;

constexpr size_t MiB = 1u << 20;
constexpr size_t WS_CTL = 0, CTL_ZERO_BYTES = 128 * 1024;
constexpr size_t WS_MODP = 1 * MiB;
constexpr size_t WS_HID2 = 2 * MiB;
constexpr size_t WS_ROT = 3 * MiB;
constexpr size_t WS_W3T = 4 * MiB;
constexpr size_t WS_ROUTE = 5 * MiB;
constexpr size_t WS_LISTT = 6 * MiB;
constexpr size_t WS_LISTG = 8 * MiB;
constexpr size_t WS_WGT = 10 * MiB;
constexpr size_t WS_WET = 11 * MiB;
constexpr size_t WS_HID2B = 12 * MiB;
constexpr size_t WS_W3TB = 13 * MiB;
constexpr size_t WS_W1T = 16 * MiB;
constexpr size_t WS_WHYOT = 64 * MiB;
constexpr size_t WS_WATOT = 68 * MiB;
constexpr size_t WS_WOUTT = 70 * MiB;
constexpr size_t WS_KF = 80 * MiB;
constexpr size_t WS_H = 144 * MiB;
constexpr size_t WS_PHY = 176 * MiB;
constexpr size_t WS_QKV = 224 * MiB;
constexpr size_t WS_G = 296 * MiB;
constexpr size_t WS_YHY = 360 * MiB;
constexpr size_t WS_YAT = 376 * MiB;
constexpr size_t WS_TMP = 384 * MiB;
constexpr size_t WS_MERGED = 448 * MiB;
constexpr size_t WS_Y = 480 * MiB;
constexpr size_t WS_X1 = 544 * MiB;
constexpr size_t WS_H2 = 608 * MiB;
constexpr size_t WS_ACT = 640 * MiB;
constexpr size_t WS_YB = 672 * MiB;
constexpr size_t WS_END = 800 * MiB;
constexpr int CW_BAR = 4096;
constexpr int CW_CNT = 16384, CNT_STRIDE = 64;

constexpr int RING_BYTES = 131072;
constexpr int LDS_BYTES = 163840;
constexpr int MISC_OFF = LDS_BYTES - 256;
constexpr int MOE_OFFS_OFF = LDS_BYTES - 1024;

#define GAS __attribute__((address_space(1)))
#define LAS __attribute__((address_space(3)))
typedef unsigned short bf16;
typedef unsigned v4u __attribute__((ext_vector_type(4)));
typedef unsigned v2u __attribute__((ext_vector_type(2)));
typedef float f32x4 __attribute__((ext_vector_type(4)));
typedef LAS float lfloat;

__device__ __forceinline__ unsigned f2bf(float f) { unsigned u = __builtin_bit_cast(unsigned, f); return (u + 0x7fffu + ((u >> 16) & 1u)) >> 16; }
__device__ __forceinline__ unsigned pk2(float lo, float hi) { return f2bf(lo) | (f2bf(hi) << 16); }
__device__ __forceinline__ float bf2f(unsigned short b) { return __builtin_bit_cast(float, ((unsigned)b) << 16); }
__device__ __forceinline__ float bflo(unsigned w) { return __builtin_bit_cast(float, w << 16); }
__device__ __forceinline__ float bfhi(unsigned w) { return __builtin_bit_cast(float, w & 0xffff0000u); }

#define XB_TMO      128
#define XB_XCNT(j)  (256  + 64 * (j))
#define XB_XSUB(j)  (1280 + 64 * (j))
#define XB_XGEN(j)  (2304 + 64 * (j))
#define XB_TOP      3328
#define XB_TOPGEN   3392
#define XCD_BAR_WORDS 3456
#define XB_SPIN_CAP (1u << 18)
__device__ __forceinline__ unsigned xb_ld(unsigned* p)              { return __hip_atomic_load(p, __ATOMIC_RELAXED, __HIP_MEMORY_SCOPE_AGENT); }
__device__ __forceinline__ unsigned xb_add(unsigned* p, unsigned v) { return __hip_atomic_fetch_add(p, v, __ATOMIC_RELAXED, __HIP_MEMORY_SCOPE_AGENT); }
__device__ __forceinline__ unsigned xb_xcc_id() { return (unsigned)__builtin_amdgcn_s_getreg((3 << 11) | 20) & 0xFu; }
#define XB_SPIN(cond, bar) do { unsigned _sp = 0; while (cond) { __builtin_amdgcn_s_sleep(1); \
    if ((++_sp & 255u) == 0u) { if (xb_ld(&(bar)[XB_TMO])) break; if (_sp > XB_SPIN_CAP) { atomicAdd(&(bar)[XB_TMO], 1u); break; } } } } while (0)
struct XcdBarrier { unsigned* bar; unsigned x; volatile LAS unsigned* st; };
__device__ __forceinline__ XcdBarrier xcd_barrier_post(unsigned* bar, volatile LAS unsigned* st) {
    XcdBarrier b; b.bar = bar; b.x = xb_xcc_id(); b.st = st;
    if (threadIdx.x == 0) (void)xb_add(&bar[XB_XCNT(b.x)], 1u);
    return b;
}
__device__ __forceinline__ void xcd_barrier_complete(unsigned* bar, unsigned x, unsigned& nloc, unsigned& nx) {
    const unsigned G = gridDim.x * gridDim.y * gridDim.z;
    unsigned sum, cnt, mine, sp = 0u;
    for (;;) {
        sum = 0u; cnt = 0u; mine = 0u;
#pragma unroll
        for (unsigned j = 0; j < 16; ++j) { const unsigned c = xb_ld(&bar[XB_XCNT(j)]); sum += c; cnt += (c > 0u) ? 1u : 0u; mine = (j == x) ? c : mine; }
        if (sum == G) break;
        __builtin_amdgcn_s_sleep(1);
        if ((++sp & 255u) == 0u) { if (xb_ld(&bar[XB_TMO])) break; if (sp > XB_SPIN_CAP) { atomicAdd(&bar[XB_TMO], 1u); break; } }
    }
    nloc = mine > 0u ? mine : 1u; nx = cnt > 0u ? cnt : 1u;
}
__device__ __forceinline__ void xcd_barrier(const XcdBarrier& b) {
    asm volatile("s_waitcnt vmcnt(0)" ::: "memory");
    __syncthreads();
    if (threadIdx.x == 0) {
        unsigned* bar = b.bar;
        __builtin_amdgcn_s_waitcnt(0);
        unsigned nloc = b.st[0], nx = b.st[1];
        if (nloc == 0u) { xcd_barrier_complete(bar, b.x, nloc, nx); b.st[0] = nloc; b.st[1] = nx; }
        const unsigned old = xb_add(&bar[XB_XSUB(b.x)], 1u);
        const unsigned gen = old / nloc;
        if (old + 1u == (gen + 1u) * nloc) {
            __builtin_amdgcn_fence(__ATOMIC_RELEASE, "agent");
            asm volatile("s_waitcnt vmcnt(0)" ::: "memory");
            const unsigned og = xb_add(&bar[XB_TOP], 1u);
            const unsigned tg = og / nx;
            if (og + 1u == (tg + 1u) * nx) xb_add(&bar[XB_TOPGEN], 1u);
            else XB_SPIN(xb_ld(&bar[XB_TOPGEN]) == tg, bar);
            __builtin_amdgcn_fence(__ATOMIC_ACQUIRE, "agent");
            xb_add(&bar[XB_XGEN(b.x)], 1u);
            asm volatile("s_waitcnt vmcnt(0)" ::: "memory");
        } else {
            XB_SPIN(xb_ld(&bar[XB_XGEN(b.x)]) == gen, bar);
            __builtin_amdgcn_fence(__ATOMIC_ACQUIRE, "agent");
            asm volatile("s_waitcnt vmcnt(0)" ::: "memory");
        }
    }
    __syncthreads();
}

struct Args { const void* in[31]; float* out; unsigned char* ws; int ph_lo, ph_hi; };
struct Frame {
    LAS unsigned char* lds;
    int tid, lane, wave, G, bid;
    const float *x, *c, *w_ada, *b_ada, *g_mix_pre, *g_mix_post, *g_ffn_pre, *g_ffn_post, *w_in, *conv_w, *conv_b, *fw1, *fb1, *fw2, *fb2, *fw3, *ffreq, *hskip,
        *w_bg, *b_bg, *w_hy_o, *w_at_o, *w_out, *w_group, *b_group, *w_expert, *b_expert, *w1e, *w3e, *w2e;
    const int* positions;
    float* out;
    unsigned* ctl; float *MODP, *HID2, *ROT, *W3T, *TMP, *Y, *X1, *ACT, *YB, *LISTG, *WGT, *WET; bf16 *KF, *HID2B, *W3TB;
    unsigned* ROUTE; int* LISTT;
    bf16 *W1T, *WHYOT, *WATOT, *WOUTT, *H, *PHY, *QKV, *GT, *YHY, *YAT, *MERGED, *H2, *ACTB, *YBB;
};

__device__ __forceinline__ float wave_sum(float v) {
#pragma unroll
    for (int o = 1; o < 64; o <<= 1) v += __shfl_xor(v, o);
    return v;
}
__device__ __forceinline__ float wave_max(float v) {
#pragma unroll
    for (int o = 1; o < 64; o <<= 1) v = fmaxf(v, __shfl_xor(v, o));
    return v;
}

__device__ __forceinline__ void p0_transpose_item(const float* W, int K, int N, bf16* WT, int row_off, LAS float* scr, int item, int lane) {
    const int nblk = N / 32, kb = item / nblk, nb = item % nblk, k0 = 64 * kb, n0 = 32 * nb;
#pragma unroll 8
    for (int i = 0; i < 32; ++i) { const int kk = 2 * i + (lane >> 5); scr[kk * 33 + (lane & 31)] = W[(size_t)(k0 + kk) * N + n0 + (lane & 31)]; }
    asm volatile("s_waitcnt lgkmcnt(0)" ::: "memory");
    const int c = lane & 7;
#pragma unroll
    for (int j = 0; j < 4; ++j) { const int n = (lane >> 3) + 8 * j; const LAS float* s = scr + (8 * c) * 33 + n;
        v4u o; o.x = pk2(s[0 * 33], s[1 * 33]); o.y = pk2(s[2 * 33], s[3 * 33]); o.z = pk2(s[4 * 33], s[5 * 33]); o.w = pk2(s[6 * 33], s[7 * 33]);
        *(v4u*)(WT + (size_t)(row_off + n0 + n) * K + k0 + 8 * c) = o; }
    asm volatile("s_waitcnt lgkmcnt(0)" ::: "memory");
}

__device__ __forceinline__ f32x4 mod_sum4(Frame& F, int b, int col) {
    f32x4 s = *(const f32x4*)(F.b_ada + col);
#pragma unroll
    for (int ks = 0; ks < 8; ++ks) s += *(const f32x4*)(F.MODP + (size_t)(ks * 2 + b) * (6 * D) + col);
    return s;
}
__device__ __forceinline__ void load_mod(Frame& F, LAS float* dst, int which) {
#pragma unroll 2
    for (int i = F.tid; i < 2 * D / 4; i += NTHR) { const int b = i / (D / 4), d4 = i % (D / 4); *(LAS f32x4*)(dst + 4 * i) = mod_sum4(F, b, which * D + 4 * d4); }
}
__device__ __forceinline__ void load_mod1(Frame& F, LAS float* dst, int which, int b) {
    *(LAS f32x4*)(dst + 4 * F.tid) = mod_sum4(F, b, which * D + 4 * F.tid);
}

template <int SKIP = 0> __device__ __forceinline__ void p0_prologue(Frame& F) {
    LAS float* L = (LAS float*)F.lds;
    if (!(SKIP & 1))
    {
        typedef float f32x2 __attribute__((ext_vector_type(2)));
        LAS float* sc = L;
        LAS float* red = L + 512;
        for (int u = F.bid; u < 96 * 8; u += F.G) {
            const int chunk = u % 96, ks = u / 96;
            __syncthreads();
            { const int b = F.tid >> 8, i = F.tid & 255; const float cv = F.c[b * D + ks * 256 + i]; sc[b * 256 + i] = cv / (1.f + __expf(-cv)); }
            __syncthreads();
            f32x2 a0 = {0.f, 0.f}, a1 = {0.f, 0.f};
            const float* wp = F.w_ada + (size_t)(ks * 256 + F.wave * 32) * (6 * D) + chunk * 128 + F.lane * 2;
#pragma unroll 16
            for (int r = 0; r < 32; ++r) { const f32x2 w = *(const f32x2*)(wp + (size_t)r * (6 * D)); const float s0 = sc[F.wave * 32 + r], s1 = sc[256 + F.wave * 32 + r]; a0 += w * s0; a1 += w * s1; }
            *(LAS f32x2*)(red + (F.wave * 2 + 0) * 128 + F.lane * 2) = a0;
            *(LAS f32x2*)(red + (F.wave * 2 + 1) * 128 + F.lane * 2) = a1;
            __syncthreads();
            if (F.tid < 256) { const int b = F.tid >> 7, col = F.tid & 127; float s = 0.f;
#pragma unroll
              for (int w = 0; w < 8; ++w) s += red[(w * 2 + b) * 128 + col];
              F.MODP[(size_t)(ks * 2 + b) * (6 * D) + chunk * 128 + col] = s; }
        }
        __syncthreads();
    }
    const int gw = F.bid * NWAVES + F.wave, NGW = F.G * NWAVES;
    if (!(SKIP & 2)) {
        LAS float* scr = (LAS float*)(F.lds + F.wave * 16384);
        constexpr int I_IN = (D / 64) * (INW / 32), I_BG = (D / 64) * (2 * D / 32), I_HY = (HW / 64) * (D / 32), I_AT = (512 / 64) * (D / 32), I_OUT = (D / 64) * (D / 32);
        constexpr int NITEMS = I_IN + I_BG + I_HY + I_AT + I_OUT;
        for (int it = gw; it < NITEMS; it += NGW) {
            int r = it;
            if (r < I_IN) { p0_transpose_item(F.w_in, D, INW, F.W1T, 0, scr, r, F.lane); continue; } r -= I_IN;
            if (r < I_BG) { p0_transpose_item(F.w_bg, D, 2 * D, F.W1T, INW, scr, r, F.lane); continue; } r -= I_BG;
            if (r < I_HY) { p0_transpose_item(F.w_hy_o, HW, D, F.WHYOT, 0, scr, r, F.lane); continue; } r -= I_HY;
            if (r < I_AT) { p0_transpose_item(F.w_at_o, 512, D, F.WATOT, 0, scr, r, F.lane); continue; } r -= I_AT;
            p0_transpose_item(F.w_out, D, D, F.WOUTT, 0, scr, r, F.lane);
        }
    }
    if (!(SKIP & 4)) {
    for (int i = F.bid * NTHR + F.tid; i < 64 * 4096; i += F.G * NTHR) { const int n = i >> 6, j = i & 63; F.W3TB[i] = (bf16)f2bf(F.fw3[j * 4096 + n]); }
    for (int i = F.bid * NTHR + F.tid; i < 8 * D; i += F.G * NTHR) { const int n = i / D, d = i % D; F.WGT[i] = F.w_group[d * 8 + n]; }
    for (int i = F.bid * NTHR + F.tid; i < 64 * D; i += F.G * NTHR) { const int ge = i / D, d = i % D, g = ge >> 3, e = ge & 7; F.WET[i] = F.w_expert[((size_t)g * D + d) * 8 + e]; }
    }
    if (!(SKIP & 8))
    for (int t = gw; t < SEQ; t += NGW) {
        const int j = F.lane;
        const float tn = (float)t * (1.0f / (float)(SEQ - 1));
        const float w = 6.283185307179586f * (float)t / (float)SEQ;
        float feat = 0.f;
        if (j == 0) feat = tn;
        else if (j <= 16) { const float band = 1e-4f + (float)(j - 1) * ((15.0f - 1e-4f) / 15.0f); feat = cosf(band * w); }
        else if (j <= 32) { const float band = 1e-4f + (float)(j - 17) * ((15.0f - 1e-4f) / 15.0f); feat = -sinf(band * w); }
        float a = F.fb1[j];
        for (int i = 0; i < 33; ++i) a += __shfl(feat, i) * F.fw1[i * 64 + j];
        const float fr = F.ffreq[j];
        const float h1 = sinf(fr * a);
        float a2 = F.fb2[j];
        for (int i = 0; i < 64; ++i) a2 += __shfl(h1, i) * F.fw2[i * 64 + j];
        { const float hv = sinf(fr * a2); F.HID2[t * 64 + j] = hv; F.HID2B[t * 64 + j] = (bf16)f2bf(hv); }
    }
    if (!(SKIP & 16))
    for (int i = F.bid * NTHR + F.tid; i < T * 16; i += F.G * NTHR) {
        const int tok = i >> 4, k = i & 15;
        const float inv = powf(500000.0f, -(float)k * (1.0f / 16.0f));
        const float ang = (float)F.positions[tok] * inv;
        F.ROT[tok * 32 + k] = cosf(ang); F.ROT[tok * 32 + 16 + k] = sinf(ang);
    }
}

__device__ __forceinline__ void p1_rows_filters(Frame& F) {
    LAS float* L = (LAS float*)F.lds;
    LAS float* shiftv = L;
    LAS float* scalev = L + 2 * D;
    load_mod(F, shiftv, 0); load_mod(F, scalev, 1);
    LAS float* gpre = L + 4 * D;
    *(LAS f32x4*)(gpre + 4 * F.tid) = *(const f32x4*)(F.g_mix_pre + 4 * F.tid);
    __syncthreads();
    const int gw = F.bid * NWAVES + F.wave, NGW = F.G * NWAVES;
    for (int m0 = gw; m0 < T; m0 += 4 * NGW) {
        f32x4 v[4][8];
#pragma unroll
        for (int r = 0; r < 4; ++r) { const int m = m0 + r * NGW; if (m < T) { const f32x4* xr = (const f32x4*)(F.x + (size_t)m * D) + F.lane;
#pragma unroll
            for (int j = 0; j < 8; ++j) v[r][j] = xr[64 * j]; } }
#pragma unroll
        for (int r = 0; r < 4; ++r) { const int m = m0 + r * NGW; if (m < T) { const int b = m / SEQ; float s = 0.f;
#pragma unroll
            for (int j = 0; j < 8; ++j) s += (v[r][j].x * v[r][j].x + v[r][j].y * v[r][j].y) + (v[r][j].z * v[r][j].z + v[r][j].w * v[r][j].w);
            const float rstd = 1.0f / sqrtf(wave_sum(s) * (1.f / D) + RMS_EPS);
            v2u* o8 = (v2u*)(F.H + (size_t)m * D) + F.lane;
#pragma unroll
            for (int j = 0; j < 8; ++j) { const int d = 256 * j + 4 * F.lane;
                const f32x4 g = *(LAS f32x4*)(gpre + d); const f32x4 sc = *(LAS f32x4*)(scalev + b * D + d), sh = *(LAS f32x4*)(shiftv + b * D + d);
                f32x4 h; h = (v[r][j] * rstd) * g; h = h * (sc + 1.0f) + sh;
                v2u w; w.x = pk2(h.x, h.y); w.y = pk2(h.z, h.w); o8[64 * j] = w; } } }
    }
    {
        typedef short bf16x8 __attribute__((ext_vector_type(8)));
        typedef float f32x16 __attribute__((ext_vector_type(16)));
        const int r31 = F.lane & 31, hh = F.lane >> 5;
        const float mind = -3.0701134573253945f, maxd = -15.350567286626972f;
        for (int u = gw; u < 128 * 32; u += NGW) {
            const int tt = u & 127, ng = u >> 7, t = tt * 32 + r31;
            bf16x8 bq[4];
#pragma unroll
            for (int s = 0; s < 4; ++s) bq[s] = *(const bf16x8*)(F.HID2B + (size_t)t * 64 + 16 * s + 8 * hh);
            const float tn = (float)t * (1.0f / (float)(SEQ - 1));
#pragma unroll 1
            for (int q = 0; q < 4; ++q) {
                const int n0 = (ng * 4 + q) * 32;
                f32x16 c;
#pragma unroll
                for (int i = 0; i < 16; ++i) c[i] = 0.f;
#pragma unroll
                for (int s = 0; s < 4; ++s) { const bf16x8 a = *(const bf16x8*)(F.W3TB + (size_t)(n0 + r31) * 64 + 16 * s + 8 * hh); c = __builtin_amdgcn_mfma_f32_32x32x16_bf16(a, bq[s], c, 0, 0, 0); }
#pragma unroll
                for (int i = 0; i < 16; ++i) { const int n = n0 + (i & 3) + 8 * (i >> 2) + 4 * hh, ch = n & (HW - 1);
                    const float delta = fabsf(mind + (float)ch * ((maxd - mind) / (float)(HW - 1)));
                    F.KF[(size_t)n * SEQ + t] = (bf16)f2bf(c[i] * __expf(-tn * delta)); }
            }
        }
    }
}

template <int NB, class LA, class LB, class EP>
__device__ __forceinline__ void simt_tile(LAS float* L, int K, int tid, const LA& la, const LB& lb, const EP& ep) {
    LAS float* As = L;
    LAS float* Bs = L + 32 * 68;
    const int ty = tid >> 4, tx = tid & 15;
    float acc[NB][2][4];
#pragma unroll
    for (int q = 0; q < NB; ++q)
#pragma unroll
        for (int i = 0; i < 2; ++i)
#pragma unroll
            for (int j = 0; j < 4; ++j) acc[q][i][j] = 0.f;
    for (int k0 = 0; k0 < K; k0 += 32) {
        __syncthreads();
        for (int e = tid; e < 64 * 32; e += NTHR) { const int r = e >> 5, kk = e & 31; As[kk * 68 + r] = la(r, k0 + kk); }
#pragma unroll
        for (int q = 0; q < NB; ++q)
            for (int e = tid; e < 32 * 64; e += NTHR) { const int kk = e >> 6, cc = e & 63; Bs[(q * 32 + kk) * 68 + cc] = lb(q, k0 + kk, cc); }
        __syncthreads();
#pragma unroll 8
        for (int kk = 0; kk < 32; ++kk) {
            const float a0 = As[kk * 68 + 2 * ty], a1 = As[kk * 68 + 2 * ty + 1];
#pragma unroll
            for (int q = 0; q < NB; ++q) { const f32x4 b = *(LAS f32x4*)(Bs + (q * 32 + kk) * 68 + 4 * tx);
                acc[q][0][0] += a0 * b.x; acc[q][0][1] += a0 * b.y; acc[q][0][2] += a0 * b.z; acc[q][0][3] += a0 * b.w;
                acc[q][1][0] += a1 * b.x; acc[q][1][1] += a1 * b.y; acc[q][1][2] += a1 * b.z; acc[q][1][3] += a1 * b.w; }
        }
    }
#pragma unroll
    for (int i = 0; i < 2; ++i)
#pragma unroll
        for (int j = 0; j < 4; ++j) { float v[NB];
#pragma unroll
            for (int q = 0; q < NB; ++q) v[q] = acc[q][i][j];
            ep(2 * ty + i, 4 * tx + j, v); }
}

struct EpiProj {
    static constexpr bool PERM = true, AFTER_DRAIN = false;
    bf16* QKVp; bf16* Gp; const float* ROT; const float* bias;
    __device__ __forceinline__ void operator()(const pg8::f32x4 (&acc)[2][2][4][2], const pg8::Unit& u, int wr, int wc, int fr, int fq) const {
        using namespace pg8;
        const int row0 = u.pm * BM + wr * 64 + fr;
        const int colt = u.pn * BM;
        if (colt < QKVW) {
            const bool rot = (colt < 2 * NH * HD) && (wc == 0);
#pragma unroll
            for (int ai = 0; ai < 2; ++ai)
#pragma unroll
                for (int m = 0; m < 4; ++m) { const int row = row0 + ai * HALF + m * 16;
                    bf16* rowp = QKVp + (size_t)row * QKVW + colt + wc * 32 + 8 * fq;
                    f32x4 cs0, cs1, sn0, sn1;
                    if (rot) { const float* rp = ROT + (size_t)row * 32 + 8 * (fq & 1); cs0 = *(const f32x4*)rp; cs1 = *(const f32x4*)(rp + 4); sn0 = *(const f32x4*)(rp + 16); sn1 = *(const f32x4*)(rp + 20); }
#pragma unroll
                    for (int bj = 0; bj < 2; ++bj) { f32x4 v0 = acc[ai][bj][m][0], v1 = acc[ai][bj][m][1];
                        if (rot) {
                            f32x4 o0, o1;
#pragma unroll
                            for (int j = 0; j < 4; ++j) { o0[j] = __shfl_xor(v0[j], 32); o1[j] = __shfl_xor(v1[j], 32); }
                            if (fq < 2) { v0 = v0 * cs0 - o0 * sn0; v1 = v1 * cs1 - o1 * sn1; }
                            else        { v0 = v0 * cs0 + o0 * sn0; v1 = v1 * cs1 + o1 * sn1; }
                        }
                        u32x4 w; w.x = cvt_pk_bf16(v0[0], v0[1]); w.y = cvt_pk_bf16(v0[2], v0[3]); w.z = cvt_pk_bf16(v1[0], v1[1]); w.w = cvt_pk_bf16(v1[2], v1[3]);
                        *(u32x4*)(rowp + bj * HALF) = w; } }
        } else {
            const int gc = colt - QKVW + wc * 32 + 8 * fq;
            f32x4 bv[2][2];
#pragma unroll
            for (int bj = 0; bj < 2; ++bj)
#pragma unroll
                for (int n = 0; n < 2; ++n) bv[bj][n] = *(const f32x4*)(bias + gc + bj * HALF + 4 * n);
#pragma unroll
            for (int ai = 0; ai < 2; ++ai)
#pragma unroll
                for (int m = 0; m < 4; ++m) { bf16* rowp = Gp + (size_t)(row0 + ai * HALF + m * 16) * (2 * D) + gc;
#pragma unroll
                    for (int bj = 0; bj < 2; ++bj) { f32x4 v0 = acc[ai][bj][m][0] + bv[bj][0], v1 = acc[ai][bj][m][1] + bv[bj][1];
#pragma unroll
                        for (int j = 0; j < 4; ++j) { v0[j] = 1.0f / (1.0f + __expf(-v0[j])); v1[j] = 1.0f / (1.0f + __expf(-v1[j])); }
                        u32x4 w; w.x = cvt_pk_bf16(v0[0], v0[1]); w.y = cvt_pk_bf16(v0[2], v0[3]); w.z = cvt_pk_bf16(v1[0], v1[1]); w.w = cvt_pk_bf16(v1[2], v1[3]);
                        *(u32x4*)(rowp + bj * HALF) = w; } }
        }
    }
};
struct EpiPlainBf16 {
    static constexpr bool PERM = true, AFTER_DRAIN = false;
    bf16* O; int ldc;
    __device__ __forceinline__ void operator()(const pg8::f32x4 (&acc)[2][2][4][2], const pg8::Unit& u, int wr, int wc, int fr, int fq) const {
        using namespace pg8;
        const int row0 = u.pm * BM + wr * 64 + fr, col0 = u.pn * BM + wc * 32 + 8 * fq;
#pragma unroll
        for (int ai = 0; ai < 2; ++ai)
#pragma unroll
            for (int m = 0; m < 4; ++m) { bf16* rowp = O + (size_t)(row0 + ai * HALF + m * 16) * ldc + col0;
#pragma unroll
                for (int bj = 0; bj < 2; ++bj) { const f32x4 v0 = acc[ai][bj][m][0], v1 = acc[ai][bj][m][1];
                    u32x4 w; w.x = cvt_pk_bf16(v0[0], v0[1]); w.y = cvt_pk_bf16(v0[2], v0[3]); w.z = cvt_pk_bf16(v1[0], v1[1]); w.w = cvt_pk_bf16(v1[2], v1[3]);
                    *(u32x4*)(rowp + bj * HALF) = w; } }
    }
};
template <int STAGE> struct EpiGate {
    static constexpr bool PERM = true, AFTER_DRAIN = false;
    const bf16* Gp; int goff; float* TMPp; bf16* Mp;
    __device__ __forceinline__ void operator()(const pg8::f32x4 (&acc)[2][2][4][2], const pg8::Unit& u, int wr, int wc, int fr, int fq) const {
        using namespace pg8;
        const int row0 = u.pm * BM + wr * 64 + fr, col0 = u.pn * BM + wc * 32 + 8 * fq;
#pragma unroll
        for (int ai = 0; ai < 2; ++ai)
#pragma unroll
            for (int m = 0; m < 4; ++m) { const size_t row = (size_t)(row0 + ai * HALF + m * 16);
#pragma unroll
                for (int bj = 0; bj < 2; ++bj) { const int col = col0 + bj * HALF;
                    const u32x4 gw = *(const u32x4*)(Gp + row * (2 * D) + goff + col);
                    f32x4 g0 = {bflo(gw.x), bfhi(gw.x), bflo(gw.y), bfhi(gw.y)}, g1 = {bflo(gw.z), bfhi(gw.z), bflo(gw.w), bfhi(gw.w)};
                    f32x4 v0 = acc[ai][bj][m][0] * g0, v1 = acc[ai][bj][m][1] * g1;
                    bf16* tp = (bf16*)TMPp + row * D + col;
                    if (STAGE == 0) { u32x4 w; w.x = cvt_pk_bf16(v0[0], v0[1]); w.y = cvt_pk_bf16(v0[2], v0[3]); w.z = cvt_pk_bf16(v1[0], v1[1]); w.w = cvt_pk_bf16(v1[2], v1[3]); *(u32x4*)tp = w; }
                    else { const u32x4 tw = *(const u32x4*)tp; v0 += (f32x4){bflo(tw.x), bfhi(tw.x), bflo(tw.y), bfhi(tw.y)}; v1 += (f32x4){bflo(tw.z), bfhi(tw.z), bflo(tw.w), bfhi(tw.w)};
                        u32x4 w; w.x = cvt_pk_bf16(v0[0], v0[1]); w.y = cvt_pk_bf16(v0[2], v0[3]); w.z = cvt_pk_bf16(v1[0], v1[1]); w.w = cvt_pk_bf16(v1[2], v1[3]);
                        *(u32x4*)(Mp + row * D + col) = w; } } }
    }
};
struct EpiF32 {
    static constexpr bool PERM = false, AFTER_DRAIN = false;
    float* C; int ldc;
    __device__ __forceinline__ void operator()(const pg8::f32x4 (&acc)[2][2][4][2], const pg8::Unit& u, int wr, int wc, int fr, int fq) const {
        using namespace pg8;
        const int row0 = u.pm * BM + wr * 64 + fr, col0 = u.pn * BM + wc * 32 + 4 * fq;
#pragma unroll
        for (int ai = 0; ai < 2; ++ai)
#pragma unroll
            for (int m = 0; m < 4; ++m) { float* rowp = C + (size_t)(row0 + ai * HALF + m * 16) * ldc + col0;
#pragma unroll
                for (int bj = 0; bj < 2; ++bj)
#pragma unroll
                    for (int n = 0; n < 2; ++n) *(f32x4*)(rowp + bj * HALF + n * 16) = acc[ai][bj][m][n]; }
    }
};


struct DualOrder {
    pg8::StaticOrder s0, s1; int G, c; const bf16* A0; const bf16* B0; const bf16* A1; const bf16* B1;
    __device__ __forceinline__ bool next(int i, pg8::Unit& u) const {
        const int L = i * G + c;
        if (L < s1.nwg) { pg8::StaticOrder t = s1; t.G = 1; t.c = L; const bool ok = t.next(0, u); u.kind = 1; return ok; }
        pg8::StaticOrder t = s0; t.G = 1; t.c = L - s1.nwg; const bool ok = t.next(0, u); u.kind = 0; return ok;
    }
    __device__ __forceinline__ void a_ready(const pg8::Unit&) const {}
    __device__ __forceinline__ void done(const pg8::Unit&) const {}
    __device__ __forceinline__ const bf16* abase(const pg8::Gemm&, const pg8::Unit& u) const { return u.kind ? A1 : A0; }
    __device__ __forceinline__ const bf16* bbase(const pg8::Gemm&, const pg8::Unit& u) const { return u.kind ? B1 : B0; }
};
struct EpiDual {
    static constexpr bool PERM = true, AFTER_DRAIN = false;
    EpiPlainBf16 e0; EpiProj e1;
    __device__ __forceinline__ void operator()(const pg8::f32x4 (&acc)[2][2][4][2], const pg8::Unit& u, int wr, int wc, int fr, int fq) const {
        if (u.kind == 0) e0(acc, u, wr, wc, fr, fq); else e1(acc, u, wr, wc, fr, fq);
    }
};
template <class Epi>
__device__ __forceinline__ void run_gemm(Frame& F, const bf16* A, const bf16* Bt, int M, int N, int K, const Epi& E) {
    pg8::Gemm g{A, Bt, M, N, K}; pg8::StaticOrder S; S.init(M, N, F.G, F.bid);
    pg8::gemm_phase<Epi, pg8::StaticOrder, true, true>(F.lds, g, S, E);
}

__device__ __forceinline__ float sconv_at(const bf16* rowp, int t, float w0, float w1, float w2, float bias) {
    const float um = t > 0 ? bf2f(rowp[t - 1]) : 0.f, u0 = bf2f(rowp[t]), up = t < SEQ - 1 ? bf2f(rowp[t + 1]) : 0.f;
    return um * w0 + u0 * w1 + up * w2 + bias;
}
__device__ __forceinline__ void conv8(const LAS float* kk, const LAS float* z, int t0, float (&acc)[2][8]) {
#pragma unroll
    for (int b = 0; b < 2; ++b)
#pragma unroll
        for (int j = 0; j < 8; ++j) acc[b][j] = 0.f;
    for (int s8 = 0; s8 < SEQ; s8 += 8) {
        const int base = t0 - s8 + (SEQ - 1);
        float kw[15];
#pragma unroll
        for (int i = 0; i < 15; ++i) kw[i] = kk[base - 7 + i];
        float zz[2][8];
#pragma unroll
        for (int b = 0; b < 2; ++b) { const f32x4 q0 = *(const LAS f32x4*)(z + b * SEQ + s8), q1 = *(const LAS f32x4*)(z + b * SEQ + s8 + 4);
            zz[b][0] = q0.x; zz[b][1] = q0.y; zz[b][2] = q0.z; zz[b][3] = q0.w; zz[b][4] = q1.x; zz[b][5] = q1.y; zz[b][6] = q1.z; zz[b][7] = q1.w; }
#pragma unroll
        for (int ds = 0; ds < 8; ++ds)
#pragma unroll
            for (int j = 0; j < 8; ++j) { const float k = kw[7 + j - ds]; acc[0][j] += k * zz[0][ds]; acc[1][j] += k * zz[1][ds]; }
    }
}
__device__ __forceinline__ void p3_hyena_naive(Frame& F) {
    LAS float* L = (LAS float*)F.lds;
    LAS float* zin = L;
    LAS float* kk = L + 2 * SEQ;
    LAS float* zmid = L + 4 * SEQ;
    for (int c = F.bid; c < HW; c += F.G) {
        __syncthreads();
        const float cw[3][3] = {{F.conv_w[c], F.conv_w[3 * HW + c], F.conv_w[6 * HW + c]},
                                {F.conv_w[HW + c], F.conv_w[3 * HW + HW + c], F.conv_w[6 * HW + HW + c]},
                                {F.conv_w[2 * HW + c], F.conv_w[3 * HW + 2 * HW + c], F.conv_w[6 * HW + 2 * HW + c]}};
        const float cb[3] = {F.conv_b[c], F.conv_b[HW + c], F.conv_b[2 * HW + c]};
        const bf16* pv = F.PHY + (size_t)c * T; const bf16* px1 = F.PHY + (size_t)(HW + c) * T; const bf16* px2 = F.PHY + (size_t)(2 * HW + c) * T;
        for (int i = F.tid; i < T; i += NTHR) { const int b = i / SEQ, t = i % SEQ; zin[i] = sconv_at(pv + b * SEQ, t, cw[0][0], cw[0][1], cw[0][2], cb[0]); }
        for (int i = F.tid; i < 2 * SEQ; i += NTHR) { const int d = i - (SEQ - 1);
            kk[i] = (i == 2 * SEQ - 1) ? 0.f : bf2f(d >= 0 ? F.KF[(size_t)(0 * HW + c) * SEQ + d] : F.KF[(size_t)(1 * HW + c) * SEQ - d]); }
        __syncthreads();
        const int t0 = F.tid * 8; float acc[2][8];
        conv8(kk, zin, t0, acc);
        const float sk0 = F.hskip[c], sk1 = F.hskip[HW + c];
#pragma unroll
        for (int b = 0; b < 2; ++b)
#pragma unroll
            for (int j = 0; j < 8; ++j) { const float x1 = sconv_at(px1 + b * SEQ, t0 + j, cw[1][0], cw[1][1], cw[1][2], cb[1]);
                zmid[b * SEQ + t0 + j] = x1 * (acc[b][j] + sk0 * zin[b * SEQ + t0 + j]); }
        __syncthreads();
        for (int i = F.tid; i < 2 * SEQ; i += NTHR) { const int d = i - (SEQ - 1);
            kk[i] = (i == 2 * SEQ - 1) ? 0.f : bf2f(d >= 0 ? F.KF[(size_t)(2 * HW + c) * SEQ + d] : F.KF[(size_t)(3 * HW + c) * SEQ - d]); }
        __syncthreads();
        conv8(kk, zmid, t0, acc);
#pragma unroll
        for (int b = 0; b < 2; ++b)
#pragma unroll
            for (int j = 0; j < 8; ++j) { const float x2 = sconv_at(px2 + b * SEQ, t0 + j, cw[2][0], cw[2][1], cw[2][2], cb[2]);
                const float z2 = x2 * (acc[b][j] + sk1 * zmid[b * SEQ + t0 + j]);
                F.YHY[(size_t)(b * SEQ + t0 + j) * HW + c] = (bf16)f2bf(z2); }
    }
}

constexpr int HY_KCOPY = 16448;
constexpr int HY_K_OFF = 0;
constexpr int HY_ZIN_OFF = 4 * HY_KCOPY;
constexpr int HY_ZBYTES = 160 * 2 * 80;
constexpr int HY_ZMID_OFF = HY_ZIN_OFF + HY_ZBYTES;
constexpr int HY_X1_OFF = HY_ZMID_OFF + HY_ZBYTES;
constexpr int HY_X2_OFF = HY_X1_OFF + 2 * SEQ * 2;
static_assert(HY_X2_OFF + 2 * SEQ * 2 <= MOE_OFFS_OFF, "hyena LDS map");
__device__ __forceinline__ unsigned hy_zaddr(int b, int t) { return (unsigned)((((t >> 5) + 16) * 2 + b) * 80 + (t & 31) * 2); }
__device__ __forceinline__ void hy_build_k(Frame& F, const bf16* hf, const bf16* hb) {
    LAS unsigned char* lds = F.lds + HY_K_OFF;
    const int i = F.tid;
    const v4u ca = *(const v4u*)(hf + (SEQ - 8 - 8 * i)), cb = *(const v4u*)(hb + 8 * i);
    unsigned short ga[8], gb[8];
    ga[7] = (unsigned short)(ca.x & 0xffff); ga[6] = (unsigned short)(ca.x >> 16); ga[5] = (unsigned short)(ca.y & 0xffff); ga[4] = (unsigned short)(ca.y >> 16);
    ga[3] = (unsigned short)(ca.z & 0xffff); ga[2] = (unsigned short)(ca.z >> 16); ga[1] = (unsigned short)(ca.w & 0xffff); ga[0] = (unsigned short)(ca.w >> 16);
    gb[0] = (unsigned short)(cb.x & 0xffff); gb[1] = (unsigned short)(cb.x >> 16); gb[2] = (unsigned short)(cb.y & 0xffff); gb[3] = (unsigned short)(cb.y >> 16);
    gb[4] = (unsigned short)(cb.z & 0xffff); gb[5] = (unsigned short)(cb.z >> 16); gb[6] = (unsigned short)(cb.w & 0xffff); gb[7] = (unsigned short)(cb.w >> 16);
#pragma unroll
    for (int s = 0; s < 4; ++s) {
        LAS unsigned char* cp = lds + s * HY_KCOPY;
#pragma unroll
        for (int j = 0; j < 8; ++j) { const int xa = 8 * i + 1 + j, xb = SEQ + 8 * i + j;
            if (xa - s >= 0) *(LAS unsigned short*)(cp + 2 * (xa - s)) = ga[j];
            if (xb > SEQ) *(LAS unsigned short*)(cp + 2 * (xb - s)) = gb[j]; }
    }
}
__device__ __forceinline__ void hy_stage_inputs(Frame& F, int c, const float (&cw)[3][3], const float (&cb)[3]) {
    LAS unsigned char* lds = F.lds;
    v4u ch[6]; unsigned short lo[6], hi[6];
#pragma unroll
    for (int k = 0; k < 6; ++k) { const int wh = k >> 1, chunk = F.tid + 512 * (k & 1), b = chunk >> 9, t0 = (chunk & 511) * 8;
        const bf16* rowp = F.PHY + (size_t)(wh * HW + c) * T + b * SEQ;
        ch[k] = *(const v4u*)(rowp + t0); lo[k] = t0 > 0 ? rowp[t0 - 1] : (unsigned short)0; hi[k] = t0 + 8 < SEQ ? rowp[t0 + 8] : (unsigned short)0; }
#pragma unroll
    for (int k = 0; k < 6; ++k) { const int wh = k >> 1, chunk = F.tid + 512 * (k & 1), b = chunk >> 9, t0 = (chunk & 511) * 8;
        float u[10]; u[0] = bf2f(lo[k]); u[9] = bf2f(hi[k]);
        u[1] = bflo(ch[k].x); u[2] = bfhi(ch[k].x); u[3] = bflo(ch[k].y); u[4] = bfhi(ch[k].y); u[5] = bflo(ch[k].z); u[6] = bfhi(ch[k].z); u[7] = bflo(ch[k].w); u[8] = bfhi(ch[k].w);
        float o[8];
#pragma unroll
        for (int j = 0; j < 8; ++j) o[j] = u[j] * cw[wh][0] + u[j + 1] * cw[wh][1] + u[j + 2] * cw[wh][2] + cb[wh];
        v4u pk; pk.x = pk2(o[0], o[1]); pk.y = pk2(o[2], o[3]); pk.z = pk2(o[4], o[5]); pk.w = pk2(o[6], o[7]);
        const unsigned off = (wh == 0) ? (unsigned)HY_ZIN_OFF + hy_zaddr(b, t0) : (unsigned)((wh == 1 ? HY_X1_OFF : HY_X2_OFF) + 2 * (b * SEQ + t0));
        *(LAS v4u*)(lds + off) = pk; }
}
__device__ __forceinline__ void hy_conv(Frame& F, unsigned zoff, pg8::f32x4 (&acc)[4]) {
    typedef short bf16x8 __attribute__((ext_vector_type(8)));
    typedef float f32x16 __attribute__((ext_vector_type(16)));
    const int lane = F.lane, q = F.wave, r = lane & 31, hh = lane >> 5, sg = (4 - (r & 3)) & 3, nn = r >> 1, b = r & 1;
    const int d0 = 16 * q - 127;
    unsigned aaddr = (unsigned)(HY_K_OFF + sg * HY_KCOPY + 2 * (SEQ - 32 * d0 - r + 8 * hh - sg));
    unsigned baddr = zoff + (unsigned)(((16 * q + nn - d0 + 16) * 2 + b) * 80 + 16 * hh);
    f32x16 c;
#pragma unroll
    for (int i = 0; i < 16; ++i) c[i] = 0.f;
    struct FragSet { v2u a[2][2][2]; bf16x8 b[2][2]; };
#define HY_LOAD(S, ADDR_A, ADDR_B) do { _Pragma("unroll") for (int _o = 0; _o < 2; ++_o) { const unsigned _ao = (ADDR_A) + (_o ? 0u : 64u), _bo = (ADDR_B) + (_o ? 0u : 160u); \
        _Pragma("unroll") for (int _h = 0; _h < 2; ++_h) { S.a[_o][_h][0] = *(volatile LAS v2u*)(F.lds + _ao + 32 * _h); S.a[_o][_h][1] = *(volatile LAS v2u*)(F.lds + _ao + 32 * _h + 8); \
            S.b[_o][_h] = *(const LAS bf16x8*)(F.lds + _bo + 32 * _h); } } } while (0)
#define HY_MMA(S) do { _Pragma("unroll") for (int _o = 0; _o < 2; ++_o) _Pragma("unroll") for (int _h = 0; _h < 2; ++_h) { union { bf16x8 v; v2u h[2]; } _a; _a.h[0] = S.a[_o][_h][0]; _a.h[1] = S.a[_o][_h][1]; \
        c = __builtin_amdgcn_mfma_f32_32x32x16_bf16(_a.v, S.b[_o][_h], c, 0, 0, 0); } } while (0)
    {
        union { bf16x8 v; v2u h[2]; } a0, a1;
        a0.h[0] = *(volatile LAS v2u*)(F.lds + aaddr);      a0.h[1] = *(volatile LAS v2u*)(F.lds + aaddr + 8);
        a1.h[0] = *(volatile LAS v2u*)(F.lds + aaddr + 32); a1.h[1] = *(volatile LAS v2u*)(F.lds + aaddr + 40);
        const bf16x8 b0 = *(const LAS bf16x8*)(F.lds + baddr), b1 = *(const LAS bf16x8*)(F.lds + baddr + 32);
        c = __builtin_amdgcn_mfma_f32_32x32x16_bf16(a0.v, b0, c, 0, 0, 0);
        c = __builtin_amdgcn_mfma_f32_32x32x16_bf16(a1.v, b1, c, 0, 0, 0);
    }
    FragSet sA, sB;
    aaddr -= 128; baddr -= 320;
    HY_LOAD(sA, aaddr, baddr);
#pragma clang loop unroll(disable)
    for (int it = 0; it < 35; ++it) {
        aaddr -= 128; baddr -= 320;
        asm volatile("" : "+v"(aaddr), "+v"(baddr));
        HY_LOAD(sB, aaddr, baddr);
        HY_MMA(sA);
        aaddr -= 128; baddr -= 320;
        asm volatile("" : "+v"(aaddr), "+v"(baddr));
        HY_LOAD(sA, aaddr, baddr);
        HY_MMA(sB);
    }
    HY_MMA(sA);
#undef HY_LOAD
#undef HY_MMA
#pragma unroll
    for (int g = 0; g < 4; ++g) acc[g] = (pg8::f32x4){c[4 * g], c[4 * g + 1], c[4 * g + 2], c[4 * g + 3]};
}
__device__ __forceinline__ void p3_hyena_mfma(Frame& F) {
    LAS unsigned char* lds = F.lds;
    for (int i = F.tid; i < 2 * HY_ZBYTES / 4; i += NTHR) *(LAS unsigned*)(lds + HY_ZIN_OFF + 4 * i) = 0u;
    const int lane = F.lane, q = F.wave, r = lane & 31, hh = lane >> 5, nn = r >> 1, b = r & 1;
    for (int c = F.bid; c < HW; c += F.G) {
        __syncthreads();
        const float cw[3][3] = {{F.conv_w[c], F.conv_w[3 * HW + c], F.conv_w[6 * HW + c]},
                                {F.conv_w[HW + c], F.conv_w[3 * HW + HW + c], F.conv_w[6 * HW + HW + c]},
                                {F.conv_w[2 * HW + c], F.conv_w[3 * HW + 2 * HW + c], F.conv_w[6 * HW + 2 * HW + c]}};
        const float cb[3] = {F.conv_b[c], F.conv_b[HW + c], F.conv_b[2 * HW + c]};
        const bf16* pv = F.PHY + (size_t)c * T; const bf16* px1 = F.PHY + (size_t)(HW + c) * T; const bf16* px2 = F.PHY + (size_t)(2 * HW + c) * T;
        hy_stage_inputs(F, c, cw, cb);
        hy_build_k(F, F.KF + (size_t)(0 * HW + c) * SEQ, F.KF + (size_t)(1 * HW + c) * SEQ);
        __syncthreads();
        pg8::f32x4 acc[4];
#if HY_REP & 1
        { pg8::f32x4 acc2[4]; hy_conv(F, HY_ZIN_OFF, acc2); asm volatile("" :: "v"(acc2[0][0]), "v"(acc2[1][1]), "v"(acc2[2][2]), "v"(acc2[3][3])); }
#endif
#if HY_REP & 2
        __syncthreads(); hy_build_k(F, F.KF + (size_t)(0 * HW + c) * SEQ, F.KF + (size_t)(1 * HW + c) * SEQ); __syncthreads();
#endif
#if HY_REP & 4
        __syncthreads(); hy_stage_inputs(F, c, cw, cb); __syncthreads();
#endif
        hy_conv(F, HY_ZIN_OFF, acc);
        const float sk0 = F.hskip[c], sk1 = F.hskip[HW + c];
        {
            unsigned zb = (unsigned)(((16 * q + nn + 16) * 2 + b) * 80 + 8 * hh), xb = (unsigned)(2 * (b * SEQ + 32 * (16 * q + nn) + 4 * hh));
            asm volatile("" : "+v"(zb), "+v"(xb));
#pragma unroll
            for (int g = 0; g < 4; ++g)
#pragma unroll
                for (int e = 0; e < 4; ++e) { const unsigned o = (unsigned)(16 * g + 2 * e);
                    const float vz = bf2f(*(LAS unsigned short*)(lds + HY_ZIN_OFF + zb + o)), x1 = bf2f(*(LAS unsigned short*)(lds + HY_X1_OFF + xb + o));
                    *(LAS unsigned short*)(lds + HY_ZMID_OFF + zb + o) = (unsigned short)f2bf(x1 * (acc[g][e] + sk0 * vz)); }
        }
        __syncthreads();
        hy_build_k(F, F.KF + (size_t)(2 * HW + c) * SEQ, F.KF + (size_t)(3 * HW + c) * SEQ);
        __syncthreads();
        hy_conv(F, HY_ZMID_OFF, acc);
        {
            unsigned zb = (unsigned)(((16 * q + nn + 16) * 2 + b) * 80 + 8 * hh), xb = (unsigned)(2 * (b * SEQ + 32 * (16 * q + nn) + 4 * hh));
            asm volatile("" : "+v"(zb), "+v"(xb));
            bf16* yp = F.YHY + (size_t)(b * SEQ + 32 * (16 * q + nn) + 4 * hh) * HW + c;
#pragma unroll
            for (int g = 0; g < 4; ++g)
#pragma unroll
                for (int e = 0; e < 4; ++e) { const unsigned o = (unsigned)(16 * g + 2 * e);
                    const float z1 = bf2f(*(LAS unsigned short*)(lds + HY_ZMID_OFF + zb + o)), x2 = bf2f(*(LAS unsigned short*)(lds + HY_X2_OFF + xb + o));
                    yp[(size_t)(8 * g + e) * HW] = (bf16)f2bf(x2 * (acc[g][e] + sk1 * z1)); }
        }
    }
}
__device__ __forceinline__ void p3_attn_naive(Frame& F) {
    LAS float* qs = (LAS float*)F.lds + F.wave * 128;
    const int gw = F.bid * NWAVES + F.wave, NGW = F.G * NWAVES;
    const float scale = 0.08838834764831845f;
    for (int u = gw; u < T * 4; u += NGW) {
        const int m = u >> 2, hh = u & 3, b = m / SEQ, s = m % SEQ;
        float Mrun = -3.0e38f, Lrun = 0.f, o0 = 0.f, o1 = 0.f;
#pragma unroll 1
        for (int g = 0; g < 3; ++g) {
            const int head = g * 4 + hh, dil = (g == 0) ? 1 : (g == 1 ? 4 : 16);
            const bf16* qp = F.QKV + (size_t)m * QKVW + head * HD;
            { const unsigned qq = *(const unsigned*)(qp + 2 * F.lane); qs[2 * F.lane] = bflo(qq); qs[2 * F.lane + 1] = bfhi(qq); }
            asm volatile("s_waitcnt lgkmcnt(0)" ::: "memory");
            float sc[3];
#pragma unroll
            for (int p = 0; p < 3; ++p) {
                const int j = (p == 0) ? F.lane - 64 : (p == 1 ? F.lane : 64);
                const int ks = s + j * dil; const bool valid = (ks >= 0) && (ks < SEQ) && (p < 2 || F.lane == 0);
                float dot = 0.f;
                if (valid) { const v4u* kp = (const v4u*)(F.QKV + (size_t)(b * SEQ + ks) * QKVW + NH * HD + head * HD);
#pragma unroll 4
                    for (int c8 = 0; c8 < 16; ++c8) { const v4u kv = kp[c8]; const LAS float* q8 = qs + 8 * c8;
                        dot += bflo(kv.x) * q8[0] + bfhi(kv.x) * q8[1] + bflo(kv.y) * q8[2] + bfhi(kv.y) * q8[3] + bflo(kv.z) * q8[4] + bfhi(kv.z) * q8[5] + bflo(kv.w) * q8[6] + bfhi(kv.w) * q8[7]; } }
                sc[p] = valid ? dot * scale : -1.0e30f;
            }
            const float mg = wave_max(fmaxf(fmaxf(sc[0], sc[1]), sc[2]));
            const float mnew = fmaxf(Mrun, mg), resc = __expf(Mrun - mnew);
            float pr[3];
#pragma unroll
            for (int p = 0; p < 3; ++p) pr[p] = (sc[p] > -1.0e29f) ? __expf(sc[p] - mnew) : 0.f;
            Lrun = Lrun * resc + wave_sum(pr[0] + pr[1] + pr[2]); o0 *= resc; o1 *= resc; Mrun = mnew;
            const bf16* vbase = F.QKV + 2 * NH * HD + head * HD + 2 * F.lane;
            for (int jj = 0; jj < 129; ++jj) {
                const int j = jj - 64, ks = s + j * dil;
                if (ks < 0 || ks >= SEQ) continue;
                const float pk = (jj < 64) ? __shfl(pr[0], jj) : (jj < 128 ? __shfl(pr[1], jj - 64) : __shfl(pr[2], 0));
                const unsigned vv = *(const unsigned*)(vbase + (size_t)(b * SEQ + ks) * QKVW);
                o0 += pk * bflo(vv); o1 += pk * bfhi(vv);
            }
        }
        const float inv = 1.0f / Lrun;
        *(unsigned*)(F.YAT + (size_t)m * 512 + hh * HD + 2 * F.lane) = pk2(o0 * inv, o1 * inv);
    }
}


constexpr int AT_VPITCH = 320, AT_VBYTES = 32 * AT_VPITCH;
typedef short s16x4 __attribute__((ext_vector_type(4)));
#define AT_TR8(S, VB, R) asm volatile( \
    "ds_read_b64_tr_b16 %0, %8 offset:%9\n\tds_read_b64_tr_b16 %1, %8 offset:%10\n\tds_read_b64_tr_b16 %2, %8 offset:%11\n\tds_read_b64_tr_b16 %3, %8 offset:%12\n\t" \
    "ds_read_b64_tr_b16 %4, %8 offset:%13\n\tds_read_b64_tr_b16 %5, %8 offset:%14\n\tds_read_b64_tr_b16 %6, %8 offset:%15\n\tds_read_b64_tr_b16 %7, %8 offset:%16\n\ts_waitcnt lgkmcnt(0)" \
    : "=&v"(R[0]), "=&v"(R[1]), "=&v"(R[2]), "=&v"(R[3]), "=&v"(R[4]), "=&v"(R[5]), "=&v"(R[6]), "=&v"(R[7]) \
    : "v"(VB), "i"((16 * (S)) * AT_VPITCH), "i"((16 * (S) + 8) * AT_VPITCH), "i"((16 * (S)) * AT_VPITCH + 64), "i"((16 * (S) + 8) * AT_VPITCH + 64), \
      "i"((16 * (S)) * AT_VPITCH + 128), "i"((16 * (S) + 8) * AT_VPITCH + 128), "i"((16 * (S)) * AT_VPITCH + 192), "i"((16 * (S) + 8) * AT_VPITCH + 192) : "memory")
__device__ __forceinline__ void p4_attn_mfma(Frame& F) {
    typedef short bf16x8 __attribute__((ext_vector_type(8)));
    typedef float f32x16 __attribute__((ext_vector_type(16)));
    typedef float f32x2 __attribute__((ext_vector_type(2)));
    typedef __bf16 bf16x2v __attribute__((ext_vector_type(2)));
    const int lane = F.lane, w = F.wave, r31 = lane & 31, hh = lane >> 5;
    LAS unsigned char* vimg = F.lds + w * AT_VBYTES;
    const unsigned vb = (unsigned)(size_t)vimg + (unsigned)((4 * hh + ((lane & 15) >> 2)) * AT_VPITCH + 32 * ((lane >> 4) & 1) + 8 * (lane & 3));
    const int gw = F.bid * NWAVES + w, NGW = F.G * NWAVES;
    const float scale = 0.08838834764831845f;
    bf16* AO = (bf16*)F.YB; float* LSE = (float*)((unsigned char*)F.YB + 32 * MiB);
    const int nunit = 2 * NH * 128, per_wg = (nunit + F.G - 1) / F.G;
    for (int k = w; k < per_wg; k += NWAVES) {
        const int u = F.bid * per_wg + k; if (u >= nunit) break;
        const int b = u / (NH * 128), rem = u % (NH * 128), head = rem >> 7, blk = rem & 127, g = head >> 2, hs = head & 3;
        const int dl = (g == 0) ? 0 : (g == 1 ? 2 : 4), dil = 1 << dl, res = blk & (dil - 1), q0 = (blk >> dl) * 32, n = SEQ >> dl;
        const size_t tokq = (size_t)(b * SEQ + res + dil * (q0 + r31));
        bf16x8 qf[8];
        { const bf16* qrow = F.QKV + tokq * QKVW + head * HD + 8 * hh;
#pragma unroll
          for (int s = 0; s < 8; ++s) qf[s] = *(const bf16x8*)(qrow + 16 * s); }
        f32x16 o[4];
#pragma unroll
        for (int dt = 0; dt < 4; ++dt)
#pragma unroll
            for (int i = 0; i < 16; ++i) o[dt][i] = 0.f;
        float mrun = -3.0e38f, lrun = 0.f;
        const int kt_lo = (q0 >= 64) ? 0 : (64 - q0) >> 5, kt_hi = ((n + 32 - q0) >> 5) < 4 ? ((n + 32 - q0) >> 5) : 4;
        bf16x8 kfN[8], vvN[8];
#define AT_FETCH(KT) do { const int _k0 = q0 - 64 + 32 * (KT); \
            const bf16* _krow = F.QKV + (size_t)(b * SEQ + res + dil * (_k0 + r31)) * QKVW + NH * HD + head * HD + 8 * hh; \
            const bf16* _vsrc = F.QKV + (size_t)(b * SEQ + res + dil * (_k0 + (lane >> 4))) * QKVW + 2 * NH * HD + head * HD + (lane & 15) * 8; \
            _Pragma("unroll") for (int _s = 0; _s < 8; ++_s) kfN[_s] = *(const bf16x8*)(_krow + 16 * _s); \
            _Pragma("unroll") for (int _i = 0; _i < 8; ++_i) vvN[_i] = *(const bf16x8*)(_vsrc + (size_t)(4 * _i * dil) * QKVW); } while (0)
        AT_FETCH(kt_lo);
#pragma unroll 1
        for (int kt = kt_lo; kt <= kt_hi; ++kt) {
            const int kt0 = q0 - 64 + 32 * kt;
            bf16x8 kf[8];
#pragma unroll
            for (int s = 0; s < 8; ++s) kf[s] = kfN[s];
#pragma unroll
            for (int i = 0; i < 8; ++i) *(LAS bf16x8*)(vimg + (4 * i + (lane >> 4)) * AT_VPITCH + (lane & 15) * 16) = vvN[i];
            if (kt < kt_hi) AT_FETCH(kt + 1);
            f32x16 sacc;
#pragma unroll
            for (int i = 0; i < 16; ++i) sacc[i] = 0.f;
#pragma unroll
            for (int s = 0; s < 8; ++s) sacc = __builtin_amdgcn_mfma_f32_32x32x16_bf16(kf[s], qf[s], sacc, 0, 0, 0);
            float p[16]; float mx = -3.0e38f;
            const bool edge = (kt == 0) || (kt == 4);
#pragma unroll
            for (int i = 0; i < 16; ++i) { float sv = sacc[i] * scale;
                if (edge) { const int diff = (q0 + r31) - (kt0 + (i & 3) + 8 * (i >> 2) + 4 * hh); if (diff > 64 || diff < -64) sv = -1.0e30f; }
                p[i] = sv; mx = fmaxf(mx, sv); }
            mx = fmaxf(mx, __shfl_xor(mx, 32));
            const float mnew = fmaxf(mrun, mx), resc = __expf(mrun - mnew);
            float ps = 0.f;
#pragma unroll
            for (int i = 0; i < 16; ++i) { p[i] = (p[i] > -1.0e29f) ? __expf(p[i] - mnew) : 0.f; ps += p[i]; }
            ps += __shfl_xor(ps, 32);
            lrun = lrun * resc + ps; mrun = mnew;
#pragma unroll
            for (int dt = 0; dt < 4; ++dt)
#pragma unroll
                for (int i = 0; i < 16; ++i) o[dt][i] *= resc;
            bf16x8 pf[2];
#pragma unroll
            for (int s = 0; s < 2; ++s) { union { bf16x8 v; bf16x2v h[4]; } cv;
#pragma unroll
                for (int j = 0; j < 4; ++j) cv.h[j] = __builtin_convertvector((f32x2){p[8 * s + 2 * j], p[8 * s + 2 * j + 1]}, bf16x2v);
                pf[s] = cv.v; }
            asm volatile("s_waitcnt lgkmcnt(0)" ::: "memory");
            { s16x4 tr[8]; AT_TR8(0, vb, tr);
#pragma unroll
              for (int dt = 0; dt < 4; ++dt) { const bf16x8 va = __builtin_shufflevector(tr[2 * dt], tr[2 * dt + 1], 0, 1, 2, 3, 4, 5, 6, 7); o[dt] = __builtin_amdgcn_mfma_f32_32x32x16_bf16(va, pf[0], o[dt], 0, 0, 0); } }
            { s16x4 tr[8]; AT_TR8(1, vb, tr);
#pragma unroll
              for (int dt = 0; dt < 4; ++dt) { const bf16x8 va = __builtin_shufflevector(tr[2 * dt], tr[2 * dt + 1], 0, 1, 2, 3, 4, 5, 6, 7); o[dt] = __builtin_amdgcn_mfma_f32_32x32x16_bf16(va, pf[1], o[dt], 0, 0, 0); } }
        }
#undef AT_FETCH
        const float inv = 1.0f / lrun;
        bf16* op = AO + ((size_t)g * T + tokq) * 512 + hs * HD + 4 * hh;
#pragma unroll
        for (int dt = 0; dt < 4; ++dt)
#pragma unroll
            for (int a = 0; a < 4; ++a) { v2u ov; ov.x = pk2(o[dt][4 * a] * inv, o[dt][4 * a + 1] * inv); ov.y = pk2(o[dt][4 * a + 2] * inv, o[dt][4 * a + 3] * inv);
                *(v2u*)(op + 32 * dt + 8 * a) = ov; }
        if (hh == 0) LSE[((size_t)g * T + tokq) * 4 + hs] = mrun + logf(lrun);
    }
}
__device__ __forceinline__ void p4b_combine(Frame& F) {
    const bf16* AO = (const bf16*)F.YB; const float* LSE = (const float*)((const unsigned char*)F.YB + 32 * MiB);
    const int gw = F.bid * NWAVES + F.wave, NGW = F.G * NWAVES, lane = F.lane, hs = lane >> 4;
    for (int m = gw; m < T; m += NGW) {
        float l[3];
#pragma unroll
        for (int g = 0; g < 3; ++g) l[g] = LSE[((size_t)g * T + m) * 4 + hs];
        const float mx = fmaxf(fmaxf(l[0], l[1]), l[2]);
        float wg[3], den = 0.f;
#pragma unroll
        for (int g = 0; g < 3; ++g) { wg[g] = __expf(l[g] - mx); den += wg[g]; }
        const float inv = 1.0f / den;
        float acc[8];
#pragma unroll
        for (int j = 0; j < 8; ++j) acc[j] = 0.f;
#pragma unroll
        for (int g = 0; g < 3; ++g) { const v4u q = *(const v4u*)(AO + ((size_t)g * T + m) * 512 + 8 * lane); const float ww = wg[g] * inv;
            acc[0] += ww * bflo(q.x); acc[1] += ww * bfhi(q.x); acc[2] += ww * bflo(q.y); acc[3] += ww * bfhi(q.y); acc[4] += ww * bflo(q.z); acc[5] += ww * bfhi(q.z); acc[6] += ww * bflo(q.w); acc[7] += ww * bfhi(q.w); }
        v4u ov; ov.x = pk2(acc[0], acc[1]); ov.y = pk2(acc[2], acc[3]); ov.z = pk2(acc[4], acc[5]); ov.w = pk2(acc[6], acc[7]);
        *(v4u*)(F.YAT + (size_t)m * 512 + 8 * lane) = ov;
    }
}
constexpr int RT_MOD_OFF = 0;
constexpr int RT_W_OFF = 5 * D * 4;
constexpr int RT_INFO_OFF = RT_W_OFF + 8 * D * 4;
__device__ __forceinline__ void rt_dot8(const f32x4 (&v)[8], const LAS float* W, int lane, float (&out)[8]) {
#pragma unroll
    for (int n = 0; n < 8; ++n) { float a = 0.f;
#pragma unroll
        for (int j = 0; j < 8; ++j) { const f32x4 w = *(const LAS f32x4*)(W + n * D + 256 * j + 4 * lane); a += (v[j].x * w.x + v[j].y * w.y) + (v[j].z * w.z + v[j].w * w.w); }
        out[n] = wave_sum(a); }
}
template <bool DRY> __device__ __forceinline__ void p6_rows_router(Frame& F) {
    LAS float* L = (LAS float*)F.lds;
    LAS float* gatem = L, *shiftf = L + D, *scalef = L + 2 * D, *gpost = L + 3 * D, *gpre = L + 4 * D;
    LAS float* Wl = (LAS float*)(F.lds + RT_W_OFF);
    LAS float* info = (LAS float*)(F.lds + RT_INFO_OFF);
    const int lane = F.lane;
    for (int blk = F.bid; blk < T / 32; blk += F.G) {
        const int m0 = blk * 32, b = m0 / SEQ;
        __syncthreads();
        load_mod1(F, gatem, 2, b); load_mod1(F, shiftf, 3, b); load_mod1(F, scalef, 4, b);
        *(LAS f32x4*)(gpost + 4 * F.tid) = *(const f32x4*)(F.g_mix_post + 4 * F.tid); *(LAS f32x4*)(gpre + 4 * F.tid) = *(const f32x4*)(F.g_ffn_pre + 4 * F.tid);
        for (int i = F.tid; i < 8 * D / 4; i += NTHR) *(LAS f32x4*)(Wl + 4 * i) = *(const f32x4*)(F.WGT + 4 * i);
        __syncthreads();
#pragma unroll 1
        for (int ip = 0; ip < 4; ip += 2) {
            v2u yv[2][8]; f32x4 xv[2][8];
#pragma unroll
            for (int r = 0; r < 2; ++r) { const int m = m0 + 4 * F.wave + ip + r;
                const v2u* yr = (const v2u*)((const bf16*)F.Y + (size_t)m * D) + lane; const f32x4* xr = (const f32x4*)(F.x + (size_t)m * D) + lane;
#pragma unroll
                for (int j = 0; j < 8; ++j) { yv[r][j] = yr[64 * j]; xv[r][j] = xr[64 * j]; } }
#pragma unroll
            for (int r = 0; r < 2; ++r) {
                const int rl = 4 * F.wave + ip + r, m = m0 + rl;
                f32x4 v[8]; float s = 0.f;
#pragma unroll
                for (int j = 0; j < 8; ++j) { const v2u yw = yv[r][j]; v[j] = (f32x4){bflo(yw.x), bfhi(yw.x), bflo(yw.y), bfhi(yw.y)}; s += (v[j].x * v[j].x + v[j].y * v[j].y) + (v[j].z * v[j].z + v[j].w * v[j].w); }
                const float rstd = 1.0f / sqrtf(wave_sum(s) * (1.f / D) + RMS_EPS);
                float s1 = 0.f;
                f32x4* x1r = (f32x4*)(F.X1 + (size_t)m * D) + lane;
#pragma unroll
                for (int j = 0; j < 8; ++j) { const int d = 256 * j + 4 * lane;
                    const f32x4 g = *(LAS f32x4*)(gpost + d), gm = *(LAS f32x4*)(gatem + d);
                    const f32x4 x1 = xv[r][j] + gm * ((v[j] * rstd) * g);
                    x1r[64 * j] = x1; v[j] = x1; s1 += (x1.x * x1.x + x1.y * x1.y) + (x1.z * x1.z + x1.w * x1.w); }
                const float rstd1 = 1.0f / sqrtf(wave_sum(s1) * (1.f / D) + RMS_EPS);
                v2u* o8 = (v2u*)(F.H2 + (size_t)m * D) + lane;
#pragma unroll
                for (int j = 0; j < 8; ++j) { const int d = 256 * j + 4 * lane;
                    const f32x4 g = *(LAS f32x4*)(gpre + d), sc = *(LAS f32x4*)(scalef + d), sh = *(LAS f32x4*)(shiftf + d);
                    f32x4 h = (v[j] * rstd1) * g; h = h * (sc + 1.0f) + sh; v[j] = h;
                    v2u w; w.x = pk2(h.x, h.y); w.y = pk2(h.z, h.w); o8[64 * j] = w; }
                float gl[8]; rt_dot8(v, Wl, lane, gl);
                float gmax = -3.0e38f; int gi = 0;
#pragma unroll
                for (int g = 0; g < 8; ++g) { gl[g] += F.b_group[g]; if (gl[g] > gmax) { gmax = gl[g]; gi = g; } }
                float gden = 0.f;
#pragma unroll
                for (int g = 0; g < 8; ++g) gden += expf(gl[g] - gmax);
                if (lane == 0) { info[rl] = rstd1; info[32 + rl] = 1.0f / gden; ((LAS int*)info)[64 + rl] = gi; }
            }
        }
        __syncthreads();
#pragma unroll 1
        for (int g = 0; g < 8; ++g) {
            int cnt = 0;
#pragma unroll 1
            for (int rl = 0; rl < 32; ++rl) cnt += (((LAS int*)info)[64 + rl] == g) ? 1 : 0;
            if (cnt == 0) continue;
            for (int i = F.tid; i < 8 * D / 4; i += NTHR) *(LAS f32x4*)(Wl + 4 * i) = *(const f32x4*)(F.WET + (size_t)g * 8 * D + 4 * i);
            __syncthreads();
            int k = 0;
#pragma unroll 1
            for (int rl = 0; rl < 32; ++rl) {
                if (((LAS int*)info)[64 + rl] != g) continue;
                const bool mine = ((k & 7) == F.wave); ++k;
                if (!mine) continue;
                const int m = m0 + rl; const float rstd1 = info[rl], gval = info[32 + rl];
                const f32x4* x1r = (const f32x4*)(F.X1 + (size_t)m * D) + lane;
                f32x4 v[8];
#pragma unroll
                for (int j = 0; j < 8; ++j) { const int d = 256 * j + 4 * lane;
                    const f32x4 gg = *(LAS f32x4*)(gpre + d), sc = *(LAS f32x4*)(scalef + d), sh = *(LAS f32x4*)(shiftf + d);
                    f32x4 h = (x1r[64 * j] * rstd1) * gg; v[j] = h * (sc + 1.0f) + sh; }
                float el[8]; rt_dot8(v, Wl, lane, el);
                float e0v = -3.0e38f, e1v = -3.0e38f; int e0i = 0, e1i = 0;
#pragma unroll
                for (int q = 0; q < 8; ++q) { el[q] += F.b_expert[g * 8 + q];
                    if (el[q] > e0v) { e1v = e0v; e1i = e0i; e0v = el[q]; e0i = q; } else if (el[q] > e1v) { e1v = el[q]; e1i = q; } }
                const float p1 = expf(e1v - e0v), den = 1.0f + p1;
                const float gate0 = gval / den, gate1 = gval * p1 / den;
                if (DRY) { if (gate0 + gate1 == 12345.f) F.LISTG[0] = gate0; }
                if (lane == 0 && !DRY) {
                    ((LAS int*)info)[96 + rl] = (g * 8 + e0i) | ((g * 8 + e1i) << 8); info[128 + rl] = gate0; info[160 + rl] = gate1; }
            }
            __syncthreads();
        }
        if (!DRY && F.tid < 32) {
            const int rl = F.tid, m = m0 + rl; const int ee = ((LAS int*)info)[96 + rl], ex0 = ee & 255, ex1 = ee >> 8; const float gate0 = info[128 + rl], gate1 = info[160 + rl];
            const unsigned pos0 = atomicAdd(F.ctl + CW_CNT + CNT_STRIDE * ex0, 1u), pos1 = atomicAdd(F.ctl + CW_CNT + CNT_STRIDE * ex1, 1u);
            F.LISTT[ex0 * T + pos0] = m; F.LISTG[ex0 * T + pos0] = gate0;
            F.LISTT[ex1 * T + pos1] = m; F.LISTG[ex1 * T + pos1] = gate1;
            F.ROUTE[m * 4 + 0] = (unsigned)(ex0 * T) + pos0; F.ROUTE[m * 4 + 1] = (unsigned)(ex1 * T) + pos1;
        }
    }
}

__device__ __forceinline__ void moe_offsets(Frame& F, LAS int* offs  , LAS int* toff  ) {
    if (F.tid < 64) { const int c = (int)__hip_atomic_load(F.ctl + CW_CNT + CNT_STRIDE * F.tid, __ATOMIC_RELAXED, __HIP_MEMORY_SCOPE_AGENT); const int tc = (c + 63) / 64; int incl = c, tincl = tc;
#pragma unroll
        for (int o = 1; o < 64; o <<= 1) { const int v = __shfl_up(incl, o), tv = __shfl_up(tincl, o); if (F.tid >= o) { incl += v; tincl += tv; } }
        offs[F.tid] = incl - c; toff[F.tid] = tincl - tc; if (F.tid == 63) { offs[NE] = incl; toff[NE] = tincl; } }
    __syncthreads();
}
__device__ __forceinline__ void p7_moe1(Frame& F) {
    LAS float* L = (LAS float*)F.lds;
    LAS int* offs = (LAS int*)(L + 8192 * 3); LAS int* toff = offs + 80;
    moe_offsets(F, offs, toff);
    const int ntiles = toff[NE];
    for (int u = F.bid; u < ntiles * 8; u += F.G) {
        const int rt = u >> 3, ct = u & 7;
        int e = 0; while (toff[e + 1] <= rt) ++e;
        const int r0 = (rt - toff[e]) * 64, ne = offs[e + 1] - offs[e];
        const int* lt = F.LISTT + e * T + r0;
        const float* W1 = F.w1e + (size_t)e * D * FF + ct * 64; const float* W3 = F.w3e + (size_t)e * D * FF + ct * 64;
        const bf16* H2 = F.H2;
        auto la = [&](int r, int k) -> float { return (r0 + r < ne) ? bf2f(H2[(size_t)lt[r] * D + k]) : 0.f; };
        auto lb = [&](int q, int k, int c) -> float { return (q == 0 ? W1 : W3)[(size_t)k * FF + c]; };
        float* ACT = F.ACT + (size_t)(offs[e] + r0) * FF + ct * 64;
        auto ep = [&](int r, int c, const float (&v)[2]) { if (r0 + r < ne) { const float a = v[0], bb = v[1]; ACT[(size_t)r * FF + c] = (a / (1.0f + __expf(-a))) * bb; } };
        simt_tile<2>(L, D, F.tid, la, lb, ep);
    }
}
__device__ __forceinline__ void p8_moe2(Frame& F) {
    LAS float* L = (LAS float*)F.lds;
    LAS int* offs = (LAS int*)(L + 8192 * 3); LAS int* toff = offs + 80;
    moe_offsets(F, offs, toff);
    const int ntiles = toff[NE];
    for (int u = F.bid; u < ntiles * 32; u += F.G) {
        const int rt = u >> 5, ct = u & 31;
        int e = 0; while (toff[e + 1] <= rt) ++e;
        const int r0 = (rt - toff[e]) * 64, ne = offs[e + 1] - offs[e];
        const float* A = F.ACT + (size_t)(offs[e] + r0) * FF;
        const float* W2 = F.w2e + (size_t)e * FF * D + ct * 64;
        const float* lg = F.LISTG + e * T + r0;
        auto la = [&](int r, int k) -> float { return (r0 + r < ne) ? A[(size_t)r * FF + k] : 0.f; };
        auto lb = [&](int q, int k, int c) -> float { return W2[(size_t)k * D + c]; };
        float* YB = F.YB + (size_t)(offs[e] + r0) * D + ct * 64;
        auto ep = [&](int r, int c, const float (&v)[1]) { if (r0 + r < ne) YB[(size_t)r * D + c] = v[0] * lg[r]; };
        simt_tile<1>(L, FF, F.tid, la, lb, ep);
    }
}

template <int MODE, int VAR = 0>
__device__ __forceinline__ void moe_mfma(Frame& F) {
    constexpr int K = MODE == 0 ? D : FF, LDW = MODE == 0 ? FF : D, NSL = MODE == 0 ? 8 : 16, NK = K / 32;
    constexpr int RPP = 368, NT = 23, S = MOE_S, WST = 16384, XST = NT * 1024, STB = WST + XST;
    static_assert(S * STB <= MOE_OFFS_OFF, "MoE stage ring vs LDS map");
    typedef short bf16x8 __attribute__((ext_vector_type(8)));
    LAS unsigned char* lds = F.lds;
    LAS int* offs = (LAS int*)(lds + MOE_OFFS_OFF);
    __syncthreads();
    if (F.tid < 64) { const int c = (int)__hip_atomic_load(F.ctl + CW_CNT + CNT_STRIDE * F.tid, __ATOMIC_RELAXED, __HIP_MEMORY_SCOPE_AGENT); int incl = c;
#pragma unroll
        for (int o = 1; o < 64; o <<= 1) { const int v = __shfl_up(incl, o); if (F.tid >= o) incl += v; }
        offs[F.tid] = incl - c; if (F.tid == 63) offs[NE] = incl; }
    __syncthreads();
    const int lane = F.lane, w = F.wave, cq = w & 3, rh = w >> 2;
    const int vcu = (F.G % 8 == 0) ? (F.bid % 8) * (F.G / 8) + F.bid / 8 : F.bid;
    for (int u = vcu; u < NE * NSL; u += F.G) {
        const int e = u / NSL, sl = u % NSL;
        const int oe = offs[e], ne = offs[e + 1] - oe;
        if (ne == 0) continue;
        const float* Wm0; const float* Wm1;
        if (MODE == 0) { Wm0 = F.w1e + (size_t)e * D * FF + sl * 64; Wm1 = F.w3e + (size_t)e * D * FF + sl * 64; }
        else { Wm0 = F.w2e + (size_t)e * FF * D + sl * 128; Wm1 = Wm0 + 64; }
        for (int r0 = 0; r0 < ne; r0 += RPP) {
            const int nr = (ne - r0) < RPP ? (ne - r0) : RPP, ntile = (nr + 15) >> 4;
            const char* xsrc[3]; unsigned xdst[3];
#pragma unroll
            for (int i = 0; i < 3; ++i) { int tile = 3 * w + i; if (tile > NT - 1) tile = NT - 1;
                int row = r0 + 16 * tile + (lane >> 2); if (row > ne - 1) row = ne - 1;
                const size_t srow = (MODE == 0) ? (size_t)F.LISTT[e * T + row] : (size_t)(oe + row);
                xsrc[i] = (const char*)(MODE == 0 ? (const void*)F.H2 : (const void*)F.ACTB) + srow * (size_t)(K * 2) + (lane & 3) * 16;
                xdst[i] = (unsigned)(WST + tile * 1024); }
            const char* wsrc[2]; unsigned wdst[2];
#pragma unroll
            for (int i = 0; i < 2; ++i) { const int kr = 8 * (w & 3) + 4 * i;
                wsrc[i] = (const char*)((w >> 2) ? Wm1 : Wm0) + ((size_t)(kr + (lane >> 4)) * LDW) * 4 + (lane & 15) * 16;
                if (VAR == 10) wsrc[i] = (const char*)F.w1e + (size_t)(u & 255) * (K * 128 * 4) + (size_t)(2 * w + i) * 1024 + lane * 16;
                wdst[i] = (unsigned)((w >> 2) * 8192 + kr * 256); }
            asm volatile("s_waitcnt vmcnt(0)" ::: "memory");
#define MOE_ISSUE(stage, ks) do { const unsigned _sb = (unsigned)(stage) * STB; const size_t _kx = (size_t)(ks) * 64, _kw = (VAR == 10) ? (size_t)(ks) * 16384 : (size_t)(ks) * 32 * LDW * 4; \
            if (VAR < 8) { _Pragma("unroll") for (int _i = 0; _i < 3; ++_i) __builtin_amdgcn_global_load_lds((const unsigned*)(xsrc[_i] + _kx), (LAS unsigned*)(lds + _sb + xdst[_i]), 16, 0, 0); } \
                        { _Pragma("unroll") for (int _i = 0; _i < 2; ++_i) __builtin_amdgcn_global_load_lds((const unsigned*)(wsrc[_i] + _kw), (LAS unsigned*)(lds + _sb + wdst[_i]), 16, 0, 2  ); } } while (0)
            if (VAR >= 11) {
                v4u r[4][2];
#pragma unroll
                for (int q = 0; q < 4; ++q) { r[q][0] = (v4u){0u, 0u, 0u, 0u}; r[q][1] = (v4u){0u, 0u, 0u, 0u}; }
#define RS_LOAD(slot, ks) do { const size_t _kw = (size_t)(ks) * 32 * LDW * 4; _Pragma("unroll") for (int _i = 0; _i < 2; ++_i) { \
                    if (VAR == 11) asm volatile("global_load_dwordx4 %0, %1, off nt" : "+v"(r[slot][_i]) : "v"(wsrc[_i] + _kw) : "memory"); \
                    else asm volatile("global_load_dwordx4 %0, %1, off" : "+v"(r[slot][_i]) : "v"(wsrc[_i] + _kw) : "memory"); } } while (0)
                RS_LOAD(0, 0); RS_LOAD(1, 1); RS_LOAD(2, 2);
#pragma unroll 1
                for (int t = 0; t < NK; t += 4) {
#pragma unroll
                    for (int q = 0; q < 4; ++q) { asm volatile("s_waitcnt vmcnt(4)" ::: "memory"); __builtin_amdgcn_s_barrier(); const int tn = t + q + 3; RS_LOAD((q + 3) & 3, tn < NK ? tn : 0); }
                }
                asm volatile("s_waitcnt vmcnt(0)" : "+v"(r[0][0]), "+v"(r[0][1]), "+v"(r[1][0]), "+v"(r[1][1]), "+v"(r[2][0]), "+v"(r[2][1]), "+v"(r[3][0]), "+v"(r[3][1]) :: "memory");
                unsigned sk = 0u;
#pragma unroll
                for (int q = 0; q < 4; ++q) sk ^= r[q][0].x ^ r[q][1].y;
                if (sk == 0x9e3779b9u) F.ctl[200] = sk;
                __builtin_amdgcn_s_barrier();
#undef RS_LOAD
                continue;
            }
            f32x4 acc[2][12]; unsigned sink = 0u;
#pragma unroll
            for (int m = 0; m < 2; ++m)
#pragma unroll
                for (int j = 0; j < 12; ++j) acc[m][j] = (f32x4){0.f, 0.f, 0.f, 0.f};
#pragma unroll
            for (int s = 0; s < S - 1; ++s) MOE_ISSUE(s, s);
            const unsigned wrd = (unsigned)((8 * (lane >> 4)) * 256 + (16 * cq + (lane & 15)) * 4);
            const unsigned xrd = (unsigned)(WST + (lane & 15) * 64 + (lane >> 4) * 16);
#pragma unroll 1
            for (int t = 0; t < NK; ++t) {
                if (VAR >= 8) asm volatile("s_waitcnt vmcnt(4)" ::: "memory"); else
                if (S == 3) asm volatile("s_waitcnt vmcnt(5)" ::: "memory"); else asm volatile("s_waitcnt vmcnt(10)" ::: "memory");
                __builtin_amdgcn_s_barrier();
                asm volatile("" ::: "memory");
                { const int tn = t + S - 1; MOE_ISSUE((S == 4 ? (tn & 3) : (tn % S)), tn < NK ? tn : 0); }
                if (VAR >= 8) continue;
                const unsigned sb = (unsigned)(S == 4 ? (t & 3) : (t % S)) * STB;
                bf16x8 af[2];
#pragma unroll
                for (int m = 0; m < 2; ++m) { float f[8];
#pragma unroll
                    for (int j = 0; j < 8; ++j) f[j] = *(const LAS float*)(lds + sb + m * 8192 + wrd + j * 256);
                    union { bf16x8 v; unsigned u[4]; } cv;
#pragma unroll
                    for (int p = 0; p < 4; ++p) cv.u[p] = pg8::cvt_pk_bf16(f[2 * p], f[2 * p + 1]);
                    af[m] = cv.v; }
#pragma unroll
                for (int jb = 0; jb < 12; jb += 6) { bf16x8 xb[6];
#pragma unroll
                    for (int q = 0; q < 6; ++q) { int tile = 2 * (jb + q) + rh; if (tile > NT - 1) tile = NT - 1; xb[q] = *(const LAS bf16x8*)(lds + sb + xrd + tile * 1024); }
#pragma unroll
                    for (int q = 0; q < 6; ++q) { const int j = jb + q;
                        if (2 * j + rh < ntile) {
                            acc[0][j] = __builtin_amdgcn_mfma_f32_16x16x32_bf16(af[0], xb[q], acc[0][j], 0, 0, 0);
                            acc[1][j] = __builtin_amdgcn_mfma_f32_16x16x32_bf16(af[1], xb[q], acc[1][j], 0, 0, 0); } } }
            }
            asm volatile("s_waitcnt vmcnt(0)" ::: "memory");
            __builtin_amdgcn_s_barrier();
            asm volatile("" ::: "memory");
            if (VAR >= 11 && sink == 0x9e3779b9u) F.ctl[200] = sink;
#undef MOE_ISSUE
#pragma unroll
            for (int j = 0; j < 12; ++j) { const int tile = 2 * j + rh, row = r0 + 16 * tile + (lane & 15);
                if (tile < ntile && row < ne) {
                    if (MODE == 0) { const f32x4 a = acc[0][j], b = acc[1][j]; f32x4 v;
#pragma unroll
                        for (int i = 0; i < 4; ++i) v[i] = (a[i] / (1.0f + __expf(-a[i]))) * b[i];
                        v2u o; o.x = pk2(v[0], v[1]); o.y = pk2(v[2], v[3]);
                        *(v2u*)((VAR ? F.YBB : F.ACTB) + (size_t)(oe + row) * FF + sl * 64 + 16 * cq + 4 * (lane >> 4)) = o; }
                    else { const float g = F.LISTG[e * T + row]; const f32x4 a = acc[0][j] * g, b = acc[1][j] * g;
                        bf16* yp = F.YBB + (size_t)(oe + row) * D + sl * 128 + 16 * cq + 4 * (lane >> 4);
                        v2u o0; o0.x = pk2(a[0], a[1]); o0.y = pk2(a[2], a[3]); *(v2u*)yp = o0;
                        v2u o1; o1.x = pk2(b[0], b[1]); o1.y = pk2(b[2], b[3]); *(v2u*)(yp + 64) = o1; }
                } }
        }
    }
}
__device__ __forceinline__ void p9_final(Frame& F) {
    LAS float* L = (LAS float*)F.lds;
    LAS float* gatef = L;
    LAS int* offs = (LAS int*)(L + 8192 * 3); LAS int* toff = offs + 80;
    load_mod(F, gatef, 5);
    LAS float* gpo = L + 2 * D;
    *(LAS f32x4*)(gpo + 4 * F.tid) = *(const f32x4*)(F.g_ffn_post + 4 * F.tid);
    moe_offsets(F, offs, toff);
    const int gw = F.bid * NWAVES + F.wave, NGW = F.G * NWAVES;
#if MOE_SIMT
    for (int m = gw; m < T; m += NGW) {
        const int b = m / SEQ;
        const unsigned s0 = F.ROUTE[m * 4 + 0], s1 = F.ROUTE[m * 4 + 1];
        const size_t r0 = (size_t)offs[s0 / T] + (s0 % T), r1 = (size_t)offs[s1 / T] + (s1 % T);
        f32x4 v[8]; float s = 0.f;
        const f32x4* y0 = (const f32x4*)(F.YB + r0 * D) + F.lane; const f32x4* y1 = (const f32x4*)(F.YB + r1 * D) + F.lane;
#pragma unroll
        for (int j = 0; j < 8; ++j) { v[j] = y0[64 * j] + y1[64 * j]; s += (v[j].x * v[j].x + v[j].y * v[j].y) + (v[j].z * v[j].z + v[j].w * v[j].w); }
        const float rstd = 1.0f / sqrtf(wave_sum(s) * (1.f / D) + RMS_EPS);
        const f32x4* x1r = (const f32x4*)(F.X1 + (size_t)m * D) + F.lane; f32x4* outr = (f32x4*)(F.out + (size_t)m * D) + F.lane;
#pragma unroll
        for (int j = 0; j < 8; ++j) { const int d = 256 * j + 4 * F.lane;
            const f32x4 g = *(LAS f32x4*)(gpo + d), gf = *(LAS f32x4*)(gatef + b * D + d);
            outr[64 * j] = x1r[64 * j] + gf * ((v[j] * rstd) * g); }
    }
#else
    for (int m0 = gw; m0 < T; m0 += 2 * NGW) {
        unsigned sl[2][2];
#pragma unroll
        for (int r = 0; r < 2; ++r) { const int m = m0 + r * NGW; if (m < T) { sl[r][0] = F.ROUTE[m * 4 + 0]; sl[r][1] = F.ROUTE[m * 4 + 1]; } else { sl[r][0] = 0; sl[r][1] = 0; } }
        v2u ya[2][8], yb[2][8]; f32x4 xv[2][8];
#pragma unroll
        for (int r = 0; r < 2; ++r) { const int m = m0 + r * NGW; if (m < T) {
            const size_t r0 = (size_t)offs[sl[r][0] / T] + (sl[r][0] % T), r1 = (size_t)offs[sl[r][1] / T] + (sl[r][1] % T);
            const v2u* y0 = (const v2u*)(F.YBB + r0 * D) + F.lane; const v2u* y1 = (const v2u*)(F.YBB + r1 * D) + F.lane; const f32x4* x1r = (const f32x4*)(F.X1 + (size_t)m * D) + F.lane;
#pragma unroll
            for (int j = 0; j < 8; ++j) { ya[r][j] = y0[64 * j]; yb[r][j] = y1[64 * j]; xv[r][j] = x1r[64 * j]; } } }
#pragma unroll
        for (int r = 0; r < 2; ++r) { const int m = m0 + r * NGW; if (m < T) { const int b = m / SEQ; f32x4 v[8]; float s = 0.f;
#pragma unroll
            for (int j = 0; j < 8; ++j) { const v2u a = ya[r][j], b2 = yb[r][j];
                v[j] = (f32x4){bflo(a.x) + bflo(b2.x), bfhi(a.x) + bfhi(b2.x), bflo(a.y) + bflo(b2.y), bfhi(a.y) + bfhi(b2.y)};
                s += (v[j].x * v[j].x + v[j].y * v[j].y) + (v[j].z * v[j].z + v[j].w * v[j].w); }
            const float rstd = 1.0f / sqrtf(wave_sum(s) * (1.f / D) + RMS_EPS);
            f32x4* outr = (f32x4*)(F.out + (size_t)m * D) + F.lane;
#pragma unroll
            for (int j = 0; j < 8; ++j) { const int d = 256 * j + 4 * F.lane;
                const f32x4 g = *(LAS f32x4*)(gpo + d), gf = *(LAS f32x4*)(gatef + b * D + d);
                outr[64 * j] = xv[r][j] + gf * ((v[j] * rstd) * g); } } }
    }
#endif
}

#if SIMPLE_GEMM
template <class EP>
__device__ __forceinline__ void simple_gemm(Frame& F, const bf16* A, const bf16* Bt, int M, int N, int K, const EP& ep) {
    LAS float* L = (LAS float*)F.lds;
    const int tn = N / 64, nt = (M / 64) * tn;
    for (int u = F.bid; u < nt; u += F.G) {
        const int r0 = (u / tn) * 64, c0 = (u % tn) * 64;
        auto la = [&](int r, int k) -> float { return bf2f(A[(size_t)(r0 + r) * K + k]); };
        auto lb = [&](int q, int k, int c) -> float { return bf2f(Bt[(size_t)(c0 + c) * K + k]); };
        auto e2 = [&](int r, int c, const float (&v)[1]) { ep(r0 + r, c0 + c, v[0]); };
        simt_tile<1>(L, K, F.tid, la, lb, e2);
    }
}
#endif

#ifndef REPEAT_MASK
#define REPEAT_MASK 0
#endif
__device__ __forceinline__ void phase_gemm2(Frame& F) {
#if SIMPLE_GEMM
        { bf16* PHY = F.PHY; simple_gemm(F, F.W1T, F.H, 3 * HW, T, D, [&](int r, int c, float v) { PHY[(size_t)r * T + c] = (bf16)f2bf(v); }); }
        __syncthreads();
        { bf16* QKVp = F.QKV; bf16* Gp = F.GT; const float* bias = F.b_bg;
          simple_gemm(F, F.H, F.W1T + (size_t)(3 * HW) * D, T, QKVW + 2 * D, D, [&](int r, int c, float v) {
              if (c < QKVW) QKVp[(size_t)r * QKVW + c] = (bf16)f2bf(v); else Gp[(size_t)r * (2 * D) + (c - QKVW)] = (bf16)f2bf(1.0f / (1.0f + __expf(-(v + bias[c - QKVW])))); }); }
#else
        { DualOrder S; S.s0.init(3 * HW, T, 1, 0); S.s1.init(T, QKVW + 2 * D, 1, 0); S.G = F.G; S.c = F.bid;
          S.A0 = F.W1T; S.B0 = F.H; S.A1 = F.H; S.B1 = F.W1T + (size_t)(3 * HW) * D;
          EpiDual E{EpiPlainBf16{F.PHY, T}, EpiProj{F.QKV, F.GT, F.ROT, F.b_bg}};
          pg8::Gemm g{F.H, F.H, T, T, D};
          pg8::gemm_phase<EpiDual, DualOrder, true, true>(F.lds, g, S, E); }
#endif
}
__device__ __forceinline__ void phase_gemm6(Frame& F) {
#if SIMPLE_GEMM
        { float* TMP = F.TMP; const bf16* G = F.GT; simple_gemm(F, F.YHY, F.WHYOT, T, D, HW, [&](int r, int c, float v) { TMP[(size_t)r * D + c] = v * bf2f(G[(size_t)r * (2 * D) + c]); }); }
        __syncthreads();
        { float* TMP = F.TMP; const bf16* G = F.GT; bf16* Mp = F.MERGED; simple_gemm(F, F.YAT, F.WATOT, T, D, 512, [&](int r, int c, float v) { Mp[(size_t)r * D + c] = (bf16)f2bf(TMP[(size_t)r * D + c] + v * bf2f(G[(size_t)r * (2 * D) + D + c])); }); }
#else
        { EpiGate<0> E{F.GT, 0, F.TMP, F.MERGED}; run_gemm(F, F.YHY, F.WHYOT, T, D, HW, E); }
        { EpiGate<1> E{F.GT, D, F.TMP, F.MERGED}; run_gemm(F, F.YAT, F.WATOT, T, D, 512, E); }
#endif
}
__device__ __forceinline__ void phase_gemm7(Frame& F) {
#if SIMPLE_GEMM
        { float* Y = F.Y; simple_gemm(F, F.MERGED, F.WOUTT, T, D, D, [&](int r, int c, float v) { Y[(size_t)r * D + c] = v; }); }
#else
        { EpiPlainBf16 E{(bf16*)F.Y, D}; run_gemm(F, F.MERGED, F.WOUTT, T, D, D, E); }
#endif
}
__global__ void __launch_bounds__(NTHR, 2) fwd_kernel(Args args) {
    extern __shared__ __attribute__((aligned(16))) unsigned char lds_raw[];
    Frame F;
    F.lds = (LAS unsigned char*)lds_raw;
    F.tid = threadIdx.x; F.lane = F.tid & 63; F.wave = __builtin_amdgcn_readfirstlane(F.tid >> 6); F.G = gridDim.x; F.bid = blockIdx.x;
    F.x = (const float*)args.in[0]; F.c = (const float*)args.in[1]; F.positions = (const int*)args.in[2]; F.w_ada = (const float*)args.in[3]; F.b_ada = (const float*)args.in[4];
    F.g_mix_pre = (const float*)args.in[5]; F.g_mix_post = (const float*)args.in[6]; F.g_ffn_pre = (const float*)args.in[7]; F.g_ffn_post = (const float*)args.in[8];
    F.w_in = (const float*)args.in[9]; F.conv_w = (const float*)args.in[10]; F.conv_b = (const float*)args.in[11]; F.fw1 = (const float*)args.in[12]; F.fb1 = (const float*)args.in[13];
    F.fw2 = (const float*)args.in[14]; F.fb2 = (const float*)args.in[15]; F.fw3 = (const float*)args.in[16]; F.ffreq = (const float*)args.in[17]; F.hskip = (const float*)args.in[18];
    F.w_bg = (const float*)args.in[19]; F.b_bg = (const float*)args.in[20]; F.w_hy_o = (const float*)args.in[21]; F.w_at_o = (const float*)args.in[22]; F.w_out = (const float*)args.in[23];
    F.w_group = (const float*)args.in[24]; F.b_group = (const float*)args.in[25]; F.w_expert = (const float*)args.in[26]; F.b_expert = (const float*)args.in[27];
    F.w1e = (const float*)args.in[28]; F.w3e = (const float*)args.in[29]; F.w2e = (const float*)args.in[30];
    F.out = args.out;
    unsigned char* ws = args.ws;
    F.ctl = (unsigned*)(ws + WS_CTL); F.MODP = (float*)(ws + WS_MODP); F.HID2 = (float*)(ws + WS_HID2); F.ROT = (float*)(ws + WS_ROT); F.W3T = (float*)(ws + WS_W3T);
    F.WGT = (float*)(ws + WS_WGT); F.WET = (float*)(ws + WS_WET); F.HID2B = (bf16*)(ws + WS_HID2B); F.W3TB = (bf16*)(ws + WS_W3TB);
    F.ROUTE = (unsigned*)(ws + WS_ROUTE); F.LISTT = (int*)(ws + WS_LISTT); F.LISTG = (float*)(ws + WS_LISTG);
    F.W1T = (bf16*)(ws + WS_W1T); F.WHYOT = (bf16*)(ws + WS_WHYOT); F.WATOT = (bf16*)(ws + WS_WATOT); F.WOUTT = (bf16*)(ws + WS_WOUTT);
    F.KF = (bf16*)(ws + WS_KF); F.H = (bf16*)(ws + WS_H); F.PHY = (bf16*)(ws + WS_PHY); F.QKV = (bf16*)(ws + WS_QKV); F.GT = (bf16*)(ws + WS_G);
    F.YHY = (bf16*)(ws + WS_YHY); F.YAT = (bf16*)(ws + WS_YAT); F.TMP = (float*)(ws + WS_TMP); F.MERGED = (bf16*)(ws + WS_MERGED); F.Y = (float*)(ws + WS_Y);
    F.X1 = (float*)(ws + WS_X1); F.H2 = (bf16*)(ws + WS_H2); F.ACT = (float*)(ws + WS_ACT); F.YB = (float*)(ws + WS_YB); F.ACTB = (bf16*)(ws + WS_ACT); F.YBB = (bf16*)(ws + WS_YB);

    volatile LAS unsigned* MISC = (volatile LAS unsigned*)(F.lds + MISC_OFF);
    if (F.tid < 32) MISC[F.tid] = 0u;
    __syncthreads();
    const int lo = args.ph_lo, hi = args.ph_hi;
    const bool multi = (hi - lo) > 1;
#if TLB_TOUCH
    {
        unsigned acc = 0u; const int sub = F.bid >> 3;
        const size_t nws = WS_END >> 21;
        for (size_t p = (size_t)sub * 16 + (F.tid >> 5); p < nws; p += 512) if ((F.tid & 31) == 0) acc += *(const volatile unsigned*)(ws + (p << 21));
        const void* big[8] = {args.in[0], args.in[3], args.in[9], args.in[19], args.in[23], args.in[28], args.in[29], args.in[30]};
        const size_t bsz[8] = {(size_t)T * D * 4, (size_t)D * 6 * D * 4, (size_t)D * INW * 4, (size_t)D * 2 * D * 4, (size_t)D * D * 4, (size_t)NE * D * FF * 4, (size_t)NE * D * FF * 4, (size_t)NE * D * FF * 4};
#pragma unroll
        for (int q = 0; q < 8; ++q) { const size_t np = bsz[q] >> 21;
            for (size_t p = (size_t)sub * 16 + (F.tid >> 5); p < np; p += 512) if ((F.tid & 31) == 0) acc += *(const volatile unsigned*)((const unsigned char*)big[q] + (p << 21)); }
        if (acc == 0x12345679u) F.ctl[100] = acc;
    }
#endif
    XcdBarrier bar; bar.bar = F.ctl + CW_BAR; bar.x = 0; bar.st = nullptr;
    if (multi) bar = xcd_barrier_post(F.ctl + CW_BAR, MISC + 8);
#ifndef PHASE_MASK
#define PHASE_MASK 0xFFFF
#endif
#define IN(k) ((((PHASE_MASK) >> (k)) & 1) && lo <= (k) && (k) < hi)
#ifndef REPEAT_MASK
#define REPEAT_MASK 0
#endif
#define REP(k) for (int _rep = 0; _rep < 1 + (((REPEAT_MASK) >> (k)) & 1); ++_rep)
#ifndef PROBE_TS
#define PROBE_TS -1
#endif
#ifndef PROBE_TSB
#define PROBE_TSB (PROBE_TS + 1)
#endif
#define STAMP(i) do { if (PROBE_TS >= -1 && F.bid == 0 && F.tid == 0) ((unsigned long long*)(F.ctl + 65536))[i] = __builtin_amdgcn_s_memrealtime(); } while (0)
#define SEAM(k) do { if (IN(k) && IN((k) + 1)) xcd_barrier(bar); if (PROBE_TS >= 0) STAMP((k) + 1); } while (0)

#ifndef P0_SKIP
#define P0_SKIP 0
#endif
    if (IN(0)) { p0_prologue<0>(F); if ((REPEAT_MASK) & 1) { __syncthreads(); p0_prologue<P0_SKIP>(F); } } SEAM(0);
    if (IN(1)) REP(1) { __syncthreads(); p1_rows_filters(F); } SEAM(1);
    if (IN(2)) { phase_gemm2(F); if (((REPEAT_MASK) >> 2) & 1) { __syncthreads(); phase_gemm2(F); } } SEAM(2);
    if (IN(3)) {
#if SIMPLE_GEMM
        for (int i = F.bid * NTHR + F.tid; i < T * 24 * 16; i += F.G * NTHR) { const int k = i & 15, hd = (i >> 4) % 24, tok = (i >> 4) / 24;
            bf16* p = F.QKV + (size_t)tok * QKVW + hd * HD; const float a = bf2f(p[k]), b2 = bf2f(p[k + 16]), cs = F.ROT[tok * 32 + k], sn = F.ROT[tok * 32 + 16 + k];
            p[k] = (bf16)f2bf(a * cs - b2 * sn); p[k + 16] = (bf16)f2bf(b2 * cs + a * sn); }
#endif
    }
#if SIMPLE_GEMM
    SEAM(3);
#endif
#if HYENA_NAIVE
    if (IN(4)) { p3_hyena_naive(F); __syncthreads(); p3_attn_naive(F); } SEAM(4);
#elif ATTN_NAIVE
    if (IN(4)) { p3_hyena_mfma(F); __syncthreads(); p3_attn_naive(F); } SEAM(4);
#else
#ifndef P4_PARTS
#define P4_PARTS 3
#endif
    if (IN(4)) REP(4) { __syncthreads(); if (P4_PARTS & 1) p3_hyena_mfma(F); __syncthreads(); if (P4_PARTS & 2) p4_attn_mfma(F);
#if ATTN_REP
        __syncthreads(); p4_attn_mfma(F);
#endif
    } SEAM(4);
    if (IN(5)) REP(5) { p4b_combine(F); } SEAM(5);
#endif
    if (IN(6)) { phase_gemm6(F); if (((REPEAT_MASK) >> 6) & 1) { __syncthreads(); phase_gemm6(F); } } SEAM(6);
    if (IN(7)) { phase_gemm7(F); if (((REPEAT_MASK) >> 7) & 1) { __syncthreads(); phase_gemm7(F); } } SEAM(7);
#ifndef EXTRA_BARRIERS
#define EXTRA_BARRIERS 0
#endif
    if (IN(8)) { if (((REPEAT_MASK) >> 8) & 1) { p6_rows_router<true>(F); __syncthreads(); } for (int _e = 0; _e < EXTRA_BARRIERS; ++_e) xcd_barrier(bar); p6_rows_router<false>(F); } SEAM(8);
#if MOE_SIMT
    if (IN(9)) { p7_moe1(F); } SEAM(9);
    if (IN(10)) { p8_moe2(F); } SEAM(10);
#else
#ifndef MOE_SHADOW
#define MOE_SHADOW 0
#endif
    if (IN(9)) { if (MOE_SHADOW) { moe_mfma<0, (MOE_SHADOW ? MOE_SHADOW : 8)>(F); __syncthreads(); } } if (IN(9)) REP(9) { moe_mfma<0>(F); } SEAM(9);
    if (IN(10)) REP(10) { moe_mfma<1>(F); } SEAM(10);
#endif
    if (IN(11)) REP(11) { __syncthreads(); p9_final(F); }
#if PROBE_TS >= 0
    if (F.bid == 0 && F.tid == 0) { asm volatile("s_waitcnt vmcnt(0)" ::: "memory");
        const unsigned long long* ts = (const unsigned long long*)(F.ctl + 65536);
        const float us = (PROBE_TS == 99) ? 100.0f : (float)(ts[PROBE_TSB] - ts[PROBE_TS]) * 0.01f;
        F.out[0] += sqrtf(198.0f * us); }
#endif
#undef IN
#undef SEAM
}

extern "C" void kernel_launch(void* const* d_in, const int* in_sizes, int n_in, void* d_out, int out_size, void* d_ws, size_t ws_size, hipStream_t stream) {
    static int grid = 0;
    if (grid == 0) {
        if (n_in != 31 || out_size != T * D || ws_size < WS_END) { fprintf(stderr, "kernel_launch: unexpected shapes (n_in %d out %d ws %zu)\n", n_in, out_size, ws_size); grid = -1; return; }
        int dev = 0, cus = 0, per_cu = 0;
        if (hipGetDevice(&dev) != hipSuccess || hipDeviceGetAttribute(&cus, hipDeviceAttributeMultiprocessorCount, dev) != hipSuccess) { grid = -1; return; }
        if (hipFuncSetAttribute((const void*)fwd_kernel, hipFuncAttributeMaxDynamicSharedMemorySize, LDS_BYTES) != hipSuccess) { fprintf(stderr, "kernel_launch: hipFuncSetAttribute failed\n"); grid = -1; return; }
        if (hipOccupancyMaxActiveBlocksPerMultiprocessor(&per_cu, (const void*)fwd_kernel, NTHR, LDS_BYTES) != hipSuccess || per_cu < 1) fprintf(stderr, "kernel_launch: occupancy query says %d\n", per_cu);
        (void)hipGetLastError();
        grid = cus;
    }
    if (grid < 0) return;
    if (hipMemsetAsync((char*)d_ws + WS_CTL, 0, CTL_ZERO_BYTES, stream) != hipSuccess) return;
    Args a{};
    for (int i = 0; i < 31; ++i) a.in[i] = d_in[i];
    a.out = (float*)d_out; a.ws = (unsigned char*)d_ws;
#if N_LAUNCH_MODE == 1
    a.ph_lo = 0; a.ph_hi = NPHASE;
    hipLaunchKernelGGL(fwd_kernel, dim3(grid), dim3(NTHR), LDS_BYTES, stream, a);
#else
    for (int p = 0; p < NPHASE; ++p) { if (p == 3 && !SIMPLE_GEMM) continue; if (p == 5 && (HYENA_NAIVE || ATTN_NAIVE)) continue; a.ph_lo = p; a.ph_hi = p + 1; hipLaunchKernelGGL(fwd_kernel, dim3(grid), dim3(NTHR), LDS_BYTES, stream, a); }
#endif
}
```

```cpp
#include <hip/hip_runtime.h>
#include <cstdio>
#include <cstdint>
namespace pg8 {
#define PG8_LAS __attribute__((address_space(3)))
typedef unsigned short bf16_t;
typedef short bf16x8 __attribute__((ext_vector_type(8)));
typedef float f32x4 __attribute__((ext_vector_type(4)));
typedef unsigned u32x4 __attribute__((ext_vector_type(4)));
constexpr int BM = 256, BK = 64, HALF = 128, HTB = HALF * BK * 2  , STAGE_BYTES = 8 * HTB, NXCD = 8, WGM = 8;

__host__ __device__ __forceinline__ int lds_byte(int r, int c) { const int st = (r >> 4) * 2 + (c >> 5), rr = r & 15, cc = c & 31, ob = rr * 64 + cc * 2; return st * 1024 + (ob ^ (((ob >> 9) & 1) << 5)); }
__host__ __device__ __forceinline__ void stage_rc(int b, int& R, int& C) { const int st = b / 1024, sb = b % 1024, swz = sb ^ (((sb >> 9) & 1) << 5); R = (st >> 1) * 16 + swz / 64; C = (st & 1) * 32 + (swz % 64) / 2; }
__host__ __device__ __forceinline__ int perm32(int rho) { const int n = rho >> 4, i = rho & 15; return 8 * (i >> 2) + 4 * n + (i & 3); }

struct Unit { int pm, pn, kind; };
struct Gemm { const bf16_t* A; const bf16_t* Bt; int M, N, K; };

struct StaticOrder {
    int nM, nN, nwg, G, c;
    __host__ __device__ void init(int M, int N, int G_, int c_) { nM = M / BM; nN = N / BM; nwg = nM * nN; G = G_; c = c_; }
    __host__ __device__ bool next(int i, Unit& u) const {
        const long L = (long)i * G + c; if (L >= nwg) return false;
        int wgid = (int)L; { const int q = nwg / NXCD, r = nwg % NXCD, xcd = wgid % NXCD, off = wgid / NXCD; wgid = (xcd < r ? xcd * (q + 1) : r * (q + 1) + (xcd - r) * q) + off; }
        const int nig = WGM * nN, gid = wgid / nig, fm = gid * WGM, gsz = (nM - fm) < WGM ? (nM - fm) : WGM;
        u.pm = fm + ((wgid % nig) % gsz); u.pn = (wgid % nig) / gsz; u.kind = 0; return true;
    }
    __device__ __forceinline__ void a_ready(const Unit&) const {}
    __device__ __forceinline__ void done(const Unit&) const {}
    __device__ __forceinline__ const bf16_t* abase(const Gemm& g, const Unit&) const { return g.A; }
    __device__ __forceinline__ const bf16_t* bbase(const Gemm& g, const Unit&) const { return g.Bt; }
};

__device__ __forceinline__ unsigned cvt_pk_bf16(float lo, float hi) { unsigned r; asm volatile("v_cvt_pk_bf16_f32 %0, %1, %2" : "=v"(r) : "v"(lo), "v"(hi)); return r; }
typedef float f32x2 __attribute__((ext_vector_type(2)));
template <class Epi, class Sched, bool ALIGN_EPI = false, bool SP2 = false>
__device__ __forceinline__ void gemm_phase(PG8_LAS unsigned char* lds, const Gemm g, const Sched& S, const Epi& E) {
    const int tid = threadIdx.x, wid = __builtin_amdgcn_readfirstlane(tid >> 6), lane = tid & 63, wr = wid >> 2, wc = wid & 3, fr = lane & 15, fq = lane >> 4;
    const int K = g.K, nt = K / BK;
    unsigned voffA[2], voffB[2];
#pragma unroll
    for (int i = 0; i < 2; ++i) { int R, C; stage_rc(tid * 16 + i * 8192, R, C); const int Rb = Epi::PERM ? ((R & ~31) + perm32(R & 31)) : R;
        voffA[i] = (unsigned)(R * K + C) * 2u; voffB[i] = (unsigned)(Rb * K + C) * 2u; }
    const size_t kstep = (size_t)(BK * 2);
    const size_t hstep = (size_t)HALF * K * 2;
    const size_t tstep = 2 * hstep;
    const unsigned ldsw = (unsigned)wid * 1024u;
    const int aoff = lds_byte(wr * 64 + fr, fq * 8), boff = lds_byte(wc * 32 + fr, fq * 8);
#define PG8_SA(b, h) (((b) * 2 + (h)) * HTB)
#define PG8_SB(b, h) ((4 + (b) * 2 + (h)) * HTB)
#define PG8_STAGE(bufoff, gbase, voff) do { _Pragma("unroll") for (int _i = 0; _i < 2; ++_i) \
        __builtin_amdgcn_global_load_lds((const unsigned*)((const char*)(gbase) + (voff)[_i]), (PG8_LAS unsigned*)(lds + (bufoff) + ldsw + _i * 8192), 16, 0, 0); } while (0)
#define PG8_LDA(dst, b, h) do { _Pragma("unroll") for (int m = 0; m < 4; ++m) _Pragma("unroll") for (int k = 0; k < 2; ++k) dst[m][k] = *(const PG8_LAS bf16x8*)(lds + PG8_SA(b, h) + aoff + m * 2048 + k * 1024); } while (0)
#define PG8_LDB(dst, b, h) do { _Pragma("unroll") for (int n = 0; n < 2; ++n) _Pragma("unroll") for (int k = 0; k < 2; ++k) dst[n][k] = *(const PG8_LAS bf16x8*)(lds + PG8_SB(b, h) + boff + n * 2048 + k * 1024); } while (0)
#define PG8_MMA(ai, bj, At, Bt) do { __builtin_amdgcn_s_setprio(1); _Pragma("unroll") for (int m = 0; m < 4; ++m) _Pragma("unroll") for (int n = 0; n < 2; ++n) _Pragma("unroll") for (int k = 0; k < 2; ++k) \
        acc[ai][bj][m][n] = __builtin_amdgcn_mfma_f32_16x16x32_bf16(Bt[n][k], At[m][k], acc[ai][bj][m][n], 0, 0, 0); __builtin_amdgcn_s_setprio(0); } while (0)
#define PG8_WAIT_V(n) asm volatile("s_waitcnt vmcnt(" #n ")" ::: "memory")
#define PG8_WAIT_L(n) asm volatile("s_waitcnt lgkmcnt(" #n ")" ::: "memory")
#define PG8_BAR __builtin_amdgcn_s_barrier()
#define PG8_SCHED __builtin_amdgcn_sched_barrier(0)
    Unit cur, nxt; int ui = 0;
    if (!S.next(0, cur)) return;
    f32x4 acc[2][2][4][2];
#pragma unroll
    for (int a = 0; a < 2; ++a)
#pragma unroll
        for (int b = 0; b < 2; ++b)
#pragma unroll
            for (int m = 0; m < 4; ++m)
#pragma unroll
                for (int n = 0; n < 2; ++n) acc[a][b][m][n] = (f32x4){0.f, 0.f, 0.f, 0.f};
    bf16x8 At[4][2], B0[2][2], B1[2][2];
    const char* cA = (const char*)S.abase(g, cur) + (size_t)cur.pm * tstep; const char* cB = (const char*)S.bbase(g, cur) + (size_t)cur.pn * tstep;
    S.a_ready(cur);
    if constexpr (SP2) {
        PG8_STAGE(PG8_SB(0, 0), cB, voffB); PG8_STAGE(PG8_SB(0, 1), cB + hstep, voffB); PG8_STAGE(PG8_SA(0, 0), cA, voffA); PG8_STAGE(PG8_SA(0, 1), cA + hstep, voffA);
        if (wr == 1) PG8_BAR;
        PG8_WAIT_V(2); PG8_BAR;
        PG8_STAGE(PG8_SB(1, 0), cB + kstep, voffB); PG8_STAGE(PG8_SA(1, 0), cA + kstep, voffA); PG8_STAGE(PG8_SB(1, 1), cB + hstep + kstep, voffB);
        PG8_WAIT_V(6); PG8_BAR;
    } else {
        PG8_STAGE(PG8_SB(0, 0), cB, voffB); PG8_STAGE(PG8_SA(0, 0), cA, voffA); PG8_STAGE(PG8_SB(0, 1), cB + hstep, voffB); PG8_STAGE(PG8_SA(0, 1), cA + hstep, voffA);
        if (wr == 1) PG8_BAR;
        PG8_WAIT_V(4); PG8_BAR;
        PG8_STAGE(PG8_SB(1, 0), cB + kstep, voffB); PG8_STAGE(PG8_SA(1, 0), cA + kstep, voffA); PG8_STAGE(PG8_SB(1, 1), cB + hstep + kstep, voffB);
        PG8_WAIT_V(6); PG8_BAR;
    }
    for (;;) {
        const bool has_next = S.next(ui + 1, nxt);
        const char* nA = has_next ? (const char*)S.abase(g, nxt) + (size_t)nxt.pm * tstep : cA; const char* nB = has_next ? (const char*)S.bbase(g, nxt) + (size_t)nxt.pn * tstep : cB;
        asm volatile(".p2align 8" ::: "memory");
        for (int t = 0; t < nt; t += 2) {
            const bool last = (t == nt - 2);
            const char* a1 = cA + (size_t)(t + 1) * kstep;
            const char* a2 = last ? nA : cA + (size_t)(t + 2) * kstep; const char* b2 = last ? nB : cB + (size_t)(t + 2) * kstep;
            const char* a3 = a2 + kstep; const char* b3 = b2 + kstep;
            if (last && has_next) S.a_ready(nxt);
            if constexpr (SP2) {
            PG8_LDB(B0, 0, 0); PG8_LDB(B1, 0, 1); PG8_SCHED; PG8_LDA(At, 0, 0); PG8_STAGE(PG8_SA(1, 1), a1 + hstep, voffA);
            PG8_WAIT_V(8); PG8_WAIT_L(0); PG8_BAR; PG8_MMA(0, 0, At, B0); PG8_MMA(0, 1, At, B1); PG8_BAR; PG8_SCHED;
            PG8_LDA(At, 0, 1); PG8_STAGE(PG8_SB(0, 0), b2, voffB); PG8_STAGE(PG8_SB(0, 1), b2 + hstep, voffB); PG8_STAGE(PG8_SA(0, 0), a2, voffA);
            PG8_WAIT_V(8); PG8_WAIT_L(0); PG8_BAR; PG8_MMA(1, 0, At, B0); PG8_MMA(1, 1, At, B1); PG8_BAR; PG8_SCHED;
            PG8_LDB(B0, 1, 0); PG8_LDB(B1, 1, 1); PG8_SCHED; PG8_LDA(At, 1, 0); PG8_STAGE(PG8_SA(0, 1), a2 + hstep, voffA);
            PG8_WAIT_V(8); PG8_WAIT_L(0); PG8_BAR; PG8_MMA(0, 0, At, B0); PG8_MMA(0, 1, At, B1); PG8_BAR; PG8_SCHED;
            PG8_LDA(At, 1, 1); PG8_STAGE(PG8_SB(1, 0), b3, voffB); PG8_STAGE(PG8_SB(1, 1), b3 + hstep, voffB); PG8_STAGE(PG8_SA(1, 0), a3, voffA);
            PG8_WAIT_V(8); PG8_WAIT_L(0); PG8_BAR; PG8_MMA(1, 0, At, B0); PG8_MMA(1, 1, At, B1); PG8_BAR; PG8_SCHED;
            } else {
            PG8_LDB(B0, 0, 0); PG8_SCHED; PG8_LDA(At, 0, 0); PG8_STAGE(PG8_SA(1, 1), a1 + hstep, voffA);
            PG8_WAIT_L(8); PG8_BAR; PG8_WAIT_L(0); PG8_MMA(0, 0, At, B0); PG8_BAR; PG8_SCHED;
            PG8_LDB(B1, 0, 1); PG8_STAGE(PG8_SB(0, 0), b2, voffB);
            PG8_BAR; PG8_WAIT_L(0); PG8_MMA(0, 1, At, B1); PG8_BAR;
            PG8_LDA(At, 0, 1); PG8_STAGE(PG8_SA(0, 0), a2, voffA);
            PG8_BAR; PG8_WAIT_L(0); PG8_MMA(1, 0, At, B0); PG8_BAR; PG8_SCHED;
            PG8_STAGE(PG8_SB(0, 1), b2 + hstep, voffB);
            PG8_WAIT_V(6); PG8_BAR; PG8_MMA(1, 1, At, B1); PG8_BAR;
            PG8_LDB(B0, 1, 0); PG8_SCHED; PG8_LDA(At, 1, 0); PG8_STAGE(PG8_SA(0, 1), a2 + hstep, voffA);
            PG8_WAIT_L(8); PG8_BAR; PG8_WAIT_L(0); PG8_MMA(0, 0, At, B0); PG8_BAR; PG8_SCHED;
            PG8_LDB(B1, 1, 1); PG8_STAGE(PG8_SB(1, 0), b3, voffB);
            PG8_BAR; PG8_WAIT_L(0); PG8_MMA(0, 1, At, B1); PG8_BAR;
            PG8_LDA(At, 1, 1); PG8_STAGE(PG8_SA(1, 0), a3, voffA);
            PG8_BAR; PG8_WAIT_L(0); PG8_MMA(1, 0, At, B0); PG8_BAR; PG8_SCHED;
            PG8_STAGE(PG8_SB(1, 1), b3 + hstep, voffB);
            PG8_WAIT_V(6); PG8_BAR; PG8_MMA(1, 1, At, B1); PG8_BAR;
            }
        }
        if constexpr (ALIGN_EPI) { if (wr == 0) PG8_BAR; }
        if constexpr (!Epi::AFTER_DRAIN) { E(acc, cur, wr, wc, fr, fq); S.done(cur); }
        if (!has_next) break;
#pragma unroll
        for (int a = 0; a < 2; ++a)
#pragma unroll
            for (int b = 0; b < 2; ++b)
#pragma unroll
                for (int m = 0; m < 4; ++m)
#pragma unroll
                    for (int n = 0; n < 2; ++n) acc[a][b][m][n] = (f32x4){0.f, 0.f, 0.f, 0.f};
        cur = nxt; cA = nA; cB = nB; ++ui;
        if constexpr (ALIGN_EPI) { if (wr == 1) PG8_BAR; }
    }
    PG8_WAIT_V(0);
    if constexpr (!ALIGN_EPI) { if (wr == 0) PG8_BAR; }
    PG8_BAR;
    if constexpr (Epi::AFTER_DRAIN) { E.fused(acc, cur, wr, wc, fr, fq, lds, wid, lane); S.done(cur); }
#undef PG8_SA
#undef PG8_SB
#undef PG8_STAGE
#undef PG8_LDA
#undef PG8_LDB
#undef PG8_MMA
#undef PG8_WAIT_V
#undef PG8_WAIT_L
#undef PG8_BAR
#undef PG8_SCHED
}
}


#ifndef N_LAUNCH_MODE
#define N_LAUNCH_MODE 1
#endif
#ifndef MOE_SIMT
#define MOE_SIMT 0
#endif
#ifndef HYENA_NAIVE
#define HYENA_NAIVE 0
#endif
#ifndef ATTN_NAIVE
#define ATTN_NAIVE 0
#endif
#ifndef TLB_TOUCH
#define TLB_TOUCH 0
#endif
#ifndef DUAL_BIG_FIRST
#define DUAL_BIG_FIRST 1
#endif
#ifndef MOE_S
#define MOE_S 4
#endif
#ifndef HY_REP
#define HY_REP 0
#endif
#ifndef ATTN_REP
#define ATTN_REP 0
#endif
#ifndef SIMPLE_GEMM
#define SIMPLE_GEMM 0
#endif

constexpr int D = 2048, BATCH = 2, SEQ = 4096, T = BATCH * SEQ;
constexpr int HW = 1024;
constexpr int NH = 12, HD = 128, QKVW = 3 * NH * HD;
constexpr int INW = 3 * HW + QKVW;
constexpr int N1 = INW + 2 * D;
constexpr int NE = 64, FF = 512;
constexpr float RMS_EPS = 1e-6f;
constexpr int NWAVES = 8, NTHR = 512;
constexpr int NPHASE = 12;

constexpr size_t MiB = 1u << 20;
constexpr size_t WS_CTL = 0, CTL_ZERO_BYTES = 128 * 1024;
constexpr size_t WS_MODP = 1 * MiB;
constexpr size_t WS_HID2 = 2 * MiB;
constexpr size_t WS_ROT = 3 * MiB;
constexpr size_t WS_W3T = 4 * MiB;
constexpr size_t WS_ROUTE = 5 * MiB;
constexpr size_t WS_LISTT = 6 * MiB;
constexpr size_t WS_LISTG = 8 * MiB;
constexpr size_t WS_WGT = 10 * MiB;
constexpr size_t WS_WET = 11 * MiB;
constexpr size_t WS_HID2B = 12 * MiB;
constexpr size_t WS_W3TB = 13 * MiB;
constexpr size_t WS_W1T = 16 * MiB;
constexpr size_t WS_WHYOT = 64 * MiB;
constexpr size_t WS_WATOT = 68 * MiB;
constexpr size_t WS_WOUTT = 70 * MiB;
constexpr size_t WS_KF = 80 * MiB;
constexpr size_t WS_H = 144 * MiB;
constexpr size_t WS_PHY = 176 * MiB;
constexpr size_t WS_QKV = 224 * MiB;
constexpr size_t WS_G = 296 * MiB;
constexpr size_t WS_YHY = 360 * MiB;
constexpr size_t WS_YAT = 376 * MiB;
constexpr size_t WS_TMP = 384 * MiB;
constexpr size_t WS_MERGED = 448 * MiB;
constexpr size_t WS_Y = 480 * MiB;
constexpr size_t WS_X1 = 544 * MiB;
constexpr size_t WS_H2 = 608 * MiB;
constexpr size_t WS_ACT = 640 * MiB;
constexpr size_t WS_YB = 672 * MiB;
constexpr size_t WS_END = 800 * MiB;
constexpr int CW_BAR = 4096;
constexpr int CW_CNT = 16384, CNT_STRIDE = 64;

constexpr int RING_BYTES = 131072;
constexpr int LDS_BYTES = 163840;
constexpr int MISC_OFF = LDS_BYTES - 256;
constexpr int MOE_OFFS_OFF = LDS_BYTES - 1024;

#define GAS __attribute__((address_space(1)))
#define LAS __attribute__((address_space(3)))
typedef unsigned short bf16;
typedef unsigned v4u __attribute__((ext_vector_type(4)));
typedef unsigned v2u __attribute__((ext_vector_type(2)));
typedef float f32x4 __attribute__((ext_vector_type(4)));
typedef LAS float lfloat;

__device__ __forceinline__ unsigned f2bf(float f) { unsigned u = __builtin_bit_cast(unsigned, f); return (u + 0x7fffu + ((u >> 16) & 1u)) >> 16; }
__device__ __forceinline__ unsigned pk2(float lo, float hi) { return f2bf(lo) | (f2bf(hi) << 16); }
__device__ __forceinline__ float bf2f(unsigned short b) { return __builtin_bit_cast(float, ((unsigned)b) << 16); }
__device__ __forceinline__ float bflo(unsigned w) { return __builtin_bit_cast(float, w << 16); }
__device__ __forceinline__ float bfhi(unsigned w) { return __builtin_bit_cast(float, w & 0xffff0000u); }

#define XB_TMO      128
#define XB_XCNT(j)  (256  + 64 * (j))
#define XB_XSUB(j)  (1280 + 64 * (j))
#define XB_XGEN(j)  (2304 + 64 * (j))
#define XB_TOP      3328
#define XB_TOPGEN   3392
#define XCD_BAR_WORDS 3456
#define XB_SPIN_CAP (1u << 18)
__device__ __forceinline__ unsigned xb_ld(unsigned* p)              { return __hip_atomic_load(p, __ATOMIC_RELAXED, __HIP_MEMORY_SCOPE_AGENT); }
__device__ __forceinline__ unsigned xb_add(unsigned* p, unsigned v) { return __hip_atomic_fetch_add(p, v, __ATOMIC_RELAXED, __HIP_MEMORY_SCOPE_AGENT); }
__device__ __forceinline__ unsigned xb_xcc_id() { return (unsigned)__builtin_amdgcn_s_getreg((3 << 11) | 20) & 0xFu; }
#define XB_SPIN(cond, bar) do { unsigned _sp = 0; while (cond) { __builtin_amdgcn_s_sleep(1); \
    if ((++_sp & 255u) == 0u) { if (xb_ld(&(bar)[XB_TMO])) break; if (_sp > XB_SPIN_CAP) { atomicAdd(&(bar)[XB_TMO], 1u); break; } } } } while (0)
struct XcdBarrier { unsigned* bar; unsigned x; volatile LAS unsigned* st; };
__device__ __forceinline__ XcdBarrier xcd_barrier_post(unsigned* bar, volatile LAS unsigned* st) {
    XcdBarrier b; b.bar = bar; b.x = xb_xcc_id(); b.st = st;
    if (threadIdx.x == 0) (void)xb_add(&bar[XB_XCNT(b.x)], 1u);
    return b;
}
__device__ __forceinline__ void xcd_barrier_complete(unsigned* bar, unsigned x, unsigned& nloc, unsigned& nx) {
    const unsigned G = gridDim.x * gridDim.y * gridDim.z;
    unsigned sum, cnt, mine, sp = 0u;
    for (;;) {
        sum = 0u; cnt = 0u; mine = 0u;
#pragma unroll
        for (unsigned j = 0; j < 16; ++j) { const unsigned c = xb_ld(&bar[XB_XCNT(j)]); sum += c; cnt += (c > 0u) ? 1u : 0u; mine = (j == x) ? c : mine; }
        if (sum == G) break;
        __builtin_amdgcn_s_sleep(1);
        if ((++sp & 255u) == 0u) { if (xb_ld(&bar[XB_TMO])) break; if (sp > XB_SPIN_CAP) { atomicAdd(&bar[XB_TMO], 1u); break; } }
    }
    nloc = mine > 0u ? mine : 1u; nx = cnt > 0u ? cnt : 1u;
}
__device__ __forceinline__ void xcd_barrier(const XcdBarrier& b) {
    asm volatile("s_waitcnt vmcnt(0)" ::: "memory");
    __syncthreads();
    if (threadIdx.x == 0) {
        unsigned* bar = b.bar;
        __builtin_amdgcn_s_waitcnt(0);
        unsigned nloc = b.st[0], nx = b.st[1];
        if (nloc == 0u) { xcd_barrier_complete(bar, b.x, nloc, nx); b.st[0] = nloc; b.st[1] = nx; }
        const unsigned old = xb_add(&bar[XB_XSUB(b.x)], 1u);
        const unsigned gen = old / nloc;
        if (old + 1u == (gen + 1u) * nloc) {
            __builtin_amdgcn_fence(__ATOMIC_RELEASE, "agent");
            asm volatile("s_waitcnt vmcnt(0)" ::: "memory");
            const unsigned og = xb_add(&bar[XB_TOP], 1u);
            const unsigned tg = og / nx;
            if (og + 1u == (tg + 1u) * nx) xb_add(&bar[XB_TOPGEN], 1u);
            else XB_SPIN(xb_ld(&bar[XB_TOPGEN]) == tg, bar);
            __builtin_amdgcn_fence(__ATOMIC_ACQUIRE, "agent");
            xb_add(&bar[XB_XGEN(b.x)], 1u);
            asm volatile("s_waitcnt vmcnt(0)" ::: "memory");
        } else {
            XB_SPIN(xb_ld(&bar[XB_XGEN(b.x)]) == gen, bar);
            __builtin_amdgcn_fence(__ATOMIC_ACQUIRE, "agent");
            asm volatile("s_waitcnt vmcnt(0)" ::: "memory");
        }
    }
    __syncthreads();
}

struct Args { const void* in[31]; float* out; unsigned char* ws; int ph_lo, ph_hi; };
struct Frame {
    LAS unsigned char* lds;
    int tid, lane, wave, G, bid;
    const float *x, *c, *w_ada, *b_ada, *g_mix_pre, *g_mix_post, *g_ffn_pre, *g_ffn_post, *w_in, *conv_w, *conv_b, *fw1, *fb1, *fw2, *fb2, *fw3, *ffreq, *hskip,
        *w_bg, *b_bg, *w_hy_o, *w_at_o, *w_out, *w_group, *b_group, *w_expert, *b_expert, *w1e, *w3e, *w2e;
    const int* positions;
    float* out;
    unsigned* ctl; float *MODP, *HID2, *ROT, *W3T, *TMP, *Y, *X1, *ACT, *YB, *LISTG, *WGT, *WET; bf16 *KF, *HID2B, *W3TB;
    unsigned* ROUTE; int* LISTT;
    bf16 *W1T, *WHYOT, *WATOT, *WOUTT, *H, *PHY, *QKV, *GT, *YHY, *YAT, *MERGED, *H2, *ACTB, *YBB;
};

__device__ __forceinline__ float wave_sum(float v) {
#pragma unroll
    for (int o = 1; o < 64; o <<= 1) v += __shfl_xor(v, o);
    return v;
}
__device__ __forceinline__ float wave_max(float v) {
#pragma unroll
    for (int o = 1; o < 64; o <<= 1) v = fmaxf(v, __shfl_xor(v, o));
    return v;
}

struct TrItem { const float* W; bf16* WT; int K, N, row_off, k0, n0; };
__device__ __forceinline__ void tr_load(const TrItem& q, int lane, f32x4 (&t4)[8]) {
#pragma unroll
    for (int i = 0; i < 8; ++i) t4[i] = *(const f32x4*)(q.W + (size_t)(q.k0 + 8 * i + (lane >> 3)) * q.N + q.n0 + 4 * (lane & 7));
}
__device__ __forceinline__ void tr_store(const TrItem& q, int lane, const f32x4 (&t4)[8], LAS float* scr) {
#pragma unroll
    for (int i = 0; i < 8; ++i) { LAS float* d = scr + (8 * i + (lane >> 3)) * 33 + 4 * (lane & 7); d[0] = t4[i].x; d[1] = t4[i].y; d[2] = t4[i].z; d[3] = t4[i].w; }
    asm volatile("s_waitcnt lgkmcnt(0)" ::: "memory");
    const int c = lane & 7;
#pragma unroll
    for (int j = 0; j < 4; ++j) { const int n = (lane >> 3) + 8 * j; const LAS float* s = scr + (8 * c) * 33 + n;
        v4u o; o.x = pk2(s[0 * 33], s[1 * 33]); o.y = pk2(s[2 * 33], s[3 * 33]); o.z = pk2(s[4 * 33], s[5 * 33]); o.w = pk2(s[6 * 33], s[7 * 33]);
        *(v4u*)(q.WT + (size_t)(q.row_off + q.n0 + n) * q.K + q.k0 + 8 * c) = o; }
    asm volatile("s_waitcnt lgkmcnt(0)" ::: "memory");
}

__device__ __forceinline__ f32x4 mod_sum4(Frame& F, int b, int col) {
    f32x4 s = *(const f32x4*)(F.b_ada + col);
#pragma unroll
    for (int ks = 0; ks < 8; ++ks) s += *(const f32x4*)(F.MODP + (size_t)(ks * 2 + b) * (6 * D) + col);
    return s;
}
__device__ __forceinline__ void load_mod(Frame& F, LAS float* dst, int which) {
#pragma unroll 2
    for (int i = F.tid; i < 2 * D / 4; i += NTHR) { const int b = i / (D / 4), d4 = i % (D / 4); *(LAS f32x4*)(dst + 4 * i) = mod_sum4(F, b, which * D + 4 * d4); }
}
__device__ __forceinline__ void load_mod1(Frame& F, LAS float* dst, int which, int b) {
    *(LAS f32x4*)(dst + 4 * F.tid) = mod_sum4(F, b, which * D + 4 * F.tid);
}

template <int SKIP = 0> __device__ __forceinline__ void p0_prologue(Frame& F) {
    LAS float* L = (LAS float*)F.lds;
    if (!(SKIP & 1))
    {
        typedef float f32x2 __attribute__((ext_vector_type(2)));
        LAS float* sc = L;
        LAS float* red = L + 512;
        for (int u = F.bid; u < 96 * 8; u += F.G) {
            const int chunk = u % 96, ks = u / 96;
            __syncthreads();
            { const int b = F.tid >> 8, i = F.tid & 255; const float cv = F.c[b * D + ks * 256 + i]; sc[b * 256 + i] = cv / (1.f + __expf(-cv)); }
            __syncthreads();
            f32x2 a0 = {0.f, 0.f}, a1 = {0.f, 0.f};
            const float* wp = F.w_ada + (size_t)(ks * 256 + F.wave * 32) * (6 * D) + chunk * 128 + F.lane * 2;
#pragma unroll
            for (int r = 0; r < 32; ++r) { const f32x2 w = *(const f32x2*)(wp + (size_t)r * (6 * D)); const float s0 = sc[F.wave * 32 + r], s1 = sc[256 + F.wave * 32 + r]; a0 += w * s0; a1 += w * s1; }
            *(LAS f32x2*)(red + (F.wave * 2 + 0) * 128 + F.lane * 2) = a0;
            *(LAS f32x2*)(red + (F.wave * 2 + 1) * 128 + F.lane * 2) = a1;
            __syncthreads();
            if (F.tid < 256) { const int b = F.tid >> 7, col = F.tid & 127; float s = 0.f;
#pragma unroll
              for (int w = 0; w < 8; ++w) s += red[(w * 2 + b) * 128 + col];
              F.MODP[(size_t)(ks * 2 + b) * (6 * D) + chunk * 128 + col] = s; }
        }
        __syncthreads();
    }
    const int gw = F.bid * NWAVES + F.wave, NGW = F.G * NWAVES;
    if (!(SKIP & 2)) {
        LAS float* scr = (LAS float*)(F.lds + F.wave * 16384);
        constexpr int I_IN = (D / 64) * (INW / 32), I_BG = (D / 64) * (2 * D / 32), I_HY = (HW / 64) * (D / 32), I_AT = (512 / 64) * (D / 32), I_OUT = (D / 64) * (D / 32);
        constexpr int NITEMS = I_IN + I_BG + I_HY + I_AT + I_OUT;
        auto resolve = [&](int it) -> TrItem { TrItem q; int r = it;
            if (r < I_IN) { q.W = F.w_in; q.K = D; q.N = INW; q.WT = F.W1T; q.row_off = 0; }
            else if ((r -= I_IN) < I_BG) { q.W = F.w_bg; q.K = D; q.N = 2 * D; q.WT = F.W1T; q.row_off = INW; }
            else if ((r -= I_BG) < I_HY) { q.W = F.w_hy_o; q.K = HW; q.N = D; q.WT = F.WHYOT; q.row_off = 0; }
            else if ((r -= I_HY) < I_AT) { q.W = F.w_at_o; q.K = 512; q.N = D; q.WT = F.WATOT; q.row_off = 0; }
            else { r -= I_AT; q.W = F.w_out; q.K = D; q.N = D; q.WT = F.WOUTT; q.row_off = 0; }
            const int nblk = q.N / 32; q.k0 = 64 * (r / nblk); q.n0 = 32 * (r % nblk); return q; };
        f32x4 ta[8], tb[8]; TrItem qa, qb;
        int it = gw;
        if (it < NITEMS) { qa = resolve(it); tr_load(qa, F.lane, ta); }
        while (it < NITEMS) {
            const int i1 = it + NGW; const bool h1 = i1 < NITEMS;
            if (h1) { qb = resolve(i1); tr_load(qb, F.lane, tb); }
            tr_store(qa, F.lane, ta, scr);
            if (!h1) break;
            const int i2 = i1 + NGW; const bool h2 = i2 < NITEMS;
            if (h2) { qa = resolve(i2); tr_load(qa, F.lane, ta); }
            tr_store(qb, F.lane, tb, scr);
            if (!h2) break;
            it = i2;
        }
    }
    if (!(SKIP & 4)) {
    for (int i = F.bid * NTHR + F.tid; i < 64 * 4096; i += F.G * NTHR) { const int n = i >> 6, j = i & 63; F.W3TB[i] = (bf16)f2bf(F.fw3[j * 4096 + n]); }
    for (int i = F.bid * NTHR + F.tid; i < 8 * D; i += F.G * NTHR) { const int n = i / D, d = i % D; F.WGT[i] = F.w_group[d * 8 + n]; }
    for (int i = F.bid * NTHR + F.tid; i < 64 * D; i += F.G * NTHR) { const int ge = i / D, d = i % D, g = ge >> 3, e = ge & 7; F.WET[i] = F.w_expert[((size_t)g * D + d) * 8 + e]; }
    }
    if (!(SKIP & 8)) {
        LAS float* w1s = (LAS float*)(F.lds + 131072);
        LAS float* w2s = w1s + 33 * 64;
        __syncthreads();
        for (int i = F.tid; i < 33 * 64; i += NTHR) w1s[i] = F.fw1[i];
        for (int i = F.tid; i < 64 * 64; i += NTHR) w2s[i] = F.fw2[i];
        __syncthreads();
        const int j = F.lane; const float fr = F.ffreq[j], bb1 = F.fb1[j], bb2 = F.fb2[j];
        for (int t = gw; t < SEQ; t += NGW) {
            const float tn = (float)t * (1.0f / (float)(SEQ - 1));
            const float w = 6.283185307179586f * (float)t / (float)SEQ;
            float feat = 0.f;
            if (j == 0) feat = tn;
            else if (j <= 16) { const float band = 1e-4f + (float)(j - 1) * ((15.0f - 1e-4f) / 15.0f); feat = cosf(band * w); }
            else if (j <= 32) { const float band = 1e-4f + (float)(j - 17) * ((15.0f - 1e-4f) / 15.0f); feat = -sinf(band * w); }
            float a = bb1;
#pragma unroll
            for (int i = 0; i < 33; ++i) a += __shfl(feat, i) * w1s[i * 64 + j];
            const float h1 = sinf(fr * a);
            float a2 = bb2;
#pragma unroll
            for (int i = 0; i < 64; ++i) a2 += __shfl(h1, i) * w2s[i * 64 + j];
            { const float hv = sinf(fr * a2); F.HID2[t * 64 + j] = hv; F.HID2B[t * 64 + j] = (bf16)f2bf(hv); }
        }
    }
    if (!(SKIP & 16))
    for (int i = F.bid * NTHR + F.tid; i < T * 16; i += F.G * NTHR) {
        const int tok = i >> 4, k = i & 15;
        const float inv = powf(500000.0f, -(float)k * (1.0f / 16.0f));
        const float ang = (float)F.positions[tok] * inv;
        F.ROT[tok * 32 + k] = cosf(ang); F.ROT[tok * 32 + 16 + k] = sinf(ang);
    }
}

__device__ __forceinline__ void p1_rows_filters(Frame& F) {
    LAS float* L = (LAS float*)F.lds;
    LAS float* shiftv = L;
    LAS float* scalev = L + 2 * D;
    load_mod(F, shiftv, 0); load_mod(F, scalev, 1);
    LAS float* gpre = L + 4 * D;
    *(LAS f32x4*)(gpre + 4 * F.tid) = *(const f32x4*)(F.g_mix_pre + 4 * F.tid);
    __syncthreads();
    const int gw = F.bid * NWAVES + F.wave, NGW = F.G * NWAVES;
    for (int m0 = gw; m0 < T; m0 += 4 * NGW) {
        f32x4 v[4][8];
#pragma unroll
        for (int r = 0; r < 4; ++r) { const int m = m0 + r * NGW; if (m < T) { const f32x4* xr = (const f32x4*)(F.x + (size_t)m * D) + F.lane;
#pragma unroll
            for (int j = 0; j < 8; ++j) v[r][j] = xr[64 * j]; } }
#pragma unroll
        for (int r = 0; r < 4; ++r) { const int m = m0 + r * NGW; if (m < T) { const int b = m / SEQ; float s = 0.f;
#pragma unroll
            for (int j = 0; j < 8; ++j) s += (v[r][j].x * v[r][j].x + v[r][j].y * v[r][j].y) + (v[r][j].z * v[r][j].z + v[r][j].w * v[r][j].w);
            const float rstd = 1.0f / sqrtf(wave_sum(s) * (1.f / D) + RMS_EPS);
            v2u* o8 = (v2u*)(F.H + (size_t)m * D) + F.lane;
#pragma unroll
            for (int j = 0; j < 8; ++j) { const int d = 256 * j + 4 * F.lane;
                const f32x4 g = *(LAS f32x4*)(gpre + d); const f32x4 sc = *(LAS f32x4*)(scalev + b * D + d), sh = *(LAS f32x4*)(shiftv + b * D + d);
                f32x4 h; h = (v[r][j] * rstd) * g; h = h * (sc + 1.0f) + sh;
                v2u w; w.x = pk2(h.x, h.y); w.y = pk2(h.z, h.w); o8[64 * j] = w; } } }
    }
    {
        typedef short bf16x8 __attribute__((ext_vector_type(8)));
        typedef float f32x16 __attribute__((ext_vector_type(16)));
        const int r31 = F.lane & 31, hh = F.lane >> 5;
        const float mind = -3.0701134573253945f, maxd = -15.350567286626972f;
        for (int u = gw; u < 128 * 32; u += NGW) {
            const int tt = u & 127, ng = u >> 7, t = tt * 32 + r31;
            bf16x8 bq[4];
#pragma unroll
            for (int s = 0; s < 4; ++s) bq[s] = *(const bf16x8*)(F.HID2B + (size_t)t * 64 + 16 * s + 8 * hh);
            const float tn = (float)t * (1.0f / (float)(SEQ - 1));
#pragma unroll 1
            for (int q = 0; q < 4; ++q) {
                const int n0 = (ng * 4 + q) * 32;
                f32x16 c;
#pragma unroll
                for (int i = 0; i < 16; ++i) c[i] = 0.f;
#pragma unroll
                for (int s = 0; s < 4; ++s) { const bf16x8 a = *(const bf16x8*)(F.W3TB + (size_t)(n0 + r31) * 64 + 16 * s + 8 * hh); c = __builtin_amdgcn_mfma_f32_32x32x16_bf16(a, bq[s], c, 0, 0, 0); }
#pragma unroll
                for (int i = 0; i < 16; ++i) { const int n = n0 + (i & 3) + 8 * (i >> 2) + 4 * hh, ch = n & (HW - 1);
                    const float delta = fabsf(mind + (float)ch * ((maxd - mind) / (float)(HW - 1)));
                    F.KF[(size_t)n * SEQ + t] = (bf16)f2bf(c[i] * __expf(-tn * delta)); }
            }
        }
    }
}

template <int NB, class LA, class LB, class EP>
__device__ __forceinline__ void simt_tile(LAS float* L, int K, int tid, const LA& la, const LB& lb, const EP& ep) {
    LAS float* As = L;
    LAS float* Bs = L + 32 * 68;
    const int ty = tid >> 4, tx = tid & 15;
    float acc[NB][2][4];
#pragma unroll
    for (int q = 0; q < NB; ++q)
#pragma unroll
        for (int i = 0; i < 2; ++i)
#pragma unroll
            for (int j = 0; j < 4; ++j) acc[q][i][j] = 0.f;
    for (int k0 = 0; k0 < K; k0 += 32) {
        __syncthreads();
        for (int e = tid; e < 64 * 32; e += NTHR) { const int r = e >> 5, kk = e & 31; As[kk * 68 + r] = la(r, k0 + kk); }
#pragma unroll
        for (int q = 0; q < NB; ++q)
            for (int e = tid; e < 32 * 64; e += NTHR) { const int kk = e >> 6, cc = e & 63; Bs[(q * 32 + kk) * 68 + cc] = lb(q, k0 + kk, cc); }
        __syncthreads();
#pragma unroll 8
        for (int kk = 0; kk < 32; ++kk) {
            const float a0 = As[kk * 68 + 2 * ty], a1 = As[kk * 68 + 2 * ty + 1];
#pragma unroll
            for (int q = 0; q < NB; ++q) { const f32x4 b = *(LAS f32x4*)(Bs + (q * 32 + kk) * 68 + 4 * tx);
                acc[q][0][0] += a0 * b.x; acc[q][0][1] += a0 * b.y; acc[q][0][2] += a0 * b.z; acc[q][0][3] += a0 * b.w;
                acc[q][1][0] += a1 * b.x; acc[q][1][1] += a1 * b.y; acc[q][1][2] += a1 * b.z; acc[q][1][3] += a1 * b.w; }
        }
    }
#pragma unroll
    for (int i = 0; i < 2; ++i)
#pragma unroll
        for (int j = 0; j < 4; ++j) { float v[NB];
#pragma unroll
            for (int q = 0; q < NB; ++q) v[q] = acc[q][i][j];
            ep(2 * ty + i, 4 * tx + j, v); }
}

struct EpiProj {
    static constexpr bool PERM = true, AFTER_DRAIN = false;
    bf16* QKVp; bf16* Gp; const float* ROT; const float* bias;
    __device__ __forceinline__ void operator()(const pg8::f32x4 (&acc)[2][2][4][2], const pg8::Unit& u, int wr, int wc, int fr, int fq) const {
        using namespace pg8;
        const int row0 = u.pm * BM + wr * 64 + fr;
        const int colt = u.pn * BM;
        if (colt < QKVW) {
            const bool rot = (colt < 2 * NH * HD) && (wc == 0);
#pragma unroll
            for (int ai = 0; ai < 2; ++ai)
#pragma unroll
                for (int m = 0; m < 4; ++m) { const int row = row0 + ai * HALF + m * 16;
                    bf16* rowp = QKVp + (size_t)row * QKVW + colt + wc * 32 + 8 * fq;
                    f32x4 cs0, cs1, sn0, sn1;
                    if (rot) { const float* rp = ROT + (size_t)row * 32 + 8 * (fq & 1); cs0 = *(const f32x4*)rp; cs1 = *(const f32x4*)(rp + 4); sn0 = *(const f32x4*)(rp + 16); sn1 = *(const f32x4*)(rp + 20); }
#pragma unroll
                    for (int bj = 0; bj < 2; ++bj) { f32x4 v0 = acc[ai][bj][m][0], v1 = acc[ai][bj][m][1];
                        if (rot) {
                            f32x4 o0, o1;
#pragma unroll
                            for (int j = 0; j < 4; ++j) { o0[j] = __shfl_xor(v0[j], 32); o1[j] = __shfl_xor(v1[j], 32); }
                            if (fq < 2) { v0 = v0 * cs0 - o0 * sn0; v1 = v1 * cs1 - o1 * sn1; }
                            else        { v0 = v0 * cs0 + o0 * sn0; v1 = v1 * cs1 + o1 * sn1; }
                        }
                        u32x4 w; w.x = cvt_pk_bf16(v0[0], v0[1]); w.y = cvt_pk_bf16(v0[2], v0[3]); w.z = cvt_pk_bf16(v1[0], v1[1]); w.w = cvt_pk_bf16(v1[2], v1[3]);
                        *(u32x4*)(rowp + bj * HALF) = w; } }
        } else {
            const int gc = colt - QKVW + wc * 32 + 8 * fq;
            f32x4 bv[2][2];
#pragma unroll
            for (int bj = 0; bj < 2; ++bj)
#pragma unroll
                for (int n = 0; n < 2; ++n) bv[bj][n] = *(const f32x4*)(bias + gc + bj * HALF + 4 * n);
#pragma unroll
            for (int ai = 0; ai < 2; ++ai)
#pragma unroll
                for (int m = 0; m < 4; ++m) { bf16* rowp = Gp + (size_t)(row0 + ai * HALF + m * 16) * (2 * D) + gc;
#pragma unroll
                    for (int bj = 0; bj < 2; ++bj) { f32x4 v0 = acc[ai][bj][m][0] + bv[bj][0], v1 = acc[ai][bj][m][1] + bv[bj][1];
#pragma unroll
                        for (int j = 0; j < 4; ++j) { v0[j] = 1.0f / (1.0f + __expf(-v0[j])); v1[j] = 1.0f / (1.0f + __expf(-v1[j])); }
                        u32x4 w; w.x = cvt_pk_bf16(v0[0], v0[1]); w.y = cvt_pk_bf16(v0[2], v0[3]); w.z = cvt_pk_bf16(v1[0], v1[1]); w.w = cvt_pk_bf16(v1[2], v1[3]);
                        *(u32x4*)(rowp + bj * HALF) = w; } }
        }
    }
};
struct EpiPlainBf16 {
    static constexpr bool PERM = true, AFTER_DRAIN = false;
    bf16* O; int ldc;
    __device__ __forceinline__ void operator()(const pg8::f32x4 (&acc)[2][2][4][2], const pg8::Unit& u, int wr, int wc, int fr, int fq) const {
        using namespace pg8;
        const int row0 = u.pm * BM + wr * 64 + fr, col0 = u.pn * BM + wc * 32 + 8 * fq;
#pragma unroll
        for (int ai = 0; ai < 2; ++ai)
#pragma unroll
            for (int m = 0; m < 4; ++m) { bf16* rowp = O + (size_t)(row0 + ai * HALF + m * 16) * ldc + col0;
#pragma unroll
                for (int bj = 0; bj < 2; ++bj) { const f32x4 v0 = acc[ai][bj][m][0], v1 = acc[ai][bj][m][1];
                    u32x4 w; w.x = cvt_pk_bf16(v0[0], v0[1]); w.y = cvt_pk_bf16(v0[2], v0[3]); w.z = cvt_pk_bf16(v1[0], v1[1]); w.w = cvt_pk_bf16(v1[2], v1[3]);
                    *(u32x4*)(rowp + bj * HALF) = w; } }
    }
};
template <int STAGE> struct EpiGate {
    static constexpr bool PERM = true, AFTER_DRAIN = false;
    const bf16* Gp; int goff; float* TMPp; bf16* Mp;
    __device__ __forceinline__ void operator()(const pg8::f32x4 (&acc)[2][2][4][2], const pg8::Unit& u, int wr, int wc, int fr, int fq) const {
        using namespace pg8;
        const int row0 = u.pm * BM + wr * 64 + fr, col0 = u.pn * BM + wc * 32 + 8 * fq;
#pragma unroll
        for (int ai = 0; ai < 2; ++ai)
#pragma unroll
            for (int m = 0; m < 4; ++m) { const size_t row = (size_t)(row0 + ai * HALF + m * 16);
#pragma unroll
                for (int bj = 0; bj < 2; ++bj) { const int col = col0 + bj * HALF;
                    const u32x4 gw = *(const u32x4*)(Gp + row * (2 * D) + goff + col);
                    f32x4 g0 = {bflo(gw.x), bfhi(gw.x), bflo(gw.y), bfhi(gw.y)}, g1 = {bflo(gw.z), bfhi(gw.z), bflo(gw.w), bfhi(gw.w)};
                    f32x4 v0 = acc[ai][bj][m][0] * g0, v1 = acc[ai][bj][m][1] * g1;
                    bf16* tp = (bf16*)TMPp + row * D + col;
                    if (STAGE == 0) { u32x4 w; w.x = cvt_pk_bf16(v0[0], v0[1]); w.y = cvt_pk_bf16(v0[2], v0[3]); w.z = cvt_pk_bf16(v1[0], v1[1]); w.w = cvt_pk_bf16(v1[2], v1[3]); *(u32x4*)tp = w; }
                    else { const u32x4 tw = *(const u32x4*)tp; v0 += (f32x4){bflo(tw.x), bfhi(tw.x), bflo(tw.y), bfhi(tw.y)}; v1 += (f32x4){bflo(tw.z), bfhi(tw.z), bflo(tw.w), bfhi(tw.w)};
                        u32x4 w; w.x = cvt_pk_bf16(v0[0], v0[1]); w.y = cvt_pk_bf16(v0[2], v0[3]); w.z = cvt_pk_bf16(v1[0], v1[1]); w.w = cvt_pk_bf16(v1[2], v1[3]);
                        *(u32x4*)(Mp + row * D + col) = w; } } }
    }
};
struct EpiF32 {
    static constexpr bool PERM = false, AFTER_DRAIN = false;
    float* C; int ldc;
    __device__ __forceinline__ void operator()(const pg8::f32x4 (&acc)[2][2][4][2], const pg8::Unit& u, int wr, int wc, int fr, int fq) const {
        using namespace pg8;
        const int row0 = u.pm * BM + wr * 64 + fr, col0 = u.pn * BM + wc * 32 + 4 * fq;
#pragma unroll
        for (int ai = 0; ai < 2; ++ai)
#pragma unroll
            for (int m = 0; m < 4; ++m) { float* rowp = C + (size_t)(row0 + ai * HALF + m * 16) * ldc + col0;
#pragma unroll
                for (int bj = 0; bj < 2; ++bj)
#pragma unroll
                    for (int n = 0; n < 2; ++n) *(f32x4*)(rowp + bj * HALF + n * 16) = acc[ai][bj][m][n]; }
    }
};


struct DualOrder {
    pg8::StaticOrder s0, s1; int G, c; const bf16* A0; const bf16* B0; const bf16* A1; const bf16* B1;
    __device__ __forceinline__ bool next(int i, pg8::Unit& u) const {
        const int L = i * G + c;
        if (L < s1.nwg) { pg8::StaticOrder t = s1; t.G = 1; t.c = L; const bool ok = t.next(0, u); u.kind = 1; return ok; }
        pg8::StaticOrder t = s0; t.G = 1; t.c = L - s1.nwg; const bool ok = t.next(0, u); u.kind = 0; return ok;
    }
    __device__ __forceinline__ void a_ready(const pg8::Unit&) const {}
    __device__ __forceinline__ void done(const pg8::Unit&) const {}
    __device__ __forceinline__ const bf16* abase(const pg8::Gemm&, const pg8::Unit& u) const { return u.kind ? A1 : A0; }
    __device__ __forceinline__ const bf16* bbase(const pg8::Gemm&, const pg8::Unit& u) const { return u.kind ? B1 : B0; }
};
struct EpiDual {
    static constexpr bool PERM = true, AFTER_DRAIN = false;
    EpiPlainBf16 e0; EpiProj e1;
    __device__ __forceinline__ void operator()(const pg8::f32x4 (&acc)[2][2][4][2], const pg8::Unit& u, int wr, int wc, int fr, int fq) const {
        if (u.kind == 0) e0(acc, u, wr, wc, fr, fq); else e1(acc, u, wr, wc, fr, fq);
    }
};
template <class Epi>
__device__ __forceinline__ void run_gemm(Frame& F, const bf16* A, const bf16* Bt, int M, int N, int K, const Epi& E) {
    pg8::Gemm g{A, Bt, M, N, K}; pg8::StaticOrder S; S.init(M, N, F.G, F.bid);
    pg8::gemm_phase<Epi, pg8::StaticOrder, true, true>(F.lds, g, S, E);
}

__device__ __forceinline__ float sconv_at(const bf16* rowp, int t, float w0, float w1, float w2, float bias) {
    const float um = t > 0 ? bf2f(rowp[t - 1]) : 0.f, u0 = bf2f(rowp[t]), up = t < SEQ - 1 ? bf2f(rowp[t + 1]) : 0.f;
    return um * w0 + u0 * w1 + up * w2 + bias;
}
__device__ __forceinline__ void conv8(const LAS float* kk, const LAS float* z, int t0, float (&acc)[2][8]) {
#pragma unroll
    for (int b = 0; b < 2; ++b)
#pragma unroll
        for (int j = 0; j < 8; ++j) acc[b][j] = 0.f;
    for (int s8 = 0; s8 < SEQ; s8 += 8) {
        const int base = t0 - s8 + (SEQ - 1);
        float kw[15];
#pragma unroll
        for (int i = 0; i < 15; ++i) kw[i] = kk[base - 7 + i];
        float zz[2][8];
#pragma unroll
        for (int b = 0; b < 2; ++b) { const f32x4 q0 = *(const LAS f32x4*)(z + b * SEQ + s8), q1 = *(const LAS f32x4*)(z + b * SEQ + s8 + 4);
            zz[b][0] = q0.x; zz[b][1] = q0.y; zz[b][2] = q0.z; zz[b][3] = q0.w; zz[b][4] = q1.x; zz[b][5] = q1.y; zz[b][6] = q1.z; zz[b][7] = q1.w; }
#pragma unroll
        for (int ds = 0; ds < 8; ++ds)
#pragma unroll
            for (int j = 0; j < 8; ++j) { const float k = kw[7 + j - ds]; acc[0][j] += k * zz[0][ds]; acc[1][j] += k * zz[1][ds]; }
    }
}
__device__ __forceinline__ void p3_hyena_naive(Frame& F) {
    LAS float* L = (LAS float*)F.lds;
    LAS float* zin = L;
    LAS float* kk = L + 2 * SEQ;
    LAS float* zmid = L + 4 * SEQ;
    for (int c = F.bid; c < HW; c += F.G) {
        __syncthreads();
        const float cw[3][3] = {{F.conv_w[c], F.conv_w[3 * HW + c], F.conv_w[6 * HW + c]},
                                {F.conv_w[HW + c], F.conv_w[3 * HW + HW + c], F.conv_w[6 * HW + HW + c]},
                                {F.conv_w[2 * HW + c], F.conv_w[3 * HW + 2 * HW + c], F.conv_w[6 * HW + 2 * HW + c]}};
        const float cb[3] = {F.conv_b[c], F.conv_b[HW + c], F.conv_b[2 * HW + c]};
        const bf16* pv = F.PHY + (size_t)c * T; const bf16* px1 = F.PHY + (size_t)(HW + c) * T; const bf16* px2 = F.PHY + (size_t)(2 * HW + c) * T;
        for (int i = F.tid; i < T; i += NTHR) { const int b = i / SEQ, t = i % SEQ; zin[i] = sconv_at(pv + b * SEQ, t, cw[0][0], cw[0][1], cw[0][2], cb[0]); }
        for (int i = F.tid; i < 2 * SEQ; i += NTHR) { const int d = i - (SEQ - 1);
            kk[i] = (i == 2 * SEQ - 1) ? 0.f : bf2f(d >= 0 ? F.KF[(size_t)(0 * HW + c) * SEQ + d] : F.KF[(size_t)(1 * HW + c) * SEQ - d]); }
        __syncthreads();
        const int t0 = F.tid * 8; float acc[2][8];
        conv8(kk, zin, t0, acc);
        const float sk0 = F.hskip[c], sk1 = F.hskip[HW + c];
#pragma unroll
        for (int b = 0; b < 2; ++b)
#pragma unroll
            for (int j = 0; j < 8; ++j) { const float x1 = sconv_at(px1 + b * SEQ, t0 + j, cw[1][0], cw[1][1], cw[1][2], cb[1]);
                zmid[b * SEQ + t0 + j] = x1 * (acc[b][j] + sk0 * zin[b * SEQ + t0 + j]); }
        __syncthreads();
        for (int i = F.tid; i < 2 * SEQ; i += NTHR) { const int d = i - (SEQ - 1);
            kk[i] = (i == 2 * SEQ - 1) ? 0.f : bf2f(d >= 0 ? F.KF[(size_t)(2 * HW + c) * SEQ + d] : F.KF[(size_t)(3 * HW + c) * SEQ - d]); }
        __syncthreads();
        conv8(kk, zmid, t0, acc);
#pragma unroll
        for (int b = 0; b < 2; ++b)
#pragma unroll
            for (int j = 0; j < 8; ++j) { const float x2 = sconv_at(px2 + b * SEQ, t0 + j, cw[2][0], cw[2][1], cw[2][2], cb[2]);
                const float z2 = x2 * (acc[b][j] + sk1 * zmid[b * SEQ + t0 + j]);
                F.YHY[(size_t)(b * SEQ + t0 + j) * HW + c] = (bf16)f2bf(z2); }
    }
}

constexpr int HY_KCOPY = 16448;
constexpr int HY_K_OFF = 0;
constexpr int HY_ZIN_OFF = 4 * HY_KCOPY;
constexpr int HY_ZBYTES = 160 * 2 * 80;
constexpr int HY_ZMID_OFF = HY_ZIN_OFF + HY_ZBYTES;
constexpr int HY_X1_OFF = HY_ZMID_OFF + HY_ZBYTES;
constexpr int HY_X2_OFF = HY_X1_OFF + 2 * SEQ * 2;
static_assert(HY_X2_OFF + 2 * SEQ * 2 <= MOE_OFFS_OFF, "hyena LDS map");
__device__ __forceinline__ unsigned hy_zaddr(int b, int t) { return (unsigned)((((t >> 5) + 16) * 2 + b) * 80 + (t & 31) * 2); }
__device__ __forceinline__ void hy_build_k(Frame& F, const bf16* hf, const bf16* hb) {
    LAS unsigned char* lds = F.lds + HY_K_OFF;
    const int i = F.tid;
    const v4u ca = *(const v4u*)(hf + (SEQ - 8 - 8 * i)), cb = *(const v4u*)(hb + 8 * i);
    unsigned short ga[8], gb[8];
    ga[7] = (unsigned short)(ca.x & 0xffff); ga[6] = (unsigned short)(ca.x >> 16); ga[5] = (unsigned short)(ca.y & 0xffff); ga[4] = (unsigned short)(ca.y >> 16);
    ga[3] = (unsigned short)(ca.z & 0xffff); ga[2] = (unsigned short)(ca.z >> 16); ga[1] = (unsigned short)(ca.w & 0xffff); ga[0] = (unsigned short)(ca.w >> 16);
    gb[0] = (unsigned short)(cb.x & 0xffff); gb[1] = (unsigned short)(cb.x >> 16); gb[2] = (unsigned short)(cb.y & 0xffff); gb[3] = (unsigned short)(cb.y >> 16);
    gb[4] = (unsigned short)(cb.z & 0xffff); gb[5] = (unsigned short)(cb.z >> 16); gb[6] = (unsigned short)(cb.w & 0xffff); gb[7] = (unsigned short)(cb.w >> 16);
#pragma unroll
    for (int s = 0; s < 4; ++s) {
        LAS unsigned char* cp = lds + s * HY_KCOPY;
#pragma unroll
        for (int j = 0; j < 8; ++j) { const int xa = 8 * i + 1 + j, xb = SEQ + 8 * i + j;
            if (xa - s >= 0) *(LAS unsigned short*)(cp + 2 * (xa - s)) = ga[j];
            if (xb > SEQ) *(LAS unsigned short*)(cp + 2 * (xb - s)) = gb[j]; }
    }
}
__device__ __forceinline__ void hy_stage_inputs(Frame& F, int c, const float (&cw)[3][3], const float (&cb)[3]) {
    LAS unsigned char* lds = F.lds;
    v4u ch[6]; unsigned short lo[6], hi[6];
#pragma unroll
    for (int k = 0; k < 6; ++k) { const int wh = k >> 1, chunk = F.tid + 512 * (k & 1), b = chunk >> 9, t0 = (chunk & 511) * 8;
        const bf16* rowp = F.PHY + (size_t)(wh * HW + c) * T + b * SEQ;
        ch[k] = *(const v4u*)(rowp + t0); lo[k] = t0 > 0 ? rowp[t0 - 1] : (unsigned short)0; hi[k] = t0 + 8 < SEQ ? rowp[t0 + 8] : (unsigned short)0; }
#pragma unroll
    for (int k = 0; k < 6; ++k) { const int wh = k >> 1, chunk = F.tid + 512 * (k & 1), b = chunk >> 9, t0 = (chunk & 511) * 8;
        float u[10]; u[0] = bf2f(lo[k]); u[9] = bf2f(hi[k]);
        u[1] = bflo(ch[k].x); u[2] = bfhi(ch[k].x); u[3] = bflo(ch[k].y); u[4] = bfhi(ch[k].y); u[5] = bflo(ch[k].z); u[6] = bfhi(ch[k].z); u[7] = bflo(ch[k].w); u[8] = bfhi(ch[k].w);
        float o[8];
#pragma unroll
        for (int j = 0; j < 8; ++j) o[j] = u[j] * cw[wh][0] + u[j + 1] * cw[wh][1] + u[j + 2] * cw[wh][2] + cb[wh];
        v4u pk; pk.x = pk2(o[0], o[1]); pk.y = pk2(o[2], o[3]); pk.z = pk2(o[4], o[5]); pk.w = pk2(o[6], o[7]);
        const unsigned off = (wh == 0) ? (unsigned)HY_ZIN_OFF + hy_zaddr(b, t0) : (unsigned)((wh == 1 ? HY_X1_OFF : HY_X2_OFF) + 2 * (b * SEQ + t0));
        *(LAS v4u*)(lds + off) = pk; }
}
__device__ __forceinline__ void hy_conv(Frame& F, unsigned zoff, pg8::f32x4 (&acc)[4]) {
    typedef short bf16x8 __attribute__((ext_vector_type(8)));
    typedef float f32x16 __attribute__((ext_vector_type(16)));
    const int lane = F.lane, q = F.wave, r = lane & 31, hh = lane >> 5, sg = (4 - (r & 3)) & 3, nn = r >> 1, b = r & 1;
    const int d0 = 16 * q - 127;
    unsigned aaddr = (unsigned)(HY_K_OFF + sg * HY_KCOPY + 2 * (SEQ - 32 * d0 - r + 8 * hh - sg));
    unsigned baddr = zoff + (unsigned)(((16 * q + nn - d0 + 16) * 2 + b) * 80 + 16 * hh);
    f32x16 c;
#pragma unroll
    for (int i = 0; i < 16; ++i) c[i] = 0.f;
    struct FragSet { v2u a[2][2][2]; bf16x8 b[2][2]; };
#define HY_LOAD(S, ADDR_A, ADDR_B) do { _Pragma("unroll") for (int _o = 0; _o < 2; ++_o) { const unsigned _ao = (ADDR_A) + (_o ? 0u : 64u), _bo = (ADDR_B) + (_o ? 0u : 160u); \
        _Pragma("unroll") for (int _h = 0; _h < 2; ++_h) { S.a[_o][_h][0] = *(volatile LAS v2u*)(F.lds + _ao + 32 * _h); S.a[_o][_h][1] = *(volatile LAS v2u*)(F.lds + _ao + 32 * _h + 8); \
            S.b[_o][_h] = *(const LAS bf16x8*)(F.lds + _bo + 32 * _h); } } } while (0)
#define HY_MMA(S) do { _Pragma("unroll") for (int _o = 0; _o < 2; ++_o) _Pragma("unroll") for (int _h = 0; _h < 2; ++_h) { union { bf16x8 v; v2u h[2]; } _a; _a.h[0] = S.a[_o][_h][0]; _a.h[1] = S.a[_o][_h][1]; \
        c = __builtin_amdgcn_mfma_f32_32x32x16_bf16(_a.v, S.b[_o][_h], c, 0, 0, 0); } } while (0)
    {
        union { bf16x8 v; v2u h[2]; } a0, a1;
        a0.h[0] = *(volatile LAS v2u*)(F.lds + aaddr);      a0.h[1] = *(volatile LAS v2u*)(F.lds + aaddr + 8);
        a1.h[0] = *(volatile LAS v2u*)(F.lds + aaddr + 32); a1.h[1] = *(volatile LAS v2u*)(F.lds + aaddr + 40);
        const bf16x8 b0 = *(const LAS bf16x8*)(F.lds + baddr), b1 = *(const LAS bf16x8*)(F.lds + baddr + 32);
        c = __builtin_amdgcn_mfma_f32_32x32x16_bf16(a0.v, b0, c, 0, 0, 0);
        c = __builtin_amdgcn_mfma_f32_32x32x16_bf16(a1.v, b1, c, 0, 0, 0);
    }
    FragSet sA, sB;
    aaddr -= 128; baddr -= 320;
    HY_LOAD(sA, aaddr, baddr);
#pragma clang loop unroll(disable)
    for (int it = 0; it < 35; ++it) {
        aaddr -= 128; baddr -= 320;
        asm volatile("" : "+v"(aaddr), "+v"(baddr));
        HY_LOAD(sB, aaddr, baddr);
        HY_MMA(sA);
        aaddr -= 128; baddr -= 320;
        asm volatile("" : "+v"(aaddr), "+v"(baddr));
        HY_LOAD(sA, aaddr, baddr);
        HY_MMA(sB);
    }
    HY_MMA(sA);
#undef HY_LOAD
#undef HY_MMA
#pragma unroll
    for (int g = 0; g < 4; ++g) acc[g] = (pg8::f32x4){c[4 * g], c[4 * g + 1], c[4 * g + 2], c[4 * g + 3]};
}
__device__ __forceinline__ void p3_hyena_mfma(Frame& F) {
    LAS unsigned char* lds = F.lds;
    for (int i = F.tid; i < 2 * HY_ZBYTES / 4; i += NTHR) *(LAS unsigned*)(lds + HY_ZIN_OFF + 4 * i) = 0u;
    const int lane = F.lane, q = F.wave, r = lane & 31, hh = lane >> 5, nn = r >> 1, b = r & 1;
    for (int c = F.bid; c < HW; c += F.G) {
        __syncthreads();
        const float cw[3][3] = {{F.conv_w[c], F.conv_w[3 * HW + c], F.conv_w[6 * HW + c]},
                                {F.conv_w[HW + c], F.conv_w[3 * HW + HW + c], F.conv_w[6 * HW + HW + c]},
                                {F.conv_w[2 * HW + c], F.conv_w[3 * HW + 2 * HW + c], F.conv_w[6 * HW + 2 * HW + c]}};
        const float cb[3] = {F.conv_b[c], F.conv_b[HW + c], F.conv_b[2 * HW + c]};
        const bf16* pv = F.PHY + (size_t)c * T; const bf16* px1 = F.PHY + (size_t)(HW + c) * T; const bf16* px2 = F.PHY + (size_t)(2 * HW + c) * T;
        hy_stage_inputs(F, c, cw, cb);
        hy_build_k(F, F.KF + (size_t)(0 * HW + c) * SEQ, F.KF + (size_t)(1 * HW + c) * SEQ);
        __syncthreads();
        pg8::f32x4 acc[4];
#if HY_REP & 1
        { pg8::f32x4 acc2[4]; hy_conv(F, HY_ZIN_OFF, acc2); asm volatile("" :: "v"(acc2[0][0]), "v"(acc2[1][1]), "v"(acc2[2][2]), "v"(acc2[3][3])); }
#endif
#if HY_REP & 2
        __syncthreads(); hy_build_k(F, F.KF + (size_t)(0 * HW + c) * SEQ, F.KF + (size_t)(1 * HW + c) * SEQ); __syncthreads();
#endif
#if HY_REP & 4
        __syncthreads(); hy_stage_inputs(F, c, cw, cb); __syncthreads();
#endif
        hy_conv(F, HY_ZIN_OFF, acc);
        const float sk0 = F.hskip[c], sk1 = F.hskip[HW + c];
        {
            unsigned zb = (unsigned)(((16 * q + nn + 16) * 2 + b) * 80 + 8 * hh), xb = (unsigned)(2 * (b * SEQ + 32 * (16 * q + nn) + 4 * hh));
            asm volatile("" : "+v"(zb), "+v"(xb));
#pragma unroll
            for (int g = 0; g < 4; ++g)
#pragma unroll
                for (int e = 0; e < 4; ++e) { const unsigned o = (unsigned)(16 * g + 2 * e);
                    const float vz = bf2f(*(LAS unsigned short*)(lds + HY_ZIN_OFF + zb + o)), x1 = bf2f(*(LAS unsigned short*)(lds + HY_X1_OFF + xb + o));
                    *(LAS unsigned short*)(lds + HY_ZMID_OFF + zb + o) = (unsigned short)f2bf(x1 * (acc[g][e] + sk0 * vz)); }
        }
        __syncthreads();
        hy_build_k(F, F.KF + (size_t)(2 * HW + c) * SEQ, F.KF + (size_t)(3 * HW + c) * SEQ);
        __syncthreads();
        hy_conv(F, HY_ZMID_OFF, acc);
        {
            unsigned zb = (unsigned)(((16 * q + nn + 16) * 2 + b) * 80 + 8 * hh), xb = (unsigned)(2 * (b * SEQ + 32 * (16 * q + nn) + 4 * hh));
            asm volatile("" : "+v"(zb), "+v"(xb));
            bf16* yp = F.YHY + (size_t)(b * SEQ + 32 * (16 * q + nn) + 4 * hh) * HW + c;
#pragma unroll
            for (int g = 0; g < 4; ++g)
#pragma unroll
                for (int e = 0; e < 4; ++e) { const unsigned o = (unsigned)(16 * g + 2 * e);
                    const float z1 = bf2f(*(LAS unsigned short*)(lds + HY_ZMID_OFF + zb + o)), x2 = bf2f(*(LAS unsigned short*)(lds + HY_X2_OFF + xb + o));
                    yp[(size_t)(8 * g + e) * HW] = (bf16)f2bf(x2 * (acc[g][e] + sk1 * z1)); }
        }
    }
}
__device__ __forceinline__ void p3_attn_naive(Frame& F) {
    LAS float* qs = (LAS float*)F.lds + F.wave * 128;
    const int gw = F.bid * NWAVES + F.wave, NGW = F.G * NWAVES;
    const float scale = 0.08838834764831845f;
    for (int u = gw; u < T * 4; u += NGW) {
        const int m = u >> 2, hh = u & 3, b = m / SEQ, s = m % SEQ;
        float Mrun = -3.0e38f, Lrun = 0.f, o0 = 0.f, o1 = 0.f;
#pragma unroll 1
        for (int g = 0; g < 3; ++g) {
            const int head = g * 4 + hh, dil = (g == 0) ? 1 : (g == 1 ? 4 : 16);
            const bf16* qp = F.QKV + (size_t)m * QKVW + head * HD;
            { const unsigned qq = *(const unsigned*)(qp + 2 * F.lane); qs[2 * F.lane] = bflo(qq); qs[2 * F.lane + 1] = bfhi(qq); }
            asm volatile("s_waitcnt lgkmcnt(0)" ::: "memory");
            float sc[3];
#pragma unroll
            for (int p = 0; p < 3; ++p) {
                const int j = (p == 0) ? F.lane - 64 : (p == 1 ? F.lane : 64);
                const int ks = s + j * dil; const bool valid = (ks >= 0) && (ks < SEQ) && (p < 2 || F.lane == 0);
                float dot = 0.f;
                if (valid) { const v4u* kp = (const v4u*)(F.QKV + (size_t)(b * SEQ + ks) * QKVW + NH * HD + head * HD);
#pragma unroll 4
                    for (int c8 = 0; c8 < 16; ++c8) { const v4u kv = kp[c8]; const LAS float* q8 = qs + 8 * c8;
                        dot += bflo(kv.x) * q8[0] + bfhi(kv.x) * q8[1] + bflo(kv.y) * q8[2] + bfhi(kv.y) * q8[3] + bflo(kv.z) * q8[4] + bfhi(kv.z) * q8[5] + bflo(kv.w) * q8[6] + bfhi(kv.w) * q8[7]; } }
                sc[p] = valid ? dot * scale : -1.0e30f;
            }
            const float mg = wave_max(fmaxf(fmaxf(sc[0], sc[1]), sc[2]));
            const float mnew = fmaxf(Mrun, mg), resc = __expf(Mrun - mnew);
            float pr[3];
#pragma unroll
            for (int p = 0; p < 3; ++p) pr[p] = (sc[p] > -1.0e29f) ? __expf(sc[p] - mnew) : 0.f;
            Lrun = Lrun * resc + wave_sum(pr[0] + pr[1] + pr[2]); o0 *= resc; o1 *= resc; Mrun = mnew;
            const bf16* vbase = F.QKV + 2 * NH * HD + head * HD + 2 * F.lane;
            for (int jj = 0; jj < 129; ++jj) {
                const int j = jj - 64, ks = s + j * dil;
                if (ks < 0 || ks >= SEQ) continue;
                const float pk = (jj < 64) ? __shfl(pr[0], jj) : (jj < 128 ? __shfl(pr[1], jj - 64) : __shfl(pr[2], 0));
                const unsigned vv = *(const unsigned*)(vbase + (size_t)(b * SEQ + ks) * QKVW);
                o0 += pk * bflo(vv); o1 += pk * bfhi(vv);
            }
        }
        const float inv = 1.0f / Lrun;
        *(unsigned*)(F.YAT + (size_t)m * 512 + hh * HD + 2 * F.lane) = pk2(o0 * inv, o1 * inv);
    }
}


constexpr int AT_VPITCH = 320, AT_VBYTES = 32 * AT_VPITCH;
typedef short s16x4 __attribute__((ext_vector_type(4)));
#define AT_TR8(S, VB, R) asm volatile( \
    "ds_read_b64_tr_b16 %0, %8 offset:%9\n\tds_read_b64_tr_b16 %1, %8 offset:%10\n\tds_read_b64_tr_b16 %2, %8 offset:%11\n\tds_read_b64_tr_b16 %3, %8 offset:%12\n\t" \
    "ds_read_b64_tr_b16 %4, %8 offset:%13\n\tds_read_b64_tr_b16 %5, %8 offset:%14\n\tds_read_b64_tr_b16 %6, %8 offset:%15\n\tds_read_b64_tr_b16 %7, %8 offset:%16\n\ts_waitcnt lgkmcnt(0)" \
    : "=&v"(R[0]), "=&v"(R[1]), "=&v"(R[2]), "=&v"(R[3]), "=&v"(R[4]), "=&v"(R[5]), "=&v"(R[6]), "=&v"(R[7]) \
    : "v"(VB), "i"((16 * (S)) * AT_VPITCH), "i"((16 * (S) + 8) * AT_VPITCH), "i"((16 * (S)) * AT_VPITCH + 64), "i"((16 * (S) + 8) * AT_VPITCH + 64), \
      "i"((16 * (S)) * AT_VPITCH + 128), "i"((16 * (S) + 8) * AT_VPITCH + 128), "i"((16 * (S)) * AT_VPITCH + 192), "i"((16 * (S) + 8) * AT_VPITCH + 192) : "memory")
__device__ __forceinline__ void p4_attn_mfma(Frame& F) {
    typedef short bf16x8 __attribute__((ext_vector_type(8)));
    typedef float f32x16 __attribute__((ext_vector_type(16)));
    typedef float f32x2 __attribute__((ext_vector_type(2)));
    typedef __bf16 bf16x2v __attribute__((ext_vector_type(2)));
    const int lane = F.lane, w = F.wave, r31 = lane & 31, hh = lane >> 5;
    LAS unsigned char* vimg = F.lds + w * AT_VBYTES;
    const unsigned vb = (unsigned)(size_t)vimg + (unsigned)((4 * hh + ((lane & 15) >> 2)) * AT_VPITCH + 32 * ((lane >> 4) & 1) + 8 * (lane & 3));
    const int gw = F.bid * NWAVES + w, NGW = F.G * NWAVES;
    const float scale = 0.08838834764831845f;
    bf16* AO = (bf16*)F.YB; float* LSE = (float*)((unsigned char*)F.YB + 32 * MiB);
    const int nunit = 2 * NH * 128, per_wg = (nunit + F.G - 1) / F.G;
    for (int k = w; k < per_wg; k += NWAVES) {
        const int u = F.bid * per_wg + k; if (u >= nunit) break;
        const int b = u / (NH * 128), rem = u % (NH * 128), head = rem >> 7, blk = rem & 127, g = head >> 2, hs = head & 3;
        const int dl = (g == 0) ? 0 : (g == 1 ? 2 : 4), dil = 1 << dl, res = blk & (dil - 1), q0 = (blk >> dl) * 32, n = SEQ >> dl;
        const size_t tokq = (size_t)(b * SEQ + res + dil * (q0 + r31));
        bf16x8 qf[8];
        { const bf16* qrow = F.QKV + tokq * QKVW + head * HD + 8 * hh;
#pragma unroll
          for (int s = 0; s < 8; ++s) qf[s] = *(const bf16x8*)(qrow + 16 * s); }
        f32x16 o[4];
#pragma unroll
        for (int dt = 0; dt < 4; ++dt)
#pragma unroll
            for (int i = 0; i < 16; ++i) o[dt][i] = 0.f;
        float mrun = -3.0e38f, lrun = 0.f;
        const int kt_lo = (q0 >= 64) ? 0 : (64 - q0) >> 5, kt_hi = ((n + 32 - q0) >> 5) < 4 ? ((n + 32 - q0) >> 5) : 4;
        bf16x8 kfN[8], vvN[8];
#define AT_FETCH(KT) do { const int _k0 = q0 - 64 + 32 * (KT); \
            const bf16* _krow = F.QKV + (size_t)(b * SEQ + res + dil * (_k0 + r31)) * QKVW + NH * HD + head * HD + 8 * hh; \
            const bf16* _vsrc = F.QKV + (size_t)(b * SEQ + res + dil * (_k0 + (lane >> 4))) * QKVW + 2 * NH * HD + head * HD + (lane & 15) * 8; \
            _Pragma("unroll") for (int _s = 0; _s < 8; ++_s) kfN[_s] = *(const bf16x8*)(_krow + 16 * _s); \
            _Pragma("unroll") for (int _i = 0; _i < 8; ++_i) vvN[_i] = *(const bf16x8*)(_vsrc + (size_t)(4 * _i * dil) * QKVW); } while (0)
        AT_FETCH(kt_lo);
#pragma unroll 1
        for (int kt = kt_lo; kt <= kt_hi; ++kt) {
            const int kt0 = q0 - 64 + 32 * kt;
            bf16x8 kf[8];
#pragma unroll
            for (int s = 0; s < 8; ++s) kf[s] = kfN[s];
#pragma unroll
            for (int i = 0; i < 8; ++i) *(LAS bf16x8*)(vimg + (4 * i + (lane >> 4)) * AT_VPITCH + (lane & 15) * 16) = vvN[i];
            if (kt < kt_hi) AT_FETCH(kt + 1);
            f32x16 sacc;
#pragma unroll
            for (int i = 0; i < 16; ++i) sacc[i] = 0.f;
#pragma unroll
            for (int s = 0; s < 8; ++s) sacc = __builtin_amdgcn_mfma_f32_32x32x16_bf16(kf[s], qf[s], sacc, 0, 0, 0);
            float p[16]; float mx = -3.0e38f;
            const bool edge = (kt == 0) || (kt == 4);
#pragma unroll
            for (int i = 0; i < 16; ++i) { float sv = sacc[i] * scale;
                if (edge) { const int diff = (q0 + r31) - (kt0 + (i & 3) + 8 * (i >> 2) + 4 * hh); if (diff > 64 || diff < -64) sv = -1.0e30f; }
                p[i] = sv; mx = fmaxf(mx, sv); }
            mx = fmaxf(mx, __shfl_xor(mx, 32));
            const float mnew = fmaxf(mrun, mx), resc = __expf(mrun - mnew);
            float ps = 0.f;
#pragma unroll
            for (int i = 0; i < 16; ++i) { p[i] = (p[i] > -1.0e29f) ? __expf(p[i] - mnew) : 0.f; ps += p[i]; }
            ps += __shfl_xor(ps, 32);
            lrun = lrun * resc + ps; mrun = mnew;
#pragma unroll
            for (int dt = 0; dt < 4; ++dt)
#pragma unroll
                for (int i = 0; i < 16; ++i) o[dt][i] *= resc;
            bf16x8 pf[2];
#pragma unroll
            for (int s = 0; s < 2; ++s) { union { bf16x8 v; bf16x2v h[4]; } cv;
#pragma unroll
                for (int j = 0; j < 4; ++j) cv.h[j] = __builtin_convertvector((f32x2){p[8 * s + 2 * j], p[8 * s + 2 * j + 1]}, bf16x2v);
                pf[s] = cv.v; }
            asm volatile("s_waitcnt lgkmcnt(0)" ::: "memory");
            { s16x4 tr[8]; AT_TR8(0, vb, tr);
#pragma unroll
              for (int dt = 0; dt < 4; ++dt) { const bf16x8 va = __builtin_shufflevector(tr[2 * dt], tr[2 * dt + 1], 0, 1, 2, 3, 4, 5, 6, 7); o[dt] = __builtin_amdgcn_mfma_f32_32x32x16_bf16(va, pf[0], o[dt], 0, 0, 0); } }
            { s16x4 tr[8]; AT_TR8(1, vb, tr);
#pragma unroll
              for (int dt = 0; dt < 4; ++dt) { const bf16x8 va = __builtin_shufflevector(tr[2 * dt], tr[2 * dt + 1], 0, 1, 2, 3, 4, 5, 6, 7); o[dt] = __builtin_amdgcn_mfma_f32_32x32x16_bf16(va, pf[1], o[dt], 0, 0, 0); } }
        }
#undef AT_FETCH
        const float inv = 1.0f / lrun;
        bf16* op = AO + ((size_t)g * T + tokq) * 512 + hs * HD + 4 * hh;
#pragma unroll
        for (int dt = 0; dt < 4; ++dt)
#pragma unroll
            for (int a = 0; a < 4; ++a) { v2u ov; ov.x = pk2(o[dt][4 * a] * inv, o[dt][4 * a + 1] * inv); ov.y = pk2(o[dt][4 * a + 2] * inv, o[dt][4 * a + 3] * inv);
                *(v2u*)(op + 32 * dt + 8 * a) = ov; }
        if (hh == 0) LSE[((size_t)g * T + tokq) * 4 + hs] = mrun + logf(lrun);
    }
}
__device__ __forceinline__ void p4b_combine(Frame& F) {
    const bf16* AO = (const bf16*)F.YB; const float* LSE = (const float*)((const unsigned char*)F.YB + 32 * MiB);
    const int gw = F.bid * NWAVES + F.wave, NGW = F.G * NWAVES, lane = F.lane, hs = lane >> 4;
    for (int m = gw; m < T; m += NGW) {
        float l[3];
#pragma unroll
        for (int g = 0; g < 3; ++g) l[g] = LSE[((size_t)g * T + m) * 4 + hs];
        const float mx = fmaxf(fmaxf(l[0], l[1]), l[2]);
        float wg[3], den = 0.f;
#pragma unroll
        for (int g = 0; g < 3; ++g) { wg[g] = __expf(l[g] - mx); den += wg[g]; }
        const float inv = 1.0f / den;
        float acc[8];
#pragma unroll
        for (int j = 0; j < 8; ++j) acc[j] = 0.f;
#pragma unroll
        for (int g = 0; g < 3; ++g) { const v4u q = *(const v4u*)(AO + ((size_t)g * T + m) * 512 + 8 * lane); const float ww = wg[g] * inv;
            acc[0] += ww * bflo(q.x); acc[1] += ww * bfhi(q.x); acc[2] += ww * bflo(q.y); acc[3] += ww * bfhi(q.y); acc[4] += ww * bflo(q.z); acc[5] += ww * bfhi(q.z); acc[6] += ww * bflo(q.w); acc[7] += ww * bfhi(q.w); }
        v4u ov; ov.x = pk2(acc[0], acc[1]); ov.y = pk2(acc[2], acc[3]); ov.z = pk2(acc[4], acc[5]); ov.w = pk2(acc[6], acc[7]);
        *(v4u*)(F.YAT + (size_t)m * 512 + 8 * lane) = ov;
    }
}
constexpr int RT_MOD_OFF = 0;
constexpr int RT_W_OFF = 5 * D * 4;
constexpr int RT_INFO_OFF = RT_W_OFF + 8 * D * 4;
__device__ __forceinline__ void rt_dot8(const f32x4 (&v)[8], const LAS float* W, int lane, float (&out)[8]) {
#pragma unroll
    for (int n = 0; n < 8; ++n) { float a = 0.f;
#pragma unroll
        for (int j = 0; j < 8; ++j) { const f32x4 w = *(const LAS f32x4*)(W + n * D + 256 * j + 4 * lane); a += (v[j].x * w.x + v[j].y * w.y) + (v[j].z * w.z + v[j].w * w.w); }
        out[n] = wave_sum(a); }
}
template <bool DRY> __device__ __forceinline__ void p6_rows_router(Frame& F) {
    LAS float* L = (LAS float*)F.lds;
    LAS float* gatem = L, *shiftf = L + D, *scalef = L + 2 * D, *gpost = L + 3 * D, *gpre = L + 4 * D;
    LAS float* Wl = (LAS float*)(F.lds + RT_W_OFF);
    LAS float* info = (LAS float*)(F.lds + RT_INFO_OFF);
    const int lane = F.lane;
    for (int blk = F.bid; blk < T / 32; blk += F.G) {
        const int m0 = blk * 32, b = m0 / SEQ;
        __syncthreads();
        load_mod1(F, gatem, 2, b); load_mod1(F, shiftf, 3, b); load_mod1(F, scalef, 4, b);
        *(LAS f32x4*)(gpost + 4 * F.tid) = *(const f32x4*)(F.g_mix_post + 4 * F.tid); *(LAS f32x4*)(gpre + 4 * F.tid) = *(const f32x4*)(F.g_ffn_pre + 4 * F.tid);
        for (int i = F.tid; i < 8 * D / 4; i += NTHR) *(LAS f32x4*)(Wl + 4 * i) = *(const f32x4*)(F.WGT + 4 * i);
        __syncthreads();
#pragma unroll 1
        for (int ip = 0; ip < 4; ip += 2) {
            v2u yv[2][8]; f32x4 xv[2][8];
#pragma unroll
            for (int r = 0; r < 2; ++r) { const int m = m0 + 4 * F.wave + ip + r;
                const v2u* yr = (const v2u*)((const bf16*)F.Y + (size_t)m * D) + lane; const f32x4* xr = (const f32x4*)(F.x + (size_t)m * D) + lane;
#pragma unroll
                for (int j = 0; j < 8; ++j) { yv[r][j] = yr[64 * j]; xv[r][j] = xr[64 * j]; } }
#pragma unroll
            for (int r = 0; r < 2; ++r) {
                const int rl = 4 * F.wave + ip + r, m = m0 + rl;
                f32x4 v[8]; float s = 0.f;
#pragma unroll
                for (int j = 0; j < 8; ++j) { const v2u yw = yv[r][j]; v[j] = (f32x4){bflo(yw.x), bfhi(yw.x), bflo(yw.y), bfhi(yw.y)}; s += (v[j].x * v[j].x + v[j].y * v[j].y) + (v[j].z * v[j].z + v[j].w * v[j].w); }
                const float rstd = 1.0f / sqrtf(wave_sum(s) * (1.f / D) + RMS_EPS);
                float s1 = 0.f;
                f32x4* x1r = (f32x4*)(F.X1 + (size_t)m * D) + lane;
#pragma unroll
                for (int j = 0; j < 8; ++j) { const int d = 256 * j + 4 * lane;
                    const f32x4 g = *(LAS f32x4*)(gpost + d), gm = *(LAS f32x4*)(gatem + d);
                    const f32x4 x1 = xv[r][j] + gm * ((v[j] * rstd) * g);
                    x1r[64 * j] = x1; v[j] = x1; s1 += (x1.x * x1.x + x1.y * x1.y) + (x1.z * x1.z + x1.w * x1.w); }
                const float rstd1 = 1.0f / sqrtf(wave_sum(s1) * (1.f / D) + RMS_EPS);
                v2u* o8 = (v2u*)(F.H2 + (size_t)m * D) + lane;
#pragma unroll
                for (int j = 0; j < 8; ++j) { const int d = 256 * j + 4 * lane;
                    const f32x4 g = *(LAS f32x4*)(gpre + d), sc = *(LAS f32x4*)(scalef + d), sh = *(LAS f32x4*)(shiftf + d);
                    f32x4 h = (v[j] * rstd1) * g; h = h * (sc + 1.0f) + sh; v[j] = h;
                    v2u w; w.x = pk2(h.x, h.y); w.y = pk2(h.z, h.w); o8[64 * j] = w; }
                float gl[8]; rt_dot8(v, Wl, lane, gl);
                float gmax = -3.0e38f; int gi = 0;
#pragma unroll
                for (int g = 0; g < 8; ++g) { gl[g] += F.b_group[g]; if (gl[g] > gmax) { gmax = gl[g]; gi = g; } }
                float gden = 0.f;
#pragma unroll
                for (int g = 0; g < 8; ++g) gden += expf(gl[g] - gmax);
                if (lane == 0) { info[rl] = rstd1; info[32 + rl] = 1.0f / gden; ((LAS int*)info)[64 + rl] = gi; }
            }
        }
        __syncthreads();
#pragma unroll 1
        for (int g = 0; g < 8; ++g) {
            int cnt = 0;
#pragma unroll 1
            for (int rl = 0; rl < 32; ++rl) cnt += (((LAS int*)info)[64 + rl] == g) ? 1 : 0;
            if (cnt == 0) continue;
            for (int i = F.tid; i < 8 * D / 4; i += NTHR) *(LAS f32x4*)(Wl + 4 * i) = *(const f32x4*)(F.WET + (size_t)g * 8 * D + 4 * i);
            __syncthreads();
            int k = 0;
#pragma unroll 1
            for (int rl = 0; rl < 32; ++rl) {
                if (((LAS int*)info)[64 + rl] != g) continue;
                const bool mine = ((k & 7) == F.wave); ++k;
                if (!mine) continue;
                const int m = m0 + rl; const float rstd1 = info[rl], gval = info[32 + rl];
                const f32x4* x1r = (const f32x4*)(F.X1 + (size_t)m * D) + lane;
                f32x4 v[8];
#pragma unroll
                for (int j = 0; j < 8; ++j) { const int d = 256 * j + 4 * lane;
                    const f32x4 gg = *(LAS f32x4*)(gpre + d), sc = *(LAS f32x4*)(scalef + d), sh = *(LAS f32x4*)(shiftf + d);
                    f32x4 h = (x1r[64 * j] * rstd1) * gg; v[j] = h * (sc + 1.0f) + sh; }
                float el[8]; rt_dot8(v, Wl, lane, el);
                float e0v = -3.0e38f, e1v = -3.0e38f; int e0i = 0, e1i = 0;
#pragma unroll
                for (int q = 0; q < 8; ++q) { el[q] += F.b_expert[g * 8 + q];
                    if (el[q] > e0v) { e1v = e0v; e1i = e0i; e0v = el[q]; e0i = q; } else if (el[q] > e1v) { e1v = el[q]; e1i = q; } }
                const float p1 = expf(e1v - e0v), den = 1.0f + p1;
                const float gate0 = gval / den, gate1 = gval * p1 / den;
                if (DRY) { if (gate0 + gate1 == 12345.f) F.LISTG[0] = gate0; }
                if (lane == 0 && !DRY) {
                    ((LAS int*)info)[96 + rl] = (g * 8 + e0i) | ((g * 8 + e1i) << 8); info[128 + rl] = gate0; info[160 + rl] = gate1; }
            }
            __syncthreads();
        }
        if (!DRY && F.tid < 32) {
            const int rl = F.tid, m = m0 + rl; const int ee = ((LAS int*)info)[96 + rl], ex0 = ee & 255, ex1 = ee >> 8; const float gate0 = info[128 + rl], gate1 = info[160 + rl];
            const unsigned pos0 = atomicAdd(F.ctl + CW_CNT + CNT_STRIDE * ex0, 1u), pos1 = atomicAdd(F.ctl + CW_CNT + CNT_STRIDE * ex1, 1u);
            F.LISTT[ex0 * T + pos0] = m; F.LISTG[ex0 * T + pos0] = gate0;
            F.LISTT[ex1 * T + pos1] = m; F.LISTG[ex1 * T + pos1] = gate1;
            F.ROUTE[m * 4 + 0] = (unsigned)(ex0 * T) + pos0; F.ROUTE[m * 4 + 1] = (unsigned)(ex1 * T) + pos1;
        }
    }
}

__device__ __forceinline__ void moe_offsets(Frame& F, LAS int* offs  , LAS int* toff  ) {
    if (F.tid < 64) { const int c = (int)__hip_atomic_load(F.ctl + CW_CNT + CNT_STRIDE * F.tid, __ATOMIC_RELAXED, __HIP_MEMORY_SCOPE_AGENT); const int tc = (c + 63) / 64; int incl = c, tincl = tc;
#pragma unroll
        for (int o = 1; o < 64; o <<= 1) { const int v = __shfl_up(incl, o), tv = __shfl_up(tincl, o); if (F.tid >= o) { incl += v; tincl += tv; } }
        offs[F.tid] = incl - c; toff[F.tid] = tincl - tc; if (F.tid == 63) { offs[NE] = incl; toff[NE] = tincl; } }
    __syncthreads();
}
__device__ __forceinline__ void p7_moe1(Frame& F) {
    LAS float* L = (LAS float*)F.lds;
    LAS int* offs = (LAS int*)(L + 8192 * 3); LAS int* toff = offs + 80;
    moe_offsets(F, offs, toff);
    const int ntiles = toff[NE];
    for (int u = F.bid; u < ntiles * 8; u += F.G) {
        const int rt = u >> 3, ct = u & 7;
        int e = 0; while (toff[e + 1] <= rt) ++e;
        const int r0 = (rt - toff[e]) * 64, ne = offs[e + 1] - offs[e];
        const int* lt = F.LISTT + e * T + r0;
        const float* W1 = F.w1e + (size_t)e * D * FF + ct * 64; const float* W3 = F.w3e + (size_t)e * D * FF + ct * 64;
        const bf16* H2 = F.H2;
        auto la = [&](int r, int k) -> float { return (r0 + r < ne) ? bf2f(H2[(size_t)lt[r] * D + k]) : 0.f; };
        auto lb = [&](int q, int k, int c) -> float { return (q == 0 ? W1 : W3)[(size_t)k * FF + c]; };
        float* ACT = F.ACT + (size_t)(offs[e] + r0) * FF + ct * 64;
        auto ep = [&](int r, int c, const float (&v)[2]) { if (r0 + r < ne) { const float a = v[0], bb = v[1]; ACT[(size_t)r * FF + c] = (a / (1.0f + __expf(-a))) * bb; } };
        simt_tile<2>(L, D, F.tid, la, lb, ep);
    }
}
__device__ __forceinline__ void p8_moe2(Frame& F) {
    LAS float* L = (LAS float*)F.lds;
    LAS int* offs = (LAS int*)(L + 8192 * 3); LAS int* toff = offs + 80;
    moe_offsets(F, offs, toff);
    const int ntiles = toff[NE];
    for (int u = F.bid; u < ntiles * 32; u += F.G) {
        const int rt = u >> 5, ct = u & 31;
        int e = 0; while (toff[e + 1] <= rt) ++e;
        const int r0 = (rt - toff[e]) * 64, ne = offs[e + 1] - offs[e];
        const float* A = F.ACT + (size_t)(offs[e] + r0) * FF;
        const float* W2 = F.w2e + (size_t)e * FF * D + ct * 64;
        const float* lg = F.LISTG + e * T + r0;
        auto la = [&](int r, int k) -> float { return (r0 + r < ne) ? A[(size_t)r * FF + k] : 0.f; };
        auto lb = [&](int q, int k, int c) -> float { return W2[(size_t)k * D + c]; };
        float* YB = F.YB + (size_t)(offs[e] + r0) * D + ct * 64;
        auto ep = [&](int r, int c, const float (&v)[1]) { if (r0 + r < ne) YB[(size_t)r * D + c] = v[0] * lg[r]; };
        simt_tile<1>(L, FF, F.tid, la, lb, ep);
    }
}

template <int MODE, int VAR = 0>
__device__ __forceinline__ void moe_mfma(Frame& F) {
    constexpr int K = MODE == 0 ? D : FF, LDW = MODE == 0 ? FF : D, NSL = MODE == 0 ? 8 : 16, NK = K / 32;
    constexpr int RPP = 368, NT = 23, S = MOE_S, WST = 16384, XST = NT * 1024, STB = WST + XST;
    static_assert(S * STB <= MOE_OFFS_OFF, "MoE stage ring vs LDS map");
    typedef short bf16x8 __attribute__((ext_vector_type(8)));
    LAS unsigned char* lds = F.lds;
    LAS int* offs = (LAS int*)(lds + MOE_OFFS_OFF);
    __syncthreads();
    if (F.tid < 64) { const int c = (int)__hip_atomic_load(F.ctl + CW_CNT + CNT_STRIDE * F.tid, __ATOMIC_RELAXED, __HIP_MEMORY_SCOPE_AGENT); int incl = c;
#pragma unroll
        for (int o = 1; o < 64; o <<= 1) { const int v = __shfl_up(incl, o); if (F.tid >= o) incl += v; }
        offs[F.tid] = incl - c; if (F.tid == 63) offs[NE] = incl; }
    __syncthreads();
    const int lane = F.lane, w = F.wave, cq = w & 3, rh = w >> 2;
    const int vcu = (F.G % 8 == 0) ? (F.bid % 8) * (F.G / 8) + F.bid / 8 : F.bid;
    for (int u = vcu; u < NE * NSL; u += F.G) {
        const int e = u / NSL, sl = u % NSL;
        const int oe = offs[e], ne = offs[e + 1] - oe;
        if (ne == 0) continue;
        const float* Wm0; const float* Wm1;
        if (MODE == 0) { Wm0 = F.w1e + (size_t)e * D * FF + sl * 64; Wm1 = F.w3e + (size_t)e * D * FF + sl * 64; }
        else { Wm0 = F.w2e + (size_t)e * FF * D + sl * 128; Wm1 = Wm0 + 64; }
        for (int r0 = 0; r0 < ne; r0 += RPP) {
            const int nr = (ne - r0) < RPP ? (ne - r0) : RPP, ntile = (nr + 15) >> 4;
            const char* xsrc[3]; unsigned xdst[3];
#pragma unroll
            for (int i = 0; i < 3; ++i) { int tile = 3 * w + i; if (tile > NT - 1) tile = NT - 1;
                int row = r0 + 16 * tile + (lane >> 2); if (row > ne - 1) row = ne - 1;
                const size_t srow = (MODE == 0) ? (size_t)F.LISTT[e * T + row] : (size_t)(oe + row);
                xsrc[i] = (const char*)(MODE == 0 ? (const void*)F.H2 : (const void*)F.ACTB) + srow * (size_t)(K * 2) + (lane & 3) * 16;
                xdst[i] = (unsigned)(WST + tile * 1024); }
            const char* wsrc[2]; unsigned wdst[2];
#pragma unroll
            for (int i = 0; i < 2; ++i) { const int kr = 8 * (w & 3) + 4 * i;
                wsrc[i] = (const char*)((w >> 2) ? Wm1 : Wm0) + ((size_t)(kr + (lane >> 4)) * LDW) * 4 + (lane & 15) * 16;
                if (VAR == 10) wsrc[i] = (const char*)F.w1e + (size_t)(u & 255) * (K * 128 * 4) + (size_t)(2 * w + i) * 1024 + lane * 16;
                wdst[i] = (unsigned)((w >> 2) * 8192 + kr * 256); }
            asm volatile("s_waitcnt vmcnt(0)" ::: "memory");
#define MOE_ISSUE(stage, ks) do { const unsigned _sb = (unsigned)(stage) * STB; const size_t _kx = (size_t)(ks) * 64, _kw = (VAR == 10) ? (size_t)(ks) * 16384 : (size_t)(ks) * 32 * LDW * 4; \
            if (VAR < 8) { _Pragma("unroll") for (int _i = 0; _i < 3; ++_i) __builtin_amdgcn_global_load_lds((const unsigned*)(xsrc[_i] + _kx), (LAS unsigned*)(lds + _sb + xdst[_i]), 16, 0, 0); } \
                        { _Pragma("unroll") for (int _i = 0; _i < 2; ++_i) __builtin_amdgcn_global_load_lds((const unsigned*)(wsrc[_i] + _kw), (LAS unsigned*)(lds + _sb + wdst[_i]), 16, 0, 2  ); } } while (0)
            if (VAR >= 11) {
                v4u r[4][2];
#pragma unroll
                for (int q = 0; q < 4; ++q) { r[q][0] = (v4u){0u, 0u, 0u, 0u}; r[q][1] = (v4u){0u, 0u, 0u, 0u}; }
#define RS_LOAD(slot, ks) do { const size_t _kw = (size_t)(ks) * 32 * LDW * 4; _Pragma("unroll") for (int _i = 0; _i < 2; ++_i) { \
                    if (VAR == 11) asm volatile("global_load_dwordx4 %0, %1, off nt" : "+v"(r[slot][_i]) : "v"(wsrc[_i] + _kw) : "memory"); \
                    else asm volatile("global_load_dwordx4 %0, %1, off" : "+v"(r[slot][_i]) : "v"(wsrc[_i] + _kw) : "memory"); } } while (0)
                RS_LOAD(0, 0); RS_LOAD(1, 1); RS_LOAD(2, 2);
#pragma unroll 1
                for (int t = 0; t < NK; t += 4) {
#pragma unroll
                    for (int q = 0; q < 4; ++q) { asm volatile("s_waitcnt vmcnt(4)" ::: "memory"); __builtin_amdgcn_s_barrier(); const int tn = t + q + 3; RS_LOAD((q + 3) & 3, tn < NK ? tn : 0); }
                }
                asm volatile("s_waitcnt vmcnt(0)" : "+v"(r[0][0]), "+v"(r[0][1]), "+v"(r[1][0]), "+v"(r[1][1]), "+v"(r[2][0]), "+v"(r[2][1]), "+v"(r[3][0]), "+v"(r[3][1]) :: "memory");
                unsigned sk = 0u;
#pragma unroll
                for (int q = 0; q < 4; ++q) sk ^= r[q][0].x ^ r[q][1].y;
                if (sk == 0x9e3779b9u) F.ctl[200] = sk;
                __builtin_amdgcn_s_barrier();
#undef RS_LOAD
                continue;
            }
            f32x4 acc[2][12]; unsigned sink = 0u;
#pragma unroll
            for (int m = 0; m < 2; ++m)
#pragma unroll
                for (int j = 0; j < 12; ++j) acc[m][j] = (f32x4){0.f, 0.f, 0.f, 0.f};
#pragma unroll
            for (int s = 0; s < S - 1; ++s) MOE_ISSUE(s, s);
            const unsigned wrd = (unsigned)((8 * (lane >> 4)) * 256 + (16 * cq + (lane & 15)) * 4);
            const unsigned xrd = (unsigned)(WST + (lane & 15) * 64 + (lane >> 4) * 16);
#pragma unroll 1
            for (int t = 0; t < NK; ++t) {
                if (VAR >= 8) asm volatile("s_waitcnt vmcnt(4)" ::: "memory"); else
                if (S == 3) asm volatile("s_waitcnt vmcnt(5)" ::: "memory"); else asm volatile("s_waitcnt vmcnt(10)" ::: "memory");
                __builtin_amdgcn_s_barrier();
                asm volatile("" ::: "memory");
                { const int tn = t + S - 1; MOE_ISSUE((S == 4 ? (tn & 3) : (tn % S)), tn < NK ? tn : 0); }
                if (VAR >= 8) continue;
                const unsigned sb = (unsigned)(S == 4 ? (t & 3) : (t % S)) * STB;
                bf16x8 af[2];
#pragma unroll
                for (int m = 0; m < 2; ++m) { float f[8];
#pragma unroll
                    for (int j = 0; j < 8; ++j) f[j] = *(const LAS float*)(lds + sb + m * 8192 + wrd + j * 256);
                    union { bf16x8 v; unsigned u[4]; } cv;
#pragma unroll
                    for (int p = 0; p < 4; ++p) cv.u[p] = pg8::cvt_pk_bf16(f[2 * p], f[2 * p + 1]);
                    af[m] = cv.v; }
#pragma unroll
                for (int jb = 0; jb < 12; jb += 6) { bf16x8 xb[6];
#pragma unroll
                    for (int q = 0; q < 6; ++q) { int tile = 2 * (jb + q) + rh; if (tile > NT - 1) tile = NT - 1; xb[q] = *(const LAS bf16x8*)(lds + sb + xrd + tile * 1024); }
#pragma unroll
                    for (int q = 0; q < 6; ++q) { const int j = jb + q;
                        if (2 * j + rh < ntile) {
                            acc[0][j] = __builtin_amdgcn_mfma_f32_16x16x32_bf16(af[0], xb[q], acc[0][j], 0, 0, 0);
                            acc[1][j] = __builtin_amdgcn_mfma_f32_16x16x32_bf16(af[1], xb[q], acc[1][j], 0, 0, 0); } } }
            }
            asm volatile("s_waitcnt vmcnt(0)" ::: "memory");
            __builtin_amdgcn_s_barrier();
            asm volatile("" ::: "memory");
            if (VAR >= 11 && sink == 0x9e3779b9u) F.ctl[200] = sink;
#undef MOE_ISSUE
#pragma unroll
            for (int j = 0; j < 12; ++j) { const int tile = 2 * j + rh, row = r0 + 16 * tile + (lane & 15);
                if (tile < ntile && row < ne) {
                    if (MODE == 0) { const f32x4 a = acc[0][j], b = acc[1][j]; f32x4 v;
#pragma unroll
                        for (int i = 0; i < 4; ++i) v[i] = (a[i] / (1.0f + __expf(-a[i]))) * b[i];
                        v2u o; o.x = pk2(v[0], v[1]); o.y = pk2(v[2], v[3]);
                        *(v2u*)((VAR ? F.YBB : F.ACTB) + (size_t)(oe + row) * FF + sl * 64 + 16 * cq + 4 * (lane >> 4)) = o; }
                    else { const float g = F.LISTG[e * T + row]; const f32x4 a = acc[0][j] * g, b = acc[1][j] * g;
                        bf16* yp = F.YBB + (size_t)(oe + row) * D + sl * 128 + 16 * cq + 4 * (lane >> 4);
                        v2u o0; o0.x = pk2(a[0], a[1]); o0.y = pk2(a[2], a[3]); *(v2u*)yp = o0;
                        v2u o1; o1.x = pk2(b[0], b[1]); o1.y = pk2(b[2], b[3]); *(v2u*)(yp + 64) = o1; }
                } }
        }
    }
}
__device__ __forceinline__ void p9_final(Frame& F) {
    LAS float* L = (LAS float*)F.lds;
    LAS float* gatef = L;
    LAS int* offs = (LAS int*)(L + 8192 * 3); LAS int* toff = offs + 80;
    load_mod(F, gatef, 5);
    LAS float* gpo = L + 2 * D;
    *(LAS f32x4*)(gpo + 4 * F.tid) = *(const f32x4*)(F.g_ffn_post + 4 * F.tid);
    moe_offsets(F, offs, toff);
    const int gw = F.bid * NWAVES + F.wave, NGW = F.G * NWAVES;
#if MOE_SIMT
    for (int m = gw; m < T; m += NGW) {
        const int b = m / SEQ;
        const unsigned s0 = F.ROUTE[m * 4 + 0], s1 = F.ROUTE[m * 4 + 1];
        const size_t r0 = (size_t)offs[s0 / T] + (s0 % T), r1 = (size_t)offs[s1 / T] + (s1 % T);
        f32x4 v[8]; float s = 0.f;
        const f32x4* y0 = (const f32x4*)(F.YB + r0 * D) + F.lane; const f32x4* y1 = (const f32x4*)(F.YB + r1 * D) + F.lane;
#pragma unroll
        for (int j = 0; j < 8; ++j) { v[j] = y0[64 * j] + y1[64 * j]; s += (v[j].x * v[j].x + v[j].y * v[j].y) + (v[j].z * v[j].z + v[j].w * v[j].w); }
        const float rstd = 1.0f / sqrtf(wave_sum(s) * (1.f / D) + RMS_EPS);
        const f32x4* x1r = (const f32x4*)(F.X1 + (size_t)m * D) + F.lane; f32x4* outr = (f32x4*)(F.out + (size_t)m * D) + F.lane;
#pragma unroll
        for (int j = 0; j < 8; ++j) { const int d = 256 * j + 4 * F.lane;
            const f32x4 g = *(LAS f32x4*)(gpo + d), gf = *(LAS f32x4*)(gatef + b * D + d);
            outr[64 * j] = x1r[64 * j] + gf * ((v[j] * rstd) * g); }
    }
#else
    for (int m0 = gw; m0 < T; m0 += 2 * NGW) {
        unsigned sl[2][2];
#pragma unroll
        for (int r = 0; r < 2; ++r) { const int m = m0 + r * NGW; if (m < T) { sl[r][0] = F.ROUTE[m * 4 + 0]; sl[r][1] = F.ROUTE[m * 4 + 1]; } else { sl[r][0] = 0; sl[r][1] = 0; } }
        v2u ya[2][8], yb[2][8]; f32x4 xv[2][8];
#pragma unroll
        for (int r = 0; r < 2; ++r) { const int m = m0 + r * NGW; if (m < T) {
            const size_t r0 = (size_t)offs[sl[r][0] / T] + (sl[r][0] % T), r1 = (size_t)offs[sl[r][1] / T] + (sl[r][1] % T);
            const v2u* y0 = (const v2u*)(F.YBB + r0 * D) + F.lane; const v2u* y1 = (const v2u*)(F.YBB + r1 * D) + F.lane; const f32x4* x1r = (const f32x4*)(F.X1 + (size_t)m * D) + F.lane;
#pragma unroll
            for (int j = 0; j < 8; ++j) { ya[r][j] = y0[64 * j]; yb[r][j] = y1[64 * j]; xv[r][j] = x1r[64 * j]; } } }
#pragma unroll
        for (int r = 0; r < 2; ++r) { const int m = m0 + r * NGW; if (m < T) { const int b = m / SEQ; f32x4 v[8]; float s = 0.f;
#pragma unroll
            for (int j = 0; j < 8; ++j) { const v2u a = ya[r][j], b2 = yb[r][j];
                v[j] = (f32x4){bflo(a.x) + bflo(b2.x), bfhi(a.x) + bfhi(b2.x), bflo(a.y) + bflo(b2.y), bfhi(a.y) + bfhi(b2.y)};
                s += (v[j].x * v[j].x + v[j].y * v[j].y) + (v[j].z * v[j].z + v[j].w * v[j].w); }
            const float rstd = 1.0f / sqrtf(wave_sum(s) * (1.f / D) + RMS_EPS);
            f32x4* outr = (f32x4*)(F.out + (size_t)m * D) + F.lane;
#pragma unroll
            for (int j = 0; j < 8; ++j) { const int d = 256 * j + 4 * F.lane;
                const f32x4 g = *(LAS f32x4*)(gpo + d), gf = *(LAS f32x4*)(gatef + b * D + d);
                outr[64 * j] = xv[r][j] + gf * ((v[j] * rstd) * g); } } }
    }
#endif
}

#if SIMPLE_GEMM
template <class EP>
__device__ __forceinline__ void simple_gemm(Frame& F, const bf16* A, const bf16* Bt, int M, int N, int K, const EP& ep) {
    LAS float* L = (LAS float*)F.lds;
    const int tn = N / 64, nt = (M / 64) * tn;
    for (int u = F.bid; u < nt; u += F.G) {
        const int r0 = (u / tn) * 64, c0 = (u % tn) * 64;
        auto la = [&](int r, int k) -> float { return bf2f(A[(size_t)(r0 + r) * K + k]); };
        auto lb = [&](int q, int k, int c) -> float { return bf2f(Bt[(size_t)(c0 + c) * K + k]); };
        auto e2 = [&](int r, int c, const float (&v)[1]) { ep(r0 + r, c0 + c, v[0]); };
        simt_tile<1>(L, K, F.tid, la, lb, e2);
    }
}
#endif

#ifndef REPEAT_MASK
#define REPEAT_MASK 0
#endif
__device__ __forceinline__ void phase_gemm2(Frame& F) {
#if SIMPLE_GEMM
        { bf16* PHY = F.PHY; simple_gemm(F, F.W1T, F.H, 3 * HW, T, D, [&](int r, int c, float v) { PHY[(size_t)r * T + c] = (bf16)f2bf(v); }); }
        __syncthreads();
        { bf16* QKVp = F.QKV; bf16* Gp = F.GT; const float* bias = F.b_bg;
          simple_gemm(F, F.H, F.W1T + (size_t)(3 * HW) * D, T, QKVW + 2 * D, D, [&](int r, int c, float v) {
              if (c < QKVW) QKVp[(size_t)r * QKVW + c] = (bf16)f2bf(v); else Gp[(size_t)r * (2 * D) + (c - QKVW)] = (bf16)f2bf(1.0f / (1.0f + __expf(-(v + bias[c - QKVW])))); }); }
#else
        { DualOrder S; S.s0.init(3 * HW, T, 1, 0); S.s1.init(T, QKVW + 2 * D, 1, 0); S.G = F.G; S.c = F.bid;
          S.A0 = F.W1T; S.B0 = F.H; S.A1 = F.H; S.B1 = F.W1T + (size_t)(3 * HW) * D;
          EpiDual E{EpiPlainBf16{F.PHY, T}, EpiProj{F.QKV, F.GT, F.ROT, F.b_bg}};
          pg8::Gemm g{F.H, F.H, T, T, D};
          pg8::gemm_phase<EpiDual, DualOrder, true, true>(F.lds, g, S, E); }
#endif
}
__device__ __forceinline__ void phase_gemm6(Frame& F) {
#if SIMPLE_GEMM
        { float* TMP = F.TMP; const bf16* G = F.GT; simple_gemm(F, F.YHY, F.WHYOT, T, D, HW, [&](int r, int c, float v) { TMP[(size_t)r * D + c] = v * bf2f(G[(size_t)r * (2 * D) + c]); }); }
        __syncthreads();
        { float* TMP = F.TMP; const bf16* G = F.GT; bf16* Mp = F.MERGED; simple_gemm(F, F.YAT, F.WATOT, T, D, 512, [&](int r, int c, float v) { Mp[(size_t)r * D + c] = (bf16)f2bf(TMP[(size_t)r * D + c] + v * bf2f(G[(size_t)r * (2 * D) + D + c])); }); }
#else
        { EpiGate<0> E{F.GT, 0, F.TMP, F.MERGED}; run_gemm(F, F.YHY, F.WHYOT, T, D, HW, E); }
        { EpiGate<1> E{F.GT, D, F.TMP, F.MERGED}; run_gemm(F, F.YAT, F.WATOT, T, D, 512, E); }
#endif
}
__device__ __forceinline__ void phase_gemm7(Frame& F) {
#if SIMPLE_GEMM
        { float* Y = F.Y; simple_gemm(F, F.MERGED, F.WOUTT, T, D, D, [&](int r, int c, float v) { Y[(size_t)r * D + c] = v; }); }
#else
        { EpiPlainBf16 E{(bf16*)F.Y, D}; run_gemm(F, F.MERGED, F.WOUTT, T, D, D, E); }
#endif
}
__global__ void __launch_bounds__(NTHR, 2) fwd_kernel(Args args) {
    extern __shared__ __attribute__((aligned(16))) unsigned char lds_raw[];
    Frame F;
    F.lds = (LAS unsigned char*)lds_raw;
    F.tid = threadIdx.x; F.lane = F.tid & 63; F.wave = __builtin_amdgcn_readfirstlane(F.tid >> 6); F.G = gridDim.x; F.bid = blockIdx.x;
    F.x = (const float*)args.in[0]; F.c = (const float*)args.in[1]; F.positions = (const int*)args.in[2]; F.w_ada = (const float*)args.in[3]; F.b_ada = (const float*)args.in[4];
    F.g_mix_pre = (const float*)args.in[5]; F.g_mix_post = (const float*)args.in[6]; F.g_ffn_pre = (const float*)args.in[7]; F.g_ffn_post = (const float*)args.in[8];
    F.w_in = (const float*)args.in[9]; F.conv_w = (const float*)args.in[10]; F.conv_b = (const float*)args.in[11]; F.fw1 = (const float*)args.in[12]; F.fb1 = (const float*)args.in[13];
    F.fw2 = (const float*)args.in[14]; F.fb2 = (const float*)args.in[15]; F.fw3 = (const float*)args.in[16]; F.ffreq = (const float*)args.in[17]; F.hskip = (const float*)args.in[18];
    F.w_bg = (const float*)args.in[19]; F.b_bg = (const float*)args.in[20]; F.w_hy_o = (const float*)args.in[21]; F.w_at_o = (const float*)args.in[22]; F.w_out = (const float*)args.in[23];
    F.w_group = (const float*)args.in[24]; F.b_group = (const float*)args.in[25]; F.w_expert = (const float*)args.in[26]; F.b_expert = (const float*)args.in[27];
    F.w1e = (const float*)args.in[28]; F.w3e = (const float*)args.in[29]; F.w2e = (const float*)args.in[30];
    F.out = args.out;
    unsigned char* ws = args.ws;
    F.ctl = (unsigned*)(ws + WS_CTL); F.MODP = (float*)(ws + WS_MODP); F.HID2 = (float*)(ws + WS_HID2); F.ROT = (float*)(ws + WS_ROT); F.W3T = (float*)(ws + WS_W3T);
    F.WGT = (float*)(ws + WS_WGT); F.WET = (float*)(ws + WS_WET); F.HID2B = (bf16*)(ws + WS_HID2B); F.W3TB = (bf16*)(ws + WS_W3TB);
    F.ROUTE = (unsigned*)(ws + WS_ROUTE); F.LISTT = (int*)(ws + WS_LISTT); F.LISTG = (float*)(ws + WS_LISTG);
    F.W1T = (bf16*)(ws + WS_W1T); F.WHYOT = (bf16*)(ws + WS_WHYOT); F.WATOT = (bf16*)(ws + WS_WATOT); F.WOUTT = (bf16*)(ws + WS_WOUTT);
    F.KF = (bf16*)(ws + WS_KF); F.H = (bf16*)(ws + WS_H); F.PHY = (bf16*)(ws + WS_PHY); F.QKV = (bf16*)(ws + WS_QKV); F.GT = (bf16*)(ws + WS_G);
    F.YHY = (bf16*)(ws + WS_YHY); F.YAT = (bf16*)(ws + WS_YAT); F.TMP = (float*)(ws + WS_TMP); F.MERGED = (bf16*)(ws + WS_MERGED); F.Y = (float*)(ws + WS_Y);
    F.X1 = (float*)(ws + WS_X1); F.H2 = (bf16*)(ws + WS_H2); F.ACT = (float*)(ws + WS_ACT); F.YB = (float*)(ws + WS_YB); F.ACTB = (bf16*)(ws + WS_ACT); F.YBB = (bf16*)(ws + WS_YB);

    volatile LAS unsigned* MISC = (volatile LAS unsigned*)(F.lds + MISC_OFF);
    if (F.tid < 32) MISC[F.tid] = 0u;
    __syncthreads();
    const int lo = args.ph_lo, hi = args.ph_hi;
    const bool multi = (hi - lo) > 1;
#if TLB_TOUCH
    {
        unsigned acc = 0u; const int sub = F.bid >> 3;
        const size_t nws = WS_END >> 21;
        for (size_t p = (size_t)sub * 16 + (F.tid >> 5); p < nws; p += 512) if ((F.tid & 31) == 0) acc += *(const volatile unsigned*)(ws + (p << 21));
        const void* big[8] = {args.in[0], args.in[3], args.in[9], args.in[19], args.in[23], args.in[28], args.in[29], args.in[30]};
        const size_t bsz[8] = {(size_t)T * D * 4, (size_t)D * 6 * D * 4, (size_t)D * INW * 4, (size_t)D * 2 * D * 4, (size_t)D * D * 4, (size_t)NE * D * FF * 4, (size_t)NE * D * FF * 4, (size_t)NE * D * FF * 4};
#pragma unroll
        for (int q = 0; q < 8; ++q) { const size_t np = bsz[q] >> 21;
            for (size_t p = (size_t)sub * 16 + (F.tid >> 5); p < np; p += 512) if ((F.tid & 31) == 0) acc += *(const volatile unsigned*)((const unsigned char*)big[q] + (p << 21)); }
        if (acc == 0x12345679u) F.ctl[100] = acc;
    }
#endif
    XcdBarrier bar; bar.bar = F.ctl + CW_BAR; bar.x = 0; bar.st = nullptr;
    if (multi) bar = xcd_barrier_post(F.ctl + CW_BAR, MISC + 8);
#ifndef PHASE_MASK
#define PHASE_MASK 0xFFFF
#endif
#define IN(k) ((((PHASE_MASK) >> (k)) & 1) && lo <= (k) && (k) < hi)
#ifndef REPEAT_MASK
#define REPEAT_MASK 0
#endif
#define REP(k) for (int _rep = 0; _rep < 1 + (((REPEAT_MASK) >> (k)) & 1); ++_rep)
#ifndef PROBE_TS
#define PROBE_TS -1
#endif
#ifndef PROBE_TSB
#define PROBE_TSB (PROBE_TS + 1)
#endif
#define STAMP(i) do { if (PROBE_TS >= -1 && F.bid == 0 && F.tid == 0) ((unsigned long long*)(F.ctl + 65536))[i] = __builtin_amdgcn_s_memrealtime(); } while (0)
#define SEAM(k) do { if (IN(k) && IN((k) + 1)) xcd_barrier(bar); if (PROBE_TS >= 0) STAMP((k) + 1); } while (0)

#ifndef P0_SKIP
#define P0_SKIP 0
#endif
    if (IN(0)) { p0_prologue<0>(F); if ((REPEAT_MASK) & 1) { __syncthreads(); p0_prologue<P0_SKIP>(F); } } SEAM(0);
    if (IN(1)) REP(1) { __syncthreads(); p1_rows_filters(F); } SEAM(1);
    if (IN(2)) { phase_gemm2(F); if (((REPEAT_MASK) >> 2) & 1) { __syncthreads(); phase_gemm2(F); } } SEAM(2);
    if (IN(3)) {
#if SIMPLE_GEMM
        for (int i = F.bid * NTHR + F.tid; i < T * 24 * 16; i += F.G * NTHR) { const int k = i & 15, hd = (i >> 4) % 24, tok = (i >> 4) / 24;
            bf16* p = F.QKV + (size_t)tok * QKVW + hd * HD; const float a = bf2f(p[k]), b2 = bf2f(p[k + 16]), cs = F.ROT[tok * 32 + k], sn = F.ROT[tok * 32 + 16 + k];
            p[k] = (bf16)f2bf(a * cs - b2 * sn); p[k + 16] = (bf16)f2bf(b2 * cs + a * sn); }
#endif
    }
#if SIMPLE_GEMM
    SEAM(3);
#endif
#if HYENA_NAIVE
    if (IN(4)) { p3_hyena_naive(F); __syncthreads(); p3_attn_naive(F); } SEAM(4);
#elif ATTN_NAIVE
    if (IN(4)) { p3_hyena_mfma(F); __syncthreads(); p3_attn_naive(F); } SEAM(4);
#else
#ifndef P4_PARTS
#define P4_PARTS 3
#endif
    if (IN(4)) REP(4) { __syncthreads(); if (P4_PARTS & 1) p3_hyena_mfma(F); __syncthreads(); if (P4_PARTS & 2) p4_attn_mfma(F);
#if ATTN_REP
        __syncthreads(); p4_attn_mfma(F);
#endif
    } SEAM(4);
    if (IN(5)) REP(5) { p4b_combine(F); } SEAM(5);
#endif
    if (IN(6)) { phase_gemm6(F); if (((REPEAT_MASK) >> 6) & 1) { __syncthreads(); phase_gemm6(F); } } SEAM(6);
    if (IN(7)) { phase_gemm7(F); if (((REPEAT_MASK) >> 7) & 1) { __syncthreads(); phase_gemm7(F); } } SEAM(7);
#ifndef EXTRA_BARRIERS
#define EXTRA_BARRIERS 0
#endif
    if (IN(8)) { if (((REPEAT_MASK) >> 8) & 1) { p6_rows_router<true>(F); __syncthreads(); } for (int _e = 0; _e < EXTRA_BARRIERS; ++_e) xcd_barrier(bar); p6_rows_router<false>(F); } SEAM(8);
#if MOE_SIMT
    if (IN(9)) { p7_moe1(F); } SEAM(9);
    if (IN(10)) { p8_moe2(F); } SEAM(10);
#else
#ifndef MOE_SHADOW
#define MOE_SHADOW 0
#endif
    if (IN(9)) { if (MOE_SHADOW) { moe_mfma<0, (MOE_SHADOW ? MOE_SHADOW : 8)>(F); __syncthreads(); } } if (IN(9)) REP(9) { moe_mfma<0>(F); } SEAM(9);
    if (IN(10)) REP(10) { moe_mfma<1>(F); } SEAM(10);
#endif
    if (IN(11)) REP(11) { __syncthreads(); p9_final(F); }
#if PROBE_TS >= 0
    if (F.bid == 0 && F.tid == 0) { asm volatile("s_waitcnt vmcnt(0)" ::: "memory");
        const unsigned long long* ts = (const unsigned long long*)(F.ctl + 65536);
        const float us = (PROBE_TS == 99) ? 100.0f : (float)(ts[PROBE_TSB] - ts[PROBE_TS]) * 0.01f;
        F.out[0] += sqrtf(198.0f * us); }
#endif
#undef IN
#undef SEAM
}

extern "C" void kernel_launch(void* const* d_in, const int* in_sizes, int n_in, void* d_out, int out_size, void* d_ws, size_t ws_size, hipStream_t stream) {
    static int grid = 0;
    if (grid == 0) {
        if (n_in != 31 || out_size != T * D || ws_size < WS_END) { fprintf(stderr, "kernel_launch: unexpected shapes (n_in %d out %d ws %zu)\n", n_in, out_size, ws_size); grid = -1; return; }
        int dev = 0, cus = 0, per_cu = 0;
        if (hipGetDevice(&dev) != hipSuccess || hipDeviceGetAttribute(&cus, hipDeviceAttributeMultiprocessorCount, dev) != hipSuccess) { grid = -1; return; }
        if (hipFuncSetAttribute((const void*)fwd_kernel, hipFuncAttributeMaxDynamicSharedMemorySize, LDS_BYTES) != hipSuccess) { fprintf(stderr, "kernel_launch: hipFuncSetAttribute failed\n"); grid = -1; return; }
        if (hipOccupancyMaxActiveBlocksPerMultiprocessor(&per_cu, (const void*)fwd_kernel, NTHR, LDS_BYTES) != hipSuccess || per_cu < 1) fprintf(stderr, "kernel_launch: occupancy query says %d\n", per_cu);
        (void)hipGetLastError();
        grid = cus;
    }
    if (grid < 0) return;
    if (hipMemsetAsync((char*)d_ws + WS_CTL, 0, CTL_ZERO_BYTES, stream) != hipSuccess) return;
    Args a{};
    for (int i = 0; i < 31; ++i) a.in[i] = d_in[i];
    a.out = (float*)d_out; a.ws = (unsigned char*)d_ws;
#if N_LAUNCH_MODE == 1
    a.ph_lo = 0; a.ph_hi = NPHASE;
    hipLaunchKernelGGL(fwd_kernel, dim3(grid), dim3(NTHR), LDS_BYTES, stream, a);
#else
    for (int p = 0; p < NPHASE; ++p) { if (p == 3 && !SIMPLE_GEMM) continue; if (p == 5 && (HYENA_NAIVE || ATTN_NAIVE)) continue; a.ph_lo = p; a.ph_hi = p + 1; hipLaunchKernelGGL(fwd_kernel, dim3(grid), dim3(NTHR), LDS_BYTES, stream, a); }
#endif
}
```

```cpp
#include <hip/hip_runtime.h>
#include <cstdio>
#include <cstdint>
namespace pg8 {
#define PG8_LAS __attribute__((address_space(3)))
typedef unsigned short bf16_t;
typedef short bf16x8 __attribute__((ext_vector_type(8)));
typedef float f32x4 __attribute__((ext_vector_type(4)));
typedef unsigned u32x4 __attribute__((ext_vector_type(4)));
constexpr int BM = 256, BK = 64, HALF = 128, HTB = HALF * BK * 2  , STAGE_BYTES = 8 * HTB, NXCD = 8, WGM = 8;

__host__ __device__ __forceinline__ int lds_byte(int r, int c) { const int st = (r >> 4) * 2 + (c >> 5), rr = r & 15, cc = c & 31, ob = rr * 64 + cc * 2; return st * 1024 + (ob ^ (((ob >> 9) & 1) << 5)); }
__host__ __device__ __forceinline__ void stage_rc(int b, int& R, int& C) { const int st = b / 1024, sb = b % 1024, swz = sb ^ (((sb >> 9) & 1) << 5); R = (st >> 1) * 16 + swz / 64; C = (st & 1) * 32 + (swz % 64) / 2; }
__host__ __device__ __forceinline__ int perm32(int rho) { const int n = rho >> 4, i = rho & 15; return 8 * (i >> 2) + 4 * n + (i & 3); }

struct Unit { int pm, pn, kind; };
struct Gemm { const bf16_t* A; const bf16_t* Bt; int M, N, K; };

struct StaticOrder {
    int nM, nN, nwg, G, c;
    __host__ __device__ void init(int M, int N, int G_, int c_) { nM = M / BM; nN = N / BM; nwg = nM * nN; G = G_; c = c_; }
    __host__ __device__ bool next(int i, Unit& u) const {
        const long L = (long)i * G + c; if (L >= nwg) return false;
        int wgid = (int)L; { const int q = nwg / NXCD, r = nwg % NXCD, xcd = wgid % NXCD, off = wgid / NXCD; wgid = (xcd < r ? xcd * (q + 1) : r * (q + 1) + (xcd - r) * q) + off; }
        const int nig = WGM * nN, gid = wgid / nig, fm = gid * WGM, gsz = (nM - fm) < WGM ? (nM - fm) : WGM;
        u.pm = fm + ((wgid % nig) % gsz); u.pn = (wgid % nig) / gsz; u.kind = 0; return true;
    }
    __device__ __forceinline__ void a_ready(const Unit&) const {}
    __device__ __forceinline__ void done(const Unit&) const {}
    __device__ __forceinline__ const bf16_t* abase(const Gemm& g, const Unit&) const { return g.A; }
    __device__ __forceinline__ const bf16_t* bbase(const Gemm& g, const Unit&) const { return g.Bt; }
};

__device__ __forceinline__ unsigned cvt_pk_bf16(float lo, float hi) { unsigned r; asm volatile("v_cvt_pk_bf16_f32 %0, %1, %2" : "=v"(r) : "v"(lo), "v"(hi)); return r; }
typedef float f32x2 __attribute__((ext_vector_type(2)));
template <class Epi, class Sched, bool ALIGN_EPI = false, bool SP2 = false>
__device__ __forceinline__ void gemm_phase(PG8_LAS unsigned char* lds, const Gemm g, const Sched& S, const Epi& E) {
    const int tid = threadIdx.x, wid = __builtin_amdgcn_readfirstlane(tid >> 6), lane = tid & 63, wr = wid >> 2, wc = wid & 3, fr = lane & 15, fq = lane >> 4;
    const int K = g.K, nt = K / BK;
    unsigned voffA[2], voffB[2];
#pragma unroll
    for (int i = 0; i < 2; ++i) { int R, C; stage_rc(tid * 16 + i * 8192, R, C); const int Rb = Epi::PERM ? ((R & ~31) + perm32(R & 31)) : R;
        voffA[i] = (unsigned)(R * K + C) * 2u; voffB[i] = (unsigned)(Rb * K + C) * 2u; }
    const size_t kstep = (size_t)(BK * 2);
    const size_t hstep = (size_t)HALF * K * 2;
    const size_t tstep = 2 * hstep;
    const unsigned ldsw = (unsigned)wid * 1024u;
    const int aoff = lds_byte(wr * 64 + fr, fq * 8), boff = lds_byte(wc * 32 + fr, fq * 8);
#define PG8_SA(b, h) (((b) * 2 + (h)) * HTB)
#define PG8_SB(b, h) ((4 + (b) * 2 + (h)) * HTB)
#define PG8_STAGE(bufoff, gbase, voff) do { _Pragma("unroll") for (int _i = 0; _i < 2; ++_i) \
        __builtin_amdgcn_global_load_lds((const unsigned*)((const char*)(gbase) + (voff)[_i]), (PG8_LAS unsigned*)(lds + (bufoff) + ldsw + _i * 8192), 16, 0, 0); } while (0)
#define PG8_LDA(dst, b, h) do { _Pragma("unroll") for (int m = 0; m < 4; ++m) _Pragma("unroll") for (int k = 0; k < 2; ++k) dst[m][k] = *(const PG8_LAS bf16x8*)(lds + PG8_SA(b, h) + aoff + m * 2048 + k * 1024); } while (0)
#define PG8_LDB(dst, b, h) do { _Pragma("unroll") for (int n = 0; n < 2; ++n) _Pragma("unroll") for (int k = 0; k < 2; ++k) dst[n][k] = *(const PG8_LAS bf16x8*)(lds + PG8_SB(b, h) + boff + n * 2048 + k * 1024); } while (0)
#define PG8_MMA(ai, bj, At, Bt) do { __builtin_amdgcn_s_setprio(1); _Pragma("unroll") for (int m = 0; m < 4; ++m) _Pragma("unroll") for (int n = 0; n < 2; ++n) _Pragma("unroll") for (int k = 0; k < 2; ++k) \
        acc[ai][bj][m][n] = __builtin_amdgcn_mfma_f32_16x16x32_bf16(Bt[n][k], At[m][k], acc[ai][bj][m][n], 0, 0, 0); __builtin_amdgcn_s_setprio(0); } while (0)
#define PG8_WAIT_V(n) asm volatile("s_waitcnt vmcnt(" #n ")" ::: "memory")
#define PG8_WAIT_L(n) asm volatile("s_waitcnt lgkmcnt(" #n ")" ::: "memory")
#define PG8_BAR __builtin_amdgcn_s_barrier()
#define PG8_SCHED __builtin_amdgcn_sched_barrier(0)
    Unit cur, nxt; int ui = 0;
    if (!S.next(0, cur)) return;
    f32x4 acc[2][2][4][2];
#pragma unroll
    for (int a = 0; a < 2; ++a)
#pragma unroll
        for (int b = 0; b < 2; ++b)
#pragma unroll
            for (int m = 0; m < 4; ++m)
#pragma unroll
                for (int n = 0; n < 2; ++n) acc[a][b][m][n] = (f32x4){0.f, 0.f, 0.f, 0.f};
    bf16x8 At[4][2], B0[2][2], B1[2][2];
    const char* cA = (const char*)S.abase(g, cur) + (size_t)cur.pm * tstep; const char* cB = (const char*)S.bbase(g, cur) + (size_t)cur.pn * tstep;
    S.a_ready(cur);
    if constexpr (SP2) {
        PG8_STAGE(PG8_SB(0, 0), cB, voffB); PG8_STAGE(PG8_SB(0, 1), cB + hstep, voffB); PG8_STAGE(PG8_SA(0, 0), cA, voffA); PG8_STAGE(PG8_SA(0, 1), cA + hstep, voffA);
        if (wr == 1) PG8_BAR;
        PG8_WAIT_V(2); PG8_BAR;
        PG8_STAGE(PG8_SB(1, 0), cB + kstep, voffB); PG8_STAGE(PG8_SA(1, 0), cA + kstep, voffA); PG8_STAGE(PG8_SB(1, 1), cB + hstep + kstep, voffB);
        PG8_WAIT_V(6); PG8_BAR;
    } else {
        PG8_STAGE(PG8_SB(0, 0), cB, voffB); PG8_STAGE(PG8_SA(0, 0), cA, voffA); PG8_STAGE(PG8_SB(0, 1), cB + hstep, voffB); PG8_STAGE(PG8_SA(0, 1), cA + hstep, voffA);
        if (wr == 1) PG8_BAR;
        PG8_WAIT_V(4); PG8_BAR;
        PG8_STAGE(PG8_SB(1, 0), cB + kstep, voffB); PG8_STAGE(PG8_SA(1, 0), cA + kstep, voffA); PG8_STAGE(PG8_SB(1, 1), cB + hstep + kstep, voffB);
        PG8_WAIT_V(6); PG8_BAR;
    }
    for (;;) {
        const bool has_next = S.next(ui + 1, nxt);
        const char* nA = has_next ? (const char*)S.abase(g, nxt) + (size_t)nxt.pm * tstep : cA; const char* nB = has_next ? (const char*)S.bbase(g, nxt) + (size_t)nxt.pn * tstep : cB;
        asm volatile(".p2align 8" ::: "memory");
        for (int t = 0; t < nt; t += 2) {
            const bool last = (t == nt - 2);
            const char* a1 = cA + (size_t)(t + 1) * kstep;
            const char* a2 = last ? nA : cA + (size_t)(t + 2) * kstep; const char* b2 = last ? nB : cB + (size_t)(t + 2) * kstep;
            const char* a3 = a2 + kstep; const char* b3 = b2 + kstep;
            if (last && has_next) S.a_ready(nxt);
            if constexpr (SP2) {
            PG8_LDB(B0, 0, 0); PG8_LDB(B1, 0, 1); PG8_SCHED; PG8_LDA(At, 0, 0); PG8_STAGE(PG8_SA(1, 1), a1 + hstep, voffA);
            PG8_WAIT_V(8); PG8_WAIT_L(0); PG8_BAR; PG8_MMA(0, 0, At, B0); PG8_MMA(0, 1, At, B1); PG8_BAR; PG8_SCHED;
            PG8_LDA(At, 0, 1); PG8_STAGE(PG8_SB(0, 0), b2, voffB); PG8_STAGE(PG8_SB(0, 1), b2 + hstep, voffB); PG8_STAGE(PG8_SA(0, 0), a2, voffA);
            PG8_WAIT_V(8); PG8_WAIT_L(0); PG8_BAR; PG8_MMA(1, 0, At, B0); PG8_MMA(1, 1, At, B1); PG8_BAR; PG8_SCHED;
            PG8_LDB(B0, 1, 0); PG8_LDB(B1, 1, 1); PG8_SCHED; PG8_LDA(At, 1, 0); PG8_STAGE(PG8_SA(0, 1), a2 + hstep, voffA);
            PG8_WAIT_V(8); PG8_WAIT_L(0); PG8_BAR; PG8_MMA(0, 0, At, B0); PG8_MMA(0, 1, At, B1); PG8_BAR; PG8_SCHED;
            PG8_LDA(At, 1, 1); PG8_STAGE(PG8_SB(1, 0), b3, voffB); PG8_STAGE(PG8_SB(1, 1), b3 + hstep, voffB); PG8_STAGE(PG8_SA(1, 0), a3, voffA);
            PG8_WAIT_V(8); PG8_WAIT_L(0); PG8_BAR; PG8_MMA(1, 0, At, B0); PG8_MMA(1, 1, At, B1); PG8_BAR; PG8_SCHED;
            } else {
            PG8_LDB(B0, 0, 0); PG8_SCHED; PG8_LDA(At, 0, 0); PG8_STAGE(PG8_SA(1, 1), a1 + hstep, voffA);
            PG8_WAIT_L(8); PG8_BAR; PG8_WAIT_L(0); PG8_MMA(0, 0, At, B0); PG8_BAR; PG8_SCHED;
            PG8_LDB(B1, 0, 1); PG8_STAGE(PG8_SB(0, 0), b2, voffB);
            PG8_BAR; PG8_WAIT_L(0); PG8_MMA(0, 1, At, B1); PG8_BAR;
            PG8_LDA(At, 0, 1); PG8_STAGE(PG8_SA(0, 0), a2, voffA);
            PG8_BAR; PG8_WAIT_L(0); PG8_MMA(1, 0, At, B0); PG8_BAR; PG8_SCHED;
            PG8_STAGE(PG8_SB(0, 1), b2 + hstep, voffB);
            PG8_WAIT_V(6); PG8_BAR; PG8_MMA(1, 1, At, B1); PG8_BAR;
            PG8_LDB(B0, 1, 0); PG8_SCHED; PG8_LDA(At, 1, 0); PG8_STAGE(PG8_SA(0, 1), a2 + hstep, voffA);
            PG8_WAIT_L(8); PG8_BAR; PG8_WAIT_L(0); PG8_MMA(0, 0, At, B0); PG8_BAR; PG8_SCHED;
            PG8_LDB(B1, 1, 1); PG8_STAGE(PG8_SB(1, 0), b3, voffB);
            PG8_BAR; PG8_WAIT_L(0); PG8_MMA(0, 1, At, B1); PG8_BAR;
            PG8_LDA(At, 1, 1); PG8_STAGE(PG8_SA(1, 0), a3, voffA);
            PG8_BAR; PG8_WAIT_L(0); PG8_MMA(1, 0, At, B0); PG8_BAR; PG8_SCHED;
            PG8_STAGE(PG8_SB(1, 1), b3 + hstep, voffB);
            PG8_WAIT_V(6); PG8_BAR; PG8_MMA(1, 1, At, B1); PG8_BAR;
            }
        }
        if constexpr (ALIGN_EPI) { if (wr == 0) PG8_BAR; }
        if constexpr (!Epi::AFTER_DRAIN) { E(acc, cur, wr, wc, fr, fq); S.done(cur); }
        if (!has_next) break;
#pragma unroll
        for (int a = 0; a < 2; ++a)
#pragma unroll
            for (int b = 0; b < 2; ++b)
#pragma unroll
                for (int m = 0; m < 4; ++m)
#pragma unroll
                    for (int n = 0; n < 2; ++n) acc[a][b][m][n] = (f32x4){0.f, 0.f, 0.f, 0.f};
        cur = nxt; cA = nA; cB = nB; ++ui;
        if constexpr (ALIGN_EPI) { if (wr == 1) PG8_BAR; }
    }
    PG8_WAIT_V(0);
    if constexpr (!ALIGN_EPI) { if (wr == 0) PG8_BAR; }
    PG8_BAR;
    if constexpr (Epi::AFTER_DRAIN) { E.fused(acc, cur, wr, wc, fr, fq, lds, wid, lane); S.done(cur); }
#undef PG8_SA
#undef PG8_SB
#undef PG8_STAGE
#undef PG8_LDA
#undef PG8_LDB
#undef PG8_MMA
#undef PG8_WAIT_V
#undef PG8_WAIT_L
#undef PG8_BAR
#undef PG8_SCHED
}
}


#ifndef N_LAUNCH_MODE
#define N_LAUNCH_MODE 1
#endif
#ifndef MOE_SIMT
#define MOE_SIMT 0
#endif
#ifndef HYENA_NAIVE
#define HYENA_NAIVE 0
#endif
#ifndef ATTN_NAIVE
#define ATTN_NAIVE 0
#endif
#ifndef TLB_TOUCH
#define TLB_TOUCH 0
#endif
#ifndef DUAL_BIG_FIRST
#define DUAL_BIG_FIRST 1
#endif
#ifndef MOE_S
#define MOE_S 4
#endif
#ifndef HY_REP
#define HY_REP 0
#endif
#ifndef ATTN_REP
#define ATTN_REP 0
#endif
#ifndef SIMPLE_GEMM
#define SIMPLE_GEMM 0
#endif

constexpr int D = 2048, BATCH = 2, SEQ = 4096, T = BATCH * SEQ;
constexpr int HW = 1024;
constexpr int NH = 12, HD = 128, QKVW = 3 * NH * HD;
constexpr int INW = 3 * HW + QKVW;
constexpr int N1 = INW + 2 * D;
constexpr int NE = 64, FF = 512;
constexpr float RMS_EPS = 1e-6f;
constexpr int NWAVES = 8, NTHR = 512;
constexpr int NPHASE = 12;

constexpr size_t MiB = 1u << 20;
constexpr size_t WS_CTL = 0, CTL_ZERO_BYTES = 128 * 1024;
constexpr size_t WS_MODP = 1 * MiB;
constexpr size_t WS_HID2 = 2 * MiB;
constexpr size_t WS_ROT = 3 * MiB;
constexpr size_t WS_W3T = 4 * MiB;
constexpr size_t WS_ROUTE = 5 * MiB;
constexpr size_t WS_LISTT = 6 * MiB;
constexpr size_t WS_LISTG = 8 * MiB;
constexpr size_t WS_WGT = 10 * MiB;
constexpr size_t WS_WET = 11 * MiB;
constexpr size_t WS_HID2B = 12 * MiB;
constexpr size_t WS_W3TB = 13 * MiB;
constexpr size_t WS_W1T = 16 * MiB;
constexpr size_t WS_WHYOT = 64 * MiB;
constexpr size_t WS_WATOT = 68 * MiB;
constexpr size_t WS_WOUTT = 70 * MiB;
constexpr size_t WS_KF = 80 * MiB;
constexpr size_t WS_H = 144 * MiB;
constexpr size_t WS_PHY = 176 * MiB;
constexpr size_t WS_QKV = 224 * MiB;
constexpr size_t WS_G = 296 * MiB;
constexpr size_t WS_YHY = 360 * MiB;
constexpr size_t WS_YAT = 376 * MiB;
constexpr size_t WS_TMP = 384 * MiB;
constexpr size_t WS_MERGED = 448 * MiB;
constexpr size_t WS_Y = 480 * MiB;
constexpr size_t WS_X1 = 544 * MiB;
constexpr size_t WS_H2 = 608 * MiB;
constexpr size_t WS_ACT = 640 * MiB;
constexpr size_t WS_YB = 672 * MiB;
constexpr size_t WS_END = 800 * MiB;
constexpr int CW_BAR = 4096;
constexpr int CW_CNT = 16384, CNT_STRIDE = 64;

constexpr int RING_BYTES = 131072;
constexpr int LDS_BYTES = 163840;
constexpr int MISC_OFF = LDS_BYTES - 256;
constexpr int MOE_OFFS_OFF = LDS_BYTES - 1024;

#define GAS __attribute__((address_space(1)))
#define LAS __attribute__((address_space(3)))
typedef unsigned short bf16;
typedef unsigned v4u __attribute__((ext_vector_type(4)));
typedef unsigned v2u __attribute__((ext_vector_type(2)));
typedef float f32x4 __attribute__((ext_vector_type(4)));
typedef LAS float lfloat;

__device__ __forceinline__ unsigned f2bf(float f) { unsigned u = __builtin_bit_cast(unsigned, f); return (u + 0x7fffu + ((u >> 16) & 1u)) >> 16; }
__device__ __forceinline__ unsigned pk2(float lo, float hi) { return f2bf(lo) | (f2bf(hi) << 16); }
__device__ __forceinline__ float bf2f(unsigned short b) { return __builtin_bit_cast(float, ((unsigned)b) << 16); }
__device__ __forceinline__ float bflo(unsigned w) { return __builtin_bit_cast(float, w << 16); }
__device__ __forceinline__ float bfhi(unsigned w) { return __builtin_bit_cast(float, w & 0xffff0000u); }

#define XB_TMO      128
#define XB_XCNT(j)  (256  + 64 * (j))
#define XB_XSUB(j)  (1280 + 64 * (j))
#define XB_XGEN(j)  (2304 + 64 * (j))
#define XB_TOP      3328
#define XB_TOPGEN   3392
#define XCD_BAR_WORDS 3456
#define XB_SPIN_CAP (1u << 18)
__device__ __forceinline__ unsigned xb_ld(unsigned* p)              { return __hip_atomic_load(p, __ATOMIC_RELAXED, __HIP_MEMORY_SCOPE_AGENT); }
__device__ __forceinline__ unsigned xb_add(unsigned* p, unsigned v) { return __hip_atomic_fetch_add(p, v, __ATOMIC_RELAXED, __HIP_MEMORY_SCOPE_AGENT); }
__device__ __forceinline__ unsigned xb_xcc_id() { return (unsigned)__builtin_amdgcn_s_getreg((3 << 11) | 20) & 0xFu; }
#define XB_SPIN(cond, bar) do { unsigned _sp = 0; while (cond) { __builtin_amdgcn_s_sleep(1); \
    if ((++_sp & 255u) == 0u) { if (xb_ld(&(bar)[XB_TMO])) break; if (_sp > XB_SPIN_CAP) { atomicAdd(&(bar)[XB_TMO], 1u); break; } } } } while (0)
struct XcdBarrier { unsigned* bar; unsigned x; volatile LAS unsigned* st; };
__device__ __forceinline__ XcdBarrier xcd_barrier_post(unsigned* bar, volatile LAS unsigned* st) {
    XcdBarrier b; b.bar = bar; b.x = xb_xcc_id(); b.st = st;
    if (threadIdx.x == 0) (void)xb_add(&bar[XB_XCNT(b.x)], 1u);
    return b;
}
__device__ __forceinline__ void xcd_barrier_complete(unsigned* bar, unsigned x, unsigned& nloc, unsigned& nx) {
    const unsigned G = gridDim.x * gridDim.y * gridDim.z;
    unsigned sum, cnt, mine, sp = 0u;
    for (;;) {
        sum = 0u; cnt = 0u; mine = 0u;
#pragma unroll
        for (unsigned j = 0; j < 16; ++j) { const unsigned c = xb_ld(&bar[XB_XCNT(j)]); sum += c; cnt += (c > 0u) ? 1u : 0u; mine = (j == x) ? c : mine; }
        if (sum == G) break;
        __builtin_amdgcn_s_sleep(1);
        if ((++sp & 255u) == 0u) { if (xb_ld(&bar[XB_TMO])) break; if (sp > XB_SPIN_CAP) { atomicAdd(&bar[XB_TMO], 1u); break; } }
    }
    nloc = mine > 0u ? mine : 1u; nx = cnt > 0u ? cnt : 1u;
}
__device__ __forceinline__ void xcd_barrier(const XcdBarrier& b) {
    asm volatile("s_waitcnt vmcnt(0)" ::: "memory");
    __syncthreads();
    if (threadIdx.x == 0) {
        unsigned* bar = b.bar;
        __builtin_amdgcn_s_waitcnt(0);
        unsigned nloc = b.st[0], nx = b.st[1];
        if (nloc == 0u) { xcd_barrier_complete(bar, b.x, nloc, nx); b.st[0] = nloc; b.st[1] = nx; }
        const unsigned old = xb_add(&bar[XB_XSUB(b.x)], 1u);
        const unsigned gen = old / nloc;
        if (old + 1u == (gen + 1u) * nloc) {
            __builtin_amdgcn_fence(__ATOMIC_RELEASE, "agent");
            asm volatile("s_waitcnt vmcnt(0)" ::: "memory");
            const unsigned og = xb_add(&bar[XB_TOP], 1u);
            const unsigned tg = og / nx;
            if (og + 1u == (tg + 1u) * nx) xb_add(&bar[XB_TOPGEN], 1u);
            else XB_SPIN(xb_ld(&bar[XB_TOPGEN]) == tg, bar);
            __builtin_amdgcn_fence(__ATOMIC_ACQUIRE, "agent");
            xb_add(&bar[XB_XGEN(b.x)], 1u);
            asm volatile("s_waitcnt vmcnt(0)" ::: "memory");
        } else {
            XB_SPIN(xb_ld(&bar[XB_XGEN(b.x)]) == gen, bar);
            __builtin_amdgcn_fence(__ATOMIC_ACQUIRE, "agent");
            asm volatile("s_waitcnt vmcnt(0)" ::: "memory");
        }
    }
    __syncthreads();
}

struct Args { const void* in[31]; float* out; unsigned char* ws; int ph_lo, ph_hi; };
struct Frame {
    LAS unsigned char* lds;
    int tid, lane, wave, G, bid;
    const float *x, *c, *w_ada, *b_ada, *g_mix_pre, *g_mix_post, *g_ffn_pre, *g_ffn_post, *w_in, *conv_w, *conv_b, *fw1, *fb1, *fw2, *fb2, *fw3, *ffreq, *hskip,
        *w_bg, *b_bg, *w_hy_o, *w_at_o, *w_out, *w_group, *b_group, *w_expert, *b_expert, *w1e, *w3e, *w2e;
    const int* positions;
    float* out;
    unsigned* ctl; float *MODP, *HID2, *ROT, *W3T, *TMP, *Y, *X1, *ACT, *YB, *LISTG, *WGT, *WET; bf16 *KF, *HID2B, *W3TB;
    unsigned* ROUTE; int* LISTT;
    bf16 *W1T, *WHYOT, *WATOT, *WOUTT, *H, *PHY, *QKV, *GT, *YHY, *YAT, *MERGED, *H2, *ACTB, *YBB;
};

__device__ __forceinline__ float wave_sum(float v) {
#pragma unroll
    for (int o = 1; o < 64; o <<= 1) v += __shfl_xor(v, o);
    return v;
}
__device__ __forceinline__ float wave_max(float v) {
#pragma unroll
    for (int o = 1; o < 64; o <<= 1) v = fmaxf(v, __shfl_xor(v, o));
    return v;
}

struct TrItem { const float* W; bf16* WT; int K, N, row_off, k0, n0; };
__device__ __forceinline__ void tr_load(const TrItem& q, int lane, f32x4 (&t4)[8]) {
#pragma unroll
    for (int i = 0; i < 8; ++i) t4[i] = *(const f32x4*)(q.W + (size_t)(q.k0 + 8 * i + (lane >> 3)) * q.N + q.n0 + 4 * (lane & 7));
}
__device__ __forceinline__ void tr_store(const TrItem& q, int lane, const f32x4 (&t4)[8], LAS float* scr) {
#pragma unroll
    for (int i = 0; i < 8; ++i) { LAS float* d = scr + (8 * i + (lane >> 3)) * 33 + 4 * (lane & 7); d[0] = t4[i].x; d[1] = t4[i].y; d[2] = t4[i].z; d[3] = t4[i].w; }
    asm volatile("s_waitcnt lgkmcnt(0)" ::: "memory");
    const int c = lane & 7;
#pragma unroll
    for (int j = 0; j < 4; ++j) { const int n = (lane >> 3) + 8 * j; const LAS float* s = scr + (8 * c) * 33 + n;
        v4u o; o.x = pk2(s[0 * 33], s[1 * 33]); o.y = pk2(s[2 * 33], s[3 * 33]); o.z = pk2(s[4 * 33], s[5 * 33]); o.w = pk2(s[6 * 33], s[7 * 33]);
        *(v4u*)(q.WT + (size_t)(q.row_off + q.n0 + n) * q.K + q.k0 + 8 * c) = o; }
    asm volatile("s_waitcnt lgkmcnt(0)" ::: "memory");
}

__device__ __forceinline__ f32x4 mod_sum4(Frame& F, int b, int col) {
    f32x4 s = *(const f32x4*)(F.b_ada + col);
#pragma unroll
    for (int ks = 0; ks < 8; ++ks) s += *(const f32x4*)(F.MODP + (size_t)(ks * 2 + b) * (6 * D) + col);
    return s;
}
__device__ __forceinline__ void load_mod(Frame& F, LAS float* dst, int which) {
#pragma unroll 2
    for (int i = F.tid; i < 2 * D / 4; i += NTHR) { const int b = i / (D / 4), d4 = i % (D / 4); *(LAS f32x4*)(dst + 4 * i) = mod_sum4(F, b, which * D + 4 * d4); }
}
__device__ __forceinline__ void load_mod1(Frame& F, LAS float* dst, int which, int b) {
    *(LAS f32x4*)(dst + 4 * F.tid) = mod_sum4(F, b, which * D + 4 * F.tid);
}

template <int SKIP = 0> __device__ __forceinline__ void p0_prologue(Frame& F) {
    LAS float* L = (LAS float*)F.lds;
    if (!(SKIP & 1))
    {
        typedef float f32x2 __attribute__((ext_vector_type(2)));
        LAS float* sc = L;
        LAS float* red = L + 512;
        for (int u = F.bid; u < 96 * 8; u += F.G) {
            const int chunk = u % 96, ks = u / 96;
            __syncthreads();
            { const int b = F.tid >> 8, i = F.tid & 255; const float cv = F.c[b * D + ks * 256 + i]; sc[b * 256 + i] = cv / (1.f + __expf(-cv)); }
            __syncthreads();
            f32x2 a0 = {0.f, 0.f}, a1 = {0.f, 0.f};
            const float* wp = F.w_ada + (size_t)(ks * 256 + F.wave * 32) * (6 * D) + chunk * 128 + F.lane * 2;
#pragma unroll
            for (int r = 0; r < 32; ++r) { const f32x2 w = *(const f32x2*)(wp + (size_t)r * (6 * D)); const float s0 = sc[F.wave * 32 + r], s1 = sc[256 + F.wave * 32 + r]; a0 += w * s0; a1 += w * s1; }
            *(LAS f32x2*)(red + (F.wave * 2 + 0) * 128 + F.lane * 2) = a0;
            *(LAS f32x2*)(red + (F.wave * 2 + 1) * 128 + F.lane * 2) = a1;
            __syncthreads();
            if (F.tid < 256) { const int b = F.tid >> 7, col = F.tid & 127; float s = 0.f;
#pragma unroll
              for (int w = 0; w < 8; ++w) s += red[(w * 2 + b) * 128 + col];
              F.MODP[(size_t)(ks * 2 + b) * (6 * D) + chunk * 128 + col] = s; }
        }
        __syncthreads();
    }
    const int gw = F.bid * NWAVES + F.wave, NGW = F.G * NWAVES;
    if (!(SKIP & 2)) {
        LAS float* scr = (LAS float*)(F.lds + F.wave * 16384);
        constexpr int I_IN = (D / 64) * (INW / 32), I_BG = (D / 64) * (2 * D / 32), I_HY = (HW / 64) * (D / 32), I_AT = (512 / 64) * (D / 32), I_OUT = (D / 64) * (D / 32);
        constexpr int NITEMS = I_IN + I_BG + I_HY + I_AT + I_OUT;
        auto resolve = [&](int it) -> TrItem { TrItem q; int r = it;
            if (r < I_IN) { q.W = F.w_in; q.K = D; q.N = INW; q.WT = F.W1T; q.row_off = 0; }
            else if ((r -= I_IN) < I_BG) { q.W = F.w_bg; q.K = D; q.N = 2 * D; q.WT = F.W1T; q.row_off = INW; }
            else if ((r -= I_BG) < I_HY) { q.W = F.w_hy_o; q.K = HW; q.N = D; q.WT = F.WHYOT; q.row_off = 0; }
            else if ((r -= I_HY) < I_AT) { q.W = F.w_at_o; q.K = 512; q.N = D; q.WT = F.WATOT; q.row_off = 0; }
            else { r -= I_AT; q.W = F.w_out; q.K = D; q.N = D; q.WT = F.WOUTT; q.row_off = 0; }
            const int nblk = q.N / 32; q.k0 = 64 * (r / nblk); q.n0 = 32 * (r % nblk); return q; };
        f32x4 ta[8], tb[8]; TrItem qa, qb;
        int it = gw;
        if (it < NITEMS) { qa = resolve(it); tr_load(qa, F.lane, ta); }
        while (it < NITEMS) {
            const int i1 = it + NGW; const bool h1 = i1 < NITEMS;
            if (h1) { qb = resolve(i1); tr_load(qb, F.lane, tb); }
            tr_store(qa, F.lane, ta, scr);
            if (!h1) break;
            const int i2 = i1 + NGW; const bool h2 = i2 < NITEMS;
            if (h2) { qa = resolve(i2); tr_load(qa, F.lane, ta); }
            tr_store(qb, F.lane, tb, scr);
            if (!h2) break;
            it = i2;
        }
    }
    if (!(SKIP & 4)) {
    for (int i = F.bid * NTHR + F.tid; i < 64 * 4096; i += F.G * NTHR) { const int n = i >> 6, j = i & 63; F.W3TB[i] = (bf16)f2bf(F.fw3[j * 4096 + n]); }
    for (int i = F.bid * NTHR + F.tid; i < 8 * D; i += F.G * NTHR) { const int n = i / D, d = i % D; F.WGT[i] = F.w_group[d * 8 + n]; }
    for (int i = F.bid * NTHR + F.tid; i < 64 * D; i += F.G * NTHR) { const int ge = i / D, d = i % D, g = ge >> 3, e = ge & 7; F.WET[i] = F.w_expert[((size_t)g * D + d) * 8 + e]; }
    }
    if (!(SKIP & 8)) {
        LAS float* w1s = (LAS float*)(F.lds + 131072);
        LAS float* w2s = w1s + 33 * 64;
        __syncthreads();
        for (int i = F.tid; i < 33 * 64; i += NTHR) w1s[i] = F.fw1[i];
        for (int i = F.tid; i < 64 * 64; i += NTHR) w2s[i] = F.fw2[i];
        __syncthreads();
        const int j = F.lane; const float fr = F.ffreq[j], bb1 = F.fb1[j], bb2 = F.fb2[j];
        for (int t = gw; t < SEQ; t += NGW) {
            const float tn = (float)t * (1.0f / (float)(SEQ - 1));
            const float w = 6.283185307179586f * (float)t / (float)SEQ;
            float feat = 0.f;
            if (j == 0) feat = tn;
            else if (j <= 16) { const float band = 1e-4f + (float)(j - 1) * ((15.0f - 1e-4f) / 15.0f); feat = cosf(band * w); }
            else if (j <= 32) { const float band = 1e-4f + (float)(j - 17) * ((15.0f - 1e-4f) / 15.0f); feat = -sinf(band * w); }
            float a = bb1;
#pragma unroll
            for (int i = 0; i < 33; ++i) a += __shfl(feat, i) * w1s[i * 64 + j];
            const float h1 = sinf(fr * a);
            float a2 = bb2;
#pragma unroll
            for (int i = 0; i < 64; ++i) a2 += __shfl(h1, i) * w2s[i * 64 + j];
            { const float hv = sinf(fr * a2); F.HID2[t * 64 + j] = hv; F.HID2B[t * 64 + j] = (bf16)f2bf(hv); }
        }
    }
    if (!(SKIP & 16))
    for (int i = F.bid * NTHR + F.tid; i < T * 16; i += F.G * NTHR) {
        const int tok = i >> 4, k = i & 15;
        const float inv = powf(500000.0f, -(float)k * (1.0f / 16.0f));
        const float ang = (float)F.positions[tok] * inv;
        F.ROT[tok * 32 + k] = cosf(ang); F.ROT[tok * 32 + 16 + k] = sinf(ang);
    }
}

__device__ __forceinline__ void p1_rows_filters(Frame& F) {
    LAS float* L = (LAS float*)F.lds;
    LAS float* shiftv = L;
    LAS float* scalev = L + 2 * D;
    load_mod(F, shiftv, 0); load_mod(F, scalev, 1);
    LAS float* gpre = L + 4 * D;
    *(LAS f32x4*)(gpre + 4 * F.tid) = *(const f32x4*)(F.g_mix_pre + 4 * F.tid);
    __syncthreads();
    const int gw = F.bid * NWAVES + F.wave, NGW = F.G * NWAVES;
    for (int m0 = gw; m0 < T; m0 += 4 * NGW) {
        f32x4 v[4][8];
#pragma unroll
        for (int r = 0; r < 4; ++r) { const int m = m0 + r * NGW; if (m < T) { const f32x4* xr = (const f32x4*)(F.x + (size_t)m * D) + F.lane;
#pragma unroll
            for (int j = 0; j < 8; ++j) v[r][j] = xr[64 * j]; } }
#pragma unroll
        for (int r = 0; r < 4; ++r) { const int m = m0 + r * NGW; if (m < T) { const int b = m / SEQ; float s = 0.f;
#pragma unroll
            for (int j = 0; j < 8; ++j) s += (v[r][j].x * v[r][j].x + v[r][j].y * v[r][j].y) + (v[r][j].z * v[r][j].z + v[r][j].w * v[r][j].w);
            const float rstd = 1.0f / sqrtf(wave_sum(s) * (1.f / D) + RMS_EPS);
            v2u* o8 = (v2u*)(F.H + (size_t)m * D) + F.lane;
#pragma unroll
            for (int j = 0; j < 8; ++j) { const int d = 256 * j + 4 * F.lane;
                const f32x4 g = *(LAS f32x4*)(gpre + d); const f32x4 sc = *(LAS f32x4*)(scalev + b * D + d), sh = *(LAS f32x4*)(shiftv + b * D + d);
                f32x4 h; h = (v[r][j] * rstd) * g; h = h * (sc + 1.0f) + sh;
                v2u w; w.x = pk2(h.x, h.y); w.y = pk2(h.z, h.w); o8[64 * j] = w; } } }
    }
    {
        typedef short bf16x8 __attribute__((ext_vector_type(8)));
        typedef float f32x16 __attribute__((ext_vector_type(16)));
        const int r31 = F.lane & 31, hh = F.lane >> 5;
        const float mind = -3.0701134573253945f, maxd = -15.350567286626972f;
        for (int u = gw; u < 128 * 32; u += NGW) {
            const int tt = u & 127, ng = u >> 7, t = tt * 32 + r31;
            bf16x8 bq[4];
#pragma unroll
            for (int s = 0; s < 4; ++s) bq[s] = *(const bf16x8*)(F.HID2B + (size_t)t * 64 + 16 * s + 8 * hh);
            const float tn = (float)t * (1.0f / (float)(SEQ - 1));
#pragma unroll 1
            for (int q = 0; q < 4; ++q) {
                const int n0 = (ng * 4 + q) * 32;
                f32x16 c;
#pragma unroll
                for (int i = 0; i < 16; ++i) c[i] = 0.f;
#pragma unroll
                for (int s = 0; s < 4; ++s) { const bf16x8 a = *(const bf16x8*)(F.W3TB + (size_t)(n0 + r31) * 64 + 16 * s + 8 * hh); c = __builtin_amdgcn_mfma_f32_32x32x16_bf16(a, bq[s], c, 0, 0, 0); }
#pragma unroll
                for (int i = 0; i < 16; ++i) { const int n = n0 + (i & 3) + 8 * (i >> 2) + 4 * hh, ch = n & (HW - 1);
                    const float delta = fabsf(mind + (float)ch * ((maxd - mind) / (float)(HW - 1)));
                    F.KF[(size_t)n * SEQ + t] = (bf16)f2bf(c[i] * __expf(-tn * delta)); }
            }
        }
    }
}

template <int NB, class LA, class LB, class EP>
__device__ __forceinline__ void simt_tile(LAS float* L, int K, int tid, const LA& la, const LB& lb, const EP& ep) {
    LAS float* As = L;
    LAS float* Bs = L + 32 * 68;
    const int ty = tid >> 4, tx = tid & 15;
    float acc[NB][2][4];
#pragma unroll
    for (int q = 0; q < NB; ++q)
#pragma unroll
        for (int i = 0; i < 2; ++i)
#pragma unroll
            for (int j = 0; j < 4; ++j) acc[q][i][j] = 0.f;
    for (int k0 = 0; k0 < K; k0 += 32) {
        __syncthreads();
        for (int e = tid; e < 64 * 32; e += NTHR) { const int r = e >> 5, kk = e & 31; As[kk * 68 + r] = la(r, k0 + kk); }
#pragma unroll
        for (int q = 0; q < NB; ++q)
            for (int e = tid; e < 32 * 64; e += NTHR) { const int kk = e >> 6, cc = e & 63; Bs[(q * 32 + kk) * 68 + cc] = lb(q, k0 + kk, cc); }
        __syncthreads();
#pragma unroll 8
        for (int kk = 0; kk < 32; ++kk) {
            const float a0 = As[kk * 68 + 2 * ty], a1 = As[kk * 68 + 2 * ty + 1];
#pragma unroll
            for (int q = 0; q < NB; ++q) { const f32x4 b = *(LAS f32x4*)(Bs + (q * 32 + kk) * 68 + 4 * tx);
                acc[q][0][0] += a0 * b.x; acc[q][0][1] += a0 * b.y; acc[q][0][2] += a0 * b.z; acc[q][0][3] += a0 * b.w;
                acc[q][1][0] += a1 * b.x; acc[q][1][1] += a1 * b.y; acc[q][1][2] += a1 * b.z; acc[q][1][3] += a1 * b.w; }
        }
    }
#pragma unroll
    for (int i = 0; i < 2; ++i)
#pragma unroll
        for (int j = 0; j < 4; ++j) { float v[NB];
#pragma unroll
            for (int q = 0; q < NB; ++q) v[q] = acc[q][i][j];
            ep(2 * ty + i, 4 * tx + j, v); }
}

struct EpiProj {
    static constexpr bool PERM = true, AFTER_DRAIN = false;
    bf16* QKVp; bf16* Gp; const float* ROT; const float* bias;
    __device__ __forceinline__ void operator()(const pg8::f32x4 (&acc)[2][2][4][2], const pg8::Unit& u, int wr, int wc, int fr, int fq) const {
        using namespace pg8;
        const int row0 = u.pm * BM + wr * 64 + fr;
        const int colt = u.pn * BM;
        if (colt < QKVW) {
            const bool rot = (colt < 2 * NH * HD) && (wc == 0);
#pragma unroll
            for (int ai = 0; ai < 2; ++ai)
#pragma unroll
                for (int m = 0; m < 4; ++m) { const int row = row0 + ai * HALF + m * 16;
                    bf16* rowp = QKVp + (size_t)row * QKVW + colt + wc * 32 + 8 * fq;
                    f32x4 cs0, cs1, sn0, sn1;
                    if (rot) { const float* rp = ROT + (size_t)row * 32 + 8 * (fq & 1); cs0 = *(const f32x4*)rp; cs1 = *(const f32x4*)(rp + 4); sn0 = *(const f32x4*)(rp + 16); sn1 = *(const f32x4*)(rp + 20); }
#pragma unroll
                    for (int bj = 0; bj < 2; ++bj) { f32x4 v0 = acc[ai][bj][m][0], v1 = acc[ai][bj][m][1];
                        if (rot) {
                            f32x4 o0, o1;
#pragma unroll
                            for (int j = 0; j < 4; ++j) { o0[j] = __shfl_xor(v0[j], 32); o1[j] = __shfl_xor(v1[j], 32); }
                            if (fq < 2) { v0 = v0 * cs0 - o0 * sn0; v1 = v1 * cs1 - o1 * sn1; }
                            else        { v0 = v0 * cs0 + o0 * sn0; v1 = v1 * cs1 + o1 * sn1; }
                        }
                        u32x4 w; w.x = cvt_pk_bf16(v0[0], v0[1]); w.y = cvt_pk_bf16(v0[2], v0[3]); w.z = cvt_pk_bf16(v1[0], v1[1]); w.w = cvt_pk_bf16(v1[2], v1[3]);
                        *(u32x4*)(rowp + bj * HALF) = w; } }
        } else {
            const int gc = colt - QKVW + wc * 32 + 8 * fq;
            f32x4 bv[2][2];
#pragma unroll
            for (int bj = 0; bj < 2; ++bj)
#pragma unroll
                for (int n = 0; n < 2; ++n) bv[bj][n] = *(const f32x4*)(bias + gc + bj * HALF + 4 * n);
#pragma unroll
            for (int ai = 0; ai < 2; ++ai)
#pragma unroll
                for (int m = 0; m < 4; ++m) { bf16* rowp = Gp + (size_t)(row0 + ai * HALF + m * 16) * (2 * D) + gc;
#pragma unroll
                    for (int bj = 0; bj < 2; ++bj) { f32x4 v0 = acc[ai][bj][m][0] + bv[bj][0], v1 = acc[ai][bj][m][1] + bv[bj][1];
#pragma unroll
                        for (int j = 0; j < 4; ++j) { v0[j] = 1.0f / (1.0f + __expf(-v0[j])); v1[j] = 1.0f / (1.0f + __expf(-v1[j])); }
                        u32x4 w; w.x = cvt_pk_bf16(v0[0], v0[1]); w.y = cvt_pk_bf16(v0[2], v0[3]); w.z = cvt_pk_bf16(v1[0], v1[1]); w.w = cvt_pk_bf16(v1[2], v1[3]);
                        *(u32x4*)(rowp + bj * HALF) = w; } }
        }
    }
};
struct EpiPlainBf16 {
    static constexpr bool PERM = true, AFTER_DRAIN = false;
    bf16* O; int ldc;
    __device__ __forceinline__ void operator()(const pg8::f32x4 (&acc)[2][2][4][2], const pg8::Unit& u, int wr, int wc, int fr, int fq) const {
        using namespace pg8;
        const int row0 = u.pm * BM + wr * 64 + fr, col0 = u.pn * BM + wc * 32 + 8 * fq;
#pragma unroll
        for (int ai = 0; ai < 2; ++ai)
#pragma unroll
            for (int m = 0; m < 4; ++m) { bf16* rowp = O + (size_t)(row0 + ai * HALF + m * 16) * ldc + col0;
#pragma unroll
                for (int bj = 0; bj < 2; ++bj) { const f32x4 v0 = acc[ai][bj][m][0], v1 = acc[ai][bj][m][1];
                    u32x4 w; w.x = cvt_pk_bf16(v0[0], v0[1]); w.y = cvt_pk_bf16(v0[2], v0[3]); w.z = cvt_pk_bf16(v1[0], v1[1]); w.w = cvt_pk_bf16(v1[2], v1[3]);
                    *(u32x4*)(rowp + bj * HALF) = w; } }
    }
};
template <int STAGE> struct EpiGate {
    static constexpr bool PERM = true, AFTER_DRAIN = false;
    const bf16* Gp; int goff; float* TMPp; bf16* Mp;
    __device__ __forceinline__ void operator()(const pg8::f32x4 (&acc)[2][2][4][2], const pg8::Unit& u, int wr, int wc, int fr, int fq) const {
        using namespace pg8;
        const int row0 = u.pm * BM + wr * 64 + fr, col0 = u.pn * BM + wc * 32 + 8 * fq;
#pragma unroll
        for (int ai = 0; ai < 2; ++ai)
#pragma unroll
            for (int m = 0; m < 4; ++m) { const size_t row = (size_t)(row0 + ai * HALF + m * 16);
#pragma unroll
                for (int bj = 0; bj < 2; ++bj) { const int col = col0 + bj * HALF;
                    const u32x4 gw = *(const u32x4*)(Gp + row * (2 * D) + goff + col);
                    f32x4 g0 = {bflo(gw.x), bfhi(gw.x), bflo(gw.y), bfhi(gw.y)}, g1 = {bflo(gw.z), bfhi(gw.z), bflo(gw.w), bfhi(gw.w)};
                    f32x4 v0 = acc[ai][bj][m][0] * g0, v1 = acc[ai][bj][m][1] * g1;
                    bf16* tp = (bf16*)TMPp + row * D + col;
                    if (STAGE == 0) { u32x4 w; w.x = cvt_pk_bf16(v0[0], v0[1]); w.y = cvt_pk_bf16(v0[2], v0[3]); w.z = cvt_pk_bf16(v1[0], v1[1]); w.w = cvt_pk_bf16(v1[2], v1[3]); *(u32x4*)tp = w; }
                    else { const u32x4 tw = *(const u32x4*)tp; v0 += (f32x4){bflo(tw.x), bfhi(tw.x), bflo(tw.y), bfhi(tw.y)}; v1 += (f32x4){bflo(tw.z), bfhi(tw.z), bflo(tw.w), bfhi(tw.w)};
                        u32x4 w; w.x = cvt_pk_bf16(v0[0], v0[1]); w.y = cvt_pk_bf16(v0[2], v0[3]); w.z = cvt_pk_bf16(v1[0], v1[1]); w.w = cvt_pk_bf16(v1[2], v1[3]);
                        *(u32x4*)(Mp + row * D + col) = w; } } }
    }
};
struct EpiF32 {
    static constexpr bool PERM = false, AFTER_DRAIN = false;
    float* C; int ldc;
    __device__ __forceinline__ void operator()(const pg8::f32x4 (&acc)[2][2][4][2], const pg8::Unit& u, int wr, int wc, int fr, int fq) const {
        using namespace pg8;
        const int row0 = u.pm * BM + wr * 64 + fr, col0 = u.pn * BM + wc * 32 + 4 * fq;
#pragma unroll
        for (int ai = 0; ai < 2; ++ai)
#pragma unroll
            for (int m = 0; m < 4; ++m) { float* rowp = C + (size_t)(row0 + ai * HALF + m * 16) * ldc + col0;
#pragma unroll
                for (int bj = 0; bj < 2; ++bj)
#pragma unroll
                    for (int n = 0; n < 2; ++n) *(f32x4*)(rowp + bj * HALF + n * 16) = acc[ai][bj][m][n]; }
    }
};


struct DualOrder {
    pg8::StaticOrder s0, s1; int G, c; const bf16* A0; const bf16* B0; const bf16* A1; const bf16* B1;
    __device__ __forceinline__ bool next(int i, pg8::Unit& u) const {
        const int L = i * G + c;
        if (L < s1.nwg) { pg8::StaticOrder t = s1; t.G = 1; t.c = L; const bool ok = t.next(0, u); u.kind = 1; return ok; }
        pg8::StaticOrder t = s0; t.G = 1; t.c = L - s1.nwg; const bool ok = t.next(0, u); u.kind = 0; return ok;
    }
    __device__ __forceinline__ void a_ready(const pg8::Unit&) const {}
    __device__ __forceinline__ void done(const pg8::Unit&) const {}
    __device__ __forceinline__ const bf16* abase(const pg8::Gemm&, const pg8::Unit& u) const { return u.kind ? A1 : A0; }
    __device__ __forceinline__ const bf16* bbase(const pg8::Gemm&, const pg8::Unit& u) const { return u.kind ? B1 : B0; }
};
struct EpiDual {
    static constexpr bool PERM = true, AFTER_DRAIN = false;
    EpiPlainBf16 e0; EpiProj e1;
    __device__ __forceinline__ void operator()(const pg8::f32x4 (&acc)[2][2][4][2], const pg8::Unit& u, int wr, int wc, int fr, int fq) const {
        if (u.kind == 0) e0(acc, u, wr, wc, fr, fq); else e1(acc, u, wr, wc, fr, fq);
    }
};
template <class Epi>
__device__ __forceinline__ void run_gemm(Frame& F, const bf16* A, const bf16* Bt, int M, int N, int K, const Epi& E) {
    pg8::Gemm g{A, Bt, M, N, K}; pg8::StaticOrder S; S.init(M, N, F.G, F.bid);
    pg8::gemm_phase<Epi, pg8::StaticOrder, true, true>(F.lds, g, S, E);
}

__device__ __forceinline__ float sconv_at(const bf16* rowp, int t, float w0, float w1, float w2, float bias) {
    const float um = t > 0 ? bf2f(rowp[t - 1]) : 0.f, u0 = bf2f(rowp[t]), up = t < SEQ - 1 ? bf2f(rowp[t + 1]) : 0.f;
    return um * w0 + u0 * w1 + up * w2 + bias;
}
__device__ __forceinline__ void conv8(const LAS float* kk, const LAS float* z, int t0, float (&acc)[2][8]) {
#pragma unroll
    for (int b = 0; b < 2; ++b)
#pragma unroll
        for (int j = 0; j < 8; ++j) acc[b][j] = 0.f;
    for (int s8 = 0; s8 < SEQ; s8 += 8) {
        const int base = t0 - s8 + (SEQ - 1);
        float kw[15];
#pragma unroll
        for (int i = 0; i < 15; ++i) kw[i] = kk[base - 7 + i];
        float zz[2][8];
#pragma unroll
        for (int b = 0; b < 2; ++b) { const f32x4 q0 = *(const LAS f32x4*)(z + b * SEQ + s8), q1 = *(const LAS f32x4*)(z + b * SEQ + s8 + 4);
            zz[b][0] = q0.x; zz[b][1] = q0.y; zz[b][2] = q0.z; zz[b][3] = q0.w; zz[b][4] = q1.x; zz[b][5] = q1.y; zz[b][6] = q1.z; zz[b][7] = q1.w; }
#pragma unroll
        for (int ds = 0; ds < 8; ++ds)
#pragma unroll
            for (int j = 0; j < 8; ++j) { const float k = kw[7 + j - ds]; acc[0][j] += k * zz[0][ds]; acc[1][j] += k * zz[1][ds]; }
    }
}
__device__ __forceinline__ void p3_hyena_naive(Frame& F) {
    LAS float* L = (LAS float*)F.lds;
    LAS float* zin = L;
    LAS float* kk = L + 2 * SEQ;
    LAS float* zmid = L + 4 * SEQ;
    for (int c = F.bid; c < HW; c += F.G) {
        __syncthreads();
        const float cw[3][3] = {{F.conv_w[c], F.conv_w[3 * HW + c], F.conv_w[6 * HW + c]},
                                {F.conv_w[HW + c], F.conv_w[3 * HW + HW + c], F.conv_w[6 * HW + HW + c]},
                                {F.conv_w[2 * HW + c], F.conv_w[3 * HW + 2 * HW + c], F.conv_w[6 * HW + 2 * HW + c]}};
        const float cb[3] = {F.conv_b[c], F.conv_b[HW + c], F.conv_b[2 * HW + c]};
        const bf16* pv = F.PHY + (size_t)c * T; const bf16* px1 = F.PHY + (size_t)(HW + c) * T; const bf16* px2 = F.PHY + (size_t)(2 * HW + c) * T;
        for (int i = F.tid; i < T; i += NTHR) { const int b = i / SEQ, t = i % SEQ; zin[i] = sconv_at(pv + b * SEQ, t, cw[0][0], cw[0][1], cw[0][2], cb[0]); }
        for (int i = F.tid; i < 2 * SEQ; i += NTHR) { const int d = i - (SEQ - 1);
            kk[i] = (i == 2 * SEQ - 1) ? 0.f : bf2f(d >= 0 ? F.KF[(size_t)(0 * HW + c) * SEQ + d] : F.KF[(size_t)(1 * HW + c) * SEQ - d]); }
        __syncthreads();
        const int t0 = F.tid * 8; float acc[2][8];
        conv8(kk, zin, t0, acc);
        const float sk0 = F.hskip[c], sk1 = F.hskip[HW + c];
#pragma unroll
        for (int b = 0; b < 2; ++b)
#pragma unroll
            for (int j = 0; j < 8; ++j) { const float x1 = sconv_at(px1 + b * SEQ, t0 + j, cw[1][0], cw[1][1], cw[1][2], cb[1]);
                zmid[b * SEQ + t0 + j] = x1 * (acc[b][j] + sk0 * zin[b * SEQ + t0 + j]); }
        __syncthreads();
        for (int i = F.tid; i < 2 * SEQ; i += NTHR) { const int d = i - (SEQ - 1);
            kk[i] = (i == 2 * SEQ - 1) ? 0.f : bf2f(d >= 0 ? F.KF[(size_t)(2 * HW + c) * SEQ + d] : F.KF[(size_t)(3 * HW + c) * SEQ - d]); }
        __syncthreads();
        conv8(kk, zmid, t0, acc);
#pragma unroll
        for (int b = 0; b < 2; ++b)
#pragma unroll
            for (int j = 0; j < 8; ++j) { const float x2 = sconv_at(px2 + b * SEQ, t0 + j, cw[2][0], cw[2][1], cw[2][2], cb[2]);
                const float z2 = x2 * (acc[b][j] + sk1 * zmid[b * SEQ + t0 + j]);
                F.YHY[(size_t)(b * SEQ + t0 + j) * HW + c] = (bf16)f2bf(z2); }
    }
}

constexpr int HY_KCOPY = 16448;
constexpr int HY_K_OFF = 0;
constexpr int HY_ZIN_OFF = 4 * HY_KCOPY;
constexpr int HY_PAD = 32;
constexpr int HY_ZBYTES = (128 + 2 * HY_PAD) * 2 * 80;
constexpr int HY_ZMID_OFF = HY_ZIN_OFF + HY_ZBYTES;
constexpr int HY_X1_OFF = HY_ZMID_OFF + HY_ZBYTES;
constexpr int HY_X2_OFF = HY_X1_OFF + 2 * SEQ * 2;
static_assert(HY_X2_OFF + 2 * SEQ * 2 <= MOE_OFFS_OFF, "hyena LDS map");
__device__ __forceinline__ unsigned hy_zaddr(int b, int t) { return (unsigned)((((t >> 5) + HY_PAD) * 2 + b) * 80 + (t & 31) * 2); }
__device__ __forceinline__ void hy_build_k(Frame& F, const bf16* hf, const bf16* hb) {
    LAS unsigned char* lds = F.lds + HY_K_OFF;
    const int i = F.tid;
    const v4u ca = *(const v4u*)(hf + (SEQ - 8 - 8 * i)), cb = *(const v4u*)(hb + 8 * i);
    unsigned short ga[8], gb[8];
    ga[7] = (unsigned short)(ca.x & 0xffff); ga[6] = (unsigned short)(ca.x >> 16); ga[5] = (unsigned short)(ca.y & 0xffff); ga[4] = (unsigned short)(ca.y >> 16);
    ga[3] = (unsigned short)(ca.z & 0xffff); ga[2] = (unsigned short)(ca.z >> 16); ga[1] = (unsigned short)(ca.w & 0xffff); ga[0] = (unsigned short)(ca.w >> 16);
    gb[0] = (unsigned short)(cb.x & 0xffff); gb[1] = (unsigned short)(cb.x >> 16); gb[2] = (unsigned short)(cb.y & 0xffff); gb[3] = (unsigned short)(cb.y >> 16);
    gb[4] = (unsigned short)(cb.z & 0xffff); gb[5] = (unsigned short)(cb.z >> 16); gb[6] = (unsigned short)(cb.w & 0xffff); gb[7] = (unsigned short)(cb.w >> 16);
#pragma unroll
    for (int s = 0; s < 4; ++s) {
        LAS unsigned char* cp = lds + s * HY_KCOPY;
#pragma unroll
        for (int j = 0; j < 8; ++j) { const int xa = 8 * i + 1 + j, xb = SEQ + 8 * i + j;
            if (xa - s >= 0) *(LAS unsigned short*)(cp + 2 * (xa - s)) = ga[j];
            if (xb > SEQ) *(LAS unsigned short*)(cp + 2 * (xb - s)) = gb[j]; }
        if (i < 32) *(LAS unsigned short*)(cp + 2 * (2 * SEQ - s + i)) = (unsigned short)0;
    }
}
__device__ __forceinline__ void hy_stage_inputs(Frame& F, int c, const float (&cw)[3][3], const float (&cb)[3]) {
    LAS unsigned char* lds = F.lds;
    v4u ch[6]; unsigned short lo[6], hi[6];
#pragma unroll
    for (int k = 0; k < 6; ++k) { const int wh = k >> 1, chunk = F.tid + 512 * (k & 1), b = chunk >> 9, t0 = (chunk & 511) * 8;
        const bf16* rowp = F.PHY + (size_t)(wh * HW + c) * T + b * SEQ;
        ch[k] = *(const v4u*)(rowp + t0); lo[k] = t0 > 0 ? rowp[t0 - 1] : (unsigned short)0; hi[k] = t0 + 8 < SEQ ? rowp[t0 + 8] : (unsigned short)0; }
#pragma unroll
    for (int k = 0; k < 6; ++k) { const int wh = k >> 1, chunk = F.tid + 512 * (k & 1), b = chunk >> 9, t0 = (chunk & 511) * 8;
        float u[10]; u[0] = bf2f(lo[k]); u[9] = bf2f(hi[k]);
        u[1] = bflo(ch[k].x); u[2] = bfhi(ch[k].x); u[3] = bflo(ch[k].y); u[4] = bfhi(ch[k].y); u[5] = bflo(ch[k].z); u[6] = bfhi(ch[k].z); u[7] = bflo(ch[k].w); u[8] = bfhi(ch[k].w);
        float o[8];
#pragma unroll
        for (int j = 0; j < 8; ++j) o[j] = u[j] * cw[wh][0] + u[j + 1] * cw[wh][1] + u[j + 2] * cw[wh][2] + cb[wh];
        v4u pk; pk.x = pk2(o[0], o[1]); pk.y = pk2(o[2], o[3]); pk.z = pk2(o[4], o[5]); pk.w = pk2(o[6], o[7]);
        const unsigned off = (wh == 0) ? (unsigned)HY_ZIN_OFF + hy_zaddr(b, t0) : (unsigned)((wh == 1 ? HY_X1_OFF : HY_X2_OFF) + 2 * (b * SEQ + t0));
        *(LAS v4u*)(lds + off) = pk; }
}
__device__ __forceinline__ void hy_conv(Frame& F, unsigned zoff, pg8::f32x4 (&acc)[4]) {
    typedef short bf16x8 __attribute__((ext_vector_type(8)));
    typedef float f32x16 __attribute__((ext_vector_type(16)));
    const int lane = F.lane, q = F.wave, r = lane & 31, hh = lane >> 5, sg = (4 - (r & 3)) & 3, nn = r >> 1, b = r & 1;
    const int n0 = 32 * (q >> 1), h = q & 1;
    f32x16 c0, c1;
#pragma unroll
    for (int i = 0; i < 16; ++i) { c0[i] = 0.f; c1[i] = 0.f; }
    struct Fr { v2u a[2][2]; bf16x8 b[2]; };
#define HY_LDA(S, AA) do { _Pragma("unroll") for (int _h = 0; _h < 2; ++_h) { S.a[_h][0] = *(volatile LAS v2u*)(F.lds + (AA) + 32 * _h); S.a[_h][1] = *(volatile LAS v2u*)(F.lds + (AA) + 32 * _h + 8); } } while (0)
#define HY_LDB(S, BB) do { _Pragma("unroll") for (int _h = 0; _h < 2; ++_h) S.b[_h] = *(const LAS bf16x8*)(F.lds + (BB) + 32 * _h); } while (0)
#define HY_MM(S, BP, T0, T1) do { _Pragma("unroll") for (int _h = 0; _h < 2; ++_h) { union { bf16x8 v; v2u hh2[2]; } _a; _a.hh2[0] = S.a[_h][0]; _a.hh2[1] = S.a[_h][1]; \
        if (T0) c0 = __builtin_amdgcn_mfma_f32_32x32x16_bf16(_a.v, S.b[_h], c0, 0, 0, 0); if (T1) c1 = __builtin_amdgcn_mfma_f32_32x32x16_bf16(_a.v, BP[_h], c1, 0, 0, 0); } } while (0)
    const int dbase = n0 - 128 + h;
    unsigned aaddr = (unsigned)(HY_K_OFF + sg * HY_KCOPY + 2 * (SEQ - 32 * dbase - r + 8 * hh - sg));
    unsigned baddr = zoff + (unsigned)(((n0 + nn - dbase + HY_PAD) * 2 + b) * 80 + 16 * hh);
    Fr cur;
    HY_LDA(cur, aaddr); HY_LDB(cur, baddr);
#pragma clang loop unroll(disable)
    for (int j = 0; j < 8; ++j) {
        asm volatile("" : "+v"(aaddr), "+v"(baddr));
        bf16x8 bp[2];
#pragma unroll
        for (int k = 0; k < 10; ++k) {
            Fr nxt;
            if (k < 9) { HY_LDA(nxt, aaddr - 1024 * (k + 1)); if (k < 8) HY_LDB(nxt, baddr - 2560 * (k + 1)); }
            else { HY_LDA(nxt, aaddr - 128); HY_LDB(nxt, baddr - 320); }
            HY_MM(cur, bp, k < 9, k > 0);
            if (k < 9) { bp[0] = cur.b[0]; bp[1] = cur.b[1]; }
            cur = nxt;
        }
        aaddr -= 128; baddr -= 320;
    }
#undef HY_LDA
#undef HY_LDB
#undef HY_MM
    __syncthreads();
    {
        LAS unsigned char* slot = F.lds + HY_K_OFF + (q >> 2) * HY_KCOPY + (q & 3) * 4096 + lane * 16;
#pragma unroll
        for (int g = 0; g < 4; ++g) { pg8::f32x4 v;
            if (h == 0) v = (pg8::f32x4){c1[4 * g], c1[4 * g + 1], c1[4 * g + 2], c1[4 * g + 3]}; else v = (pg8::f32x4){c0[4 * g], c0[4 * g + 1], c0[4 * g + 2], c0[4 * g + 3]};
            *(LAS pg8::f32x4*)(slot + g * 1024) = v; }
    }
    __syncthreads();
    {
        const int qp = q ^ 1;
        const LAS unsigned char* slot = F.lds + HY_K_OFF + (qp >> 2) * HY_KCOPY + (qp & 3) * 4096 + lane * 16;
#pragma unroll
        for (int g = 0; g < 4; ++g) { const pg8::f32x4 v = *(const LAS pg8::f32x4*)(slot + g * 1024);
            if (h == 0) acc[g] = (pg8::f32x4){c0[4 * g] + v[0], c0[4 * g + 1] + v[1], c0[4 * g + 2] + v[2], c0[4 * g + 3] + v[3]};
            else acc[g] = (pg8::f32x4){c1[4 * g] + v[0], c1[4 * g + 1] + v[1], c1[4 * g + 2] + v[2], c1[4 * g + 3] + v[3]}; }
    }
}
__device__ __forceinline__ void p3_hyena_mfma(Frame& F) {
    LAS unsigned char* lds = F.lds;
    for (int i = F.tid; i < 2 * HY_ZBYTES / 4; i += NTHR) *(LAS unsigned*)(lds + HY_ZIN_OFF + 4 * i) = 0u;
    const int lane = F.lane, q = F.wave, r = lane & 31, hh = lane >> 5, nn = r >> 1, b = r & 1;
    for (int c = F.bid; c < HW; c += F.G) {
        __syncthreads();
        const float cw[3][3] = {{F.conv_w[c], F.conv_w[3 * HW + c], F.conv_w[6 * HW + c]},
                                {F.conv_w[HW + c], F.conv_w[3 * HW + HW + c], F.conv_w[6 * HW + HW + c]},
                                {F.conv_w[2 * HW + c], F.conv_w[3 * HW + 2 * HW + c], F.conv_w[6 * HW + 2 * HW + c]}};
        const float cb[3] = {F.conv_b[c], F.conv_b[HW + c], F.conv_b[2 * HW + c]};
        const bf16* pv = F.PHY + (size_t)c * T; const bf16* px1 = F.PHY + (size_t)(HW + c) * T; const bf16* px2 = F.PHY + (size_t)(2 * HW + c) * T;
        hy_stage_inputs(F, c, cw, cb);
        hy_build_k(F, F.KF + (size_t)(0 * HW + c) * SEQ, F.KF + (size_t)(1 * HW + c) * SEQ);
        __syncthreads();
        pg8::f32x4 acc[4];
#if HY_REP & 1
        { pg8::f32x4 acc2[4]; hy_conv(F, HY_ZIN_OFF, acc2); asm volatile("" :: "v"(acc2[0][0]), "v"(acc2[1][1]), "v"(acc2[2][2]), "v"(acc2[3][3])); }
#endif
#if HY_REP & 2
        __syncthreads(); hy_build_k(F, F.KF + (size_t)(0 * HW + c) * SEQ, F.KF + (size_t)(1 * HW + c) * SEQ); __syncthreads();
#endif
#if HY_REP & 4
        __syncthreads(); hy_stage_inputs(F, c, cw, cb); __syncthreads();
#endif
        hy_conv(F, HY_ZIN_OFF, acc);
        const float sk0 = F.hskip[c], sk1 = F.hskip[HW + c];
        {
            unsigned zb = (unsigned)(((16 * q + nn + HY_PAD) * 2 + b) * 80 + 8 * hh), xb = (unsigned)(2 * (b * SEQ + 32 * (16 * q + nn) + 4 * hh));
            asm volatile("" : "+v"(zb), "+v"(xb));
#pragma unroll
            for (int g = 0; g < 4; ++g)
#pragma unroll
                for (int e = 0; e < 4; ++e) { const unsigned o = (unsigned)(16 * g + 2 * e);
                    const float vz = bf2f(*(LAS unsigned short*)(lds + HY_ZIN_OFF + zb + o)), x1 = bf2f(*(LAS unsigned short*)(lds + HY_X1_OFF + xb + o));
                    *(LAS unsigned short*)(lds + HY_ZMID_OFF + zb + o) = (unsigned short)f2bf(x1 * (acc[g][e] + sk0 * vz)); }
        }
        __syncthreads();
        hy_build_k(F, F.KF + (size_t)(2 * HW + c) * SEQ, F.KF + (size_t)(3 * HW + c) * SEQ);
        __syncthreads();
        hy_conv(F, HY_ZMID_OFF, acc);
        {
            unsigned zb = (unsigned)(((16 * q + nn + HY_PAD) * 2 + b) * 80 + 8 * hh), xb = (unsigned)(2 * (b * SEQ + 32 * (16 * q + nn) + 4 * hh));
            asm volatile("" : "+v"(zb), "+v"(xb));
            bf16* yp = F.YHY + (size_t)(b * SEQ + 32 * (16 * q + nn) + 4 * hh) * HW + c;
#pragma unroll
            for (int g = 0; g < 4; ++g)
#pragma unroll
                for (int e = 0; e < 4; ++e) { const unsigned o = (unsigned)(16 * g + 2 * e);
                    const float z1 = bf2f(*(LAS unsigned short*)(lds + HY_ZMID_OFF + zb + o)), x2 = bf2f(*(LAS unsigned short*)(lds + HY_X2_OFF + xb + o));
                    yp[(size_t)(8 * g + e) * HW] = (bf16)f2bf(x2 * (acc[g][e] + sk1 * z1)); }
        }
    }
}
__device__ __forceinline__ void p3_attn_naive(Frame& F) {
    LAS float* qs = (LAS float*)F.lds + F.wave * 128;
    const int gw = F.bid * NWAVES + F.wave, NGW = F.G * NWAVES;
    const float scale = 0.08838834764831845f;
    for (int u = gw; u < T * 4; u += NGW) {
        const int m = u >> 2, hh = u & 3, b = m / SEQ, s = m % SEQ;
        float Mrun = -3.0e38f, Lrun = 0.f, o0 = 0.f, o1 = 0.f;
#pragma unroll 1
        for (int g = 0; g < 3; ++g) {
            const int head = g * 4 + hh, dil = (g == 0) ? 1 : (g == 1 ? 4 : 16);
            const bf16* qp = F.QKV + (size_t)m * QKVW + head * HD;
            { const unsigned qq = *(const unsigned*)(qp + 2 * F.lane); qs[2 * F.lane] = bflo(qq); qs[2 * F.lane + 1] = bfhi(qq); }
            asm volatile("s_waitcnt lgkmcnt(0)" ::: "memory");
            float sc[3];
#pragma unroll
            for (int p = 0; p < 3; ++p) {
                const int j = (p == 0) ? F.lane - 64 : (p == 1 ? F.lane : 64);
                const int ks = s + j * dil; const bool valid = (ks >= 0) && (ks < SEQ) && (p < 2 || F.lane == 0);
                float dot = 0.f;
                if (valid) { const v4u* kp = (const v4u*)(F.QKV + (size_t)(b * SEQ + ks) * QKVW + NH * HD + head * HD);
#pragma unroll 4
                    for (int c8 = 0; c8 < 16; ++c8) { const v4u kv = kp[c8]; const LAS float* q8 = qs + 8 * c8;
                        dot += bflo(kv.x) * q8[0] + bfhi(kv.x) * q8[1] + bflo(kv.y) * q8[2] + bfhi(kv.y) * q8[3] + bflo(kv.z) * q8[4] + bfhi(kv.z) * q8[5] + bflo(kv.w) * q8[6] + bfhi(kv.w) * q8[7]; } }
                sc[p] = valid ? dot * scale : -1.0e30f;
            }
            const float mg = wave_max(fmaxf(fmaxf(sc[0], sc[1]), sc[2]));
            const float mnew = fmaxf(Mrun, mg), resc = __expf(Mrun - mnew);
            float pr[3];
#pragma unroll
            for (int p = 0; p < 3; ++p) pr[p] = (sc[p] > -1.0e29f) ? __expf(sc[p] - mnew) : 0.f;
            Lrun = Lrun * resc + wave_sum(pr[0] + pr[1] + pr[2]); o0 *= resc; o1 *= resc; Mrun = mnew;
            const bf16* vbase = F.QKV + 2 * NH * HD + head * HD + 2 * F.lane;
            for (int jj = 0; jj < 129; ++jj) {
                const int j = jj - 64, ks = s + j * dil;
                if (ks < 0 || ks >= SEQ) continue;
                const float pk = (jj < 64) ? __shfl(pr[0], jj) : (jj < 128 ? __shfl(pr[1], jj - 64) : __shfl(pr[2], 0));
                const unsigned vv = *(const unsigned*)(vbase + (size_t)(b * SEQ + ks) * QKVW);
                o0 += pk * bflo(vv); o1 += pk * bfhi(vv);
            }
        }
        const float inv = 1.0f / Lrun;
        *(unsigned*)(F.YAT + (size_t)m * 512 + hh * HD + 2 * F.lane) = pk2(o0 * inv, o1 * inv);
    }
}


constexpr int AT_VPITCH = 320, AT_VBYTES = 32 * AT_VPITCH;
typedef short s16x4 __attribute__((ext_vector_type(4)));
#define AT_TR8(S, VB, R) asm volatile( \
    "ds_read_b64_tr_b16 %0, %8 offset:%9\n\tds_read_b64_tr_b16 %1, %8 offset:%10\n\tds_read_b64_tr_b16 %2, %8 offset:%11\n\tds_read_b64_tr_b16 %3, %8 offset:%12\n\t" \
    "ds_read_b64_tr_b16 %4, %8 offset:%13\n\tds_read_b64_tr_b16 %5, %8 offset:%14\n\tds_read_b64_tr_b16 %6, %8 offset:%15\n\tds_read_b64_tr_b16 %7, %8 offset:%16\n\ts_waitcnt lgkmcnt(0)" \
    : "=&v"(R[0]), "=&v"(R[1]), "=&v"(R[2]), "=&v"(R[3]), "=&v"(R[4]), "=&v"(R[5]), "=&v"(R[6]), "=&v"(R[7]) \
    : "v"(VB), "i"((16 * (S)) * AT_VPITCH), "i"((16 * (S) + 8) * AT_VPITCH), "i"((16 * (S)) * AT_VPITCH + 64), "i"((16 * (S) + 8) * AT_VPITCH + 64), \
      "i"((16 * (S)) * AT_VPITCH + 128), "i"((16 * (S) + 8) * AT_VPITCH + 128), "i"((16 * (S)) * AT_VPITCH + 192), "i"((16 * (S) + 8) * AT_VPITCH + 192) : "memory")
__device__ __forceinline__ void p4_attn_mfma(Frame& F) {
    typedef short bf16x8 __attribute__((ext_vector_type(8)));
    typedef float f32x16 __attribute__((ext_vector_type(16)));
    typedef float f32x2 __attribute__((ext_vector_type(2)));
    typedef __bf16 bf16x2v __attribute__((ext_vector_type(2)));
    const int lane = F.lane, w = F.wave, r31 = lane & 31, hh = lane >> 5;
    LAS unsigned char* vimg = F.lds + w * AT_VBYTES;
    const unsigned vb = (unsigned)(size_t)vimg + (unsigned)((4 * hh + ((lane & 15) >> 2)) * AT_VPITCH + 32 * ((lane >> 4) & 1) + 8 * (lane & 3));
    const int gw = F.bid * NWAVES + w, NGW = F.G * NWAVES;
    const float scale = 0.08838834764831845f;
    bf16* AO = (bf16*)F.YB; float* LSE = (float*)((unsigned char*)F.YB + 32 * MiB);
    const int nunit = 2 * NH * 128, per_wg = (nunit + F.G - 1) / F.G;
    for (int k = w; k < per_wg; k += NWAVES) {
        const int u = F.bid * per_wg + k; if (u >= nunit) break;
        const int b = u / (NH * 128), rem = u % (NH * 128), head = rem >> 7, blk = rem & 127, g = head >> 2, hs = head & 3;
        const int dl = (g == 0) ? 0 : (g == 1 ? 2 : 4), dil = 1 << dl, res = blk & (dil - 1), q0 = (blk >> dl) * 32, n = SEQ >> dl;
        const size_t tokq = (size_t)(b * SEQ + res + dil * (q0 + r31));
        bf16x8 qf[8];
        { const bf16* qrow = F.QKV + tokq * QKVW + head * HD + 8 * hh;
#pragma unroll
          for (int s = 0; s < 8; ++s) qf[s] = *(const bf16x8*)(qrow + 16 * s); }
        f32x16 o[4];
#pragma unroll
        for (int dt = 0; dt < 4; ++dt)
#pragma unroll
            for (int i = 0; i < 16; ++i) o[dt][i] = 0.f;
        float mrun = -3.0e38f, lrun = 0.f;
        const int kt_lo = (q0 >= 64) ? 0 : (64 - q0) >> 5, kt_hi = ((n + 32 - q0) >> 5) < 4 ? ((n + 32 - q0) >> 5) : 4;
        bf16x8 kfN[8], vvN[8];
#define AT_FETCH(KT) do { const int _k0 = q0 - 64 + 32 * (KT); \
            const bf16* _krow = F.QKV + (size_t)(b * SEQ + res + dil * (_k0 + r31)) * QKVW + NH * HD + head * HD + 8 * hh; \
            const bf16* _vsrc = F.QKV + (size_t)(b * SEQ + res + dil * (_k0 + (lane >> 4))) * QKVW + 2 * NH * HD + head * HD + (lane & 15) * 8; \
            _Pragma("unroll") for (int _s = 0; _s < 8; ++_s) kfN[_s] = *(const bf16x8*)(_krow + 16 * _s); \
            _Pragma("unroll") for (int _i = 0; _i < 8; ++_i) vvN[_i] = *(const bf16x8*)(_vsrc + (size_t)(4 * _i * dil) * QKVW); } while (0)
        AT_FETCH(kt_lo);
#pragma unroll 1
        for (int kt = kt_lo; kt <= kt_hi; ++kt) {
            const int kt0 = q0 - 64 + 32 * kt;
            bf16x8 kf[8];
#pragma unroll
            for (int s = 0; s < 8; ++s) kf[s] = kfN[s];
#pragma unroll
            for (int i = 0; i < 8; ++i) *(LAS bf16x8*)(vimg + (4 * i + (lane >> 4)) * AT_VPITCH + (lane & 15) * 16) = vvN[i];
            if (kt < kt_hi) AT_FETCH(kt + 1);
            f32x16 sacc;
#pragma unroll
            for (int i = 0; i < 16; ++i) sacc[i] = 0.f;
#pragma unroll
            for (int s = 0; s < 8; ++s) sacc = __builtin_amdgcn_mfma_f32_32x32x16_bf16(kf[s], qf[s], sacc, 0, 0, 0);
            float p[16]; float mx = -3.0e38f;
            const bool edge = (kt == 0) || (kt == 4);
#pragma unroll
            for (int i = 0; i < 16; ++i) { float sv = sacc[i] * scale;
                if (edge) { const int diff = (q0 + r31) - (kt0 + (i & 3) + 8 * (i >> 2) + 4 * hh); if (diff > 64 || diff < -64) sv = -1.0e30f; }
                p[i] = sv; mx = fmaxf(mx, sv); }
            mx = fmaxf(mx, __shfl_xor(mx, 32));
            const float mnew = fmaxf(mrun, mx), resc = __expf(mrun - mnew);
            float ps = 0.f;
#pragma unroll
            for (int i = 0; i < 16; ++i) { p[i] = (p[i] > -1.0e29f) ? __expf(p[i] - mnew) : 0.f; ps += p[i]; }
            ps += __shfl_xor(ps, 32);
            lrun = lrun * resc + ps; mrun = mnew;
#pragma unroll
            for (int dt = 0; dt < 4; ++dt)
#pragma unroll
                for (int i = 0; i < 16; ++i) o[dt][i] *= resc;
            bf16x8 pf[2];
#pragma unroll
            for (int s = 0; s < 2; ++s) { union { bf16x8 v; bf16x2v h[4]; } cv;
#pragma unroll
                for (int j = 0; j < 4; ++j) cv.h[j] = __builtin_convertvector((f32x2){p[8 * s + 2 * j], p[8 * s + 2 * j + 1]}, bf16x2v);
                pf[s] = cv.v; }
            asm volatile("s_waitcnt lgkmcnt(0)" ::: "memory");
            { s16x4 tr[8]; AT_TR8(0, vb, tr);
#pragma unroll
              for (int dt = 0; dt < 4; ++dt) { const bf16x8 va = __builtin_shufflevector(tr[2 * dt], tr[2 * dt + 1], 0, 1, 2, 3, 4, 5, 6, 7); o[dt] = __builtin_amdgcn_mfma_f32_32x32x16_bf16(va, pf[0], o[dt], 0, 0, 0); } }
            { s16x4 tr[8]; AT_TR8(1, vb, tr);
#pragma unroll
              for (int dt = 0; dt < 4; ++dt) { const bf16x8 va = __builtin_shufflevector(tr[2 * dt], tr[2 * dt + 1], 0, 1, 2, 3, 4, 5, 6, 7); o[dt] = __builtin_amdgcn_mfma_f32_32x32x16_bf16(va, pf[1], o[dt], 0, 0, 0); } }
        }
#undef AT_FETCH
        const float inv = 1.0f / lrun;
        bf16* op = AO + ((size_t)g * T + tokq) * 512 + hs * HD + 4 * hh;
#pragma unroll
        for (int dt = 0; dt < 4; ++dt)
#pragma unroll
            for (int a = 0; a < 4; ++a) { v2u ov; ov.x = pk2(o[dt][4 * a] * inv, o[dt][4 * a + 1] * inv); ov.y = pk2(o[dt][4 * a + 2] * inv, o[dt][4 * a + 3] * inv);
                *(v2u*)(op + 32 * dt + 8 * a) = ov; }
        if (hh == 0) LSE[((size_t)g * T + tokq) * 4 + hs] = mrun + logf(lrun);
    }
}
__device__ __forceinline__ void p4b_combine(Frame& F) {
    const bf16* AO = (const bf16*)F.YB; const float* LSE = (const float*)((const unsigned char*)F.YB + 32 * MiB);
    const int gw = F.bid * NWAVES + F.wave, NGW = F.G * NWAVES, lane = F.lane, hs = lane >> 4;
    for (int m = gw; m < T; m += NGW) {
        float l[3];
#pragma unroll
        for (int g = 0; g < 3; ++g) l[g] = LSE[((size_t)g * T + m) * 4 + hs];
        const float mx = fmaxf(fmaxf(l[0], l[1]), l[2]);
        float wg[3], den = 0.f;
#pragma unroll
        for (int g = 0; g < 3; ++g) { wg[g] = __expf(l[g] - mx); den += wg[g]; }
        const float inv = 1.0f / den;
        float acc[8];
#pragma unroll
        for (int j = 0; j < 8; ++j) acc[j] = 0.f;
#pragma unroll
        for (int g = 0; g < 3; ++g) { const v4u q = *(const v4u*)(AO + ((size_t)g * T + m) * 512 + 8 * lane); const float ww = wg[g] * inv;
            acc[0] += ww * bflo(q.x); acc[1] += ww * bfhi(q.x); acc[2] += ww * bflo(q.y); acc[3] += ww * bfhi(q.y); acc[4] += ww * bflo(q.z); acc[5] += ww * bfhi(q.z); acc[6] += ww * bflo(q.w); acc[7] += ww * bfhi(q.w); }
        v4u ov; ov.x = pk2(acc[0], acc[1]); ov.y = pk2(acc[2], acc[3]); ov.z = pk2(acc[4], acc[5]); ov.w = pk2(acc[6], acc[7]);
        *(v4u*)(F.YAT + (size_t)m * 512 + 8 * lane) = ov;
    }
}
constexpr int RT_MOD_OFF = 0;
constexpr int RT_W_OFF = 5 * D * 4;
constexpr int RT_INFO_OFF = RT_W_OFF + 8 * D * 4;
__device__ __forceinline__ void rt_dot8(const f32x4 (&v)[8], const LAS float* W, int lane, float (&out)[8]) {
#pragma unroll
    for (int n = 0; n < 8; ++n) { float a = 0.f;
#pragma unroll
        for (int j = 0; j < 8; ++j) { const f32x4 w = *(const LAS f32x4*)(W + n * D + 256 * j + 4 * lane); a += (v[j].x * w.x + v[j].y * w.y) + (v[j].z * w.z + v[j].w * w.w); }
        out[n] = wave_sum(a); }
}
template <bool DRY> __device__ __forceinline__ void p6_rows_router(Frame& F) {
    LAS float* L = (LAS float*)F.lds;
    LAS float* gatem = L, *shiftf = L + D, *scalef = L + 2 * D, *gpost = L + 3 * D, *gpre = L + 4 * D;
    LAS float* Wl = (LAS float*)(F.lds + RT_W_OFF);
    LAS float* info = (LAS float*)(F.lds + RT_INFO_OFF);
    const int lane = F.lane;
    for (int blk = F.bid; blk < T / 32; blk += F.G) {
        const int m0 = blk * 32, b = m0 / SEQ;
        __syncthreads();
        load_mod1(F, gatem, 2, b); load_mod1(F, shiftf, 3, b); load_mod1(F, scalef, 4, b);
        *(LAS f32x4*)(gpost + 4 * F.tid) = *(const f32x4*)(F.g_mix_post + 4 * F.tid); *(LAS f32x4*)(gpre + 4 * F.tid) = *(const f32x4*)(F.g_ffn_pre + 4 * F.tid);
        for (int i = F.tid; i < 8 * D / 4; i += NTHR) *(LAS f32x4*)(Wl + 4 * i) = *(const f32x4*)(F.WGT + 4 * i);
        __syncthreads();
#pragma unroll 1
        for (int ip = 0; ip < 4; ip += 2) {
            v2u yv[2][8]; f32x4 xv[2][8];
#pragma unroll
            for (int r = 0; r < 2; ++r) { const int m = m0 + 4 * F.wave + ip + r;
                const v2u* yr = (const v2u*)((const bf16*)F.Y + (size_t)m * D) + lane; const f32x4* xr = (const f32x4*)(F.x + (size_t)m * D) + lane;
#pragma unroll
                for (int j = 0; j < 8; ++j) { yv[r][j] = yr[64 * j]; xv[r][j] = xr[64 * j]; } }
#pragma unroll
            for (int r = 0; r < 2; ++r) {
                const int rl = 4 * F.wave + ip + r, m = m0 + rl;
                f32x4 v[8]; float s = 0.f;
#pragma unroll
                for (int j = 0; j < 8; ++j) { const v2u yw = yv[r][j]; v[j] = (f32x4){bflo(yw.x), bfhi(yw.x), bflo(yw.y), bfhi(yw.y)}; s += (v[j].x * v[j].x + v[j].y * v[j].y) + (v[j].z * v[j].z + v[j].w * v[j].w); }
                const float rstd = 1.0f / sqrtf(wave_sum(s) * (1.f / D) + RMS_EPS);
                float s1 = 0.f;
                f32x4* x1r = (f32x4*)(F.X1 + (size_t)m * D) + lane;
#pragma unroll
                for (int j = 0; j < 8; ++j) { const int d = 256 * j + 4 * lane;
                    const f32x4 g = *(LAS f32x4*)(gpost + d), gm = *(LAS f32x4*)(gatem + d);
                    const f32x4 x1 = xv[r][j] + gm * ((v[j] * rstd) * g);
                    x1r[64 * j] = x1; v[j] = x1; s1 += (x1.x * x1.x + x1.y * x1.y) + (x1.z * x1.z + x1.w * x1.w); }
                const float rstd1 = 1.0f / sqrtf(wave_sum(s1) * (1.f / D) + RMS_EPS);
                v2u* o8 = (v2u*)(F.H2 + (size_t)m * D) + lane;
#pragma unroll
                for (int j = 0; j < 8; ++j) { const int d = 256 * j + 4 * lane;
                    const f32x4 g = *(LAS f32x4*)(gpre + d), sc = *(LAS f32x4*)(scalef + d), sh = *(LAS f32x4*)(shiftf + d);
                    f32x4 h = (v[j] * rstd1) * g; h = h * (sc + 1.0f) + sh; v[j] = h;
                    v2u w; w.x = pk2(h.x, h.y); w.y = pk2(h.z, h.w); o8[64 * j] = w; }
                float gl[8]; rt_dot8(v, Wl, lane, gl);
                float gmax = -3.0e38f; int gi = 0;
#pragma unroll
                for (int g = 0; g < 8; ++g) { gl[g] += F.b_group[g]; if (gl[g] > gmax) { gmax = gl[g]; gi = g; } }
                float gden = 0.f;
#pragma unroll
                for (int g = 0; g < 8; ++g) gden += expf(gl[g] - gmax);
                if (lane == 0) { info[rl] = rstd1; info[32 + rl] = 1.0f / gden; ((LAS int*)info)[64 + rl] = gi; }
            }
        }
        __syncthreads();
#pragma unroll 1
        for (int g = 0; g < 8; ++g) {
            int cnt = 0;
#pragma unroll 1
            for (int rl = 0; rl < 32; ++rl) cnt += (((LAS int*)info)[64 + rl] == g) ? 1 : 0;
            if (cnt == 0) continue;
            for (int i = F.tid; i < 8 * D / 4; i += NTHR) *(LAS f32x4*)(Wl + 4 * i) = *(const f32x4*)(F.WET + (size_t)g * 8 * D + 4 * i);
            __syncthreads();
            int k = 0;
#pragma unroll 1
            for (int rl = 0; rl < 32; ++rl) {
                if (((LAS int*)info)[64 + rl] != g) continue;
                const bool mine = ((k & 7) == F.wave); ++k;
                if (!mine) continue;
                const int m = m0 + rl; const float rstd1 = info[rl], gval = info[32 + rl];
                const f32x4* x1r = (const f32x4*)(F.X1 + (size_t)m * D) + lane;
                f32x4 v[8];
#pragma unroll
                for (int j = 0; j < 8; ++j) { const int d = 256 * j + 4 * lane;
                    const f32x4 gg = *(LAS f32x4*)(gpre + d), sc = *(LAS f32x4*)(scalef + d), sh = *(LAS f32x4*)(shiftf + d);
                    f32x4 h = (x1r[64 * j] * rstd1) * gg; v[j] = h * (sc + 1.0f) + sh; }
                float el[8]; rt_dot8(v, Wl, lane, el);
                float e0v = -3.0e38f, e1v = -3.0e38f; int e0i = 0, e1i = 0;
#pragma unroll
                for (int q = 0; q < 8; ++q) { el[q] += F.b_expert[g * 8 + q];
                    if (el[q] > e0v) { e1v = e0v; e1i = e0i; e0v = el[q]; e0i = q; } else if (el[q] > e1v) { e1v = el[q]; e1i = q; } }
                const float p1 = expf(e1v - e0v), den = 1.0f + p1;
                const float gate0 = gval / den, gate1 = gval * p1 / den;
                if (DRY) { if (gate0 + gate1 == 12345.f) F.LISTG[0] = gate0; }
                if (lane == 0 && !DRY) {
                    ((LAS int*)info)[96 + rl] = (g * 8 + e0i) | ((g * 8 + e1i) << 8); info[128 + rl] = gate0; info[160 + rl] = gate1; }
            }
            __syncthreads();
        }
        if (!DRY && F.tid < 32) {
            const int rl = F.tid, m = m0 + rl; const int ee = ((LAS int*)info)[96 + rl], ex0 = ee & 255, ex1 = ee >> 8; const float gate0 = info[128 + rl], gate1 = info[160 + rl];
            const unsigned pos0 = atomicAdd(F.ctl + CW_CNT + CNT_STRIDE * ex0, 1u), pos1 = atomicAdd(F.ctl + CW_CNT + CNT_STRIDE * ex1, 1u);
            F.LISTT[ex0 * T + pos0] = m; F.LISTG[ex0 * T + pos0] = gate0;
            F.LISTT[ex1 * T + pos1] = m; F.LISTG[ex1 * T + pos1] = gate1;
            F.ROUTE[m * 4 + 0] = (unsigned)(ex0 * T) + pos0; F.ROUTE[m * 4 + 1] = (unsigned)(ex1 * T) + pos1;
        }
    }
}

__device__ __forceinline__ void moe_offsets(Frame& F, LAS int* offs  , LAS int* toff  ) {
    if (F.tid < 64) { const int c = (int)__hip_atomic_load(F.ctl + CW_CNT + CNT_STRIDE * F.tid, __ATOMIC_RELAXED, __HIP_MEMORY_SCOPE_AGENT); const int tc = (c + 63) / 64; int incl = c, tincl = tc;
#pragma unroll
        for (int o = 1; o < 64; o <<= 1) { const int v = __shfl_up(incl, o), tv = __shfl_up(tincl, o); if (F.tid >= o) { incl += v; tincl += tv; } }
        offs[F.tid] = incl - c; toff[F.tid] = tincl - tc; if (F.tid == 63) { offs[NE] = incl; toff[NE] = tincl; } }
    __syncthreads();
}
__device__ __forceinline__ void p7_moe1(Frame& F) {
    LAS float* L = (LAS float*)F.lds;
    LAS int* offs = (LAS int*)(L + 8192 * 3); LAS int* toff = offs + 80;
    moe_offsets(F, offs, toff);
    const int ntiles = toff[NE];
    for (int u = F.bid; u < ntiles * 8; u += F.G) {
        const int rt = u >> 3, ct = u & 7;
        int e = 0; while (toff[e + 1] <= rt) ++e;
        const int r0 = (rt - toff[e]) * 64, ne = offs[e + 1] - offs[e];
        const int* lt = F.LISTT + e * T + r0;
        const float* W1 = F.w1e + (size_t)e * D * FF + ct * 64; const float* W3 = F.w3e + (size_t)e * D * FF + ct * 64;
        const bf16* H2 = F.H2;
        auto la = [&](int r, int k) -> float { return (r0 + r < ne) ? bf2f(H2[(size_t)lt[r] * D + k]) : 0.f; };
        auto lb = [&](int q, int k, int c) -> float { return (q == 0 ? W1 : W3)[(size_t)k * FF + c]; };
        float* ACT = F.ACT + (size_t)(offs[e] + r0) * FF + ct * 64;
        auto ep = [&](int r, int c, const float (&v)[2]) { if (r0 + r < ne) { const float a = v[0], bb = v[1]; ACT[(size_t)r * FF + c] = (a / (1.0f + __expf(-a))) * bb; } };
        simt_tile<2>(L, D, F.tid, la, lb, ep);
    }
}
__device__ __forceinline__ void p8_moe2(Frame& F) {
    LAS float* L = (LAS float*)F.lds;
    LAS int* offs = (LAS int*)(L + 8192 * 3); LAS int* toff = offs + 80;
    moe_offsets(F, offs, toff);
    const int ntiles = toff[NE];
    for (int u = F.bid; u < ntiles * 32; u += F.G) {
        const int rt = u >> 5, ct = u & 31;
        int e = 0; while (toff[e + 1] <= rt) ++e;
        const int r0 = (rt - toff[e]) * 64, ne = offs[e + 1] - offs[e];
        const float* A = F.ACT + (size_t)(offs[e] + r0) * FF;
        const float* W2 = F.w2e + (size_t)e * FF * D + ct * 64;
        const float* lg = F.LISTG + e * T + r0;
        auto la = [&](int r, int k) -> float { return (r0 + r < ne) ? A[(size_t)r * FF + k] : 0.f; };
        auto lb = [&](int q, int k, int c) -> float { return W2[(size_t)k * D + c]; };
        float* YB = F.YB + (size_t)(offs[e] + r0) * D + ct * 64;
        auto ep = [&](int r, int c, const float (&v)[1]) { if (r0 + r < ne) YB[(size_t)r * D + c] = v[0] * lg[r]; };
        simt_tile<1>(L, FF, F.tid, la, lb, ep);
    }
}

template <int MODE, int VAR = 0>
__device__ __forceinline__ void moe_mfma(Frame& F) {
    constexpr int K = MODE == 0 ? D : FF, LDW = MODE == 0 ? FF : D, NSL = MODE == 0 ? 8 : 16, NK = K / 32;
    constexpr int RPP = 368, NT = 23, S = MOE_S, WST = 16384, XST = NT * 1024, STB = WST + XST;
    static_assert(S * STB <= MOE_OFFS_OFF, "MoE stage ring vs LDS map");
    typedef short bf16x8 __attribute__((ext_vector_type(8)));
    LAS unsigned char* lds = F.lds;
    LAS int* offs = (LAS int*)(lds + MOE_OFFS_OFF);
    __syncthreads();
    if (F.tid < 64) { const int c = (int)__hip_atomic_load(F.ctl + CW_CNT + CNT_STRIDE * F.tid, __ATOMIC_RELAXED, __HIP_MEMORY_SCOPE_AGENT); int incl = c;
#pragma unroll
        for (int o = 1; o < 64; o <<= 1) { const int v = __shfl_up(incl, o); if (F.tid >= o) incl += v; }
        offs[F.tid] = incl - c; if (F.tid == 63) offs[NE] = incl; }
    __syncthreads();
    const int lane = F.lane, w = F.wave, cq = w & 3, rh = w >> 2;
    const int vcu = (F.G % 8 == 0) ? (F.bid % 8) * (F.G / 8) + F.bid / 8 : F.bid;
    for (int u = vcu; u < NE * NSL; u += F.G) {
        const int e = u / NSL, sl = u % NSL;
        const int oe = offs[e], ne = offs[e + 1] - oe;
        if (ne == 0) continue;
        const float* Wm0; const float* Wm1;
        if (MODE == 0) { Wm0 = F.w1e + (size_t)e * D * FF + sl * 64; Wm1 = F.w3e + (size_t)e * D * FF + sl * 64; }
        else { Wm0 = F.w2e + (size_t)e * FF * D + sl * 128; Wm1 = Wm0 + 64; }
        for (int r0 = 0; r0 < ne; r0 += RPP) {
            const int nr = (ne - r0) < RPP ? (ne - r0) : RPP, ntile = (nr + 15) >> 4;
            const char* xsrc[3]; unsigned xdst[3];
#pragma unroll
            for (int i = 0; i < 3; ++i) { int tile = 3 * w + i; if (tile > NT - 1) tile = NT - 1;
                int row = r0 + 16 * tile + (lane >> 2); if (row > ne - 1) row = ne - 1;
                const size_t srow = (MODE == 0) ? (size_t)F.LISTT[e * T + row] : (size_t)(oe + row);
                xsrc[i] = (const char*)(MODE == 0 ? (const void*)F.H2 : (const void*)F.ACTB) + srow * (size_t)(K * 2) + (lane & 3) * 16;
                xdst[i] = (unsigned)(WST + tile * 1024); }
            const char* wsrc[2]; unsigned wdst[2];
#pragma unroll
            for (int i = 0; i < 2; ++i) { const int kr = 8 * (w & 3) + 4 * i;
                wsrc[i] = (const char*)((w >> 2) ? Wm1 : Wm0) + ((size_t)(kr + (lane >> 4)) * LDW) * 4 + (lane & 15) * 16;
                if (VAR == 10) wsrc[i] = (const char*)F.w1e + (size_t)(u & 255) * (K * 128 * 4) + (size_t)(2 * w + i) * 1024 + lane * 16;
                wdst[i] = (unsigned)((w >> 2) * 8192 + kr * 256); }
            asm volatile("s_waitcnt vmcnt(0)" ::: "memory");
#define MOE_ISSUE(stage, ks) do { const unsigned _sb = (unsigned)(stage) * STB; const size_t _kx = (size_t)(ks) * 64, _kw = (VAR == 10) ? (size_t)(ks) * 16384 : (size_t)(ks) * 32 * LDW * 4; \
            if (VAR < 8) { _Pragma("unroll") for (int _i = 0; _i < 3; ++_i) __builtin_amdgcn_global_load_lds((const unsigned*)(xsrc[_i] + _kx), (LAS unsigned*)(lds + _sb + xdst[_i]), 16, 0, 0); } \
                        { _Pragma("unroll") for (int _i = 0; _i < 2; ++_i) __builtin_amdgcn_global_load_lds((const unsigned*)(wsrc[_i] + _kw), (LAS unsigned*)(lds + _sb + wdst[_i]), 16, 0, 2  ); } } while (0)
            if (VAR >= 11) {
                v4u r[4][2];
#pragma unroll
                for (int q = 0; q < 4; ++q) { r[q][0] = (v4u){0u, 0u, 0u, 0u}; r[q][1] = (v4u){0u, 0u, 0u, 0u}; }
#define RS_LOAD(slot, ks) do { const size_t _kw = (size_t)(ks) * 32 * LDW * 4; _Pragma("unroll") for (int _i = 0; _i < 2; ++_i) { \
                    if (VAR == 11) asm volatile("global_load_dwordx4 %0, %1, off nt" : "+v"(r[slot][_i]) : "v"(wsrc[_i] + _kw) : "memory"); \
                    else asm volatile("global_load_dwordx4 %0, %1, off" : "+v"(r[slot][_i]) : "v"(wsrc[_i] + _kw) : "memory"); } } while (0)
                RS_LOAD(0, 0); RS_LOAD(1, 1); RS_LOAD(2, 2);
#pragma unroll 1
                for (int t = 0; t < NK; t += 4) {
#pragma unroll
                    for (int q = 0; q < 4; ++q) { asm volatile("s_waitcnt vmcnt(4)" ::: "memory"); __builtin_amdgcn_s_barrier(); const int tn = t + q + 3; RS_LOAD((q + 3) & 3, tn < NK ? tn : 0); }
                }
                asm volatile("s_waitcnt vmcnt(0)" : "+v"(r[0][0]), "+v"(r[0][1]), "+v"(r[1][0]), "+v"(r[1][1]), "+v"(r[2][0]), "+v"(r[2][1]), "+v"(r[3][0]), "+v"(r[3][1]) :: "memory");
                unsigned sk = 0u;
#pragma unroll
                for (int q = 0; q < 4; ++q) sk ^= r[q][0].x ^ r[q][1].y;
                if (sk == 0x9e3779b9u) F.ctl[200] = sk;
                __builtin_amdgcn_s_barrier();
#undef RS_LOAD
                continue;
            }
            f32x4 acc[2][12]; unsigned sink = 0u;
#pragma unroll
            for (int m = 0; m < 2; ++m)
#pragma unroll
                for (int j = 0; j < 12; ++j) acc[m][j] = (f32x4){0.f, 0.f, 0.f, 0.f};
#pragma unroll
            for (int s = 0; s < S - 1; ++s) MOE_ISSUE(s, s);
            const unsigned wrd = (unsigned)((8 * (lane >> 4)) * 256 + (16 * cq + (lane & 15)) * 4);
            const unsigned xrd = (unsigned)(WST + (lane & 15) * 64 + (lane >> 4) * 16);
#pragma unroll 1
            for (int t = 0; t < NK; ++t) {
                if (VAR >= 8) asm volatile("s_waitcnt vmcnt(4)" ::: "memory"); else
                if (S == 3) asm volatile("s_waitcnt vmcnt(5)" ::: "memory"); else asm volatile("s_waitcnt vmcnt(10)" ::: "memory");
                __builtin_amdgcn_s_barrier();
                asm volatile("" ::: "memory");
                { const int tn = t + S - 1; MOE_ISSUE((S == 4 ? (tn & 3) : (tn % S)), tn < NK ? tn : 0); }
                if (VAR >= 8) continue;
                const unsigned sb = (unsigned)(S == 4 ? (t & 3) : (t % S)) * STB;
                bf16x8 af[2];
#pragma unroll
                for (int m = 0; m < 2; ++m) { float f[8];
#pragma unroll
                    for (int j = 0; j < 8; ++j) f[j] = *(const LAS float*)(lds + sb + m * 8192 + wrd + j * 256);
                    union { bf16x8 v; unsigned u[4]; } cv;
#pragma unroll
                    for (int p = 0; p < 4; ++p) cv.u[p] = pg8::cvt_pk_bf16(f[2 * p], f[2 * p + 1]);
                    af[m] = cv.v; }
#pragma unroll
                for (int jb = 0; jb < 12; jb += 6) { bf16x8 xb[6];
#pragma unroll
                    for (int q = 0; q < 6; ++q) { int tile = 2 * (jb + q) + rh; if (tile > NT - 1) tile = NT - 1; xb[q] = *(const LAS bf16x8*)(lds + sb + xrd + tile * 1024); }
#pragma unroll
                    for (int q = 0; q < 6; ++q) { const int j = jb + q;
                        if (2 * j + rh < ntile) {
                            acc[0][j] = __builtin_amdgcn_mfma_f32_16x16x32_bf16(af[0], xb[q], acc[0][j], 0, 0, 0);
                            acc[1][j] = __builtin_amdgcn_mfma_f32_16x16x32_bf16(af[1], xb[q], acc[1][j], 0, 0, 0); } } }
            }
            asm volatile("s_waitcnt vmcnt(0)" ::: "memory");
            __builtin_amdgcn_s_barrier();
            asm volatile("" ::: "memory");
            if (VAR >= 11 && sink == 0x9e3779b9u) F.ctl[200] = sink;
#undef MOE_ISSUE
#pragma unroll
            for (int j = 0; j < 12; ++j) { const int tile = 2 * j + rh, row = r0 + 16 * tile + (lane & 15);
                if (tile < ntile && row < ne) {
                    if (MODE == 0) { const f32x4 a = acc[0][j], b = acc[1][j]; f32x4 v;
#pragma unroll
                        for (int i = 0; i < 4; ++i) v[i] = (a[i] / (1.0f + __expf(-a[i]))) * b[i];
                        v2u o; o.x = pk2(v[0], v[1]); o.y = pk2(v[2], v[3]);
                        *(v2u*)((VAR ? F.YBB : F.ACTB) + (size_t)(oe + row) * FF + sl * 64 + 16 * cq + 4 * (lane >> 4)) = o; }
                    else { const float g = F.LISTG[e * T + row]; const f32x4 a = acc[0][j] * g, b = acc[1][j] * g;
                        bf16* yp = F.YBB + (size_t)(oe + row) * D + sl * 128 + 16 * cq + 4 * (lane >> 4);
                        v2u o0; o0.x = pk2(a[0], a[1]); o0.y = pk2(a[2], a[3]); *(v2u*)yp = o0;
                        v2u o1; o1.x = pk2(b[0], b[1]); o1.y = pk2(b[2], b[3]); *(v2u*)(yp + 64) = o1; }
                } }
        }
    }
}
__device__ __forceinline__ void p9_final(Frame& F) {
    LAS float* L = (LAS float*)F.lds;
    LAS float* gatef = L;
    LAS int* offs = (LAS int*)(L + 8192 * 3); LAS int* toff = offs + 80;
    load_mod(F, gatef, 5);
    LAS float* gpo = L + 2 * D;
    *(LAS f32x4*)(gpo + 4 * F.tid) = *(const f32x4*)(F.g_ffn_post + 4 * F.tid);
    moe_offsets(F, offs, toff);
    const int gw = F.bid * NWAVES + F.wave, NGW = F.G * NWAVES;
#if MOE_SIMT
    for (int m = gw; m < T; m += NGW) {
        const int b = m / SEQ;
        const unsigned s0 = F.ROUTE[m * 4 + 0], s1 = F.ROUTE[m * 4 + 1];
        const size_t r0 = (size_t)offs[s0 / T] + (s0 % T), r1 = (size_t)offs[s1 / T] + (s1 % T);
        f32x4 v[8]; float s = 0.f;
        const f32x4* y0 = (const f32x4*)(F.YB + r0 * D) + F.lane; const f32x4* y1 = (const f32x4*)(F.YB + r1 * D) + F.lane;
#pragma unroll
        for (int j = 0; j < 8; ++j) { v[j] = y0[64 * j] + y1[64 * j]; s += (v[j].x * v[j].x + v[j].y * v[j].y) + (v[j].z * v[j].z + v[j].w * v[j].w); }
        const float rstd = 1.0f / sqrtf(wave_sum(s) * (1.f / D) + RMS_EPS);
        const f32x4* x1r = (const f32x4*)(F.X1 + (size_t)m * D) + F.lane; f32x4* outr = (f32x4*)(F.out + (size_t)m * D) + F.lane;
#pragma unroll
        for (int j = 0; j < 8; ++j) { const int d = 256 * j + 4 * F.lane;
            const f32x4 g = *(LAS f32x4*)(gpo + d), gf = *(LAS f32x4*)(gatef + b * D + d);
            outr[64 * j] = x1r[64 * j] + gf * ((v[j] * rstd) * g); }
    }
#else
    for (int m0 = gw; m0 < T; m0 += 2 * NGW) {
        unsigned sl[2][2];
#pragma unroll
        for (int r = 0; r < 2; ++r) { const int m = m0 + r * NGW; if (m < T) { sl[r][0] = F.ROUTE[m * 4 + 0]; sl[r][1] = F.ROUTE[m * 4 + 1]; } else { sl[r][0] = 0; sl[r][1] = 0; } }
        v2u ya[2][8], yb[2][8]; f32x4 xv[2][8];
#pragma unroll
        for (int r = 0; r < 2; ++r) { const int m = m0 + r * NGW; if (m < T) {
            const size_t r0 = (size_t)offs[sl[r][0] / T] + (sl[r][0] % T), r1 = (size_t)offs[sl[r][1] / T] + (sl[r][1] % T);
            const v2u* y0 = (const v2u*)(F.YBB + r0 * D) + F.lane; const v2u* y1 = (const v2u*)(F.YBB + r1 * D) + F.lane; const f32x4* x1r = (const f32x4*)(F.X1 + (size_t)m * D) + F.lane;
#pragma unroll
            for (int j = 0; j < 8; ++j) { ya[r][j] = y0[64 * j]; yb[r][j] = y1[64 * j]; xv[r][j] = x1r[64 * j]; } } }
#pragma unroll
        for (int r = 0; r < 2; ++r) { const int m = m0 + r * NGW; if (m < T) { const int b = m / SEQ; f32x4 v[8]; float s = 0.f;
#pragma unroll
            for (int j = 0; j < 8; ++j) { const v2u a = ya[r][j], b2 = yb[r][j];
                v[j] = (f32x4){bflo(a.x) + bflo(b2.x), bfhi(a.x) + bfhi(b2.x), bflo(a.y) + bflo(b2.y), bfhi(a.y) + bfhi(b2.y)};
                s += (v[j].x * v[j].x + v[j].y * v[j].y) + (v[j].z * v[j].z + v[j].w * v[j].w); }
            const float rstd = 1.0f / sqrtf(wave_sum(s) * (1.f / D) + RMS_EPS);
            f32x4* outr = (f32x4*)(F.out + (size_t)m * D) + F.lane;
#pragma unroll
            for (int j = 0; j < 8; ++j) { const int d = 256 * j + 4 * F.lane;
                const f32x4 g = *(LAS f32x4*)(gpo + d), gf = *(LAS f32x4*)(gatef + b * D + d);
                outr[64 * j] = xv[r][j] + gf * ((v[j] * rstd) * g); } } }
    }
#endif
}

#if SIMPLE_GEMM
template <class EP>
__device__ __forceinline__ void simple_gemm(Frame& F, const bf16* A, const bf16* Bt, int M, int N, int K, const EP& ep) {
    LAS float* L = (LAS float*)F.lds;
    const int tn = N / 64, nt = (M / 64) * tn;
    for (int u = F.bid; u < nt; u += F.G) {
        const int r0 = (u / tn) * 64, c0 = (u % tn) * 64;
        auto la = [&](int r, int k) -> float { return bf2f(A[(size_t)(r0 + r) * K + k]); };
        auto lb = [&](int q, int k, int c) -> float { return bf2f(Bt[(size_t)(c0 + c) * K + k]); };
        auto e2 = [&](int r, int c, const float (&v)[1]) { ep(r0 + r, c0 + c, v[0]); };
        simt_tile<1>(L, K, F.tid, la, lb, e2);
    }
}
#endif

#ifndef REPEAT_MASK
#define REPEAT_MASK 0
#endif
__device__ __forceinline__ void phase_gemm2(Frame& F) {
#if SIMPLE_GEMM
        { bf16* PHY = F.PHY; simple_gemm(F, F.W1T, F.H, 3 * HW, T, D, [&](int r, int c, float v) { PHY[(size_t)r * T + c] = (bf16)f2bf(v); }); }
        __syncthreads();
        { bf16* QKVp = F.QKV; bf16* Gp = F.GT; const float* bias = F.b_bg;
          simple_gemm(F, F.H, F.W1T + (size_t)(3 * HW) * D, T, QKVW + 2 * D, D, [&](int r, int c, float v) {
              if (c < QKVW) QKVp[(size_t)r * QKVW + c] = (bf16)f2bf(v); else Gp[(size_t)r * (2 * D) + (c - QKVW)] = (bf16)f2bf(1.0f / (1.0f + __expf(-(v + bias[c - QKVW])))); }); }
#else
        { DualOrder S; S.s0.init(3 * HW, T, 1, 0); S.s1.init(T, QKVW + 2 * D, 1, 0); S.G = F.G; S.c = F.bid;
          S.A0 = F.W1T; S.B0 = F.H; S.A1 = F.H; S.B1 = F.W1T + (size_t)(3 * HW) * D;
          EpiDual E{EpiPlainBf16{F.PHY, T}, EpiProj{F.QKV, F.GT, F.ROT, F.b_bg}};
          pg8::Gemm g{F.H, F.H, T, T, D};
          pg8::gemm_phase<EpiDual, DualOrder, true, true>(F.lds, g, S, E); }
#endif
}
__device__ __forceinline__ void phase_gemm6(Frame& F) {
#if SIMPLE_GEMM
        { float* TMP = F.TMP; const bf16* G = F.GT; simple_gemm(F, F.YHY, F.WHYOT, T, D, HW, [&](int r, int c, float v) { TMP[(size_t)r * D + c] = v * bf2f(G[(size_t)r * (2 * D) + c]); }); }
        __syncthreads();
        { float* TMP = F.TMP; const bf16* G = F.GT; bf16* Mp = F.MERGED; simple_gemm(F, F.YAT, F.WATOT, T, D, 512, [&](int r, int c, float v) { Mp[(size_t)r * D + c] = (bf16)f2bf(TMP[(size_t)r * D + c] + v * bf2f(G[(size_t)r * (2 * D) + D + c])); }); }
#else
        { EpiGate<0> E{F.GT, 0, F.TMP, F.MERGED}; run_gemm(F, F.YHY, F.WHYOT, T, D, HW, E); }
        { EpiGate<1> E{F.GT, D, F.TMP, F.MERGED}; run_gemm(F, F.YAT, F.WATOT, T, D, 512, E); }
#endif
}
__device__ __forceinline__ void phase_gemm7(Frame& F) {
#if SIMPLE_GEMM
        { float* Y = F.Y; simple_gemm(F, F.MERGED, F.WOUTT, T, D, D, [&](int r, int c, float v) { Y[(size_t)r * D + c] = v; }); }
#else
        { EpiPlainBf16 E{(bf16*)F.Y, D}; run_gemm(F, F.MERGED, F.WOUTT, T, D, D, E); }
#endif
}
__global__ void __launch_bounds__(NTHR, 2) fwd_kernel(Args args) {
    extern __shared__ __attribute__((aligned(16))) unsigned char lds_raw[];
    Frame F;
    F.lds = (LAS unsigned char*)lds_raw;
    F.tid = threadIdx.x; F.lane = F.tid & 63; F.wave = __builtin_amdgcn_readfirstlane(F.tid >> 6); F.G = gridDim.x; F.bid = blockIdx.x;
    F.x = (const float*)args.in[0]; F.c = (const float*)args.in[1]; F.positions = (const int*)args.in[2]; F.w_ada = (const float*)args.in[3]; F.b_ada = (const float*)args.in[4];
    F.g_mix_pre = (const float*)args.in[5]; F.g_mix_post = (const float*)args.in[6]; F.g_ffn_pre = (const float*)args.in[7]; F.g_ffn_post = (const float*)args.in[8];
    F.w_in = (const float*)args.in[9]; F.conv_w = (const float*)args.in[10]; F.conv_b = (const float*)args.in[11]; F.fw1 = (const float*)args.in[12]; F.fb1 = (const float*)args.in[13];
    F.fw2 = (const float*)args.in[14]; F.fb2 = (const float*)args.in[15]; F.fw3 = (const float*)args.in[16]; F.ffreq = (const float*)args.in[17]; F.hskip = (const float*)args.in[18];
    F.w_bg = (const float*)args.in[19]; F.b_bg = (const float*)args.in[20]; F.w_hy_o = (const float*)args.in[21]; F.w_at_o = (const float*)args.in[22]; F.w_out = (const float*)args.in[23];
    F.w_group = (const float*)args.in[24]; F.b_group = (const float*)args.in[25]; F.w_expert = (const float*)args.in[26]; F.b_expert = (const float*)args.in[27];
    F.w1e = (const float*)args.in[28]; F.w3e = (const float*)args.in[29]; F.w2e = (const float*)args.in[30];
    F.out = args.out;
    unsigned char* ws = args.ws;
    F.ctl = (unsigned*)(ws + WS_CTL); F.MODP = (float*)(ws + WS_MODP); F.HID2 = (float*)(ws + WS_HID2); F.ROT = (float*)(ws + WS_ROT); F.W3T = (float*)(ws + WS_W3T);
    F.WGT = (float*)(ws + WS_WGT); F.WET = (float*)(ws + WS_WET); F.HID2B = (bf16*)(ws + WS_HID2B); F.W3TB = (bf16*)(ws + WS_W3TB);
    F.ROUTE = (unsigned*)(ws + WS_ROUTE); F.LISTT = (int*)(ws + WS_LISTT); F.LISTG = (float*)(ws + WS_LISTG);
    F.W1T = (bf16*)(ws + WS_W1T); F.WHYOT = (bf16*)(ws + WS_WHYOT); F.WATOT = (bf16*)(ws + WS_WATOT); F.WOUTT = (bf16*)(ws + WS_WOUTT);
    F.KF = (bf16*)(ws + WS_KF); F.H = (bf16*)(ws + WS_H); F.PHY = (bf16*)(ws + WS_PHY); F.QKV = (bf16*)(ws + WS_QKV); F.GT = (bf16*)(ws + WS_G);
    F.YHY = (bf16*)(ws + WS_YHY); F.YAT = (bf16*)(ws + WS_YAT); F.TMP = (float*)(ws + WS_TMP); F.MERGED = (bf16*)(ws + WS_MERGED); F.Y = (float*)(ws + WS_Y);
    F.X1 = (float*)(ws + WS_X1); F.H2 = (bf16*)(ws + WS_H2); F.ACT = (float*)(ws + WS_ACT); F.YB = (float*)(ws + WS_YB); F.ACTB = (bf16*)(ws + WS_ACT); F.YBB = (bf16*)(ws + WS_YB);

    volatile LAS unsigned* MISC = (volatile LAS unsigned*)(F.lds + MISC_OFF);
    if (F.tid < 32) MISC[F.tid] = 0u;
    __syncthreads();
    const int lo = args.ph_lo, hi = args.ph_hi;
    const bool multi = (hi - lo) > 1;
#if TLB_TOUCH
    {
        unsigned acc = 0u; const int sub = F.bid >> 3;
        const size_t nws = WS_END >> 21;
        for (size_t p = (size_t)sub * 16 + (F.tid >> 5); p < nws; p += 512) if ((F.tid & 31) == 0) acc += *(const volatile unsigned*)(ws + (p << 21));
        const void* big[8] = {args.in[0], args.in[3], args.in[9], args.in[19], args.in[23], args.in[28], args.in[29], args.in[30]};
        const size_t bsz[8] = {(size_t)T * D * 4, (size_t)D * 6 * D * 4, (size_t)D * INW * 4, (size_t)D * 2 * D * 4, (size_t)D * D * 4, (size_t)NE * D * FF * 4, (size_t)NE * D * FF * 4, (size_t)NE * D * FF * 4};
#pragma unroll
        for (int q = 0; q < 8; ++q) { const size_t np = bsz[q] >> 21;
            for (size_t p = (size_t)sub * 16 + (F.tid >> 5); p < np; p += 512) if ((F.tid & 31) == 0) acc += *(const volatile unsigned*)((const unsigned char*)big[q] + (p << 21)); }
        if (acc == 0x12345679u) F.ctl[100] = acc;
    }
#endif
    XcdBarrier bar; bar.bar = F.ctl + CW_BAR; bar.x = 0; bar.st = nullptr;
    if (multi) bar = xcd_barrier_post(F.ctl + CW_BAR, MISC + 8);
#ifndef PHASE_MASK
#define PHASE_MASK 0xFFFF
#endif
#define IN(k) ((((PHASE_MASK) >> (k)) & 1) && lo <= (k) && (k) < hi)
#ifndef REPEAT_MASK
#define REPEAT_MASK 0
#endif
#define REP(k) for (int _rep = 0; _rep < 1 + (((REPEAT_MASK) >> (k)) & 1); ++_rep)
#ifndef PROBE_TS
#define PROBE_TS -1
#endif
#ifndef PROBE_TSB
#define PROBE_TSB (PROBE_TS + 1)
#endif
#define STAMP(i) do { if (PROBE_TS >= -1 && F.bid == 0 && F.tid == 0) ((unsigned long long*)(F.ctl + 65536))[i] = __builtin_amdgcn_s_memrealtime(); } while (0)
#define SEAM(k) do { if (IN(k) && IN((k) + 1)) xcd_barrier(bar); if (PROBE_TS >= 0) STAMP((k) + 1); } while (0)

#ifndef P0_SKIP
#define P0_SKIP 0
#endif
    if (IN(0)) { p0_prologue<0>(F); if ((REPEAT_MASK) & 1) { __syncthreads(); p0_prologue<P0_SKIP>(F); } } SEAM(0);
    if (IN(1)) REP(1) { __syncthreads(); p1_rows_filters(F); } SEAM(1);
    if (IN(2)) { phase_gemm2(F); if (((REPEAT_MASK) >> 2) & 1) { __syncthreads(); phase_gemm2(F); } } SEAM(2);
    if (IN(3)) {
#if SIMPLE_GEMM
        for (int i = F.bid * NTHR + F.tid; i < T * 24 * 16; i += F.G * NTHR) { const int k = i & 15, hd = (i >> 4) % 24, tok = (i >> 4) / 24;
            bf16* p = F.QKV + (size_t)tok * QKVW + hd * HD; const float a = bf2f(p[k]), b2 = bf2f(p[k + 16]), cs = F.ROT[tok * 32 + k], sn = F.ROT[tok * 32 + 16 + k];
            p[k] = (bf16)f2bf(a * cs - b2 * sn); p[k + 16] = (bf16)f2bf(b2 * cs + a * sn); }
#endif
    }
#if SIMPLE_GEMM
    SEAM(3);
#endif
#if HYENA_NAIVE
    if (IN(4)) { p3_hyena_naive(F); __syncthreads(); p3_attn_naive(F); } SEAM(4);
#elif ATTN_NAIVE
    if (IN(4)) { p3_hyena_mfma(F); __syncthreads(); p3_attn_naive(F); } SEAM(4);
#else
#ifndef P4_PARTS
#define P4_PARTS 3
#endif
    if (IN(4)) REP(4) { __syncthreads(); if (P4_PARTS & 1) p3_hyena_mfma(F); __syncthreads(); if (P4_PARTS & 2) p4_attn_mfma(F);
#if ATTN_REP
        __syncthreads(); p4_attn_mfma(F);
#endif
    } SEAM(4);
    if (IN(5)) REP(5) { p4b_combine(F); } SEAM(5);
#endif
    if (IN(6)) { phase_gemm6(F); if (((REPEAT_MASK) >> 6) & 1) { __syncthreads(); phase_gemm6(F); } } SEAM(6);
    if (IN(7)) { phase_gemm7(F); if (((REPEAT_MASK) >> 7) & 1) { __syncthreads(); phase_gemm7(F); } } SEAM(7);
#ifndef EXTRA_BARRIERS
#define EXTRA_BARRIERS 0
#endif
    if (IN(8)) { if (((REPEAT_MASK) >> 8) & 1) { p6_rows_router<true>(F); __syncthreads(); } for (int _e = 0; _e < EXTRA_BARRIERS; ++_e) xcd_barrier(bar); p6_rows_router<false>(F); } SEAM(8);
#if MOE_SIMT
    if (IN(9)) { p7_moe1(F); } SEAM(9);
    if (IN(10)) { p8_moe2(F); } SEAM(10);
#else
#ifndef MOE_SHADOW
#define MOE_SHADOW 0
#endif
    if (IN(9)) { if (MOE_SHADOW) { moe_mfma<0, (MOE_SHADOW ? MOE_SHADOW : 8)>(F); __syncthreads(); } } if (IN(9)) REP(9) { moe_mfma<0>(F); } SEAM(9);
    if (IN(10)) REP(10) { moe_mfma<1>(F); } SEAM(10);
#endif
    if (IN(11)) REP(11) { __syncthreads(); p9_final(F); }
#if PROBE_TS >= 0
    if (F.bid == 0 && F.tid == 0) { asm volatile("s_waitcnt vmcnt(0)" ::: "memory");
        const unsigned long long* ts = (const unsigned long long*)(F.ctl + 65536);
        const float us = (PROBE_TS == 99) ? 100.0f : (float)(ts[PROBE_TSB] - ts[PROBE_TS]) * 0.01f;
        F.out[0] += sqrtf(198.0f * us); }
#endif
#undef IN
#undef SEAM
}

extern "C" void kernel_launch(void* const* d_in, const int* in_sizes, int n_in, void* d_out, int out_size, void* d_ws, size_t ws_size, hipStream_t stream) {
    static int grid = 0;
    if (grid == 0) {
        if (n_in != 31 || out_size != T * D || ws_size < WS_END) { fprintf(stderr, "kernel_launch: unexpected shapes (n_in %d out %d ws %zu)\n", n_in, out_size, ws_size); grid = -1; return; }
        int dev = 0, cus = 0, per_cu = 0;
        if (hipGetDevice(&dev) != hipSuccess || hipDeviceGetAttribute(&cus, hipDeviceAttributeMultiprocessorCount, dev) != hipSuccess) { grid = -1; return; }
        if (hipFuncSetAttribute((const void*)fwd_kernel, hipFuncAttributeMaxDynamicSharedMemorySize, LDS_BYTES) != hipSuccess) { fprintf(stderr, "kernel_launch: hipFuncSetAttribute failed\n"); grid = -1; return; }
        if (hipOccupancyMaxActiveBlocksPerMultiprocessor(&per_cu, (const void*)fwd_kernel, NTHR, LDS_BYTES) != hipSuccess || per_cu < 1) fprintf(stderr, "kernel_launch: occupancy query says %d\n", per_cu);
        (void)hipGetLastError();
        grid = cus;
    }
    if (grid < 0) return;
    if (hipMemsetAsync((char*)d_ws + WS_CTL, 0, CTL_ZERO_BYTES, stream) != hipSuccess) return;
    Args a{};
    for (int i = 0; i < 31; ++i) a.in[i] = d_in[i];
    a.out = (float*)d_out; a.ws = (unsigned char*)d_ws;
#if N_LAUNCH_MODE == 1
    a.ph_lo = 0; a.ph_hi = NPHASE;
    hipLaunchKernelGGL(fwd_kernel, dim3(grid), dim3(NTHR), LDS_BYTES, stream, a);
#else
    for (int p = 0; p < NPHASE; ++p) { if (p == 3 && !SIMPLE_GEMM) continue; if (p == 5 && (HYENA_NAIVE || ATTN_NAIVE)) continue; a.ph_lo = p; a.ph_hi = p + 1; hipLaunchKernelGGL(fwd_kernel, dim3(grid), dim3(NTHR), LDS_BYTES, stream, a); }
#endif
}
```
